# Optimizing an MI355X kernel written in HIP

```python
import math
import jax, jax.numpy as jnp
from jax import lax
import numpy as np

D_MODEL = 1024
BATCH = 4
SEQ = 4096
DEPTH = 2

GRID_W = 64
CTX_LEN = 256
HEAD_DIM = 64
ATTN_SCALE = HEAD_DIM ** -0.5
Q_BLOCK = 128
ROPE_BASE = 10000.0
ROPE_AXIS_DIM = HEAD_DIM // 2
ROPE_PAIRS_PER_AXIS = ROPE_AXIS_DIM // 2
EPS = 1e-6

POOL_WINDOWS = (2, 4, 8, 16)
POOL_GROUPS = len(POOL_WINDOWS)
POOL_WIDTH = D_MODEL // 2
POOL_GROUP_DIM = POOL_WIDTH // POOL_GROUPS

DIFF_HEADS = D_MODEL // 256
DIFF_WIDTH = DIFF_HEADS * 2 * HEAD_DIM

GQA_HEADS = D_MODEL // 128
GQA_KV_HEADS = GQA_HEADS // 4
GQA_GROUP = GQA_HEADS // GQA_KV_HEADS
GQA_WIDTH = GQA_HEADS * HEAD_DIM
GQA_KV_WIDTH = GQA_KV_HEADS * HEAD_DIM

N_BRANCH = 3
D_FF = 4 * D_MODEL

Q_SIDE_SPLITS = (POOL_WIDTH, POOL_WIDTH + DIFF_WIDTH, POOL_WIDTH + DIFF_WIDTH + GQA_WIDTH)
KV_OFF = POOL_WIDTH + DIFF_WIDTH + GQA_WIDTH + N_BRANCH * D_MODEL
KV_SPLITS = (DIFF_WIDTH, 2 * DIFF_WIDTH, 2 * DIFF_WIDTH + GQA_KV_WIDTH)
IN_WIDTH = KV_OFF + 2 * DIFF_WIDTH + 2 * GQA_KV_WIDTH

kernel_name = 'hybrid_pool_diffattn_gqa_prefix_dit_block'


def _rms_norm(x, g):
    xf = x.astype(jnp.float32)
    y = xf * lax.rsqrt(jnp.mean(xf * xf, axis=-1, keepdims=True) + EPS)
    return (y * g.astype(jnp.float32)).astype(x.dtype)


def _modulate(h, shift, scale):
    return h * (1 + scale) + shift


def _rope_tables(rows):
    row = jnp.repeat(jnp.arange(rows), GRID_W).astype(jnp.float32)
    col = jnp.tile(jnp.arange(GRID_W), rows).astype(jnp.float32)
    inv = 1.0 / (ROPE_BASE ** (jnp.arange(ROPE_PAIRS_PER_AXIS, dtype=jnp.float32) * 2.0 / ROPE_AXIS_DIM))
    ang = jnp.concatenate([row[:, None] * inv, col[:, None] * inv], axis=-1)
    return jnp.cos(ang), jnp.sin(ang)


def _rope(x, cos, sin):
    xf = x.astype(jnp.float32).reshape(x.shape[:-1] + (HEAD_DIM // 2, 2))
    x0, x1 = xf[..., 0], xf[..., 1]
    out = jnp.stack([x0 * cos - x1 * sin, x0 * sin + x1 * cos], axis=-1)
    return out.reshape(x.shape).astype(x.dtype)


def _heads(x, n):
    b, l, w = x.shape
    return x.reshape(b, l, n, w // n).transpose(0, 2, 1, 3)


def _merge_heads(o):
    b, h, l, d = o.shape
    return o.transpose(0, 2, 1, 3).reshape(b, l, h * d)


def _probs(s):
    return jax.nn.softmax(s.astype(jnp.float32) * ATTN_SCALE, axis=-1)


def _sweep_query_blocks(block_fn, queries):
    n = queries[0].shape[-2]
    nb = n // Q_BLOCK

    def split(q):
        q = q.reshape(q.shape[:-2] + (nb, Q_BLOCK, q.shape[-1]))
        return jnp.moveaxis(q, -3, 0)

    out = lax.map(lambda blk: block_fn(*blk), tuple(split(q) for q in queries))
    out = jnp.moveaxis(out, 0, -3)
    return out.reshape(out.shape[:-3] + (n, out.shape[-1]))


def _pool_mixer(z, w_grp, scale):
    b, l, _ = z.shape
    zg = z.reshape(b, l, POOL_GROUPS, POOL_GROUP_DIM)
    zf = zg.astype(jnp.float32)
    cs = jnp.concatenate([jnp.zeros((b, 1, POOL_GROUPS, POOL_GROUP_DIM), jnp.float32),
                          jnp.cumsum(zf, axis=1)], axis=1)
    t = jnp.arange(l)
    means = []
    for g, w in enumerate(POOL_WINDOWS):
        lo = jnp.clip(t - w // 2, 0, l)
        hi = jnp.clip(t + w // 2, 0, l)
        cnt = (hi - lo).astype(jnp.float32)[None, :, None]
        means.append((cs[:, hi, g] - cs[:, lo, g]) / cnt)
    pooled = (jnp.stack(means, axis=2) - zf).astype(z.dtype)
    mixed = jnp.einsum('blgc,gcd->blgd', pooled, w_grp)
    return mixed.reshape(b, l, POOL_WIDTH) * scale


def _diff_lambda(lq1, lk1, lq2, lk2, lam_init):
    def e(a, b):
        return jnp.exp(jnp.sum(a.astype(jnp.float32) * b.astype(jnp.float32)))
    return e(lq1, lk1) - e(lq2, lk2) + lam_init


def _diff_attention(q1, q2, k1, k2, v, lam, sub_gain, lam_init):
    def block(a, b):
        p = (_probs(jnp.einsum('bhqd,bhkd->bhqk', a, k1))
             - lam * _probs(jnp.einsum('bhqd,bhkd->bhqk', b, k2)))
        return jnp.einsum('bhqk,bhkd->bhqd', p.astype(v.dtype), v)

    o = _sweep_query_blocks(block, (q1, q2))
    o = _rms_norm(o, sub_gain) * (1.0 - lam_init)
    return _merge_heads(o)


def _gq_attention(q, k, v):
    b, h, l, d = q.shape
    qg = q.reshape(b, GQA_KV_HEADS, GQA_GROUP, l, d)

    def block(a):
        p = _probs(jnp.einsum('bhgqd,bhkd->bhgqk', a, k))
        return jnp.einsum('bhgqk,bhkd->bhgqd', p.astype(v.dtype), v)

    o = _sweep_query_blocks(block, (qg,))
    return _merge_heads(o.reshape(b, h, l, d))


def _kv_heads(kv_part, k_gain, cos, sin):
    dk, dv, gk, gv = jnp.split(kv_part, KV_SPLITS, axis=-1)
    dk = _heads(dk, DIFF_HEADS)
    k1, k2 = dk[..., :HEAD_DIM], dk[..., HEAD_DIM:]
    dv = _heads(dv, DIFF_HEADS)
    gk = _rms_norm(_heads(gk, GQA_KV_HEADS), k_gain)
    gv = _heads(gv, GQA_KV_HEADS)
    if cos is not None:
        k1, k2, gk = _rope(k1, cos, sin), _rope(k2, cos, sin), _rope(gk, cos, sin)
    return (k1, k2, dv, gk, gv)


def _mix(q_part, keys, lp, lam, lam_init, cos, sin):
    pool_in, dq, gq, gates = jnp.split(q_part, Q_SIDE_SPLITS, axis=-1)
    k1, k2, dv, gk, gv = keys
    dq = _heads(dq, DIFF_HEADS)
    q1, q2 = dq[..., :HEAD_DIM], dq[..., HEAD_DIM:]
    gq = _rms_norm(_heads(gq, GQA_HEADS), lp['gqa_q_norm'])
    if cos is not None:
        q1, q2, gq = _rope(q1, cos, sin), _rope(q2, cos, sin), _rope(gq, cos, sin)
    pool_out = _pool_mixer(pool_in, lp['w_pool_grp'], lp['pool_scale'])
    diff_out = _diff_attention(q1, q2, k1, k2, dv, lam, lp['diff_subln'], lam_init)
    gqa_out = _gq_attention(gq, gk, gv)
    b, l, _ = gates.shape
    g = jax.nn.sigmoid(gates.reshape(b, l, N_BRANCH, D_MODEL))
    merged = (g[:, :, 0] * (pool_out @ lp['w_pool_out'])
              + g[:, :, 1] * (diff_out @ lp['w_diff_out'])
              + g[:, :, 2] * (gqa_out @ lp['w_gqa_out']))
    return merged @ lp['w_o']


def _mlp(h, w1, w2):
    return jnp.square(jax.nn.relu(h @ w1)) @ w2


def _layer(x, ctx, c, c_ctx, lp, lam_init, cos, sin, update_ctx):
    sh_a, sc_a, gt_a, sh_f, sc_f, gt_f = jnp.split(
        (jax.nn.silu(c) @ lp['w_mod'] + lp['b_mod'])[:, None, :], 6, axis=-1)
    csh_a, csc_a, cgt_a, csh_f, csc_f, cgt_f = jnp.split(
        jax.nn.silu(c_ctx) @ lp['w_mod'] + lp['b_mod'], 6, axis=-1)
    lam = _diff_lambda(lp['lambda_q1'], lp['lambda_k1'], lp['lambda_q2'], lp['lambda_k2'], lam_init)

    h_lat = _modulate(_rms_norm(x, lp['g_pre_mix']), sh_a, sc_a)
    h_ctx = _modulate(_rms_norm(ctx, lp['g_pre_mix']), csh_a, csc_a)

    p_lat = h_lat @ lp['w_in']
    p_ctx = h_ctx @ lp['w_in'] if update_ctx else h_ctx @ lp['w_in'][:, KV_OFF:]
    ctx_kv = _kv_heads(p_ctx[..., -(IN_WIDTH - KV_OFF):], lp['gqa_k_norm'], None, None)
    lat_kv = _kv_heads(p_lat[..., KV_OFF:], lp['gqa_k_norm'], cos, sin)
    keys = tuple(jnp.concatenate([kc, kl], axis=2) for kc, kl in zip(ctx_kv, lat_kv))

    y_lat = _mix(p_lat[..., :KV_OFF], keys, lp, lam, lam_init, cos, sin)
    x = x + gt_a * _rms_norm(y_lat, lp['g_post_mix'])
    hf = _modulate(_rms_norm(x, lp['g_pre_ffn']), sh_f, sc_f)
    x = x + gt_f * _rms_norm(_mlp(hf, lp['w_ff1'], lp['w_ff2']), lp['g_post_ffn'])

    if update_ctx:
        y_ctx = _mix(p_ctx[..., :KV_OFF], ctx_kv, lp, lam, lam_init, None, None)
        ctx = ctx + cgt_a * _rms_norm(y_ctx, lp['g_post_mix'])
        hc = _modulate(_rms_norm(ctx, lp['g_pre_ffn']), csh_f, csc_f)
        ctx = ctx + cgt_f * _rms_norm(_mlp(hc, lp['w_ff1'], lp['w_ff2']), lp['g_post_ffn'])
    return x, ctx


def setup_inputs(seed: int = 0) -> dict:
    key = jax.random.key(seed)
    ks = jax.random.split(key, 32)

    def nrm(k, shape, scale):
        return jax.random.normal(k, shape, jnp.float32) * scale

    def gain(k, shape):
        return 1.0 + 0.02 * jax.random.normal(k, shape, jnp.float32)

    return {
        'x': nrm(ks[0], (BATCH, SEQ, D_MODEL), 1.0),
        'c': nrm(ks[1], (BATCH, D_MODEL), 1.0),
        'ctx': nrm(ks[2], (BATCH, CTX_LEN, D_MODEL), 1.0),
        'c_ctx': nrm(ks[3], (D_MODEL,), 1.0),
        'w_mod': nrm(ks[4], (DEPTH, D_MODEL, 6 * D_MODEL), D_MODEL ** -0.5),
        'b_mod': nrm(ks[5], (DEPTH, 6 * D_MODEL), 0.01),
        'g_pre_mix': gain(ks[6], (DEPTH, D_MODEL)),
        'g_post_mix': gain(ks[7], (DEPTH, D_MODEL)),
        'g_pre_ffn': gain(ks[8], (DEPTH, D_MODEL)),
        'g_post_ffn': gain(ks[9], (DEPTH, D_MODEL)),
        'w_in': nrm(ks[10], (DEPTH, D_MODEL, IN_WIDTH), D_MODEL ** -0.5),
        'w_pool_grp': nrm(ks[11], (DEPTH, POOL_GROUPS, POOL_GROUP_DIM, POOL_GROUP_DIM), POOL_GROUP_DIM ** -0.5),
        'pool_scale': gain(ks[12], (DEPTH, POOL_WIDTH)),
        'lambda_q1': nrm(ks[13], (DEPTH, HEAD_DIM), 0.1),
        'lambda_k1': nrm(ks[14], (DEPTH, HEAD_DIM), 0.1),
        'lambda_q2': nrm(ks[15], (DEPTH, HEAD_DIM), 0.1),
        'lambda_k2': nrm(ks[16], (DEPTH, HEAD_DIM), 0.1),
        'diff_subln': gain(ks[17], (DEPTH, 2 * HEAD_DIM)),
        'gqa_q_norm': gain(ks[18], (DEPTH, HEAD_DIM)),
        'gqa_k_norm': gain(ks[19], (DEPTH, HEAD_DIM)),
        'w_pool_out': nrm(ks[20], (DEPTH, POOL_WIDTH, D_MODEL), POOL_WIDTH ** -0.5),
        'w_diff_out': nrm(ks[21], (DEPTH, DIFF_WIDTH, D_MODEL), DIFF_WIDTH ** -0.5),
        'w_gqa_out': nrm(ks[22], (DEPTH, GQA_WIDTH, D_MODEL), GQA_WIDTH ** -0.5),
        'w_o': nrm(ks[23], (DEPTH, D_MODEL, D_MODEL), D_MODEL ** -0.5),
        'w_ff1': nrm(ks[24], (DEPTH, D_MODEL, D_FF), D_MODEL ** -0.5),
        'w_ff2': nrm(ks[25], (DEPTH, D_FF, D_MODEL), D_FF ** -0.5),
    }


def reference(x, c, ctx, c_ctx, w_mod, b_mod, g_pre_mix, g_post_mix, g_pre_ffn, g_post_ffn,
              w_in, w_pool_grp, pool_scale, lambda_q1, lambda_k1, lambda_q2, lambda_k2,
              diff_subln, gqa_q_norm, gqa_k_norm, w_pool_out, w_diff_out, w_gqa_out, w_o,
              w_ff1, w_ff2):
    rows = x.shape[1] // GRID_W
    cos, sin = _rope_tables(rows)
    for i in range(DEPTH):
        lp = {
            'w_mod': w_mod[i], 'b_mod': b_mod[i],
            'g_pre_mix': g_pre_mix[i], 'g_post_mix': g_post_mix[i],
            'g_pre_ffn': g_pre_ffn[i], 'g_post_ffn': g_post_ffn[i],
            'w_in': w_in[i], 'w_pool_grp': w_pool_grp[i], 'pool_scale': pool_scale[i],
            'lambda_q1': lambda_q1[i], 'lambda_k1': lambda_k1[i],
            'lambda_q2': lambda_q2[i], 'lambda_k2': lambda_k2[i],
            'diff_subln': diff_subln[i], 'gqa_q_norm': gqa_q_norm[i], 'gqa_k_norm': gqa_k_norm[i],
            'w_pool_out': w_pool_out[i], 'w_diff_out': w_diff_out[i], 'w_gqa_out': w_gqa_out[i],
            'w_o': w_o[i], 'w_ff1': w_ff1[i], 'w_ff2': w_ff2[i],
        }
        lam_init = 0.8 - 0.6 * math.exp(-0.3 * i)
        x, ctx = _layer(x, ctx, c, c_ctx, lp, lam_init, cos, sin, i < DEPTH - 1)
    return x
```

```cpp
#include <hip/hip_runtime.h>
#include <hip/hip_cooperative_groups.h>
#include <cstdio>
#include <cstdint>

namespace pg8 {
#define PG8_LAS __attribute__((address_space(3)))
typedef unsigned short bf16_t;
typedef short bf16x8 __attribute__((ext_vector_type(8)));
typedef float f32x4 __attribute__((ext_vector_type(4)));
typedef unsigned u32x4 __attribute__((ext_vector_type(4)));
constexpr int BM = 256, BK = 64, HALF = 128, HTB = HALF * BK * 2  , STAGE_BYTES = 8 * HTB, NXCD = 8, WGM = 8;

__host__ __device__ __forceinline__ int lds_byte(int r, int c) { const int st = (r >> 4) * 2 + (c >> 5), rr = r & 15, cc = c & 31, ob = rr * 64 + cc * 2; return st * 1024 + (ob ^ (((ob >> 9) & 1) << 5)); }
__host__ __device__ __forceinline__ void stage_rc(int b, int& R, int& C) { const int st = b / 1024, sb = b % 1024, swz = sb ^ (((sb >> 9) & 1) << 5); R = (st >> 1) * 16 + swz / 64; C = (st & 1) * 32 + (swz % 64) / 2; }
__host__ __device__ __forceinline__ int perm32(int rho) { const int n = rho >> 4, i = rho & 15; return 8 * (i >> 2) + 4 * n + (i & 3); }

struct Unit { int pm, pn; };
struct Gemm { const bf16_t* A; const bf16_t* Bt; int M, N, K; };

struct StaticOrder {
    int nM, nN, nwg, G, c;
    __host__ __device__ void init(int M, int N, int G_, int c_) { nM = M / BM; nN = N / BM; nwg = nM * nN; G = G_; c = c_; }
    __host__ __device__ bool next(int i, Unit& u) const {
        const long L = (long)i * G + c; if (L >= nwg) return false;
        int wgid = (int)L; { const int q = nwg / NXCD, r = nwg % NXCD, xcd = wgid % NXCD, off = wgid / NXCD; wgid = (xcd < r ? xcd * (q + 1) : r * (q + 1) + (xcd - r) * q) + off; }
        const int nig = WGM * nN, gid = wgid / nig, fm = gid * WGM, gsz = (nM - fm) < WGM ? (nM - fm) : WGM;
        u.pm = fm + ((wgid % nig) % gsz); u.pn = (wgid % nig) / gsz; return true;
    }
    __device__ __forceinline__ void a_ready(const Unit&) const {}
    __device__ __forceinline__ void done(const Unit&) const {}
};

__device__ __forceinline__ unsigned cvt_pk_bf16(float lo, float hi) { unsigned r; asm volatile("v_cvt_pk_bf16_f32 %0, %1, %2" : "=v"(r) : "v"(lo), "v"(hi)); return r; }
typedef float f32x2 __attribute__((ext_vector_type(2)));
template <class Epi, class Sched, bool ALIGN_EPI = false, bool SP2 = false>
__device__ __forceinline__ void gemm_phase(PG8_LAS unsigned char* lds, const Gemm g, const Sched& S, const Epi& E) {
    int tid_l = threadIdx.x; asm volatile("" : "+v"(tid_l)); const int tid = tid_l, wid = __builtin_amdgcn_readfirstlane(tid >> 6), lane = tid & 63, wr = wid >> 2, wc = wid & 3, fr = lane & 15, fq = lane >> 4;
    const int K = g.K, nt = K / BK;
    unsigned voffA[2], voffB[2];
#pragma unroll
    for (int i = 0; i < 2; ++i) { int R, C; stage_rc(tid * 16 + i * 8192, R, C); const int Rb = Epi::PERM ? ((R & ~31) + perm32(R & 31)) : R;
        voffA[i] = (unsigned)(R * K + C) * 2u; voffB[i] = (unsigned)(Rb * K + C) * 2u; }
    const size_t kstep = (size_t)(BK * 2);
    const size_t hstep = (size_t)HALF * K * 2;
    const size_t tstep = 2 * hstep;
    const unsigned ldsw = (unsigned)wid * 1024u;
    const int aoff = lds_byte(wr * 64 + fr, fq * 8), boff = lds_byte(wc * 32 + fr, fq * 8);
#define PG8_SA(b, h) (((b) * 2 + (h)) * HTB)
#define PG8_SB(b, h) ((4 + (b) * 2 + (h)) * HTB)
#define PG8_STAGE(bufoff, gbase, voff) do { _Pragma("unroll") for (int _i = 0; _i < 2; ++_i) \
        __builtin_amdgcn_global_load_lds((const unsigned*)((const char*)(gbase) + (voff)[_i]), (PG8_LAS unsigned*)(lds + (bufoff) + ldsw + _i * 8192), 16, 0, 0); } while (0)
#define PG8_LDA(dst, b, h) do { _Pragma("unroll") for (int m = 0; m < 4; ++m) _Pragma("unroll") for (int k = 0; k < 2; ++k) dst[m][k] = *(const PG8_LAS bf16x8*)(lds + PG8_SA(b, h) + aoff + m * 2048 + k * 1024); } while (0)
#define PG8_LDB(dst, b, h) do { _Pragma("unroll") for (int n = 0; n < 2; ++n) _Pragma("unroll") for (int k = 0; k < 2; ++k) dst[n][k] = *(const PG8_LAS bf16x8*)(lds + PG8_SB(b, h) + boff + n * 2048 + k * 1024); } while (0)
#define PG8_MMA(ai, bj, At, Bt) do { __builtin_amdgcn_s_setprio(1); _Pragma("unroll") for (int m = 0; m < 4; ++m) _Pragma("unroll") for (int n = 0; n < 2; ++n) _Pragma("unroll") for (int k = 0; k < 2; ++k) \
        acc[ai][bj][m][n] = __builtin_amdgcn_mfma_f32_16x16x32_bf16(Bt[n][k], At[m][k], acc[ai][bj][m][n], 0, 0, 0); __builtin_amdgcn_s_setprio(0); } while (0)
#define PG8_WAIT_V(n) asm volatile("s_waitcnt vmcnt(" #n ")" ::: "memory")
#define PG8_WAIT_L(n) asm volatile("s_waitcnt lgkmcnt(" #n ")" ::: "memory")
#define PG8_BAR __builtin_amdgcn_s_barrier()
#define PG8_SCHED __builtin_amdgcn_sched_barrier(0)
    Unit cur, nxt; int ui = 0;
    if (!S.next(0, cur)) return;
    f32x4 acc[2][2][4][2];
#pragma unroll
    for (int a = 0; a < 2; ++a)
#pragma unroll
        for (int b = 0; b < 2; ++b)
#pragma unroll
            for (int m = 0; m < 4; ++m)
#pragma unroll
                for (int n = 0; n < 2; ++n) acc[a][b][m][n] = (f32x4){0.f, 0.f, 0.f, 0.f};
    bf16x8 At[4][2], B0[2][2], B1[2][2];
    const char* cA = (const char*)g.A + (size_t)cur.pm * tstep; const char* cB = (const char*)g.Bt + (size_t)cur.pn * tstep;
    S.a_ready(cur);
    if constexpr (SP2) {
        PG8_STAGE(PG8_SB(0, 0), cB, voffB); PG8_STAGE(PG8_SB(0, 1), cB + hstep, voffB); PG8_STAGE(PG8_SA(0, 0), cA, voffA); PG8_STAGE(PG8_SA(0, 1), cA + hstep, voffA);
        if (wr == 1) PG8_BAR;
        PG8_WAIT_V(2); PG8_BAR;
        PG8_STAGE(PG8_SB(1, 0), cB + kstep, voffB); PG8_STAGE(PG8_SA(1, 0), cA + kstep, voffA); PG8_STAGE(PG8_SB(1, 1), cB + hstep + kstep, voffB);
        PG8_WAIT_V(6); PG8_BAR;
    } else {
        PG8_STAGE(PG8_SB(0, 0), cB, voffB); PG8_STAGE(PG8_SA(0, 0), cA, voffA); PG8_STAGE(PG8_SB(0, 1), cB + hstep, voffB); PG8_STAGE(PG8_SA(0, 1), cA + hstep, voffA);
        if (wr == 1) PG8_BAR;
        PG8_WAIT_V(4); PG8_BAR;
        PG8_STAGE(PG8_SB(1, 0), cB + kstep, voffB); PG8_STAGE(PG8_SA(1, 0), cA + kstep, voffA); PG8_STAGE(PG8_SB(1, 1), cB + hstep + kstep, voffB);
        PG8_WAIT_V(6); PG8_BAR;
    }
    for (;;) {
        const bool has_next = S.next(ui + 1, nxt);
        const char* nA = has_next ? (const char*)g.A + (size_t)nxt.pm * tstep : cA; const char* nB = has_next ? (const char*)g.Bt + (size_t)nxt.pn * tstep : cB;
        for (int t = 0; t < nt; t += 2) {
            const bool last = (t == nt - 2);
            const char* a1 = cA + (size_t)(t + 1) * kstep;
            const char* a2 = last ? nA : cA + (size_t)(t + 2) * kstep; const char* b2 = last ? nB : cB + (size_t)(t + 2) * kstep;
            const char* a3 = a2 + kstep; const char* b3 = b2 + kstep;
            if (last && has_next) S.a_ready(nxt);
            if constexpr (SP2) {
            PG8_LDB(B0, 0, 0); PG8_LDB(B1, 0, 1); PG8_SCHED; PG8_LDA(At, 0, 0); PG8_STAGE(PG8_SA(1, 1), a1 + hstep, voffA);
            PG8_WAIT_V(8); PG8_WAIT_L(0); PG8_BAR; PG8_MMA(0, 0, At, B0); PG8_MMA(0, 1, At, B1); PG8_BAR; PG8_SCHED;
            PG8_LDA(At, 0, 1); PG8_STAGE(PG8_SB(0, 0), b2, voffB); PG8_STAGE(PG8_SB(0, 1), b2 + hstep, voffB); PG8_STAGE(PG8_SA(0, 0), a2, voffA);
            PG8_WAIT_V(8); PG8_WAIT_L(0); PG8_BAR; PG8_MMA(1, 0, At, B0); PG8_MMA(1, 1, At, B1); PG8_BAR; PG8_SCHED;
            PG8_LDB(B0, 1, 0); PG8_LDB(B1, 1, 1); PG8_SCHED; PG8_LDA(At, 1, 0); PG8_STAGE(PG8_SA(0, 1), a2 + hstep, voffA);
            PG8_WAIT_V(8); PG8_WAIT_L(0); PG8_BAR; PG8_MMA(0, 0, At, B0); PG8_MMA(0, 1, At, B1); PG8_BAR; PG8_SCHED;
            PG8_LDA(At, 1, 1); PG8_STAGE(PG8_SB(1, 0), b3, voffB); PG8_STAGE(PG8_SB(1, 1), b3 + hstep, voffB); PG8_STAGE(PG8_SA(1, 0), a3, voffA);
            PG8_WAIT_V(8); PG8_WAIT_L(0); PG8_BAR; PG8_MMA(1, 0, At, B0); PG8_MMA(1, 1, At, B1); PG8_BAR; PG8_SCHED;
            } else {
            PG8_LDB(B0, 0, 0); PG8_SCHED; PG8_LDA(At, 0, 0); PG8_STAGE(PG8_SA(1, 1), a1 + hstep, voffA);
            PG8_WAIT_L(8); PG8_BAR; PG8_WAIT_L(0); PG8_MMA(0, 0, At, B0); PG8_BAR; PG8_SCHED;
            PG8_LDB(B1, 0, 1); PG8_STAGE(PG8_SB(0, 0), b2, voffB);
            PG8_BAR; PG8_WAIT_L(0); PG8_MMA(0, 1, At, B1); PG8_BAR;
            PG8_LDA(At, 0, 1); PG8_STAGE(PG8_SA(0, 0), a2, voffA);
            PG8_BAR; PG8_WAIT_L(0); PG8_MMA(1, 0, At, B0); PG8_BAR; PG8_SCHED;
            PG8_STAGE(PG8_SB(0, 1), b2 + hstep, voffB);
            PG8_WAIT_V(6); PG8_BAR; PG8_MMA(1, 1, At, B1); PG8_BAR;
            PG8_LDB(B0, 1, 0); PG8_SCHED; PG8_LDA(At, 1, 0); PG8_STAGE(PG8_SA(0, 1), a2 + hstep, voffA);
            PG8_WAIT_L(8); PG8_BAR; PG8_WAIT_L(0); PG8_MMA(0, 0, At, B0); PG8_BAR; PG8_SCHED;
            PG8_LDB(B1, 1, 1); PG8_STAGE(PG8_SB(1, 0), b3, voffB);
            PG8_BAR; PG8_WAIT_L(0); PG8_MMA(0, 1, At, B1); PG8_BAR;
            PG8_LDA(At, 1, 1); PG8_STAGE(PG8_SA(1, 0), a3, voffA);
            PG8_BAR; PG8_WAIT_L(0); PG8_MMA(1, 0, At, B0); PG8_BAR; PG8_SCHED;
            PG8_STAGE(PG8_SB(1, 1), b3 + hstep, voffB);
            PG8_WAIT_V(6); PG8_BAR; PG8_MMA(1, 1, At, B1); PG8_BAR;
            }
        }
        if constexpr (ALIGN_EPI) { if (wr == 0) PG8_BAR; }
        if constexpr (!Epi::AFTER_DRAIN) { E(acc, cur, wr, wc, fr, fq); S.done(cur); }
        if (!has_next) break;
#pragma unroll
        for (int a = 0; a < 2; ++a)
#pragma unroll
            for (int b = 0; b < 2; ++b)
#pragma unroll
                for (int m = 0; m < 4; ++m)
#pragma unroll
                    for (int n = 0; n < 2; ++n) acc[a][b][m][n] = (f32x4){0.f, 0.f, 0.f, 0.f};
        cur = nxt; cA = nA; cB = nB; ++ui;
        if constexpr (ALIGN_EPI) { if (wr == 1) PG8_BAR; }
    }
    PG8_WAIT_V(0);
    if constexpr (!ALIGN_EPI) { if (wr == 0) PG8_BAR; }
    PG8_BAR;
    if constexpr (Epi::AFTER_DRAIN) { E.fused(acc, cur, wr, wc, fr, fq, lds, wid, lane); S.done(cur); }
#undef PG8_SA
#undef PG8_SB
#undef PG8_STAGE
#undef PG8_LDA
#undef PG8_LDB
#undef PG8_MMA
#undef PG8_WAIT_V
#undef PG8_WAIT_L
#undef PG8_BAR
#undef PG8_SCHED
}
}
#include <hip/hip_bf16.h>
#include <cmath>
namespace attn_body {
using bf16=__hip_bfloat16;
using bf16x8=__attribute__((ext_vector_type(8)))short;
using s16x4=__attribute__((ext_vector_type(4)))short;
using f32x16=__attribute__((ext_vector_type(16)))float;
using u32x4=__attribute__((ext_vector_type(4)))unsigned;
constexpr int D=64;
constexpr int NW=8,QBLK=32,QB=QBLK*NW,KVBLK=64;
constexpr int ATTN_UNIT_ROWS=QB;
__device__ __forceinline__ int crow(int r,int hi){return (r&3)+8*(r>>2)+4*hi;}
#define SBAR() __builtin_amdgcn_sched_barrier(0)
__device__ __forceinline__ void cmask(f32x16&p0,f32x16&p1,int jb,int qrel,int hi){
  const float NEG=-INFINITY; int kb=64*jb+4*hi;
  #pragma unroll
  for(int r=0;r<16;++r){int kv=kb+(r&3)+8*(r>>2); if(kv>qrel)p0[r]=NEG; if(kv+32>qrel)p1[r]=NEG;}
}

constexpr int NSLOT=3, SLOTB=8192;
constexpr int LDS_K=0, LDS_V=NSLOT*SLOTB, LDS_WS=2*NSLOT*SLOTB, LDS_OST=LDS_WS+NW*64*4, LDS_BYTES=LDS_OST+NW*4096;
constexpr float C2=0.125f*1.4426950408889634f;
__device__ __forceinline__ void glds16(const void*gsrc,unsigned lds_dst){unsigned keep;
  asm volatile("s_mov_b32 %0, m0\n\ts_mov_b32 m0, %2\n\ts_nop 0\n\tglobal_load_lds_dwordx4 %1, off\n\ts_mov_b32 m0, %0":"=&s"(keep):"v"(gsrc),"s"(lds_dst):"memory");}
__device__ __forceinline__ float max3f(float a,float b,float c){float r;asm("v_max3_f32 %0, %1, %2, %3":"=v"(r):"v"(a),"v"(b),"v"(c));return r;}
__device__ __forceinline__ float max2f(float a,float b){float r;asm("v_max_f32_e32 %0, %1, %2":"=v"(r):"v"(a),"v"(b));return r;}
__device__ __forceinline__ float fadd_s(float a,float b){float r;asm("v_add_f32_e32 %0, %1, %2":"=v"(r):"v"(a),"v"(b));return r;}
__device__ __forceinline__ float fsub_s(float a,float b){float r;asm("v_sub_f32_e32 %0, %1, %2":"=v"(r):"v"(a),"v"(b));return r;}
typedef float f32x2_t __attribute__((ext_vector_type(2))); typedef __bf16 bf16x2_t __attribute__((ext_vector_type(2)));
__device__ __forceinline__ unsigned cvtpk_s(float lo,float hi){f32x2_t v={lo,hi};bf16x2_t b=__builtin_convertvector(v,bf16x2_t);return __builtin_bit_cast(unsigned,b);}
#define WAIT_BAR(N) asm volatile("s_waitcnt vmcnt(" #N ") lgkmcnt(0)\n\ts_barrier":::"memory")

__device__ __forceinline__ void qkt(f32x16&p0,f32x16&p1,const char*Kslot,const bf16x8*qr,const f32x16&negm,int r32,int hi){
  const char*kb=Kslot+hi*1024+r32*16;
  #pragma unroll
  for(int d0=0;d0<4;++d0){
    const bf16x8 b0=*reinterpret_cast<const bf16x8*>(kb+d0*2048);
    const bf16x8 b1=*reinterpret_cast<const bf16x8*>(kb+d0*2048+512);
    if(d0==0){p0=__builtin_amdgcn_mfma_f32_32x32x16_bf16(b0,qr[0],negm,0,0,0);p1=__builtin_amdgcn_mfma_f32_32x32x16_bf16(b1,qr[0],negm,0,0,0);}
    else{p0=__builtin_amdgcn_mfma_f32_32x32x16_bf16(b0,qr[d0],p0,0,0,0);p1=__builtin_amdgcn_mfma_f32_32x32x16_bf16(b1,qr[d0],p1,0,0,0);}}
}
typedef __attribute__((address_space(3))) const char* lds_cptr;
typedef short v4i16_t __attribute__((ext_vector_type(4)));
__device__ __forceinline__ void kload8(bf16x8*kf,lds_cptr kp){
  kf[0]=*(const __attribute__((address_space(3))) bf16x8*)(kp);      kf[1]=*(const __attribute__((address_space(3))) bf16x8*)(kp+512);
  kf[2]=*(const __attribute__((address_space(3))) bf16x8*)(kp+2048); kf[3]=*(const __attribute__((address_space(3))) bf16x8*)(kp+2560);
  kf[4]=*(const __attribute__((address_space(3))) bf16x8*)(kp+4096); kf[5]=*(const __attribute__((address_space(3))) bf16x8*)(kp+4608);
  kf[6]=*(const __attribute__((address_space(3))) bf16x8*)(kp+6144); kf[7]=*(const __attribute__((address_space(3))) bf16x8*)(kp+6656);
}
__device__ __forceinline__ void kload2(bf16x8*kf,lds_cptr kp,int j){ kf[2*j]=*(const __attribute__((address_space(3))) bf16x8*)(kp+j*2048); kf[2*j+1]=*(const __attribute__((address_space(3))) bf16x8*)(kp+j*2048+512); }
__device__ __forceinline__ s16x4 vtr(lds_cptr p){ return __builtin_bit_cast(s16x4,__builtin_amdgcn_ds_read_tr16_b64_v4i16((__attribute__((address_space(3))) v4i16_t*)p)); }
__device__ __forceinline__ float rowmax(const f32x16&p0,const f32x16&p1){
  float a=max3f(p0[0],p0[1],p1[0]),b=max3f(p0[2],p0[3],p1[1]);a=max3f(a,p1[2],p1[3]);
  #pragma unroll
  for(int r=4;r<16;r+=4){a=max3f(a,p0[r],p0[r+1]);b=max3f(b,p0[r+2],p0[r+3]);a=max3f(a,p1[r],p1[r+1]);b=max3f(b,p1[r+2],p1[r+3]);}
  const float m=max2f(a,b);
  auto rr=__builtin_amdgcn_permlane32_swap(__float_as_uint(m),__float_as_uint(m),false,false);
  return max2f(__uint_as_float(rr[0]),__uint_as_float(rr[1]));
}
__device__ __forceinline__ void pv(f32x16*o,int vb,bf16x8 pa0,bf16x8 pa1,bf16x8 pa2,bf16x8 pa3){
  #pragma unroll
  for(int d0=0;d0<2;++d0){s16x4 lo[4],hi[4];
    #pragma unroll
    for(int ks=0;ks<4;++ks){
      asm volatile("ds_read_b64_tr_b16 %0,%1 offset:%c2":"=&v"(lo[ks]):"v"(vb),"i"(d0*4096+ks*1024):"memory");
      asm volatile("ds_read_b64_tr_b16 %0,%1 offset:%c2":"=&v"(hi[ks]):"v"(vb),"i"(d0*4096+ks*1024+512):"memory");}
    asm volatile("s_waitcnt lgkmcnt(0)":::"memory");SBAR();
    #define PK(k) (bf16x8){lo[k][0],lo[k][1],lo[k][2],lo[k][3],hi[k][0],hi[k][1],hi[k][2],hi[k][3]}
    o[d0]=__builtin_amdgcn_mfma_f32_32x32x16_bf16(pa0,PK(0),o[d0],0,0,0);
    o[d0]=__builtin_amdgcn_mfma_f32_32x32x16_bf16(pa1,PK(1),o[d0],0,0,0);
    o[d0]=__builtin_amdgcn_mfma_f32_32x32x16_bf16(pa2,PK(2),o[d0],0,0,0);
    o[d0]=__builtin_amdgcn_mfma_f32_32x32x16_bf16(pa3,PK(3),o[d0],0,0,0);
    #undef PK
  }
}

#ifndef ATTN_STORE16
#define ATTN_STORE16(p,v) (*(u32x4*)(p)=(v))
#endif
template<int THRL> __device__ __forceinline__ void attn_unit(const bf16*Qw0,int pqs,const bf16*__restrict__ Kh,int pks,const bf16*__restrict__ Vh,int pvs,bf16*Ow0,int pos_,const int NT,char*shm){
  int tid_l=threadIdx.x; asm volatile("":"+v"(tid_l)); const int tid=tid_l,lane=tid&63,r32=lane&31,hi=lane>>5; const int wid=__builtin_amdgcn_readfirstlane(tid>>6);
  const bf16*Qw=Qw0+(long)(wid*QBLK)*pqs;
  const unsigned lds0=(unsigned)(uintptr_t)shm;
  float*wsf=(float*)(shm+LDS_WS)+wid*64;
  const bf16*ksrc=Kh+(long)lane*pks+wid*8;
  const bf16*vsrc=Vh+(long)(16*(wid&3)+(lane>>2))*pvs+(wid>>2)*32+(lane&3)*8;
  const unsigned kdst=lds0+LDS_K+wid*1024, vdst=lds0+LDS_V+wid*1024;
  #define DMA_K(t,slot) glds16(ksrc+(long)(t)*KVBLK*pks,(unsigned)__builtin_amdgcn_readfirstlane(kdst+(slot)))
  #define DMA_V(t,slot) glds16(vsrc+(long)(t)*KVBLK*pvs,(unsigned)__builtin_amdgcn_readfirstlane(vdst+(slot)))
  const int vb0=(int)(lds0+LDS_V)+((lane>>4)&1)*32+(lane&3)*8+(4*hi+((lane&15)>>2))*64;
  const char*Kbase=shm+LDS_K; bf16x8 kf[8];
  const lds_cptr shm3=(lds_cptr)shm; const lds_cptr kp0=shm3+LDS_K+hi*1024+r32*16; const lds_cptr vp0=shm3+LDS_V+((lane>>4)&1)*32+(lane&3)*8+(4*hi+((lane&15)>>2))*64;
  DMA_K(0,0);DMA_V(0,0);DMA_K(1,SLOTB);
  bf16x8 qr[4];
  #pragma unroll
  for(int d0=0;d0<4;++d0)qr[d0]=*reinterpret_cast<const bf16x8*>(&Qw[(long)r32*pqs+d0*16+hi*8]);
  float mhat=0.f,l_reg=0.f;f32x16 o[2];o[0]=f32x16{};o[1]=f32x16{};f32x16 negm=f32x16{};asm volatile("":"+v"(negm));
  #define CMASK(P0,P1,t) do{}while(0)
  bool resc=false;
  #define START(P0,P1) do{ const float rm=rowmax(P0,P1); resc=false; \
    { const float dl=rm; mhat=fadd_s(mhat,dl); \
      _Pragma("unroll") for(int r=0;r<16;++r){P0[r]=fsub_s(P0[r],dl);P1[r]=fsub_s(P1[r],dl);} \
      _Pragma("unroll") for(int r=0;r<16;++r)negm[r]=-mhat; asm volatile("":"+v"(negm)); } \
    _Pragma("unroll") for(int r=0;r<16;++r)P0[r]=__builtin_amdgcn_exp2f(P0[r]); }while(0)
  #define RESC() do{ if(resc){ asm volatile("s_waitcnt lgkmcnt(0)":::"memory"); \
      _Pragma("unroll") for(int d_=0;d_<2;++d_) _Pragma("unroll") for(int r=0;r<16;++r)o[d_][r]*=wsf[crow(r,hi)]; } }while(0)
  f32x16 pA0,pA1,pB0,pB1;
  int sl_prev=0,sl_cur=0,sl_next=SLOTB;
  #define ROT() do{sl_prev=sl_cur;sl_cur=sl_next;sl_next=(sl_next==(NSLOT-1)*SLOTB)?0:sl_next+SLOTB;}while(0)
  DMA_K(2,2*SLOTB);
  WAIT_BAR(3);
  qkt(pA0,pA1,Kbase,qr,negm,r32,hi);asm volatile("s_nop 15\n\ts_nop 7":"+v"(pA0),"+v"(pA1));CMASK(pA0,pA1,0);
  START(pA0,pA1);
  _Pragma("unroll") for(int r=0;r<16;++r)pA1[r]=__builtin_amdgcn_exp2f(pA1[r]);
  WAIT_BAR(0);
  DMA_K(3,0);DMA_V(1,SLOTB);
  ROT();
  kload8(kf,kp0+sl_cur);
  WAIT_BAR(2);
  s16x4 vlo[8],vhi[8]; u32x4 pw0,pw1,pw2,pw3;
  #define PKW(P,B) cvtpk_s(P[B],P[B+1])
  #define PAF(k) __builtin_bit_cast(bf16x8,pw##k)
  #define VFR(i) (bf16x8){vlo[i][0],vlo[i][1],vlo[i][2],vlo[i][3],vhi[i][0],vhi[i][1],vhi[i][2],vhi[i][3]}
  #define PIN(x) asm volatile("":"+v"(x))
  #define MX3(a,b,c) __builtin_fmaxf(__builtin_fmaxf((a),(b)),(c))
  #define GAPA(MF,A0,A1,A2,A3,W0,W1,PW) do{ MF; sacc+=A0; sacc+=A1; sacc+=A2; sacc+=A3; PIN(sacc); W0; W1; PIN(PW); SBAR(); }while(0)
  #define EX(v) __builtin_amdgcn_exp2f(v)
  #define GAPB(MF,X,B) do{ MF; X[B]=EX(X[B]); X[B+1]=EX(X[B+1]); X[B+2]=EX(X[B+2]); X[B+3]=EX(X[B+3]); PIN(X); SBAR(); }while(0)
  #define VRD(i) do{ vlo[i]=vtr(vp_+(((i)>>2)*4096+((i)&3)*1024)); vhi[i]=vtr(vp_+(((i)>>2)*4096+((i)&3)*1024+512)); }while(0)
  #define KRD(G,j) do{ if(G){ kload2(kf,kp0+sl_next,j); SBAR(); } }while(0)
  #define STEP(C0,C1,P0,P1,t,GK,GV,GL) do{ SBAR(); \
    const lds_cptr vp_=vp0+sl_prev; \
    VRD(0); SBAR(); float sacc=(P0[0]+P0[1]); \
    GAPA(C0=__builtin_amdgcn_mfma_f32_32x32x16_bf16(kf[0],qr[0],negm,0,0,0), P0[2],P0[3],P0[4],P0[5],     pw0[0]=PKW(P0,0), pw0[1]=PKW(P0,2), pw0); \
    VRD(4); SBAR(); GAPA(C1=__builtin_amdgcn_mfma_f32_32x32x16_bf16(kf[1],qr[0],negm,0,0,0), P0[6],P0[7],P0[8],P0[9],     pw0[2]=PKW(P0,4), pw0[3]=PKW(P0,6), pw0); \
    VRD(1); SBAR(); GAPA(C0=__builtin_amdgcn_mfma_f32_32x32x16_bf16(kf[2],qr[1],C0,0,0,0),   P0[10],P0[11],P0[12],P0[13], pw1[0]=PKW(P0,8), pw1[1]=PKW(P0,10), pw1); \
    VRD(5); SBAR(); GAPA(C1=__builtin_amdgcn_mfma_f32_32x32x16_bf16(kf[3],qr[1],C1,0,0,0),   P0[14],P0[15],P1[0],P1[1],   pw1[2]=PKW(P0,12),pw1[3]=PKW(P0,14), pw1); \
    VRD(2); SBAR(); GAPA(C0=__builtin_amdgcn_mfma_f32_32x32x16_bf16(kf[4],qr[2],C0,0,0,0),   P1[2],P1[3],P1[4],P1[5],     pw2[0]=PKW(P1,0), pw2[1]=PKW(P1,2), pw2); \
    VRD(6); SBAR(); GAPA(C1=__builtin_amdgcn_mfma_f32_32x32x16_bf16(kf[5],qr[2],C1,0,0,0),   P1[6],P1[7],P1[8],P1[9],     pw2[2]=PKW(P1,4), pw2[3]=PKW(P1,6), pw2); \
    VRD(3); SBAR(); GAPA(C0=__builtin_amdgcn_mfma_f32_32x32x16_bf16(kf[6],qr[3],C0,0,0,0),   P1[10],P1[11],P1[12],P1[13], pw3[0]=PKW(P1,8), pw3[1]=PKW(P1,10), pw3); \
    VRD(7); SBAR(); GAPA(C1=__builtin_amdgcn_mfma_f32_32x32x16_bf16(kf[7],qr[3],C1,0,0,0),   P1[14],P1[15],0.f,0.f,       pw3[2]=PKW(P1,12),pw3[3]=PKW(P1,14), pw3); \
    l_reg+=sacc; \
    if(GK){DMA_K((t)+3,sl_cur);} if(GV){DMA_V((t)+1,sl_next);} \
    CMASK(C0,C1,t); \
    { float a=MX3(C0[0],C0[1],C1[0]),b=MX3(C0[2],C0[3],C1[1]); a=MX3(a,C1[2],C1[3]); \
      _Pragma("unroll") for(int r=4;r<16;r+=4){a=MX3(a,C0[r],C0[r+1]);b=MX3(b,C0[r+2],C0[r+3]);a=MX3(a,C1[r],C1[r+1]);b=MX3(b,C1[r+2],C1[r+3]);} \
      float rm=__builtin_fmaxf(a,b); { auto rr=__builtin_amdgcn_permlane32_swap(__float_as_uint(rm),__float_as_uint(rm),false,false); rm=__builtin_fmaxf(__uint_as_float(rr[0]),__uint_as_float(rr[1])); } \
      resc=false; \
      if(__builtin_expect(__any(rm>(float)THRL),0)){ const float dl=__builtin_fmaxf(rm,0.f); mhat+=dl; \
        _Pragma("unroll") for(int r=0;r<16;++r){C0[r]-=dl;C1[r]-=dl;} \
        _Pragma("unroll") for(int r=0;r<16;++r)negm[r]=-mhat; asm volatile("":"+v"(negm)); \
        const float f=__builtin_amdgcn_exp2f(-dl); l_reg*=f; if(hi==0)wsf[r32]=f; resc=true; } } \
    SBAR(); \
    GAPB(o[0]=__builtin_amdgcn_mfma_f32_32x32x16_bf16(PAF(0),VFR(0),o[0],0,0,0), C0,0); \
    GAPB(o[1]=__builtin_amdgcn_mfma_f32_32x32x16_bf16(PAF(0),VFR(4),o[1],0,0,0), C0,4); \
    KRD(GL,0); GAPB(o[0]=__builtin_amdgcn_mfma_f32_32x32x16_bf16(PAF(1),VFR(1),o[0],0,0,0), C0,8); \
    KRD(GL,1); GAPB(o[1]=__builtin_amdgcn_mfma_f32_32x32x16_bf16(PAF(1),VFR(5),o[1],0,0,0), C0,12); \
    KRD(GL,2); GAPB(o[0]=__builtin_amdgcn_mfma_f32_32x32x16_bf16(PAF(2),VFR(2),o[0],0,0,0), C1,0); \
    KRD(GL,3); GAPB(o[1]=__builtin_amdgcn_mfma_f32_32x32x16_bf16(PAF(2),VFR(6),o[1],0,0,0), C1,4); \
    GAPB(o[0]=__builtin_amdgcn_mfma_f32_32x32x16_bf16(PAF(3),VFR(3),o[0],0,0,0), C1,8); \
    GAPB(o[1]=__builtin_amdgcn_mfma_f32_32x32x16_bf16(PAF(3),VFR(7),o[1],0,0,0), C1,12); \
    }while(0)
  int t=1;
  #undef CMASK
  #define CMASK(P0,P1,t) do{}while(0)
  for(;t+5<NT;t+=2){
    STEP(pB0,pB1,pA0,pA1,t,true,true,true);     WAIT_BAR(2); RESC(); ROT();
    STEP(pA0,pA1,pB0,pB1,t+1,true,true,true);   WAIT_BAR(2); RESC(); ROT();
  }
  #undef CMASK
  #define CMASK(P0,P1,t) do{}while(0)
  #define ENDW(tt) do{ if((tt)+3<NT){WAIT_BAR(2);} else if((tt)+2<NT){WAIT_BAR(1);} else {WAIT_BAR(0);} }while(0)
  for(;t+1<NT;t+=2){
    STEP(pB0,pB1,pA0,pA1,t,(t+3<NT),(t+1<NT),(t+1<NT));       ENDW(t);   RESC(); ROT();
    STEP(pA0,pA1,pB0,pB1,t+1,(t+4<NT),(t+2<NT),(t+2<NT));     ENDW(t+1); RESC(); ROT();
  }
  STEP(pB0,pB1,pA0,pA1,NT-1,false,false,false); RESC();
  { float sacc=pB0[0]+pB0[1]; _Pragma("unroll") for(int r=2;r<16;++r)sacc+=pB0[r]; _Pragma("unroll") for(int r=0;r<16;++r)sacc+=pB1[r]; l_reg+=sacc;
    pw0=(u32x4){PKW(pB0,0),PKW(pB0,2),PKW(pB0,4),PKW(pB0,6)};pw1=(u32x4){PKW(pB0,8),PKW(pB0,10),PKW(pB0,12),PKW(pB0,14)};pw2=(u32x4){PKW(pB1,0),PKW(pB1,2),PKW(pB1,4),PKW(pB1,6)};pw3=(u32x4){PKW(pB1,8),PKW(pB1,10),PKW(pB1,12),PKW(pB1,14)};
    SBAR(); pv(o,vb0+sl_cur,PAF(0),PAF(1),PAF(2),PAF(3)); }
  #undef PKW
  #undef PAF
  #undef VFR
  #undef PIN
  #undef MX3
  #undef GAPA
  #undef GAPB
  #undef EX
  #undef VRD
  #undef KRD
  #undef STEP
  #undef ENDW
  {auto rr=__builtin_amdgcn_permlane32_swap(__float_as_uint(l_reg),__float_as_uint(l_reg),false,false);l_reg=__uint_as_float(rr[0])+__uint_as_float(rr[1]);}
  if(hi==0)wsf[32+r32]=l_reg;asm volatile("s_waitcnt lgkmcnt(0)":::"memory");
  float rli[16];
  #pragma unroll
  for(int r=0;r<16;++r)rli[r]=__builtin_amdgcn_rcpf(wsf[32+crow(r,hi)]);
  bf16*Ow=Ow0+(long)(wid*QBLK)*pos_;
  { bf16*stg=(bf16*)(shm+LDS_OST)+wid*2048;
    #pragma unroll
    for(int r=0;r<16;++r){const int orow=crow(r,hi);
      #pragma unroll
      for(int d0=0;d0<2;++d0)stg[orow*64+d0*32+r32]=__float2bfloat16(o[d0][r]*rli[r]);}
    asm volatile("s_waitcnt lgkmcnt(0)":::"memory");
    #pragma unroll
    for(int i=0;i<4;++i){const int row=i*8+(lane>>3),ch=lane&7; const u32x4 v=*(const u32x4*)(stg+row*64+ch*8); ATTN_STORE16(Ow+(long)row*pos_+ch*8,v);} }
  asm volatile("s_waitcnt lgkmcnt(0)\n\ts_barrier":::"memory");
  #undef DMA_K
  #undef DMA_V
  #undef CMASK
  #undef START
  #undef RESC
  #undef ROT
}
constexpr int ATTN_LDS_BYTES=LDS_BYTES;
#undef SBAR
#undef WAIT_BAR
}
namespace cg = cooperative_groups;
#define LAS __attribute__((address_space(3)))
typedef unsigned short bf16;
typedef unsigned v4u __attribute__((ext_vector_type(4)));
typedef unsigned v2u __attribute__((ext_vector_type(2)));
typedef float f32x4 __attribute__((ext_vector_type(4)));
using pg8::bf16_t;

constexpr int DMODEL = 1024, NBATCH = 4, SEQL = 4096, CTXL = 256, LKV = SEQL + CTXL, ML = NBATCH * SEQL, MC = NBATCH * CTXL, MA = ML + MC, DFF = 4096, N1 = 2816, NMOD = 6 * DMODEL;
constexpr float EPSN = 1e-6f;
constexpr float QC2 = 0.125f * 1.4426950408889634f;
constexpr int NTHR = 512;
constexpr int LDS_BYTES = 147456;

constexpr size_t MiB = 1u << 20;
constexpr size_t WS_MOD = 0, WS_ROPE = 256 * 1024;
constexpr size_t W_IN = 2 * MiB, W_POOL = W_IN + (size_t)5888 * 1024 * 2, W_PO = W_POOL + 512 * 512 * 2, W_DO = W_PO + 1024 * 512 * 2, W_GO = W_DO + 1024 * 512 * 2,
                 W_O = W_GO + 1024 * 512 * 2, W_1 = W_O + 1024 * 1024 * 2, W_2 = W_1 + (size_t)4096 * 1024 * 2, W_END = W_2 + (size_t)4096 * 1024 * 2;
static_assert(W_END <= 36 * MiB, "weights");
constexpr size_t WS_CTX = 36 * MiB, WS_H = 40 * MiB;
constexpr size_t WS_POOLIN = 74 * MiB, WS_QD = 91 * MiB, WS_QG = 108 * MiB, WS_KD = 125 * MiB, WS_VD = 142 * MiB, WS_KG = 159 * MiB, WS_VG = WS_KG + (size_t)MA * 128 * 2;
constexpr size_t WS_OD = 176 * MiB, WS_GQAO = 210 * MiB, WS_POOLED = 227 * MiB;
constexpr size_t WS_DIFFO = 74 * MiB, WS_POOLO = 91 * MiB, WS_MERGED = 108 * MiB, WS_ACC = 142 * MiB, WS_Y = 142 * MiB, WS_HF = 210 * MiB, WS_U = 40 * MiB, WS_Z = 176 * MiB;
constexpr size_t WS_TOTAL = 244 * MiB;
static_assert(WS_VG + (size_t)MA * 128 * 2 <= 176 * MiB, "p1 outs");

struct Args { const float* in[26]; float* out; unsigned char* ws; };

__device__ __forceinline__ unsigned f2bf(float f) { unsigned u = __builtin_bit_cast(unsigned, f); return (u + 0x7fffu + ((u >> 16) & 1u)) >> 16; }
__device__ __forceinline__ unsigned pk2(float lo, float hi) { return f2bf(lo) | (f2bf(hi) << 16); }
__device__ __forceinline__ float bflo(unsigned w) { return __builtin_bit_cast(float, w << 16); }
__device__ __forceinline__ float bfhi(unsigned w) { return __builtin_bit_cast(float, w & 0xffff0000u); }
__device__ __forceinline__ float wave_sum(float v) {
#pragma unroll
    for (int o = 1; o < 64; o <<= 1) v += __shfl_xor(v, o);
    return v;
}

template <int ACT  > struct EpiAct {
    static constexpr bool PERM = true, AFTER_DRAIN = false;
    bf16_t* O; int ldc;
    __device__ __forceinline__ void operator()(const pg8::f32x4 (&acc)[2][2][4][2], const pg8::Unit& u, int wr, int wc, int fr, int fq) const {
        const int row0 = u.pm * 256 + wr * 64 + fr, col0 = u.pn * 256 + wc * 32 + 8 * fq;
#pragma unroll
        for (int ai = 0; ai < 2; ++ai)
#pragma unroll
            for (int m = 0; m < 4; ++m) { bf16_t* rowp = O + (size_t)(row0 + ai * 128 + m * 16) * ldc + col0;
#pragma unroll
                for (int bj = 0; bj < 2; ++bj) { float v[8];
#pragma unroll
                    for (int i = 0; i < 4; ++i) { v[i] = acc[ai][bj][m][0][i]; v[4 + i] = acc[ai][bj][m][1][i]; }
#pragma unroll
                    for (int i = 0; i < 8; ++i) {
                        if (ACT == 1) v[i] = 1.f / (1.f + __expf(-v[i]));
                        if (ACT == 2) { const float r = fmaxf(v[i], 0.f); v[i] = r * r; } }
                    pg8::u32x4 w; w.x = pk2(v[0], v[1]); w.y = pk2(v[2], v[3]); w.z = pk2(v[4], v[5]); w.w = pk2(v[6], v[7]);
                    *(pg8::u32x4*)(rowp + bj * 128) = w; } }
    }
};
struct EpiF32 {
    static constexpr bool PERM = true, AFTER_DRAIN = false;
    float* O; int ldc;
    __device__ __forceinline__ void operator()(const pg8::f32x4 (&acc)[2][2][4][2], const pg8::Unit& u, int wr, int wc, int fr, int fq) const {
        const int row0 = u.pm * 256 + wr * 64 + fr, col0 = u.pn * 256 + wc * 32 + 8 * fq;
#pragma unroll
        for (int ai = 0; ai < 2; ++ai)
#pragma unroll
            for (int m = 0; m < 4; ++m) { float* rowp = O + (size_t)(row0 + ai * 128 + m * 16) * ldc + col0;
#pragma unroll
                for (int bj = 0; bj < 2; ++bj) { *(pg8::f32x4*)(rowp + bj * 128) = acc[ai][bj][m][0]; *(pg8::f32x4*)(rowp + bj * 128 + 4) = acc[ai][bj][m][1]; } }
    }
};
struct EpiBranch {
    static constexpr bool PERM = true, AFTER_DRAIN = false;
    bf16_t* GO; float* ACC; int mode;
    __device__ __forceinline__ void operator()(const pg8::f32x4 (&acc)[2][2][4][2], const pg8::Unit& u, int wr, int wc, int fr, int fq) const {
        const int row0 = u.pm * 256 + wr * 64 + fr, col0 = u.pn * 256 + wc * 32 + 8 * fq;
#pragma unroll
        for (int ai = 0; ai < 2; ++ai)
#pragma unroll
            for (int m = 0; m < 4; ++m) { const size_t ro = (size_t)(row0 + ai * 128 + m * 16) * 1024 + col0;
#pragma unroll
                for (int bj = 0; bj < 2; ++bj) { const size_t idx = ro + bj * 128;
                    const pg8::u32x4 g = *(const pg8::u32x4*)(GO + idx);
                    pg8::f32x4 v0 = acc[ai][bj][m][0], v1 = acc[ai][bj][m][1];
                    v0[0] *= bflo(g.x); v0[1] *= bfhi(g.x); v0[2] *= bflo(g.y); v0[3] *= bfhi(g.y);
                    v1[0] *= bflo(g.z); v1[1] *= bfhi(g.z); v1[2] *= bflo(g.w); v1[3] *= bfhi(g.w);
                    if (mode > 0) { v0 += *(const pg8::f32x4*)(ACC + idx); v1 += *(const pg8::f32x4*)(ACC + idx + 4); }
                    if (mode < 2) { *(pg8::f32x4*)(ACC + idx) = v0; *(pg8::f32x4*)(ACC + idx + 4) = v1; }
                    else { pg8::u32x4 w; w.x = pk2(v0[0], v0[1]); w.y = pk2(v0[2], v0[3]); w.z = pk2(v1[0], v1[1]); w.w = pk2(v1[2], v1[3]); *(pg8::u32x4*)(GO + idx) = w; } } }
    }
};
__device__ __forceinline__ int kvrow_of(int row) { return row < ML ? (row >> 12) * LKV + CTXL + (row & 4095) : ((row - ML) >> 8) * LKV + ((row - ML) & 255); }
__device__ __forceinline__ void rope8(float (&v)[8], const float* tab, int d, int t) {
    const int p0 = d >> 1, pos = p0 < 16 ? (t >> 6) : (t & 63), j0 = p0 & 15;
    const f32x4* tp = (const f32x4*)(tab + (pos * 16 + j0) * 2);
    const f32x4 t0 = tp[0], t1 = tp[1];
    float o[8];
    o[0] = v[0] * t0[0] - v[1] * t0[1]; o[1] = v[0] * t0[1] + v[1] * t0[0];
    o[2] = v[2] * t0[2] - v[3] * t0[3]; o[3] = v[2] * t0[3] + v[3] * t0[2];
    o[4] = v[4] * t1[0] - v[5] * t1[1]; o[5] = v[4] * t1[1] + v[5] * t1[0];
    o[6] = v[6] * t1[2] - v[7] * t1[3]; o[7] = v[6] * t1[3] + v[7] * t1[2];
#pragma unroll
    for (int i = 0; i < 8; ++i) v[i] = o[i];
}
struct EpiIn {
    static constexpr bool PERM = true, AFTER_DRAIN = false;
    unsigned char* ws;
    __device__ __forceinline__ void operator()(const pg8::f32x4 (&acc)[2][2][4][2], const pg8::Unit& u, int wr, int wc, int fr, int fq) const {
        const bool latent = u.pm < (ML / 256);
        const int cw = wc * 32 + 8 * fq;
        bf16_t* const poolin = (bf16_t*)(ws + WS_POOLIN); bf16_t* const qd = (bf16_t*)(ws + WS_QD); bf16_t* const qg = (bf16_t*)(ws + WS_QG); bf16_t* const kd = (bf16_t*)(ws + WS_KD);
        bf16_t* const vd = (bf16_t*)(ws + WS_VD); bf16_t* const kg = (bf16_t*)(ws + WS_KG); bf16_t* const vg = (bf16_t*)(ws + WS_VG); const float* const rope = (const float*)(ws + WS_ROPE);
#pragma unroll
        for (int bj = 0; bj < 2; ++bj) {
            const int cb = u.pn * 2 + bj;
            bf16_t* base; int pitch, coff; bool kvmap = false, dorope = false; float sc = 1.f;
            if (cb < 4) { base = poolin; pitch = 512; coff = cb * 128; }
            else if (cb < 8) { base = qd; pitch = 512; coff = (cb - 4) * 128; dorope = latent; sc = QC2; }
            else if (cb < 12) { base = qg; pitch = 512; coff = (cb - 8) * 128; }
            else if (cb < 16) { base = kd; pitch = 512; coff = (cb - 12) * 128; kvmap = true; dorope = latent; }
            else if (cb < 20) { base = vd; pitch = 512; coff = (cb - 16) * 128; kvmap = true; }
            else if (cb == 20) { base = kg; pitch = 128; coff = 0; kvmap = true; }
            else { base = vg; pitch = 128; coff = 0; kvmap = true; }
#pragma unroll
            for (int ai = 0; ai < 2; ++ai)
#pragma unroll
                for (int m = 0; m < 4; ++m) {
                    const int row = u.pm * 256 + ai * 128 + wr * 64 + m * 16 + fr;
                    const int drow = kvmap ? kvrow_of(row) : row;
                    float v[8];
#pragma unroll
                    for (int i = 0; i < 4; ++i) { v[i] = acc[ai][bj][m][0][i]; v[4 + i] = acc[ai][bj][m][1][i]; }
                    if (dorope) rope8(v, rope, cw & 63, row & 4095);
#pragma unroll
                    for (int i = 0; i < 8; ++i) v[i] *= sc;
                    pg8::u32x4 w; w.x = pk2(v[0], v[1]); w.y = pk2(v[2], v[3]); w.z = pk2(v[4], v[5]); w.w = pk2(v[6], v[7]);
                    *(pg8::u32x4*)(base + (size_t)drow * pitch + coff + cw) = w;
                }
        }
    }
};
__device__ __forceinline__ void head_norm_fix(bf16_t* p, const float* gain, bool dorope, int t, float sc, const float* tab) {
    float ss = 0.f;
#pragma unroll
    for (int ch = 0; ch < 8; ++ch) { const v4u w = *(const v4u*)(p + ch * 8);
        const float a0 = bflo(w.x), a1 = bfhi(w.x), a2 = bflo(w.y), a3 = bfhi(w.y), a4 = bflo(w.z), a5 = bfhi(w.z), a6 = bflo(w.w), a7 = bfhi(w.w);
        ss += (a0 * a0 + a1 * a1) + (a2 * a2 + a3 * a3) + (a4 * a4 + a5 * a5) + (a6 * a6 + a7 * a7); }
    const float rstd = 1.0f / sqrtf(ss * (1.f / 64.f) + EPSN);
#pragma unroll
    for (int ch = 0; ch < 8; ++ch) { const v4u w = *(const v4u*)(p + ch * 8);
        float v[8] = {bflo(w.x), bfhi(w.x), bflo(w.y), bfhi(w.y), bflo(w.z), bfhi(w.z), bflo(w.w), bfhi(w.w)};
        const f32x4 g0 = *(const f32x4*)(gain + ch * 8), g1 = *(const f32x4*)(gain + ch * 8 + 4);
        v[0] *= rstd * g0[0]; v[1] *= rstd * g0[1]; v[2] *= rstd * g0[2]; v[3] *= rstd * g0[3];
        v[4] *= rstd * g1[0]; v[5] *= rstd * g1[1]; v[6] *= rstd * g1[2]; v[7] *= rstd * g1[3];
        if (dorope) rope8(v, tab, ch * 8, t);
        v4u o; o.x = pk2(v[0] * sc, v[1] * sc); o.y = pk2(v[2] * sc, v[3] * sc); o.z = pk2(v[4] * sc, v[5] * sc); o.w = pk2(v[6] * sc, v[7] * sc);
        *(v4u*)(p + ch * 8) = o; }
}

__device__ __forceinline__ void transpose_item(const float* W, int K, int N, bf16* WT, int k0, int n0, int drow0, LAS float* scr, int lane) {
#pragma unroll 8
    for (int i = 0; i < 32; ++i) { const int kk = 2 * i + (lane >> 5); scr[kk * 33 + (lane & 31)] = W[(size_t)(k0 + kk) * N + n0 + (lane & 31)]; }
    asm volatile("s_waitcnt lgkmcnt(0)" ::: "memory");
    const int c = lane & 7;
#pragma unroll
    for (int j = 0; j < 4; ++j) { const int n = (lane >> 3) + 8 * j; const LAS float* s = scr + (8 * c) * 33 + n;
        v4u o; o.x = pk2(s[0 * 33], s[1 * 33]); o.y = pk2(s[2 * 33], s[3 * 33]); o.z = pk2(s[4 * 33], s[5 * 33]); o.w = pk2(s[6 * 33], s[7 * 33]);
        *(v4u*)(WT + (size_t)(drow0 + n) * K + k0 + 8 * c) = o; }
    asm volatile("s_waitcnt lgkmcnt(0)" ::: "memory");
}
struct WPtrs { const float *w_in, *w_grp, *pscale, *w_po, *w_do, *w_go, *w_o, *w_1, *w_2; };
__device__ __forceinline__ void convert_weights(const WPtrs& p, int l, unsigned char* ws, LAS unsigned char* lds, int gw, int NGW, int wave, int lane, int gtid, int NTH) {
    LAS float* scr = (LAS float*)(lds + wave * 16384);
    constexpr int I_IN = (1024 / 64) * (5888 / 32), I_BR = (512 / 64) * (1024 / 32), I_O = (1024 / 64) * (1024 / 32), I_1 = (1024 / 64) * (4096 / 32), I_2 = (4096 / 64) * (1024 / 32);
    constexpr int NITEMS = I_IN + 3 * I_BR + I_O + I_1 + I_2;
    for (int it = gw; it < NITEMS; it += NGW) {
        int r = it;
        if (r < I_IN) { const int nblk = 5888 / 32, kb = r / nblk, nb = r % nblk, n0 = nb * 32;
            const int d0 = n0 < 1536 ? n0 : (n0 < 4608 ? n0 - 1536 + N1 : n0 - 4608 + 1536);
            transpose_item(p.w_in + (size_t)l * 1024 * 5888, 1024, 5888, (bf16*)(ws + W_IN), kb * 64, n0, d0, scr, lane); continue; } r -= I_IN;
        if (r < I_BR) { const int nblk = 1024 / 32, kb = r / nblk, nb = r % nblk;
            transpose_item(p.w_po + (size_t)l * 512 * 1024, 512, 1024, (bf16*)(ws + W_PO), kb * 64, nb * 32, nb * 32, scr, lane); continue; } r -= I_BR;
        if (r < I_BR) { const int nblk = 1024 / 32, kb = r / nblk, nb = r % nblk;
            transpose_item(p.w_do + (size_t)l * 512 * 1024, 512, 1024, (bf16*)(ws + W_DO), kb * 64, nb * 32, nb * 32, scr, lane); continue; } r -= I_BR;
        if (r < I_BR) { const int nblk = 1024 / 32, kb = r / nblk, nb = r % nblk;
            transpose_item(p.w_go + (size_t)l * 512 * 1024, 512, 1024, (bf16*)(ws + W_GO), kb * 64, nb * 32, nb * 32, scr, lane); continue; } r -= I_BR;
        if (r < I_O) { const int nblk = 1024 / 32, kb = r / nblk, nb = r % nblk;
            transpose_item(p.w_o + (size_t)l * 1024 * 1024, 1024, 1024, (bf16*)(ws + W_O), kb * 64, nb * 32, nb * 32, scr, lane); continue; } r -= I_O;
        if (r < I_1) { const int nblk = 4096 / 32, kb = r / nblk, nb = r % nblk;
            transpose_item(p.w_1 + (size_t)l * 1024 * 4096, 1024, 4096, (bf16*)(ws + W_1), kb * 64, nb * 32, nb * 32, scr, lane); continue; } r -= I_1;
        { const int nblk = 1024 / 32, kb = r / nblk, nb = r % nblk;
            transpose_item(p.w_2 + (size_t)l * 4096 * 1024, 4096, 1024, (bf16*)(ws + W_2), kb * 64, nb * 32, nb * 32, scr, lane); }
    }
    const float* wg = p.w_grp + (size_t)l * 4 * 128 * 128; const float* psc = p.pscale + l * 512;
    unsigned* PT = (unsigned*)(ws + W_POOL);
    for (int i = gtid; i < 512 * 256; i += NTH) { const int n = i >> 8, k = (i & 255) * 2, g = n >> 7; float v0 = 0.f, v1 = 0.f;
        if ((k >> 7) == g) { const float* q = wg + ((size_t)(g * 128 + (k & 127))) * 128 + (n & 127); const float s = psc[n]; v0 = q[0] * s; v1 = q[128] * s; }
        PT[i] = pk2(v0, v1); }
}
__device__ __forceinline__ void mod_gemv(const float* cvec, const float* cctx, const float* wmod, const float* bmod, float* modout, LAS unsigned char* lds, int tid, int lane, int wave, int bx) {
    LAS float* st = (LAS float*)lds;
    LAS float* red = (LAS float*)(lds + 32768);
    for (int i = tid; i < 5 * 1024; i += NTHR) { const int bb = i >> 10, k = i & 1023; const float v = bb < 4 ? cvec[bb * 1024 + k] : cctx[k]; st[i] = v / (1.f + expf(-v)); }
    __syncthreads();
    if (bx < 192) {
        const int l = bx / 96, n0 = (bx % 96) * 64;
        const float* w = wmod + (size_t)l * 1024 * NMOD + n0 + lane;
        float a0 = 0.f, a1 = 0.f, a2 = 0.f, a3 = 0.f, a4 = 0.f;
        const int k0 = wave * 128;
#pragma unroll 16
        for (int kk = 0; kk < 128; ++kk) { const float wv = w[(size_t)(k0 + kk) * NMOD]; const int k = k0 + kk;
            a0 += st[k] * wv; a1 += st[1024 + k] * wv; a2 += st[2048 + k] * wv; a3 += st[3072 + k] * wv; a4 += st[4096 + k] * wv; }
        red[(wave * 5 + 0) * 64 + lane] = a0; red[(wave * 5 + 1) * 64 + lane] = a1; red[(wave * 5 + 2) * 64 + lane] = a2; red[(wave * 5 + 3) * 64 + lane] = a3; red[(wave * 5 + 4) * 64 + lane] = a4;
        __syncthreads();
        if (tid < 320) { const int bb = tid >> 6; float s = bmod[l * NMOD + n0 + lane];
#pragma unroll
            for (int w8 = 0; w8 < 8; ++w8) s += red[(w8 * 5 + bb) * 64 + lane];
            modout[(l * 5 + bb) * NMOD + n0 + lane] = s; }
    }
    __syncthreads();
}
__device__ __forceinline__ void norm_phase(int M, const float* xs_lat, const float* xs_ctx, float* xd_lat, float* xd_ctx, const float* z, const float* modl, int gtc, const float* gpost,
                                           bf16* hdst, const float* gnext, const float* modn, int shc, int scc, int gw, int NGW, int lane) {
    for (int m = gw; m < M; m += NGW) {
        const bool lat = m < ML; const int bb = lat ? (m >> 12) : 4;
        const float* xs = lat ? xs_lat + (size_t)m * 1024 : xs_ctx + (size_t)(m - ML) * 1024;
        f32x4 v[4];
#pragma unroll
        for (int j = 0; j < 4; ++j) v[j] = *(const f32x4*)(xs + 4 * lane + 256 * j);
        float* xd = lat ? xd_lat + (size_t)m * 1024 : xd_ctx + (size_t)(m - ML) * 1024;
        if (!z) {
#pragma unroll
            for (int j = 0; j < 4; ++j) *(f32x4*)(xd + 4 * lane + 256 * j) = v[j];
        } else {
            f32x4 zz[4]; float ss = 0.f;
#pragma unroll
            for (int j = 0; j < 4; ++j) { zz[j] = *(const f32x4*)(z + (size_t)m * 1024 + 4 * lane + 256 * j); ss += (zz[j][0] * zz[j][0] + zz[j][1] * zz[j][1]) + (zz[j][2] * zz[j][2] + zz[j][3] * zz[j][3]); }
            const float rz = 1.0f / sqrtf(wave_sum(ss) * (1.f / 1024.f) + EPSN);
            const float* gt = modl + bb * NMOD + gtc * 1024;
#pragma unroll
            for (int j = 0; j < 4; ++j) { const int c = 4 * lane + 256 * j; const f32x4 g4 = *(const f32x4*)(gpost + c), t4 = *(const f32x4*)(gt + c);
                v[j] = v[j] + t4 * ((zz[j] * rz) * g4); *(f32x4*)(xd + c) = v[j]; }
        }
        if (hdst) {
            float ss = 0.f;
#pragma unroll
            for (int j = 0; j < 4; ++j) ss += (v[j][0] * v[j][0] + v[j][1] * v[j][1]) + (v[j][2] * v[j][2] + v[j][3] * v[j][3]);
            const float rx = 1.0f / sqrtf(wave_sum(ss) * (1.f / 1024.f) + EPSN);
            const float* sh = modn + bb * NMOD + shc * 1024; const float* sc = modn + bb * NMOD + scc * 1024;
#pragma unroll
            for (int j = 0; j < 4; ++j) { const int c = 4 * lane + 256 * j; const f32x4 g4 = *(const f32x4*)(gnext + c), s4 = *(const f32x4*)(sc + c), h4 = *(const f32x4*)(sh + c);
                const f32x4 o = ((v[j] * rx) * g4) * (s4 + 1.0f) + h4;
                v2u w; w.x = pk2(o[0], o[1]); w.y = pk2(o[2], o[3]); *(v2u*)(hdst + (size_t)m * 1024 + c) = w; }
        }
    }
}
__device__ __forceinline__ void pool_phase(int M, const bf16* zin, bf16* pooled, int gtid, int NTH) {
    for (int it = gtid; it < M * 64; it += NTH) {
        const int m = it >> 6, ch = it & 63, g = ch >> 4, w2 = 1 << g;
        int t, l;
        if (m < ML) { t = m & 4095; l = SEQL; } else { t = (m - ML) & 255; l = CTXL; }
        const int base = m - t, lo = max(t - w2, 0), hi = min(t + w2, l);
        float s[8];
#pragma unroll
        for (int i = 0; i < 8; ++i) s[i] = 0.f;
        for (int j = lo; j < hi; ++j) { const v4u w = *(const v4u*)(zin + (size_t)(base + j) * 512 + ch * 8);
            s[0] += bflo(w.x); s[1] += bfhi(w.x); s[2] += bflo(w.y); s[3] += bfhi(w.y); s[4] += bflo(w.z); s[5] += bfhi(w.z); s[6] += bflo(w.w); s[7] += bfhi(w.w); }
        const float inv = 1.0f / (float)(hi - lo);
        const v4u w = *(const v4u*)(zin + (size_t)m * 512 + ch * 8);
        v4u o; o.x = pk2(s[0] * inv - bflo(w.x), s[1] * inv - bfhi(w.x)); o.y = pk2(s[2] * inv - bflo(w.y), s[3] * inv - bfhi(w.y));
        o.z = pk2(s[4] * inv - bflo(w.z), s[5] * inv - bfhi(w.z)); o.w = pk2(s[6] * inv - bflo(w.w), s[7] * inv - bfhi(w.w));
        *(v4u*)(pooled + (size_t)m * 512 + ch * 8) = o;
    }
}
__device__ __forceinline__ void diff_combine_phase(int M, const bf16* od, bf16* diffo, const float* subln, float lam, float lam_init, int gtid, int NTH) {
    for (int it = gtid; it < M * 64; it += NTH) {
        const int l16 = it & 15, hd = (it >> 4) & 3, m = it >> 6;
        const bf16* p1 = od + (size_t)m * 1024 + hd * 256 + l16 * 8;
        const v4u a = *(const v4u*)p1, b = *(const v4u*)(p1 + 128);
        float d[8];
        d[0] = bflo(a.x) - lam * bflo(b.x); d[1] = bfhi(a.x) - lam * bfhi(b.x); d[2] = bflo(a.y) - lam * bflo(b.y); d[3] = bfhi(a.y) - lam * bfhi(b.y);
        d[4] = bflo(a.z) - lam * bflo(b.z); d[5] = bfhi(a.z) - lam * bfhi(b.z); d[6] = bflo(a.w) - lam * bflo(b.w); d[7] = bfhi(a.w) - lam * bfhi(b.w);
        float ss = 0.f;
#pragma unroll
        for (int i = 0; i < 8; ++i) ss += d[i] * d[i];
        ss += __shfl_xor(ss, 1); ss += __shfl_xor(ss, 2); ss += __shfl_xor(ss, 4); ss += __shfl_xor(ss, 8);
        const float rstd = 1.0f / sqrtf(ss * (1.f / 128.f) + EPSN), k1 = 1.0f - lam_init;
        const f32x4 g0 = *(const f32x4*)(subln + l16 * 8), g1 = *(const f32x4*)(subln + l16 * 8 + 4);
        v4u o; o.x = pk2(d[0] * rstd * g0[0] * k1, d[1] * rstd * g0[1] * k1); o.y = pk2(d[2] * rstd * g0[2] * k1, d[3] * rstd * g0[3] * k1);
        o.z = pk2(d[4] * rstd * g1[0] * k1, d[5] * rstd * g1[1] * k1); o.w = pk2(d[6] * rstd * g1[2] * k1, d[7] * rstd * g1[3] * k1);
        *(v4u*)(diffo + (size_t)m * 512 + hd * 128 + l16 * 8) = o;
    }
}

constexpr size_t WS_PTR = 300 * 1024;
struct Ids { int tid, lane, wave, bx, G, vcu, gw, NGW, gtid, NTH; };
#define FRESH_IDS(I) Ids I; { int t_ = threadIdx.x; asm volatile("" : "+v"(t_)); int b_ = blockIdx.x; asm volatile("" : "+s"(b_)); int g_ = gridDim.x; asm volatile("" : "+s"(g_)); \
    I.tid = t_; I.lane = t_ & 63; I.wave = __builtin_amdgcn_readfirstlane(t_ >> 6); I.bx = b_; I.G = g_; I.vcu = (g_ % 8 == 0) ? (b_ % 8) * (g_ / 8) + b_ / 8 : b_; \
    I.gw = I.vcu * 8 + I.wave; I.NGW = g_ * 8; I.gtid = b_ * NTHR + t_; I.NTH = g_ * NTHR; }
#define PTAB(i) (((const float* const*)(ws + WS_PTR))[i])

__global__ void __launch_bounds__(NTHR, 2) mk_fwd(Args a) {
    extern __shared__ __attribute__((aligned(16))) unsigned char lds_raw[];
    cg::grid_group grid = cg::this_grid();
    LAS unsigned char* lds = (LAS unsigned char*)lds_raw;
    unsigned char* ws = a.ws;
#define GSYNC() do { asm volatile("s_waitcnt vmcnt(0) lgkmcnt(0)" ::: "memory"); __threadfence(); grid.sync(); __threadfence(); asm volatile("" ::: "memory"); } while (0)

    {
        FRESH_IDS(I);
        if (I.bx == 0 && I.tid == 0) {
            const float** tab = (const float**)(ws + WS_PTR);
#pragma unroll
            for (int i = 0; i < 26; ++i) tab[i] = a.in[i];
            tab[26] = a.out;
        }
        mod_gemv(a.in[1], a.in[3], a.in[4], a.in[5], (float*)(ws + WS_MOD), lds, I.tid, I.lane, I.wave, I.bx);
        WPtrs wp{a.in[10], a.in[11], a.in[12], a.in[20], a.in[21], a.in[22], a.in[23], a.in[24], a.in[25]};
        convert_weights(wp, 0, ws, lds, I.gw, I.NGW, I.wave, I.lane, I.gtid, I.NTH);
        if (I.bx == I.G - 1) { float* ropet = (float*)(ws + WS_ROPE);
            for (int i = I.tid; i < 1024; i += NTHR) { const int pos = i >> 4, j = i & 15; const float inv = 1.0f / powf(10000.0f, (float)j * 2.0f / 32.0f); const float ang = (float)pos * inv;
                ropet[2 * i] = cosf(ang); ropet[2 * i + 1] = sinf(ang); } }
    }
    GSYNC();
    {
        FRESH_IDS(I);
        float* modv = (float*)(ws + WS_MOD);
        norm_phase(MA, PTAB(0), PTAB(2), (float*)PTAB(26), (float*)(ws + WS_CTX), nullptr, nullptr, 0, nullptr, (bf16*)(ws + WS_H), PTAB(6), modv, 0, 1, I.gw, I.NGW, I.lane);
    }
    GSYNC();

#pragma unroll 1
    for (int l = 0; l < 2; ++l) {
        {
            FRESH_IDS(I);
            const float* ropet = (const float*)(ws + WS_ROPE);
            pg8::Gemm g{(const bf16_t*)(ws + WS_H), (const bf16_t*)(ws + W_IN), MA, N1, 1024}; pg8::StaticOrder S; S.init(MA, N1, I.G, I.bx);
            EpiIn E{ws};
            pg8::gemm_phase<EpiIn, pg8::StaticOrder, true, true>(lds, g, S, E);
        }
        {
            asm volatile("s_waitcnt vmcnt(0)" ::: "memory"); __threadfence(); __syncthreads();
            FRESH_IDS(I);
            const float* ropet = (const float*)(ws + WS_ROPE);
            const float* qn = PTAB(18) + l * 64; const float* kn = PTAB(19) + l * 64;
            pg8::StaticOrder S; S.init(MA, N1, I.G, I.bx);
            pg8::Unit u;
            for (int i = 0; S.next(i, u); ++i) {
                const bool latent = u.pm < (ML / 256);
                if (u.pn == 4 || u.pn == 5) {
                    for (int it = I.tid; it < 1024; it += NTHR) { const int hh = it & 3, rl = it >> 2, row = u.pm * 256 + rl;
                        head_norm_fix((bf16_t*)(ws + WS_QG) + (size_t)row * 512 + (u.pn - 4) * 256 + hh * 64, qn, latent, row & 4095, QC2, ropet); }
                } else if (u.pn == 10) {
                    const int hh = I.tid & 1, rl = I.tid >> 1, row = u.pm * 256 + rl;
                    head_norm_fix((bf16_t*)(ws + WS_KG) + (size_t)kvrow_of(row) * 128 + hh * 64, kn, latent, row & 4095, 1.0f, ropet);
                }
            }
        }
        GSYNC();
        {
            FRESH_IDS(I);
            const bool last = (l == 1); const int M2 = last ? ML : MA;
            pool_phase(M2, (const bf16*)(ws + WS_POOLIN), (bf16*)(ws + WS_POOLED), I.gtid, I.NTH);
            const int total = 1536 + (last ? 0 : 96);
            for (int i = 0;; ++i) {
                const int L = i * I.G + I.vcu; if (L >= total) break;
                int b, r, m0, NT;
                if (L < 1536) { const int qb = L & 15, pair = L >> 4; b = pair / 24; r = pair % 24; m0 = b * SEQL + qb * 256; NT = LKV / 64; }
                else { const int L2 = L - 1536; b = L2 / 24; r = L2 % 24; m0 = ML + b * CTXL; NT = CTXL / 64; }
                const attn_body::bf16 *Q, *K, *V; attn_body::bf16* O; int pq, pk, pv, po;
                if (r < 16) { const int hd = r >> 2, qs = (r >> 1) & 1, vh = r & 1;
                    Q = (const attn_body::bf16*)(ws + WS_QD) + (size_t)m0 * 512 + hd * 128 + qs * 64; pq = 512;
                    K = (const attn_body::bf16*)(ws + WS_KD) + (size_t)(b * LKV) * 512 + hd * 128 + qs * 64; pk = 512;
                    V = (const attn_body::bf16*)(ws + WS_VD) + (size_t)(b * LKV) * 512 + hd * 128 + vh * 64; pv = 512;
                    O = (attn_body::bf16*)(ws + WS_OD) + (size_t)m0 * 1024 + hd * 256 + qs * 128 + vh * 64; po = 1024; }
                else { const int h = r - 16;
                    Q = (const attn_body::bf16*)(ws + WS_QG) + (size_t)m0 * 512 + h * 64; pq = 512;
                    K = (const attn_body::bf16*)(ws + WS_KG) + (size_t)(b * LKV) * 128 + (h >> 2) * 64; pk = 128;
                    V = (const attn_body::bf16*)(ws + WS_VG) + (size_t)(b * LKV) * 128 + (h >> 2) * 64; pv = 128;
                    O = (attn_body::bf16*)(ws + WS_GQAO) + (size_t)m0 * 512 + h * 64; po = 512; }
#ifndef NO_ATTN
                attn_body::attn_unit<8>(Q, pq, K, pk, V, pv, O, po, NT, (char*)lds_raw);
#endif
            }
        }
        GSYNC();
        {
            FRESH_IDS(I);
            const bool last = (l == 1); const int M2 = last ? ML : MA; const float lam_init = last ? 0.35550906759f : 0.2f;
            const float *lq1 = PTAB(13) + l * 64, *lk1 = PTAB(14) + l * 64, *lq2 = PTAB(15) + l * 64, *lk2 = PTAB(16) + l * 64;
            float d1 = 0.f, d2 = 0.f;
            for (int i = 0; i < 64; ++i) { d1 += lq1[i] * lk1[i]; d2 += lq2[i] * lk2[i]; }
            const float lam = expf(d1) - expf(d2) + lam_init;
            diff_combine_phase(M2, (const bf16*)(ws + WS_OD), (bf16*)(ws + WS_DIFFO), PTAB(17) + l * 128, lam, lam_init, I.gtid, I.NTH);
            pg8::Gemm g{(const bf16_t*)(ws + WS_POOLED), (const bf16_t*)(ws + W_POOL), M2, 512, 512}; pg8::StaticOrder S; S.init(M2, 512, I.G, I.bx);
            EpiAct<0> E{(bf16_t*)(ws + WS_POOLO), 512};
            pg8::gemm_phase<EpiAct<0>, pg8::StaticOrder, true, true>(lds, g, S, E);
        }
        GSYNC();
#pragma unroll 1
        for (int b = 0; b < 3; ++b) {
            { FRESH_IDS(I); const int M2 = (l == 1) ? ML : MA;
              pg8::Gemm g{(const bf16_t*)(ws + WS_H), (const bf16_t*)(ws + W_IN) + (size_t)(N1 + b * 1024) * 1024, M2, 1024, 1024}; pg8::StaticOrder S; S.init(M2, 1024, I.G, I.bx);
              EpiAct<1> E{(bf16_t*)(ws + WS_MERGED), 1024};
              pg8::gemm_phase<EpiAct<1>, pg8::StaticOrder, true, true>(lds, g, S, E); }
            { FRESH_IDS(I); const int M2 = (l == 1) ? ML : MA;
              const bf16_t* A = (const bf16_t*)(ws + (b == 0 ? WS_POOLO : b == 1 ? WS_DIFFO : WS_GQAO)); const bf16_t* Bt = (const bf16_t*)(ws + (b == 0 ? W_PO : b == 1 ? W_DO : W_GO));
              pg8::Gemm g{A, Bt, M2, 1024, 512}; pg8::StaticOrder S; S.init(M2, 1024, I.G, I.bx);
              EpiBranch E{(bf16_t*)(ws + WS_MERGED), (float*)(ws + WS_ACC), b};
              pg8::gemm_phase<EpiBranch, pg8::StaticOrder, true, true>(lds, g, S, E); }
        }
        GSYNC();
        {
            FRESH_IDS(I); const int M2 = (l == 1) ? ML : MA;
            pg8::Gemm g{(const bf16_t*)(ws + WS_MERGED), (const bf16_t*)(ws + W_O), M2, 1024, 1024}; pg8::StaticOrder S; S.init(M2, 1024, I.G, I.bx);
            EpiF32 E{(float*)(ws + WS_Y), 1024};
            pg8::gemm_phase<EpiF32, pg8::StaticOrder, true, true>(lds, g, S, E);
        }
        GSYNC();
        {
            FRESH_IDS(I); const int M2 = (l == 1) ? ML : MA;
            const float* modl = (const float*)(ws + WS_MOD) + l * 5 * NMOD; float* outp = (float*)PTAB(26); float* ctxx = (float*)(ws + WS_CTX);
            norm_phase(M2, outp, ctxx, outp, ctxx, (const float*)(ws + WS_Y), modl, 2, PTAB(7) + l * 1024, (bf16*)(ws + WS_HF), PTAB(8) + l * 1024, modl, 3, 4, I.gw, I.NGW, I.lane);
        }
        GSYNC();
        {
            FRESH_IDS(I); const int M2 = (l == 1) ? ML : MA;
            pg8::Gemm g{(const bf16_t*)(ws + WS_HF), (const bf16_t*)(ws + W_1), M2, DFF, 1024}; pg8::StaticOrder S; S.init(M2, DFF, I.G, I.bx);
            EpiAct<2> E{(bf16_t*)(ws + WS_U), DFF};
            pg8::gemm_phase<EpiAct<2>, pg8::StaticOrder, true, true>(lds, g, S, E);
        }
        GSYNC();
        {
            FRESH_IDS(I); const int M2 = (l == 1) ? ML : MA;
            pg8::Gemm g{(const bf16_t*)(ws + WS_U), (const bf16_t*)(ws + W_2), M2, 1024, DFF}; pg8::StaticOrder S; S.init(M2, 1024, I.G, I.bx);
            EpiF32 E{(float*)(ws + WS_Z), 1024};
            pg8::gemm_phase<EpiF32, pg8::StaticOrder, true, true>(lds, g, S, E);
        }
        GSYNC();
        {
            FRESH_IDS(I);
            const float* modl = (const float*)(ws + WS_MOD) + l * 5 * NMOD; float* outp = (float*)PTAB(26); float* ctxx = (float*)(ws + WS_CTX);
            if (l == 0) {
                WPtrs wp{PTAB(10), PTAB(11), PTAB(12), PTAB(20), PTAB(21), PTAB(22), PTAB(23), PTAB(24), PTAB(25)};
                convert_weights(wp, 1, ws, lds, I.gw, I.NGW, I.wave, I.lane, I.gtid, I.NTH);
                norm_phase(MA, outp, ctxx, outp, ctxx, (const float*)(ws + WS_Z), modl, 5, PTAB(9) + l * 1024, (bf16*)(ws + WS_H), PTAB(6) + 1024, modl + 5 * NMOD, 0, 1, I.gw, I.NGW, I.lane);
            } else {
                norm_phase(ML, outp, ctxx, outp, ctxx, (const float*)(ws + WS_Z), modl, 5, PTAB(9) + l * 1024, nullptr, nullptr, nullptr, 0, 0, I.gw, I.NGW, I.lane);
            }
        }
        if (l == 0) GSYNC();
    }
#undef GSYNC
}

extern "C" void kernel_launch(void* const* d_in, const int* in_sizes, int n_in, void* d_out, int out_size, void* d_ws, size_t ws_size, hipStream_t stream) {
    static int grid = 0;
    if (grid == 0) {
        if (n_in != 26 || out_size != ML * DMODEL || ws_size < WS_TOTAL) { fprintf(stderr, "kernel_launch: unexpected shapes (n_in %d out %d ws %zu)\n", n_in, out_size, ws_size); grid = -1; return; }
        int dev = 0, cus = 0, per_cu = 0;
        if (hipGetDevice(&dev) != hipSuccess || hipDeviceGetAttribute(&cus, hipDeviceAttributeMultiprocessorCount, dev) != hipSuccess) { grid = -1; return; }
        if (hipFuncSetAttribute((const void*)mk_fwd, hipFuncAttributeMaxDynamicSharedMemorySize, LDS_BYTES) != hipSuccess) { fprintf(stderr, "kernel_launch: hipFuncSetAttribute failed\n"); grid = -1; return; }
        if (hipOccupancyMaxActiveBlocksPerMultiprocessor(&per_cu, (const void*)mk_fwd, NTHR, LDS_BYTES) != hipSuccess || per_cu < 1) per_cu = 1;
        (void)hipGetLastError();
        grid = cus * per_cu;
    }
    if (grid < 0) return;
    Args a{};
    for (int i = 0; i < 26; ++i) a.in[i] = (const float*)d_in[i];
    a.out = (float*)d_out; a.ws = (unsigned char*)d_ws;
    void* args[] = {&a};
    hipError_t e = hipLaunchCooperativeKernel((const void*)mk_fwd, dim3(grid), dim3(NTHR), args, LDS_BYTES, stream);
    if (e != hipSuccess) fprintf(stderr, "kernel_launch: cooperative launch failed: %s (grid %d)\n", hipGetErrorString(e), grid);
}
```

```cpp
#include <hip/hip_runtime.h>
#include <hip/hip_cooperative_groups.h>
#include <cstdio>
#include <cstdint>

namespace pg8 {
#define PG8_LAS __attribute__((address_space(3)))
typedef unsigned short bf16_t;
typedef short bf16x8 __attribute__((ext_vector_type(8)));
typedef float f32x4 __attribute__((ext_vector_type(4)));
typedef unsigned u32x4 __attribute__((ext_vector_type(4)));
constexpr int BM = 256, BK = 64, HALF = 128, HTB = HALF * BK * 2  , STAGE_BYTES = 8 * HTB, NXCD = 8, WGM = 8;

__host__ __device__ __forceinline__ int lds_byte(int r, int c) { const int st = (r >> 4) * 2 + (c >> 5), rr = r & 15, cc = c & 31, ob = rr * 64 + cc * 2; return st * 1024 + (ob ^ (((ob >> 9) & 1) << 5)); }
__host__ __device__ __forceinline__ void stage_rc(int b, int& R, int& C) { const int st = b / 1024, sb = b % 1024, swz = sb ^ (((sb >> 9) & 1) << 5); R = (st >> 1) * 16 + swz / 64; C = (st & 1) * 32 + (swz % 64) / 2; }
__host__ __device__ __forceinline__ int perm32(int rho) { const int n = rho >> 4, i = rho & 15; return 8 * (i >> 2) + 4 * n + (i & 3); }

struct Unit { int pm, pn; };
struct Gemm { const bf16_t* A; const bf16_t* Bt; int M, N, K; };

struct StaticOrder {
    int nM, nN, nwg, G, c;
    __host__ __device__ void init(int M, int N, int G_, int c_) { nM = M / BM; nN = N / BM; nwg = nM * nN; G = G_; c = c_; }
    __host__ __device__ bool next(int i, Unit& u) const {
        const long L = (long)i * G + c; if (L >= nwg) return false;
        int wgid = (int)L; { const int q = nwg / NXCD, r = nwg % NXCD, xcd = wgid % NXCD, off = wgid / NXCD; wgid = (xcd < r ? xcd * (q + 1) : r * (q + 1) + (xcd - r) * q) + off; }
        const int nig = WGM * nN, gid = wgid / nig, fm = gid * WGM, gsz = (nM - fm) < WGM ? (nM - fm) : WGM;
        u.pm = fm + ((wgid % nig) % gsz); u.pn = (wgid % nig) / gsz; return true;
    }
    __device__ __forceinline__ void a_ready(const Unit&) const {}
    __device__ __forceinline__ void done(const Unit&) const {}
};

__device__ __forceinline__ unsigned cvt_pk_bf16(float lo, float hi) { unsigned r; asm volatile("v_cvt_pk_bf16_f32 %0, %1, %2" : "=v"(r) : "v"(lo), "v"(hi)); return r; }
typedef float f32x2 __attribute__((ext_vector_type(2)));
template <class Epi, class Sched, bool ALIGN_EPI = false, bool SP2 = false>
__device__ __forceinline__ void gemm_phase(PG8_LAS unsigned char* lds, const Gemm g, const Sched& S, const Epi& E) {
    int tid_l = threadIdx.x; asm volatile("" : "+v"(tid_l)); const int tid = tid_l, wid = __builtin_amdgcn_readfirstlane(tid >> 6), lane = tid & 63, wr = wid >> 2, wc = wid & 3, fr = lane & 15, fq = lane >> 4;
    const int K = g.K, nt = K / BK;
    unsigned voffA[2], voffB[2];
#pragma unroll
    for (int i = 0; i < 2; ++i) { int R, C; stage_rc(tid * 16 + i * 8192, R, C); const int Rb = Epi::PERM ? ((R & ~31) + perm32(R & 31)) : R;
        voffA[i] = (unsigned)(R * K + C) * 2u; voffB[i] = (unsigned)(Rb * K + C) * 2u; }
    const size_t kstep = (size_t)(BK * 2);
    const size_t hstep = (size_t)HALF * K * 2;
    const size_t tstep = 2 * hstep;
    const unsigned ldsw = (unsigned)wid * 1024u;
    const int aoff = lds_byte(wr * 64 + fr, fq * 8), boff = lds_byte(wc * 32 + fr, fq * 8);
#define PG8_SA(b, h) (((b) * 2 + (h)) * HTB)
#define PG8_SB(b, h) ((4 + (b) * 2 + (h)) * HTB)
#define PG8_STAGE(bufoff, gbase, voff) do { _Pragma("unroll") for (int _i = 0; _i < 2; ++_i) \
        __builtin_amdgcn_global_load_lds((const unsigned*)((const char*)(gbase) + (voff)[_i]), (PG8_LAS unsigned*)(lds + (bufoff) + ldsw + _i * 8192), 16, 0, 0); } while (0)
#define PG8_LDA(dst, b, h) do { _Pragma("unroll") for (int m = 0; m < 4; ++m) _Pragma("unroll") for (int k = 0; k < 2; ++k) dst[m][k] = *(const PG8_LAS bf16x8*)(lds + PG8_SA(b, h) + aoff + m * 2048 + k * 1024); } while (0)
#define PG8_LDB(dst, b, h) do { _Pragma("unroll") for (int n = 0; n < 2; ++n) _Pragma("unroll") for (int k = 0; k < 2; ++k) dst[n][k] = *(const PG8_LAS bf16x8*)(lds + PG8_SB(b, h) + boff + n * 2048 + k * 1024); } while (0)
#define PG8_MMA(ai, bj, At, Bt) do { __builtin_amdgcn_s_setprio(1); _Pragma("unroll") for (int m = 0; m < 4; ++m) _Pragma("unroll") for (int n = 0; n < 2; ++n) _Pragma("unroll") for (int k = 0; k < 2; ++k) \
        acc[ai][bj][m][n] = __builtin_amdgcn_mfma_f32_16x16x32_bf16(Bt[n][k], At[m][k], acc[ai][bj][m][n], 0, 0, 0); __builtin_amdgcn_s_setprio(0); } while (0)
#define PG8_WAIT_V(n) asm volatile("s_waitcnt vmcnt(" #n ")" ::: "memory")
#define PG8_WAIT_L(n) asm volatile("s_waitcnt lgkmcnt(" #n ")" ::: "memory")
#define PG8_BAR __builtin_amdgcn_s_barrier()
#define PG8_SCHED __builtin_amdgcn_sched_barrier(0)
    Unit cur, nxt; int ui = 0;
    if (!S.next(0, cur)) return;
    f32x4 acc[2][2][4][2];
#pragma unroll
    for (int a = 0; a < 2; ++a)
#pragma unroll
        for (int b = 0; b < 2; ++b)
#pragma unroll
            for (int m = 0; m < 4; ++m)
#pragma unroll
                for (int n = 0; n < 2; ++n) acc[a][b][m][n] = (f32x4){0.f, 0.f, 0.f, 0.f};
    bf16x8 At[4][2], B0[2][2], B1[2][2];
    const char* cA = (const char*)g.A + (size_t)cur.pm * tstep; const char* cB = (const char*)g.Bt + (size_t)cur.pn * tstep;
    S.a_ready(cur);
    if constexpr (SP2) {
        PG8_STAGE(PG8_SB(0, 0), cB, voffB); PG8_STAGE(PG8_SB(0, 1), cB + hstep, voffB); PG8_STAGE(PG8_SA(0, 0), cA, voffA); PG8_STAGE(PG8_SA(0, 1), cA + hstep, voffA);
        if (wr == 1) PG8_BAR;
        PG8_WAIT_V(2); PG8_BAR;
        PG8_STAGE(PG8_SB(1, 0), cB + kstep, voffB); PG8_STAGE(PG8_SA(1, 0), cA + kstep, voffA); PG8_STAGE(PG8_SB(1, 1), cB + hstep + kstep, voffB);
        PG8_WAIT_V(6); PG8_BAR;
    } else {
        PG8_STAGE(PG8_SB(0, 0), cB, voffB); PG8_STAGE(PG8_SA(0, 0), cA, voffA); PG8_STAGE(PG8_SB(0, 1), cB + hstep, voffB); PG8_STAGE(PG8_SA(0, 1), cA + hstep, voffA);
        if (wr == 1) PG8_BAR;
        PG8_WAIT_V(4); PG8_BAR;
        PG8_STAGE(PG8_SB(1, 0), cB + kstep, voffB); PG8_STAGE(PG8_SA(1, 0), cA + kstep, voffA); PG8_STAGE(PG8_SB(1, 1), cB + hstep + kstep, voffB);
        PG8_WAIT_V(6); PG8_BAR;
    }
    for (;;) {
        const bool has_next = S.next(ui + 1, nxt);
        const char* nA = has_next ? (const char*)g.A + (size_t)nxt.pm * tstep : cA; const char* nB = has_next ? (const char*)g.Bt + (size_t)nxt.pn * tstep : cB;
        for (int t = 0; t < nt; t += 2) {
            const bool last = (t == nt - 2);
            const char* a1 = cA + (size_t)(t + 1) * kstep;
            const char* a2 = last ? nA : cA + (size_t)(t + 2) * kstep; const char* b2 = last ? nB : cB + (size_t)(t + 2) * kstep;
            const char* a3 = a2 + kstep; const char* b3 = b2 + kstep;
            if (last && has_next) S.a_ready(nxt);
            if constexpr (SP2) {
            PG8_LDB(B0, 0, 0); PG8_LDB(B1, 0, 1); PG8_SCHED; PG8_LDA(At, 0, 0); PG8_STAGE(PG8_SA(1, 1), a1 + hstep, voffA);
            PG8_WAIT_V(8); PG8_WAIT_L(0); PG8_BAR; PG8_MMA(0, 0, At, B0); PG8_MMA(0, 1, At, B1); PG8_BAR; PG8_SCHED;
            PG8_LDA(At, 0, 1); PG8_STAGE(PG8_SB(0, 0), b2, voffB); PG8_STAGE(PG8_SB(0, 1), b2 + hstep, voffB); PG8_STAGE(PG8_SA(0, 0), a2, voffA);
            PG8_WAIT_V(8); PG8_WAIT_L(0); PG8_BAR; PG8_MMA(1, 0, At, B0); PG8_MMA(1, 1, At, B1); PG8_BAR; PG8_SCHED;
            PG8_LDB(B0, 1, 0); PG8_LDB(B1, 1, 1); PG8_SCHED; PG8_LDA(At, 1, 0); PG8_STAGE(PG8_SA(0, 1), a2 + hstep, voffA);
            PG8_WAIT_V(8); PG8_WAIT_L(0); PG8_BAR; PG8_MMA(0, 0, At, B0); PG8_MMA(0, 1, At, B1); PG8_BAR; PG8_SCHED;
            PG8_LDA(At, 1, 1); PG8_STAGE(PG8_SB(1, 0), b3, voffB); PG8_STAGE(PG8_SB(1, 1), b3 + hstep, voffB); PG8_STAGE(PG8_SA(1, 0), a3, voffA);
            PG8_WAIT_V(8); PG8_WAIT_L(0); PG8_BAR; PG8_MMA(1, 0, At, B0); PG8_MMA(1, 1, At, B1); PG8_BAR; PG8_SCHED;
            } else {
            PG8_LDB(B0, 0, 0); PG8_SCHED; PG8_LDA(At, 0, 0); PG8_STAGE(PG8_SA(1, 1), a1 + hstep, voffA);
            PG8_WAIT_L(8); PG8_BAR; PG8_WAIT_L(0); PG8_MMA(0, 0, At, B0); PG8_BAR; PG8_SCHED;
            PG8_LDB(B1, 0, 1); PG8_STAGE(PG8_SB(0, 0), b2, voffB);
            PG8_BAR; PG8_WAIT_L(0); PG8_MMA(0, 1, At, B1); PG8_BAR;
            PG8_LDA(At, 0, 1); PG8_STAGE(PG8_SA(0, 0), a2, voffA);
            PG8_BAR; PG8_WAIT_L(0); PG8_MMA(1, 0, At, B0); PG8_BAR; PG8_SCHED;
            PG8_STAGE(PG8_SB(0, 1), b2 + hstep, voffB);
            PG8_WAIT_V(6); PG8_BAR; PG8_MMA(1, 1, At, B1); PG8_BAR;
            PG8_LDB(B0, 1, 0); PG8_SCHED; PG8_LDA(At, 1, 0); PG8_STAGE(PG8_SA(0, 1), a2 + hstep, voffA);
            PG8_WAIT_L(8); PG8_BAR; PG8_WAIT_L(0); PG8_MMA(0, 0, At, B0); PG8_BAR; PG8_SCHED;
            PG8_LDB(B1, 1, 1); PG8_STAGE(PG8_SB(1, 0), b3, voffB);
            PG8_BAR; PG8_WAIT_L(0); PG8_MMA(0, 1, At, B1); PG8_BAR;
            PG8_LDA(At, 1, 1); PG8_STAGE(PG8_SA(1, 0), a3, voffA);
            PG8_BAR; PG8_WAIT_L(0); PG8_MMA(1, 0, At, B0); PG8_BAR; PG8_SCHED;
            PG8_STAGE(PG8_SB(1, 1), b3 + hstep, voffB);
            PG8_WAIT_V(6); PG8_BAR; PG8_MMA(1, 1, At, B1); PG8_BAR;
            }
        }
        if constexpr (ALIGN_EPI) { if (wr == 0) PG8_BAR; }
        if constexpr (!Epi::AFTER_DRAIN) { E(acc, cur, wr, wc, fr, fq); S.done(cur); }
        if (!has_next) break;
#pragma unroll
        for (int a = 0; a < 2; ++a)
#pragma unroll
            for (int b = 0; b < 2; ++b)
#pragma unroll
                for (int m = 0; m < 4; ++m)
#pragma unroll
                    for (int n = 0; n < 2; ++n) acc[a][b][m][n] = (f32x4){0.f, 0.f, 0.f, 0.f};
        cur = nxt; cA = nA; cB = nB; ++ui;
        if constexpr (ALIGN_EPI) { if (wr == 1) PG8_BAR; }
    }
    PG8_WAIT_V(0);
    if constexpr (!ALIGN_EPI) { if (wr == 0) PG8_BAR; }
    PG8_BAR;
    if constexpr (Epi::AFTER_DRAIN) { E.fused(acc, cur, wr, wc, fr, fq, lds, wid, lane); S.done(cur); }
#undef PG8_SA
#undef PG8_SB
#undef PG8_STAGE
#undef PG8_LDA
#undef PG8_LDB
#undef PG8_MMA
#undef PG8_WAIT_V
#undef PG8_WAIT_L
#undef PG8_BAR
#undef PG8_SCHED
}
}
#include <hip/hip_bf16.h>
#include <cmath>
namespace attn_body {
using bf16=__hip_bfloat16;
using bf16x8=__attribute__((ext_vector_type(8)))short;
using s16x4=__attribute__((ext_vector_type(4)))short;
using f32x16=__attribute__((ext_vector_type(16)))float;
using u32x4=__attribute__((ext_vector_type(4)))unsigned;
constexpr int D=64;
constexpr int NW=8,QBLK=32,QB=QBLK*NW,KVBLK=64;
constexpr int ATTN_UNIT_ROWS=QB;
__device__ __forceinline__ int crow(int r,int hi){return (r&3)+8*(r>>2)+4*hi;}
#define SBAR() __builtin_amdgcn_sched_barrier(0)
__device__ __forceinline__ void cmask(f32x16&p0,f32x16&p1,int jb,int qrel,int hi){
  const float NEG=-INFINITY; int kb=64*jb+4*hi;
  #pragma unroll
  for(int r=0;r<16;++r){int kv=kb+(r&3)+8*(r>>2); if(kv>qrel)p0[r]=NEG; if(kv+32>qrel)p1[r]=NEG;}
}

constexpr int NSLOT=3, SLOTB=8192;
constexpr int LDS_K=0, LDS_V=NSLOT*SLOTB, LDS_WS=2*NSLOT*SLOTB, LDS_OST=LDS_WS+NW*64*4, LDS_BYTES=LDS_OST+NW*4096;
constexpr float C2=0.125f*1.4426950408889634f;
__device__ __forceinline__ void glds16(const void*gsrc,unsigned lds_dst){unsigned keep;
  asm volatile("s_mov_b32 %0, m0\n\ts_mov_b32 m0, %2\n\ts_nop 0\n\tglobal_load_lds_dwordx4 %1, off\n\ts_mov_b32 m0, %0":"=&s"(keep):"v"(gsrc),"s"(lds_dst):"memory");}
__device__ __forceinline__ float max3f(float a,float b,float c){float r;asm("v_max3_f32 %0, %1, %2, %3":"=v"(r):"v"(a),"v"(b),"v"(c));return r;}
__device__ __forceinline__ float max2f(float a,float b){float r;asm("v_max_f32_e32 %0, %1, %2":"=v"(r):"v"(a),"v"(b));return r;}
__device__ __forceinline__ float fadd_s(float a,float b){float r;asm("v_add_f32_e32 %0, %1, %2":"=v"(r):"v"(a),"v"(b));return r;}
__device__ __forceinline__ float fsub_s(float a,float b){float r;asm("v_sub_f32_e32 %0, %1, %2":"=v"(r):"v"(a),"v"(b));return r;}
typedef float f32x2_t __attribute__((ext_vector_type(2))); typedef __bf16 bf16x2_t __attribute__((ext_vector_type(2)));
__device__ __forceinline__ unsigned cvtpk_s(float lo,float hi){f32x2_t v={lo,hi};bf16x2_t b=__builtin_convertvector(v,bf16x2_t);return __builtin_bit_cast(unsigned,b);}
#define WAIT_BAR(N) asm volatile("s_waitcnt vmcnt(" #N ") lgkmcnt(0)\n\ts_barrier":::"memory")

__device__ __forceinline__ void qkt(f32x16&p0,f32x16&p1,const char*Kslot,const bf16x8*qr,const f32x16&negm,int r32,int hi){
  const char*kb=Kslot+hi*1024+r32*16;
  #pragma unroll
  for(int d0=0;d0<4;++d0){
    const bf16x8 b0=*reinterpret_cast<const bf16x8*>(kb+d0*2048);
    const bf16x8 b1=*reinterpret_cast<const bf16x8*>(kb+d0*2048+512);
    if(d0==0){p0=__builtin_amdgcn_mfma_f32_32x32x16_bf16(b0,qr[0],negm,0,0,0);p1=__builtin_amdgcn_mfma_f32_32x32x16_bf16(b1,qr[0],negm,0,0,0);}
    else{p0=__builtin_amdgcn_mfma_f32_32x32x16_bf16(b0,qr[d0],p0,0,0,0);p1=__builtin_amdgcn_mfma_f32_32x32x16_bf16(b1,qr[d0],p1,0,0,0);}}
}
typedef __attribute__((address_space(3))) const char* lds_cptr;
typedef short v4i16_t __attribute__((ext_vector_type(4)));
__device__ __forceinline__ void kload8(bf16x8*kf,lds_cptr kp){
  kf[0]=*(const __attribute__((address_space(3))) bf16x8*)(kp);      kf[1]=*(const __attribute__((address_space(3))) bf16x8*)(kp+512);
  kf[2]=*(const __attribute__((address_space(3))) bf16x8*)(kp+2048); kf[3]=*(const __attribute__((address_space(3))) bf16x8*)(kp+2560);
  kf[4]=*(const __attribute__((address_space(3))) bf16x8*)(kp+4096); kf[5]=*(const __attribute__((address_space(3))) bf16x8*)(kp+4608);
  kf[6]=*(const __attribute__((address_space(3))) bf16x8*)(kp+6144); kf[7]=*(const __attribute__((address_space(3))) bf16x8*)(kp+6656);
}
__device__ __forceinline__ void kload2(bf16x8*kf,lds_cptr kp,int j){ kf[2*j]=*(const __attribute__((address_space(3))) bf16x8*)(kp+j*2048); kf[2*j+1]=*(const __attribute__((address_space(3))) bf16x8*)(kp+j*2048+512); }
__device__ __forceinline__ s16x4 vtr(lds_cptr p){ return __builtin_bit_cast(s16x4,__builtin_amdgcn_ds_read_tr16_b64_v4i16((__attribute__((address_space(3))) v4i16_t*)p)); }
__device__ __forceinline__ float rowmax(const f32x16&p0,const f32x16&p1){
  float a=max3f(p0[0],p0[1],p1[0]),b=max3f(p0[2],p0[3],p1[1]);a=max3f(a,p1[2],p1[3]);
  #pragma unroll
  for(int r=4;r<16;r+=4){a=max3f(a,p0[r],p0[r+1]);b=max3f(b,p0[r+2],p0[r+3]);a=max3f(a,p1[r],p1[r+1]);b=max3f(b,p1[r+2],p1[r+3]);}
  const float m=max2f(a,b);
  auto rr=__builtin_amdgcn_permlane32_swap(__float_as_uint(m),__float_as_uint(m),false,false);
  return max2f(__uint_as_float(rr[0]),__uint_as_float(rr[1]));
}
__device__ __forceinline__ void pv(f32x16*o,int vb,bf16x8 pa0,bf16x8 pa1,bf16x8 pa2,bf16x8 pa3){
  #pragma unroll
  for(int d0=0;d0<2;++d0){s16x4 lo[4],hi[4];
    #pragma unroll
    for(int ks=0;ks<4;++ks){
      asm volatile("ds_read_b64_tr_b16 %0,%1 offset:%c2":"=&v"(lo[ks]):"v"(vb),"i"(d0*4096+ks*1024):"memory");
      asm volatile("ds_read_b64_tr_b16 %0,%1 offset:%c2":"=&v"(hi[ks]):"v"(vb),"i"(d0*4096+ks*1024+512):"memory");}
    asm volatile("s_waitcnt lgkmcnt(0)":::"memory");SBAR();
    #define PK(k) (bf16x8){lo[k][0],lo[k][1],lo[k][2],lo[k][3],hi[k][0],hi[k][1],hi[k][2],hi[k][3]}
    o[d0]=__builtin_amdgcn_mfma_f32_32x32x16_bf16(pa0,PK(0),o[d0],0,0,0);
    o[d0]=__builtin_amdgcn_mfma_f32_32x32x16_bf16(pa1,PK(1),o[d0],0,0,0);
    o[d0]=__builtin_amdgcn_mfma_f32_32x32x16_bf16(pa2,PK(2),o[d0],0,0,0);
    o[d0]=__builtin_amdgcn_mfma_f32_32x32x16_bf16(pa3,PK(3),o[d0],0,0,0);
    #undef PK
  }
}

#ifndef ATTN_STORE16
#define ATTN_STORE16(p,v) (*(u32x4*)(p)=(v))
#endif
template<int THRL> __device__ __forceinline__ void attn_unit(const bf16*Qw0,int pqs,const bf16*__restrict__ Kh,int pks,const bf16*__restrict__ Vh,int pvs,bf16*Ow0,int pos_,const int NT,char*shm){
  int tid_l=threadIdx.x; asm volatile("":"+v"(tid_l)); const int tid=tid_l,lane=tid&63,r32=lane&31,hi=lane>>5; const int wid=__builtin_amdgcn_readfirstlane(tid>>6);
  const bf16*Qw=Qw0+(long)(wid*QBLK)*pqs;
  const unsigned lds0=(unsigned)(uintptr_t)shm;
  float*wsf=(float*)(shm+LDS_WS)+wid*64;
  const bf16*ksrc=Kh+(long)lane*pks+wid*8;
  const bf16*vsrc=Vh+(long)(16*(wid&3)+(lane>>2))*pvs+(wid>>2)*32+(lane&3)*8;
  const unsigned kdst=lds0+LDS_K+wid*1024, vdst=lds0+LDS_V+wid*1024;
  #define DMA_K(t,slot) glds16(ksrc+(long)(t)*KVBLK*pks,(unsigned)__builtin_amdgcn_readfirstlane(kdst+(slot)))
  #define DMA_V(t,slot) glds16(vsrc+(long)(t)*KVBLK*pvs,(unsigned)__builtin_amdgcn_readfirstlane(vdst+(slot)))
  const int vb0=(int)(lds0+LDS_V)+((lane>>4)&1)*32+(lane&3)*8+(4*hi+((lane&15)>>2))*64;
  const char*Kbase=shm+LDS_K; bf16x8 kf[8];
  const lds_cptr shm3=(lds_cptr)shm; const lds_cptr kp0=shm3+LDS_K+hi*1024+r32*16; const lds_cptr vp0=shm3+LDS_V+((lane>>4)&1)*32+(lane&3)*8+(4*hi+((lane&15)>>2))*64;
  DMA_K(0,0);DMA_V(0,0);DMA_K(1,SLOTB);
  bf16x8 qr[4];
  #pragma unroll
  for(int d0=0;d0<4;++d0)qr[d0]=*reinterpret_cast<const bf16x8*>(&Qw[(long)r32*pqs+d0*16+hi*8]);
  float mhat=0.f,l_reg=0.f;f32x16 o[2];o[0]=f32x16{};o[1]=f32x16{};f32x16 negm=f32x16{};asm volatile("":"+v"(negm));
  #define CMASK(P0,P1,t) do{}while(0)
  bool resc=false;
  #define START(P0,P1) do{ const float rm=rowmax(P0,P1); resc=false; \
    { const float dl=rm; mhat=fadd_s(mhat,dl); \
      _Pragma("unroll") for(int r=0;r<16;++r){P0[r]=fsub_s(P0[r],dl);P1[r]=fsub_s(P1[r],dl);} \
      _Pragma("unroll") for(int r=0;r<16;++r)negm[r]=-mhat; asm volatile("":"+v"(negm)); } \
    _Pragma("unroll") for(int r=0;r<16;++r)P0[r]=__builtin_amdgcn_exp2f(P0[r]); }while(0)
  #define RESC() do{ if(resc){ asm volatile("s_waitcnt lgkmcnt(0)":::"memory"); \
      _Pragma("unroll") for(int d_=0;d_<2;++d_) _Pragma("unroll") for(int r=0;r<16;++r)o[d_][r]*=wsf[crow(r,hi)]; } }while(0)
  f32x16 pA0,pA1,pB0,pB1;
  int sl_prev=0,sl_cur=0,sl_next=SLOTB;
  #define ROT() do{sl_prev=sl_cur;sl_cur=sl_next;sl_next=(sl_next==(NSLOT-1)*SLOTB)?0:sl_next+SLOTB;}while(0)
  DMA_K(2,2*SLOTB);
  WAIT_BAR(3);
  qkt(pA0,pA1,Kbase,qr,negm,r32,hi);asm volatile("s_nop 15\n\ts_nop 7":"+v"(pA0),"+v"(pA1));CMASK(pA0,pA1,0);
  START(pA0,pA1);
  _Pragma("unroll") for(int r=0;r<16;++r)pA1[r]=__builtin_amdgcn_exp2f(pA1[r]);
  WAIT_BAR(0);
  DMA_K(3,0);DMA_V(1,SLOTB);
  ROT();
  kload8(kf,kp0+sl_cur);
  WAIT_BAR(2);
  s16x4 vlo[8],vhi[8]; u32x4 pw0,pw1,pw2,pw3;
  #define PKW(P,B) cvtpk_s(P[B],P[B+1])
  #define PAF(k) __builtin_bit_cast(bf16x8,pw##k)
  #define VFR(i) (bf16x8){vlo[i][0],vlo[i][1],vlo[i][2],vlo[i][3],vhi[i][0],vhi[i][1],vhi[i][2],vhi[i][3]}
  #define PIN(x) asm volatile("":"+v"(x))
  #define MX3(a,b,c) __builtin_fmaxf(__builtin_fmaxf((a),(b)),(c))
  #define GAPA(MF,A0,A1,A2,A3,W0,W1,PW) do{ MF; sacc+=A0; sacc+=A1; sacc+=A2; sacc+=A3; PIN(sacc); W0; W1; PIN(PW); SBAR(); }while(0)
  #define EX(v) __builtin_amdgcn_exp2f(v)
  #define GAPB(MF,X,B) do{ MF; X[B]=EX(X[B]); X[B+1]=EX(X[B+1]); X[B+2]=EX(X[B+2]); X[B+3]=EX(X[B+3]); PIN(X); SBAR(); }while(0)
  #define VRD(i) do{ vlo[i]=vtr(vp_+(((i)>>2)*4096+((i)&3)*1024)); vhi[i]=vtr(vp_+(((i)>>2)*4096+((i)&3)*1024+512)); }while(0)
  #define KRD(G,j) do{ if(G){ kload2(kf,kp0+sl_next,j); SBAR(); } }while(0)
  #define STEP(C0,C1,P0,P1,t,GK,GV,GL) do{ SBAR(); \
    const lds_cptr vp_=vp0+sl_prev; \
    VRD(0); SBAR(); float sacc=(P0[0]+P0[1]); \
    GAPA(C0=__builtin_amdgcn_mfma_f32_32x32x16_bf16(kf[0],qr[0],negm,0,0,0), P0[2],P0[3],P0[4],P0[5],     pw0[0]=PKW(P0,0), pw0[1]=PKW(P0,2), pw0); \
    VRD(4); SBAR(); GAPA(C1=__builtin_amdgcn_mfma_f32_32x32x16_bf16(kf[1],qr[0],negm,0,0,0), P0[6],P0[7],P0[8],P0[9],     pw0[2]=PKW(P0,4), pw0[3]=PKW(P0,6), pw0); \
    VRD(1); SBAR(); GAPA(C0=__builtin_amdgcn_mfma_f32_32x32x16_bf16(kf[2],qr[1],C0,0,0,0),   P0[10],P0[11],P0[12],P0[13], pw1[0]=PKW(P0,8), pw1[1]=PKW(P0,10), pw1); \
    VRD(5); SBAR(); GAPA(C1=__builtin_amdgcn_mfma_f32_32x32x16_bf16(kf[3],qr[1],C1,0,0,0),   P0[14],P0[15],P1[0],P1[1],   pw1[2]=PKW(P0,12),pw1[3]=PKW(P0,14), pw1); \
    VRD(2); SBAR(); GAPA(C0=__builtin_amdgcn_mfma_f32_32x32x16_bf16(kf[4],qr[2],C0,0,0,0),   P1[2],P1[3],P1[4],P1[5],     pw2[0]=PKW(P1,0), pw2[1]=PKW(P1,2), pw2); \
    VRD(6); SBAR(); GAPA(C1=__builtin_amdgcn_mfma_f32_32x32x16_bf16(kf[5],qr[2],C1,0,0,0),   P1[6],P1[7],P1[8],P1[9],     pw2[2]=PKW(P1,4), pw2[3]=PKW(P1,6), pw2); \
    VRD(3); SBAR(); GAPA(C0=__builtin_amdgcn_mfma_f32_32x32x16_bf16(kf[6],qr[3],C0,0,0,0),   P1[10],P1[11],P1[12],P1[13], pw3[0]=PKW(P1,8), pw3[1]=PKW(P1,10), pw3); \
    VRD(7); SBAR(); GAPA(C1=__builtin_amdgcn_mfma_f32_32x32x16_bf16(kf[7],qr[3],C1,0,0,0),   P1[14],P1[15],0.f,0.f,       pw3[2]=PKW(P1,12),pw3[3]=PKW(P1,14), pw3); \
    l_reg+=sacc; \
    if(GK){DMA_K((t)+3,sl_cur);} if(GV){DMA_V((t)+1,sl_next);} \
    CMASK(C0,C1,t); \
    { float a=MX3(C0[0],C0[1],C1[0]),b=MX3(C0[2],C0[3],C1[1]); a=MX3(a,C1[2],C1[3]); \
      _Pragma("unroll") for(int r=4;r<16;r+=4){a=MX3(a,C0[r],C0[r+1]);b=MX3(b,C0[r+2],C0[r+3]);a=MX3(a,C1[r],C1[r+1]);b=MX3(b,C1[r+2],C1[r+3]);} \
      float rm=__builtin_fmaxf(a,b); { auto rr=__builtin_amdgcn_permlane32_swap(__float_as_uint(rm),__float_as_uint(rm),false,false); rm=__builtin_fmaxf(__uint_as_float(rr[0]),__uint_as_float(rr[1])); } \
      resc=false; \
      if(__builtin_expect(__any(rm>(float)THRL),0)){ const float dl=__builtin_fmaxf(rm,0.f); mhat+=dl; \
        _Pragma("unroll") for(int r=0;r<16;++r){C0[r]-=dl;C1[r]-=dl;} \
        _Pragma("unroll") for(int r=0;r<16;++r)negm[r]=-mhat; asm volatile("":"+v"(negm)); \
        const float f=__builtin_amdgcn_exp2f(-dl); l_reg*=f; if(hi==0)wsf[r32]=f; resc=true; } } \
    SBAR(); \
    GAPB(o[0]=__builtin_amdgcn_mfma_f32_32x32x16_bf16(PAF(0),VFR(0),o[0],0,0,0), C0,0); \
    GAPB(o[1]=__builtin_amdgcn_mfma_f32_32x32x16_bf16(PAF(0),VFR(4),o[1],0,0,0), C0,4); \
    KRD(GL,0); GAPB(o[0]=__builtin_amdgcn_mfma_f32_32x32x16_bf16(PAF(1),VFR(1),o[0],0,0,0), C0,8); \
    KRD(GL,1); GAPB(o[1]=__builtin_amdgcn_mfma_f32_32x32x16_bf16(PAF(1),VFR(5),o[1],0,0,0), C0,12); \
    KRD(GL,2); GAPB(o[0]=__builtin_amdgcn_mfma_f32_32x32x16_bf16(PAF(2),VFR(2),o[0],0,0,0), C1,0); \
    KRD(GL,3); GAPB(o[1]=__builtin_amdgcn_mfma_f32_32x32x16_bf16(PAF(2),VFR(6),o[1],0,0,0), C1,4); \
    GAPB(o[0]=__builtin_amdgcn_mfma_f32_32x32x16_bf16(PAF(3),VFR(3),o[0],0,0,0), C1,8); \
    GAPB(o[1]=__builtin_amdgcn_mfma_f32_32x32x16_bf16(PAF(3),VFR(7),o[1],0,0,0), C1,12); \
    }while(0)
  int t=1;
  #undef CMASK
  #define CMASK(P0,P1,t) do{}while(0)
  for(;t+5<NT;t+=2){
    STEP(pB0,pB1,pA0,pA1,t,true,true,true);     WAIT_BAR(2); RESC(); ROT();
    STEP(pA0,pA1,pB0,pB1,t+1,true,true,true);   WAIT_BAR(2); RESC(); ROT();
  }
  #undef CMASK
  #define CMASK(P0,P1,t) do{}while(0)
  #define ENDW(tt) do{ if((tt)+3<NT){WAIT_BAR(2);} else if((tt)+2<NT){WAIT_BAR(1);} else {WAIT_BAR(0);} }while(0)
  for(;t+1<NT;t+=2){
    STEP(pB0,pB1,pA0,pA1,t,(t+3<NT),(t+1<NT),(t+1<NT));       ENDW(t);   RESC(); ROT();
    STEP(pA0,pA1,pB0,pB1,t+1,(t+4<NT),(t+2<NT),(t+2<NT));     ENDW(t+1); RESC(); ROT();
  }
  STEP(pB0,pB1,pA0,pA1,NT-1,false,false,false); RESC();
  { float sacc=pB0[0]+pB0[1]; _Pragma("unroll") for(int r=2;r<16;++r)sacc+=pB0[r]; _Pragma("unroll") for(int r=0;r<16;++r)sacc+=pB1[r]; l_reg+=sacc;
    pw0=(u32x4){PKW(pB0,0),PKW(pB0,2),PKW(pB0,4),PKW(pB0,6)};pw1=(u32x4){PKW(pB0,8),PKW(pB0,10),PKW(pB0,12),PKW(pB0,14)};pw2=(u32x4){PKW(pB1,0),PKW(pB1,2),PKW(pB1,4),PKW(pB1,6)};pw3=(u32x4){PKW(pB1,8),PKW(pB1,10),PKW(pB1,12),PKW(pB1,14)};
    SBAR(); pv(o,vb0+sl_cur,PAF(0),PAF(1),PAF(2),PAF(3)); }
  #undef PKW
  #undef PAF
  #undef VFR
  #undef PIN
  #undef MX3
  #undef GAPA
  #undef GAPB
  #undef EX
  #undef VRD
  #undef KRD
  #undef STEP
  #undef ENDW
  {auto rr=__builtin_amdgcn_permlane32_swap(__float_as_uint(l_reg),__float_as_uint(l_reg),false,false);l_reg=__uint_as_float(rr[0])+__uint_as_float(rr[1]);}
  if(hi==0)wsf[32+r32]=l_reg;asm volatile("s_waitcnt lgkmcnt(0)":::"memory");
  float rli[16];
  #pragma unroll
  for(int r=0;r<16;++r)rli[r]=__builtin_amdgcn_rcpf(wsf[32+crow(r,hi)]);
  bf16*Ow=Ow0+(long)(wid*QBLK)*pos_;
  { bf16*stg=(bf16*)(shm+LDS_OST)+wid*2048;
    #pragma unroll
    for(int r=0;r<16;++r){const int orow=crow(r,hi);
      #pragma unroll
      for(int d0=0;d0<2;++d0)stg[orow*64+d0*32+r32]=__float2bfloat16(o[d0][r]*rli[r]);}
    asm volatile("s_waitcnt lgkmcnt(0)":::"memory");
    #pragma unroll
    for(int i=0;i<4;++i){const int row=i*8+(lane>>3),ch=lane&7; const u32x4 v=*(const u32x4*)(stg+row*64+ch*8); ATTN_STORE16(Ow+(long)row*pos_+ch*8,v);} }
  asm volatile("s_waitcnt lgkmcnt(0)\n\ts_barrier":::"memory");
  #undef DMA_K
  #undef DMA_V
  #undef CMASK
  #undef START
  #undef RESC
  #undef ROT
}
constexpr int ATTN_LDS_BYTES=LDS_BYTES;
#undef SBAR
#undef WAIT_BAR
}
namespace cg = cooperative_groups;
#define LAS __attribute__((address_space(3)))
typedef unsigned short bf16;
typedef unsigned v4u __attribute__((ext_vector_type(4)));
typedef unsigned v2u __attribute__((ext_vector_type(2)));
typedef float f32x4 __attribute__((ext_vector_type(4)));
using pg8::bf16_t;

constexpr int DMODEL = 1024, NBATCH = 4, SEQL = 4096, CTXL = 256, LKV = SEQL + CTXL, ML = NBATCH * SEQL, MC = NBATCH * CTXL, MA = ML + MC, DFF = 4096, N1 = 2816, NMOD = 6 * DMODEL;
constexpr float EPSN = 1e-6f;
constexpr float QC2 = 0.125f * 1.4426950408889634f;
constexpr int NTHR = 512;
constexpr int LDS_BYTES = 147456;

constexpr size_t MiB = 1u << 20;
constexpr size_t WS_MOD = 0, WS_ROPE = 256 * 1024;
constexpr size_t W_IN = 2 * MiB, W_POOL = W_IN + (size_t)5888 * 1024 * 2, W_PO = W_POOL + 512 * 512 * 2, W_DO = W_PO + 1024 * 512 * 2, W_GO = W_DO + 1024 * 512 * 2,
                 W_O = W_GO + 1024 * 512 * 2, W_1 = W_O + 1024 * 1024 * 2, W_2 = W_1 + (size_t)4096 * 1024 * 2, W_END = W_2 + (size_t)4096 * 1024 * 2;
static_assert(W_END <= 36 * MiB, "weights");
constexpr size_t WS_CTX = 36 * MiB, WS_H = 40 * MiB;
constexpr size_t WS_POOLIN = 74 * MiB, WS_QD = 91 * MiB, WS_QG = 108 * MiB, WS_KD = 125 * MiB, WS_VD = 142 * MiB, WS_KG = 159 * MiB, WS_VG = WS_KG + (size_t)MA * 128 * 2;
constexpr size_t WS_OD = 176 * MiB, WS_GQAO = 210 * MiB, WS_POOLED = 227 * MiB;
constexpr size_t WS_DIFFO = 74 * MiB, WS_POOLO = 91 * MiB, WS_MERGED = 108 * MiB, WS_ACC = 142 * MiB, WS_Y = 142 * MiB, WS_HF = 210 * MiB, WS_U = 40 * MiB, WS_Z = 176 * MiB;
constexpr size_t WS_TOTAL = 244 * MiB;
static_assert(WS_VG + (size_t)MA * 128 * 2 <= 176 * MiB, "p1 outs");

struct Args { const float* in[26]; float* out; unsigned char* ws; };

__device__ __forceinline__ unsigned f2bf(float f) { unsigned u = __builtin_bit_cast(unsigned, f); return (u + 0x7fffu + ((u >> 16) & 1u)) >> 16; }
__device__ __forceinline__ unsigned pk2(float lo, float hi) { return f2bf(lo) | (f2bf(hi) << 16); }
__device__ __forceinline__ float bflo(unsigned w) { return __builtin_bit_cast(float, w << 16); }
__device__ __forceinline__ float bfhi(unsigned w) { return __builtin_bit_cast(float, w & 0xffff0000u); }
__device__ __forceinline__ float wave_sum(float v) {
#pragma unroll
    for (int o = 1; o < 64; o <<= 1) v += __shfl_xor(v, o);
    return v;
}

template <int ACT  > struct EpiAct {
    static constexpr bool PERM = true, AFTER_DRAIN = false;
    bf16_t* O; int ldc;
    __device__ __forceinline__ void operator()(const pg8::f32x4 (&acc)[2][2][4][2], const pg8::Unit& u, int wr, int wc, int fr, int fq) const {
        const int row0 = u.pm * 256 + wr * 64 + fr, col0 = u.pn * 256 + wc * 32 + 8 * fq;
#pragma unroll
        for (int ai = 0; ai < 2; ++ai)
#pragma unroll
            for (int m = 0; m < 4; ++m) { bf16_t* rowp = O + (size_t)(row0 + ai * 128 + m * 16) * ldc + col0;
#pragma unroll
                for (int bj = 0; bj < 2; ++bj) { float v[8];
#pragma unroll
                    for (int i = 0; i < 4; ++i) { v[i] = acc[ai][bj][m][0][i]; v[4 + i] = acc[ai][bj][m][1][i]; }
#pragma unroll
                    for (int i = 0; i < 8; ++i) {
                        if (ACT == 1) v[i] = 1.f / (1.f + __expf(-v[i]));
                        if (ACT == 2) { const float r = fmaxf(v[i], 0.f); v[i] = r * r; } }
                    pg8::u32x4 w; w.x = pk2(v[0], v[1]); w.y = pk2(v[2], v[3]); w.z = pk2(v[4], v[5]); w.w = pk2(v[6], v[7]);
                    *(pg8::u32x4*)(rowp + bj * 128) = w; } }
    }
};
struct EpiF32 {
    static constexpr bool PERM = true, AFTER_DRAIN = false;
    float* O; int ldc;
    __device__ __forceinline__ void operator()(const pg8::f32x4 (&acc)[2][2][4][2], const pg8::Unit& u, int wr, int wc, int fr, int fq) const {
        const int row0 = u.pm * 256 + wr * 64 + fr, col0 = u.pn * 256 + wc * 32 + 8 * fq;
#pragma unroll
        for (int ai = 0; ai < 2; ++ai)
#pragma unroll
            for (int m = 0; m < 4; ++m) { float* rowp = O + (size_t)(row0 + ai * 128 + m * 16) * ldc + col0;
#pragma unroll
                for (int bj = 0; bj < 2; ++bj) { *(pg8::f32x4*)(rowp + bj * 128) = acc[ai][bj][m][0]; *(pg8::f32x4*)(rowp + bj * 128 + 4) = acc[ai][bj][m][1]; } }
    }
};
struct EpiBranch {
    static constexpr bool PERM = true, AFTER_DRAIN = false;
    bf16_t* GO; float* ACC; int mode;
    __device__ __forceinline__ void operator()(const pg8::f32x4 (&acc)[2][2][4][2], const pg8::Unit& u, int wr, int wc, int fr, int fq) const {
        const int row0 = u.pm * 256 + wr * 64 + fr, col0 = u.pn * 256 + wc * 32 + 8 * fq;
#pragma unroll
        for (int ai = 0; ai < 2; ++ai)
#pragma unroll
            for (int m = 0; m < 4; ++m) { const size_t ro = (size_t)(row0 + ai * 128 + m * 16) * 1024 + col0;
#pragma unroll
                for (int bj = 0; bj < 2; ++bj) { const size_t idx = ro + bj * 128;
                    const pg8::u32x4 g = *(const pg8::u32x4*)(GO + idx);
                    pg8::f32x4 v0 = acc[ai][bj][m][0], v1 = acc[ai][bj][m][1];
                    v0[0] *= bflo(g.x); v0[1] *= bfhi(g.x); v0[2] *= bflo(g.y); v0[3] *= bfhi(g.y);
                    v1[0] *= bflo(g.z); v1[1] *= bfhi(g.z); v1[2] *= bflo(g.w); v1[3] *= bfhi(g.w);
                    if (mode > 0) { v0 += *(const pg8::f32x4*)(ACC + idx); v1 += *(const pg8::f32x4*)(ACC + idx + 4); }
                    if (mode < 2) { *(pg8::f32x4*)(ACC + idx) = v0; *(pg8::f32x4*)(ACC + idx + 4) = v1; }
                    else { pg8::u32x4 w; w.x = pk2(v0[0], v0[1]); w.y = pk2(v0[2], v0[3]); w.z = pk2(v1[0], v1[1]); w.w = pk2(v1[2], v1[3]); *(pg8::u32x4*)(GO + idx) = w; } } }
    }
};
__device__ __forceinline__ int kvrow_of(int row) { return row < ML ? (row >> 12) * LKV + CTXL + (row & 4095) : ((row - ML) >> 8) * LKV + ((row - ML) & 255); }
__device__ __forceinline__ void rope8(float (&v)[8], const float* tab, int d, int t) {
    const int p0 = d >> 1, pos = p0 < 16 ? (t >> 6) : (t & 63), j0 = p0 & 15;
    const f32x4* tp = (const f32x4*)(tab + (pos * 16 + j0) * 2);
    const f32x4 t0 = tp[0], t1 = tp[1];
    float o[8];
    o[0] = v[0] * t0[0] - v[1] * t0[1]; o[1] = v[0] * t0[1] + v[1] * t0[0];
    o[2] = v[2] * t0[2] - v[3] * t0[3]; o[3] = v[2] * t0[3] + v[3] * t0[2];
    o[4] = v[4] * t1[0] - v[5] * t1[1]; o[5] = v[4] * t1[1] + v[5] * t1[0];
    o[6] = v[6] * t1[2] - v[7] * t1[3]; o[7] = v[6] * t1[3] + v[7] * t1[2];
#pragma unroll
    for (int i = 0; i < 8; ++i) v[i] = o[i];
}
struct EpiIn {
    static constexpr bool PERM = true, AFTER_DRAIN = false;
    unsigned char* ws;
    __device__ __forceinline__ void operator()(const pg8::f32x4 (&acc)[2][2][4][2], const pg8::Unit& u, int wr, int wc, int fr, int fq) const {
        const bool latent = u.pm < (ML / 256);
        const int cw = wc * 32 + 8 * fq;
        bf16_t* const poolin = (bf16_t*)(ws + WS_POOLIN); bf16_t* const qd = (bf16_t*)(ws + WS_QD); bf16_t* const qg = (bf16_t*)(ws + WS_QG); bf16_t* const kd = (bf16_t*)(ws + WS_KD);
        bf16_t* const vd = (bf16_t*)(ws + WS_VD); bf16_t* const kg = (bf16_t*)(ws + WS_KG); bf16_t* const vg = (bf16_t*)(ws + WS_VG); const float* const rope = (const float*)(ws + WS_ROPE);
#pragma unroll
        for (int bj = 0; bj < 2; ++bj) {
            const int cb = u.pn * 2 + bj;
            bf16_t* base; int pitch, coff; bool kvmap = false, dorope = false; float sc = 1.f;
            if (cb < 4) { base = poolin; pitch = 512; coff = cb * 128; }
            else if (cb < 8) { base = qd; pitch = 512; coff = (cb - 4) * 128; dorope = latent; sc = QC2; }
            else if (cb < 12) { base = qg; pitch = 512; coff = (cb - 8) * 128; }
            else if (cb < 16) { base = kd; pitch = 512; coff = (cb - 12) * 128; kvmap = true; dorope = latent; }
            else if (cb < 20) { base = vd; pitch = 512; coff = (cb - 16) * 128; kvmap = true; }
            else if (cb == 20) { base = kg; pitch = 128; coff = 0; kvmap = true; }
            else { base = vg; pitch = 128; coff = 0; kvmap = true; }
#pragma unroll
            for (int ai = 0; ai < 2; ++ai)
#pragma unroll
                for (int m = 0; m < 4; ++m) {
                    const int row = u.pm * 256 + ai * 128 + wr * 64 + m * 16 + fr;
                    const int drow = kvmap ? kvrow_of(row) : row;
                    float v[8];
#pragma unroll
                    for (int i = 0; i < 4; ++i) { v[i] = acc[ai][bj][m][0][i]; v[4 + i] = acc[ai][bj][m][1][i]; }
                    if (dorope) rope8(v, rope, cw & 63, row & 4095);
#pragma unroll
                    for (int i = 0; i < 8; ++i) v[i] *= sc;
                    pg8::u32x4 w; w.x = pk2(v[0], v[1]); w.y = pk2(v[2], v[3]); w.z = pk2(v[4], v[5]); w.w = pk2(v[6], v[7]);
                    *(pg8::u32x4*)(base + (size_t)drow * pitch + coff + cw) = w;
                }
        }
    }
};
__device__ __forceinline__ void head_norm_fix(bf16_t* p, const float* gain, bool dorope, int t, float sc, const float* tab) {
    float ss = 0.f;
#pragma unroll
    for (int ch = 0; ch < 8; ++ch) { const v4u w = *(const v4u*)(p + ch * 8);
        const float a0 = bflo(w.x), a1 = bfhi(w.x), a2 = bflo(w.y), a3 = bfhi(w.y), a4 = bflo(w.z), a5 = bfhi(w.z), a6 = bflo(w.w), a7 = bfhi(w.w);
        ss += (a0 * a0 + a1 * a1) + (a2 * a2 + a3 * a3) + (a4 * a4 + a5 * a5) + (a6 * a6 + a7 * a7); }
    const float rstd = 1.0f / sqrtf(ss * (1.f / 64.f) + EPSN);
#pragma unroll
    for (int ch = 0; ch < 8; ++ch) { const v4u w = *(const v4u*)(p + ch * 8);
        float v[8] = {bflo(w.x), bfhi(w.x), bflo(w.y), bfhi(w.y), bflo(w.z), bfhi(w.z), bflo(w.w), bfhi(w.w)};
        const f32x4 g0 = *(const f32x4*)(gain + ch * 8), g1 = *(const f32x4*)(gain + ch * 8 + 4);
        v[0] *= rstd * g0[0]; v[1] *= rstd * g0[1]; v[2] *= rstd * g0[2]; v[3] *= rstd * g0[3];
        v[4] *= rstd * g1[0]; v[5] *= rstd * g1[1]; v[6] *= rstd * g1[2]; v[7] *= rstd * g1[3];
        if (dorope) rope8(v, tab, ch * 8, t);
        v4u o; o.x = pk2(v[0] * sc, v[1] * sc); o.y = pk2(v[2] * sc, v[3] * sc); o.z = pk2(v[4] * sc, v[5] * sc); o.w = pk2(v[6] * sc, v[7] * sc);
        *(v4u*)(p + ch * 8) = o; }
}

__device__ __forceinline__ void transpose_item(const float* W, int K, int N, bf16* WT, int k0, int n0, int drow0, LAS float* scr, int lane) {
#pragma unroll 8
    for (int i = 0; i < 32; ++i) { const int kk = 2 * i + (lane >> 5); scr[kk * 33 + (lane & 31)] = W[(size_t)(k0 + kk) * N + n0 + (lane & 31)]; }
    asm volatile("s_waitcnt lgkmcnt(0)" ::: "memory");
    const int c = lane & 7;
#pragma unroll
    for (int j = 0; j < 4; ++j) { const int n = (lane >> 3) + 8 * j; const LAS float* s = scr + (8 * c) * 33 + n;
        v4u o; o.x = pk2(s[0 * 33], s[1 * 33]); o.y = pk2(s[2 * 33], s[3 * 33]); o.z = pk2(s[4 * 33], s[5 * 33]); o.w = pk2(s[6 * 33], s[7 * 33]);
        *(v4u*)(WT + (size_t)(drow0 + n) * K + k0 + 8 * c) = o; }
    asm volatile("s_waitcnt lgkmcnt(0)" ::: "memory");
}
struct WPtrs { const float *w_in, *w_grp, *pscale, *w_po, *w_do, *w_go, *w_o, *w_1, *w_2; };
__device__ __forceinline__ void convert_weights(const WPtrs& p, int l, unsigned char* ws, LAS unsigned char* lds, int gw, int NGW, int wave, int lane, int gtid, int NTH) {
    LAS float* scr = (LAS float*)(lds + wave * 16384);
    constexpr int I_IN = (1024 / 64) * (5888 / 32), I_BR = (512 / 64) * (1024 / 32), I_O = (1024 / 64) * (1024 / 32), I_1 = (1024 / 64) * (4096 / 32), I_2 = (4096 / 64) * (1024 / 32);
    constexpr int NITEMS = I_IN + 3 * I_BR + I_O + I_1 + I_2;
    for (int it = gw; it < NITEMS; it += NGW) {
        int r = it;
        if (r < I_IN) { const int nblk = 5888 / 32, kb = r / nblk, nb = r % nblk, n0 = nb * 32;
            const int d0 = n0 < 1536 ? n0 : (n0 < 4608 ? n0 - 1536 + N1 : n0 - 4608 + 1536);
            transpose_item(p.w_in + (size_t)l * 1024 * 5888, 1024, 5888, (bf16*)(ws + W_IN), kb * 64, n0, d0, scr, lane); continue; } r -= I_IN;
        if (r < I_BR) { const int nblk = 1024 / 32, kb = r / nblk, nb = r % nblk;
            transpose_item(p.w_po + (size_t)l * 512 * 1024, 512, 1024, (bf16*)(ws + W_PO), kb * 64, nb * 32, nb * 32, scr, lane); continue; } r -= I_BR;
        if (r < I_BR) { const int nblk = 1024 / 32, kb = r / nblk, nb = r % nblk;
            transpose_item(p.w_do + (size_t)l * 512 * 1024, 512, 1024, (bf16*)(ws + W_DO), kb * 64, nb * 32, nb * 32, scr, lane); continue; } r -= I_BR;
        if (r < I_BR) { const int nblk = 1024 / 32, kb = r / nblk, nb = r % nblk;
            transpose_item(p.w_go + (size_t)l * 512 * 1024, 512, 1024, (bf16*)(ws + W_GO), kb * 64, nb * 32, nb * 32, scr, lane); continue; } r -= I_BR;
        if (r < I_O) { const int nblk = 1024 / 32, kb = r / nblk, nb = r % nblk;
            transpose_item(p.w_o + (size_t)l * 1024 * 1024, 1024, 1024, (bf16*)(ws + W_O), kb * 64, nb * 32, nb * 32, scr, lane); continue; } r -= I_O;
        if (r < I_1) { const int nblk = 4096 / 32, kb = r / nblk, nb = r % nblk;
            transpose_item(p.w_1 + (size_t)l * 1024 * 4096, 1024, 4096, (bf16*)(ws + W_1), kb * 64, nb * 32, nb * 32, scr, lane); continue; } r -= I_1;
        { const int nblk = 1024 / 32, kb = r / nblk, nb = r % nblk;
            transpose_item(p.w_2 + (size_t)l * 4096 * 1024, 4096, 1024, (bf16*)(ws + W_2), kb * 64, nb * 32, nb * 32, scr, lane); }
    }
    const float* wg = p.w_grp + (size_t)l * 4 * 128 * 128; const float* psc = p.pscale + l * 512;
    unsigned* PT = (unsigned*)(ws + W_POOL);
    for (int i = gtid; i < 512 * 256; i += NTH) { const int n = i >> 8, k = (i & 255) * 2, g = n >> 7; float v0 = 0.f, v1 = 0.f;
        if ((k >> 7) == g) { const float* q = wg + ((size_t)(g * 128 + (k & 127))) * 128 + (n & 127); const float s = psc[n]; v0 = q[0] * s; v1 = q[128] * s; }
        PT[i] = pk2(v0, v1); }
}
__device__ __forceinline__ void mod_gemv(const float* cvec, const float* cctx, const float* wmod, const float* bmod, float* modout, LAS unsigned char* lds, int tid, int lane, int wave, int bx) {
    LAS float* st = (LAS float*)lds;
    LAS float* red = (LAS float*)(lds + 32768);
    for (int i = tid; i < 5 * 1024; i += NTHR) { const int bb = i >> 10, k = i & 1023; const float v = bb < 4 ? cvec[bb * 1024 + k] : cctx[k]; st[i] = v / (1.f + expf(-v)); }
    __syncthreads();
    if (bx < 192) {
        const int l = bx / 96, n0 = (bx % 96) * 64;
        const float* w = wmod + (size_t)l * 1024 * NMOD + n0 + lane;
        float a0 = 0.f, a1 = 0.f, a2 = 0.f, a3 = 0.f, a4 = 0.f;
        const int k0 = wave * 128;
#pragma unroll 16
        for (int kk = 0; kk < 128; ++kk) { const float wv = w[(size_t)(k0 + kk) * NMOD]; const int k = k0 + kk;
            a0 += st[k] * wv; a1 += st[1024 + k] * wv; a2 += st[2048 + k] * wv; a3 += st[3072 + k] * wv; a4 += st[4096 + k] * wv; }
        red[(wave * 5 + 0) * 64 + lane] = a0; red[(wave * 5 + 1) * 64 + lane] = a1; red[(wave * 5 + 2) * 64 + lane] = a2; red[(wave * 5 + 3) * 64 + lane] = a3; red[(wave * 5 + 4) * 64 + lane] = a4;
        __syncthreads();
        if (tid < 320) { const int bb = tid >> 6; float s = bmod[l * NMOD + n0 + lane];
#pragma unroll
            for (int w8 = 0; w8 < 8; ++w8) s += red[(w8 * 5 + bb) * 64 + lane];
            modout[(l * 5 + bb) * NMOD + n0 + lane] = s; }
    }
    __syncthreads();
}
__device__ __forceinline__ void norm_phase(int M, const float* xs_lat, const float* xs_ctx, float* xd_lat, float* xd_ctx, const float* z, const float* modl, int gtc, const float* gpost,
                                           bf16* hdst, const float* gnext, const float* modn, int shc, int scc, int gw, int NGW, int lane) {
    for (int m = gw; m < M; m += NGW) {
        const bool lat = m < ML; const int bb = lat ? (m >> 12) : 4;
        const float* xs = lat ? xs_lat + (size_t)m * 1024 : xs_ctx + (size_t)(m - ML) * 1024;
        f32x4 v[4];
#pragma unroll
        for (int j = 0; j < 4; ++j) v[j] = *(const f32x4*)(xs + 4 * lane + 256 * j);
        float* xd = lat ? xd_lat + (size_t)m * 1024 : xd_ctx + (size_t)(m - ML) * 1024;
        if (!z) {
#pragma unroll
            for (int j = 0; j < 4; ++j) *(f32x4*)(xd + 4 * lane + 256 * j) = v[j];
        } else {
            f32x4 zz[4]; float ss = 0.f;
#pragma unroll
            for (int j = 0; j < 4; ++j) { zz[j] = *(const f32x4*)(z + (size_t)m * 1024 + 4 * lane + 256 * j); ss += (zz[j][0] * zz[j][0] + zz[j][1] * zz[j][1]) + (zz[j][2] * zz[j][2] + zz[j][3] * zz[j][3]); }
            const float rz = 1.0f / sqrtf(wave_sum(ss) * (1.f / 1024.f) + EPSN);
            const float* gt = modl + bb * NMOD + gtc * 1024;
#pragma unroll
            for (int j = 0; j < 4; ++j) { const int c = 4 * lane + 256 * j; const f32x4 g4 = *(const f32x4*)(gpost + c), t4 = *(const f32x4*)(gt + c);
                v[j] = v[j] + t4 * ((zz[j] * rz) * g4); *(f32x4*)(xd + c) = v[j]; }
        }
        if (hdst) {
            float ss = 0.f;
#pragma unroll
            for (int j = 0; j < 4; ++j) ss += (v[j][0] * v[j][0] + v[j][1] * v[j][1]) + (v[j][2] * v[j][2] + v[j][3] * v[j][3]);
            const float rx = 1.0f / sqrtf(wave_sum(ss) * (1.f / 1024.f) + EPSN);
            const float* sh = modn + bb * NMOD + shc * 1024; const float* sc = modn + bb * NMOD + scc * 1024;
#pragma unroll
            for (int j = 0; j < 4; ++j) { const int c = 4 * lane + 256 * j; const f32x4 g4 = *(const f32x4*)(gnext + c), s4 = *(const f32x4*)(sc + c), h4 = *(const f32x4*)(sh + c);
                const f32x4 o = ((v[j] * rx) * g4) * (s4 + 1.0f) + h4;
                v2u w; w.x = pk2(o[0], o[1]); w.y = pk2(o[2], o[3]); *(v2u*)(hdst + (size_t)m * 1024 + c) = w; }
        }
    }
}
__device__ __forceinline__ void pool_phase(int M, const bf16* zin, bf16* pooled, int gtid, int NTH) {
    for (int it = gtid; it < M * 64; it += NTH) {
        const int m = it >> 6, ch = it & 63, g = ch >> 4, w2 = 1 << g;
        int t, l;
        if (m < ML) { t = m & 4095; l = SEQL; } else { t = (m - ML) & 255; l = CTXL; }
        const int base = m - t, lo = max(t - w2, 0), hi = min(t + w2, l);
        float s[8];
#pragma unroll
        for (int i = 0; i < 8; ++i) s[i] = 0.f;
        for (int j = lo; j < hi; ++j) { const v4u w = *(const v4u*)(zin + (size_t)(base + j) * 512 + ch * 8);
            s[0] += bflo(w.x); s[1] += bfhi(w.x); s[2] += bflo(w.y); s[3] += bfhi(w.y); s[4] += bflo(w.z); s[5] += bfhi(w.z); s[6] += bflo(w.w); s[7] += bfhi(w.w); }
        const float inv = 1.0f / (float)(hi - lo);
        const v4u w = *(const v4u*)(zin + (size_t)m * 512 + ch * 8);
        v4u o; o.x = pk2(s[0] * inv - bflo(w.x), s[1] * inv - bfhi(w.x)); o.y = pk2(s[2] * inv - bflo(w.y), s[3] * inv - bfhi(w.y));
        o.z = pk2(s[4] * inv - bflo(w.z), s[5] * inv - bfhi(w.z)); o.w = pk2(s[6] * inv - bflo(w.w), s[7] * inv - bfhi(w.w));
        *(v4u*)(pooled + (size_t)m * 512 + ch * 8) = o;
    }
}
__device__ __forceinline__ void diff_combine_phase(int M, const bf16* od, bf16* diffo, const float* subln, float lam, float lam_init, int gtid, int NTH) {
    for (int it = gtid; it < M * 64; it += NTH) {
        const int l16 = it & 15, hd = (it >> 4) & 3, m = it >> 6;
        const bf16* p1 = od + (size_t)m * 1024 + hd * 256 + l16 * 8;
        const v4u a = *(const v4u*)p1, b = *(const v4u*)(p1 + 128);
        float d[8];
        d[0] = bflo(a.x) - lam * bflo(b.x); d[1] = bfhi(a.x) - lam * bfhi(b.x); d[2] = bflo(a.y) - lam * bflo(b.y); d[3] = bfhi(a.y) - lam * bfhi(b.y);
        d[4] = bflo(a.z) - lam * bflo(b.z); d[5] = bfhi(a.z) - lam * bfhi(b.z); d[6] = bflo(a.w) - lam * bflo(b.w); d[7] = bfhi(a.w) - lam * bfhi(b.w);
        float ss = 0.f;
#pragma unroll
        for (int i = 0; i < 8; ++i) ss += d[i] * d[i];
        ss += __shfl_xor(ss, 1); ss += __shfl_xor(ss, 2); ss += __shfl_xor(ss, 4); ss += __shfl_xor(ss, 8);
        const float rstd = 1.0f / sqrtf(ss * (1.f / 128.f) + EPSN), k1 = 1.0f - lam_init;
        const f32x4 g0 = *(const f32x4*)(subln + l16 * 8), g1 = *(const f32x4*)(subln + l16 * 8 + 4);
        v4u o; o.x = pk2(d[0] * rstd * g0[0] * k1, d[1] * rstd * g0[1] * k1); o.y = pk2(d[2] * rstd * g0[2] * k1, d[3] * rstd * g0[3] * k1);
        o.z = pk2(d[4] * rstd * g1[0] * k1, d[5] * rstd * g1[1] * k1); o.w = pk2(d[6] * rstd * g1[2] * k1, d[7] * rstd * g1[3] * k1);
        *(v4u*)(diffo + (size_t)m * 512 + hd * 128 + l16 * 8) = o;
    }
}

#define RLX_AGENT __ATOMIC_RELAXED, __HIP_MEMORY_SCOPE_AGENT
#define XB_TMO      128
#define XB_XCNT(j)  (256  + 64 * (j))
#define XB_XSUB(j)  (1280 + 64 * (j))
#define XB_XGEN(j)  (2304 + 64 * (j))
#define XB_TOP      3328
#define XB_TOPGEN   3392
#define XCD_BAR_WORDS 3456
#define XB_SPIN_CAP (1u << 22)

__device__ __forceinline__ unsigned xb_ld(unsigned* p)              { return __hip_atomic_load(p, __ATOMIC_RELAXED, __HIP_MEMORY_SCOPE_AGENT); }
__device__ __forceinline__ unsigned xb_add(unsigned* p, unsigned v) { return __hip_atomic_fetch_add(p, v, __ATOMIC_RELAXED, __HIP_MEMORY_SCOPE_AGENT); }
__device__ __forceinline__ unsigned xb_xcc_id() { return (unsigned)__builtin_amdgcn_s_getreg((3 << 11) | 20) & 0xFu; }
#define XB_SPIN(cond, bar) do { unsigned _sp = 0; while (cond) { __builtin_amdgcn_s_sleep(1); \
    if ((++_sp & 255u) == 0u) { if (xb_ld(&(bar)[XB_TMO])) break; if (_sp > XB_SPIN_CAP) { atomicAdd(&(bar)[XB_TMO], 1u); break; } } } } while (0)

struct XcdBarrier {
    unsigned* bar; unsigned x;
    volatile LAS unsigned* st;
};

__device__ __forceinline__ XcdBarrier xcd_barrier_post(unsigned* bar, volatile LAS unsigned* st) {
    XcdBarrier b; b.bar = bar; b.x = xb_xcc_id(); b.st = st;
    if (threadIdx.x == 0) (void)xb_add(&bar[XB_XCNT(b.x)], 1u);
    return b;
}
__device__ __forceinline__ void xcd_barrier_complete(unsigned* bar, unsigned x, unsigned& nloc, unsigned& nx) {
    const unsigned G = gridDim.x * gridDim.y * gridDim.z;
    unsigned sum, cnt, mine, sp = 0u;
    for (;;) {
        sum = 0u; cnt = 0u; mine = 0u;
#pragma unroll
        for (unsigned j = 0; j < 16; ++j) { const unsigned c = xb_ld(&bar[XB_XCNT(j)]); sum += c; cnt += (c > 0u) ? 1u : 0u; mine = (j == x) ? c : mine; }
        if (sum == G) break;
        __builtin_amdgcn_s_sleep(1);
        if ((++sp & 255u) == 0u) { if (xb_ld(&bar[XB_TMO])) break; if (sp > XB_SPIN_CAP) { atomicAdd(&bar[XB_TMO], 1u); break; } }
    }
    nloc = mine > 0u ? mine : 1u; nx = cnt > 0u ? cnt : 1u;
}

__device__ __forceinline__ void xcd_barrier(const XcdBarrier& b) {
    asm volatile("s_waitcnt vmcnt(0)" ::: "memory");
    __syncthreads();
    if (threadIdx.x == 0) {
        unsigned* bar = b.bar;
        __builtin_amdgcn_s_waitcnt(0);
        unsigned nloc = b.st[0], nx = b.st[1];
        if (nloc == 0u) { xcd_barrier_complete(bar, b.x, nloc, nx); b.st[0] = nloc; b.st[1] = nx; }
        const unsigned old = xb_add(&bar[XB_XSUB(b.x)], 1u);
        const unsigned gen = old / nloc;
        if (old + 1u == (gen + 1u) * nloc) {
            __builtin_amdgcn_fence(__ATOMIC_RELEASE, "agent");
            asm volatile("s_waitcnt vmcnt(0)" ::: "memory");
            const unsigned og = xb_add(&bar[XB_TOP], 1u);
            const unsigned tg = og / nx;
            if (og + 1u == (tg + 1u) * nx) xb_add(&bar[XB_TOPGEN], 1u);
            else XB_SPIN(xb_ld(&bar[XB_TOPGEN]) == tg, bar);
            __builtin_amdgcn_fence(__ATOMIC_ACQUIRE, "agent");
            xb_add(&bar[XB_XGEN(b.x)], 1u);
            asm volatile("s_waitcnt vmcnt(0)" ::: "memory");
        } else {
            XB_SPIN(xb_ld(&bar[XB_XGEN(b.x)]) == gen, bar);
            __builtin_amdgcn_fence(__ATOMIC_ACQUIRE, "agent");
            asm volatile("s_waitcnt vmcnt(0)" ::: "memory");
        }
    }
    __syncthreads();
}
constexpr size_t WS_BAR = 320 * 1024;
constexpr int LDS_CTL = 131072, LDS_BARST = LDS_CTL + 352;
constexpr size_t WS_PTR = 300 * 1024;
struct Ids { int tid, lane, wave, bx, G, vcu, gw, NGW, gtid, NTH; };
#define FRESH_IDS(I) Ids I; { int t_ = threadIdx.x; asm volatile("" : "+v"(t_)); int b_ = blockIdx.x; asm volatile("" : "+s"(b_)); int g_ = gridDim.x; asm volatile("" : "+s"(g_)); \
    I.tid = t_; I.lane = t_ & 63; I.wave = __builtin_amdgcn_readfirstlane(t_ >> 6); I.bx = b_; I.G = g_; I.vcu = (g_ % 8 == 0) ? (b_ % 8) * (g_ / 8) + b_ / 8 : b_; \
    I.gw = I.vcu * 8 + I.wave; I.NGW = g_ * 8; I.gtid = b_ * NTHR + t_; I.NTH = g_ * NTHR; }
#define PTAB(i) (((const float* const*)(ws + WS_PTR))[i])

__global__ void __launch_bounds__(NTHR, 2) mk_fwd(Args a) {
    extern __shared__ __attribute__((aligned(16))) unsigned char lds_raw[];
    cg::grid_group grid = cg::this_grid();
    LAS unsigned char* lds = (LAS unsigned char*)lds_raw;
    unsigned char* ws = a.ws;
#define GSYNC_CG() do { asm volatile("s_waitcnt vmcnt(0) lgkmcnt(0)" ::: "memory"); __threadfence(); grid.sync(); __threadfence(); asm volatile("" ::: "memory"); } while (0)
#define GSYNC() do { XcdBarrier b_; b_.bar = (unsigned*)(ws + WS_BAR); b_.x = xb_xcc_id(); b_.st = (volatile LAS unsigned*)(lds + LDS_BARST); xcd_barrier(b_); asm volatile("" ::: "memory"); } while (0)
#ifndef REP_P1
#define REP_P1 1
#endif
#ifndef REP_P2
#define REP_P2 1
#endif
#ifndef REP_P3
#define REP_P3 1
#endif
#ifndef REP_P4
#define REP_P4 1
#endif
#ifndef REP_P5
#define REP_P5 1
#endif
#ifndef REP_P7
#define REP_P7 1
#endif
#ifndef REP_P8
#define REP_P8 1
#endif
#ifndef EXTRA_SYNCS
#define EXTRA_SYNCS 0
#endif
#define REPEAT(n) _Pragma("unroll 1") for (int rep_ = 0; rep_ < (n); ++rep_)
    for (int u = threadIdx.x; u < (LDS_BYTES - LDS_CTL) / 4; u += NTHR) ((LAS unsigned*)(lds + LDS_CTL))[u] = 0u;
    if (blockIdx.x == 0) for (int i = threadIdx.x; i < XCD_BAR_WORDS; i += NTHR) ((unsigned*)(ws + WS_BAR))[i] = 0u;
    __syncthreads();

    {
        FRESH_IDS(I);
        if (I.bx == 0 && I.tid == 0) {
            const float** tab = (const float**)(ws + WS_PTR);
#pragma unroll
            for (int i = 0; i < 26; ++i) tab[i] = a.in[i];
            tab[26] = a.out;
        }
        mod_gemv(a.in[1], a.in[3], a.in[4], a.in[5], (float*)(ws + WS_MOD), lds, I.tid, I.lane, I.wave, I.bx);
        WPtrs wp{a.in[10], a.in[11], a.in[12], a.in[20], a.in[21], a.in[22], a.in[23], a.in[24], a.in[25]};
        convert_weights(wp, 0, ws, lds, I.gw, I.NGW, I.wave, I.lane, I.gtid, I.NTH);
        if (I.bx == I.G - 1) { float* ropet = (float*)(ws + WS_ROPE);
            for (int i = I.tid; i < 1024; i += NTHR) { const int pos = i >> 4, j = i & 15; const float inv = 1.0f / powf(10000.0f, (float)j * 2.0f / 32.0f); const float ang = (float)pos * inv;
                ropet[2 * i] = cosf(ang); ropet[2 * i + 1] = sinf(ang); } }
    }
    GSYNC_CG();
    (void)xcd_barrier_post((unsigned*)(ws + WS_BAR), (volatile LAS unsigned*)(lds + LDS_BARST));
    for (int e_ = 0; e_ < EXTRA_SYNCS; ++e_) GSYNC();
    {
        FRESH_IDS(I);
        float* modv = (float*)(ws + WS_MOD);
        norm_phase(MA, PTAB(0), PTAB(2), (float*)PTAB(26), (float*)(ws + WS_CTX), nullptr, nullptr, 0, nullptr, (bf16*)(ws + WS_H), PTAB(6), modv, 0, 1, I.gw, I.NGW, I.lane);
    }
    GSYNC();

#pragma unroll 1
    for (int l = 0; l < 2; ++l) {
        REPEAT(REP_P1) {
        {
            FRESH_IDS(I);
            const float* ropet = (const float*)(ws + WS_ROPE);
            pg8::Gemm g{(const bf16_t*)(ws + WS_H), (const bf16_t*)(ws + W_IN), MA, N1, 1024}; pg8::StaticOrder S; S.init(MA, N1, I.G, I.bx);
            EpiIn E{ws};
            pg8::gemm_phase<EpiIn, pg8::StaticOrder, true, true>(lds, g, S, E);
        }
        {
            asm volatile("s_waitcnt vmcnt(0)" ::: "memory"); __threadfence(); __syncthreads();
            FRESH_IDS(I);
            const float* ropet = (const float*)(ws + WS_ROPE);
            const float* qn = PTAB(18) + l * 64; const float* kn = PTAB(19) + l * 64;
            pg8::StaticOrder S; S.init(MA, N1, I.G, I.bx);
            pg8::Unit u;
            for (int i = 0; S.next(i, u); ++i) {
                const bool latent = u.pm < (ML / 256);
                if (u.pn == 4 || u.pn == 5) {
                    for (int it = I.tid; it < 1024; it += NTHR) { const int hh = it & 3, rl = it >> 2, row = u.pm * 256 + rl;
                        head_norm_fix((bf16_t*)(ws + WS_QG) + (size_t)row * 512 + (u.pn - 4) * 256 + hh * 64, qn, latent, row & 4095, QC2, ropet); }
                } else if (u.pn == 10) {
                    const int hh = I.tid & 1, rl = I.tid >> 1, row = u.pm * 256 + rl;
                    head_norm_fix((bf16_t*)(ws + WS_KG) + (size_t)kvrow_of(row) * 128 + hh * 64, kn, latent, row & 4095, 1.0f, ropet);
                }
            }
        }
        GSYNC();
        }
        REPEAT(REP_P2) {
        {
            FRESH_IDS(I);
            const bool last = (l == 1); const int M2 = last ? ML : MA;
            pool_phase(M2, (const bf16*)(ws + WS_POOLIN), (bf16*)(ws + WS_POOLED), I.gtid, I.NTH);
            const int total = 1536 + (last ? 0 : 96);
            for (int i = 0;; ++i) {
                const int L = i * I.G + I.vcu; if (L >= total) break;
                int b, r, m0, NT;
                if (L < 1536) { const int qb = L & 15, pair = L >> 4; b = pair / 24; r = pair % 24; m0 = b * SEQL + qb * 256; NT = LKV / 64; }
                else { const int L2 = L - 1536; b = L2 / 24; r = L2 % 24; m0 = ML + b * CTXL; NT = CTXL / 64; }
                const attn_body::bf16 *Q, *K, *V; attn_body::bf16* O; int pq, pk, pv, po;
                if (r < 16) { const int hd = r >> 2, qs = (r >> 1) & 1, vh = r & 1;
                    Q = (const attn_body::bf16*)(ws + WS_QD) + (size_t)m0 * 512 + hd * 128 + qs * 64; pq = 512;
                    K = (const attn_body::bf16*)(ws + WS_KD) + (size_t)(b * LKV) * 512 + hd * 128 + qs * 64; pk = 512;
                    V = (const attn_body::bf16*)(ws + WS_VD) + (size_t)(b * LKV) * 512 + hd * 128 + vh * 64; pv = 512;
                    O = (attn_body::bf16*)(ws + WS_OD) + (size_t)m0 * 1024 + hd * 256 + qs * 128 + vh * 64; po = 1024; }
                else { const int h = r - 16;
                    Q = (const attn_body::bf16*)(ws + WS_QG) + (size_t)m0 * 512 + h * 64; pq = 512;
                    K = (const attn_body::bf16*)(ws + WS_KG) + (size_t)(b * LKV) * 128 + (h >> 2) * 64; pk = 128;
                    V = (const attn_body::bf16*)(ws + WS_VG) + (size_t)(b * LKV) * 128 + (h >> 2) * 64; pv = 128;
                    O = (attn_body::bf16*)(ws + WS_GQAO) + (size_t)m0 * 512 + h * 64; po = 512; }
#ifndef NO_ATTN
                attn_body::attn_unit<8>(Q, pq, K, pk, V, pv, O, po, NT, (char*)lds_raw);
#endif
            }
        }
        GSYNC();
        }
        REPEAT(REP_P3) {
        {
            FRESH_IDS(I);
            const bool last = (l == 1); const int M2 = last ? ML : MA; const float lam_init = last ? 0.35550906759f : 0.2f;
            const float *lq1 = PTAB(13) + l * 64, *lk1 = PTAB(14) + l * 64, *lq2 = PTAB(15) + l * 64, *lk2 = PTAB(16) + l * 64;
            float d1 = 0.f, d2 = 0.f;
            for (int i = 0; i < 64; ++i) { d1 += lq1[i] * lk1[i]; d2 += lq2[i] * lk2[i]; }
            const float lam = expf(d1) - expf(d2) + lam_init;
            diff_combine_phase(M2, (const bf16*)(ws + WS_OD), (bf16*)(ws + WS_DIFFO), PTAB(17) + l * 128, lam, lam_init, I.gtid, I.NTH);
            pg8::Gemm g{(const bf16_t*)(ws + WS_POOLED), (const bf16_t*)(ws + W_POOL), M2, 512, 512}; pg8::StaticOrder S; S.init(M2, 512, I.G, I.bx);
            EpiAct<0> E{(bf16_t*)(ws + WS_POOLO), 512};
            pg8::gemm_phase<EpiAct<0>, pg8::StaticOrder, true, true>(lds, g, S, E);
        }
        GSYNC();
        }
        REPEAT(REP_P4) {
#pragma unroll 1
        for (int b = 0; b < 3; ++b) {
            { FRESH_IDS(I); const int M2 = (l == 1) ? ML : MA;
              pg8::Gemm g{(const bf16_t*)(ws + WS_H), (const bf16_t*)(ws + W_IN) + (size_t)(N1 + b * 1024) * 1024, M2, 1024, 1024}; pg8::StaticOrder S; S.init(M2, 1024, I.G, I.bx);
              EpiAct<1> E{(bf16_t*)(ws + WS_MERGED), 1024};
              pg8::gemm_phase<EpiAct<1>, pg8::StaticOrder, true, true>(lds, g, S, E); }
            { FRESH_IDS(I); const int M2 = (l == 1) ? ML : MA;
              const bf16_t* A = (const bf16_t*)(ws + (b == 0 ? WS_POOLO : b == 1 ? WS_DIFFO : WS_GQAO)); const bf16_t* Bt = (const bf16_t*)(ws + (b == 0 ? W_PO : b == 1 ? W_DO : W_GO));
              pg8::Gemm g{A, Bt, M2, 1024, 512}; pg8::StaticOrder S; S.init(M2, 1024, I.G, I.bx);
              EpiBranch E{(bf16_t*)(ws + WS_MERGED), (float*)(ws + WS_ACC), b};
              pg8::gemm_phase<EpiBranch, pg8::StaticOrder, true, true>(lds, g, S, E); }
        }
        GSYNC();
        }
        REPEAT(REP_P5) {
        {
            FRESH_IDS(I); const int M2 = (l == 1) ? ML : MA;
            pg8::Gemm g{(const bf16_t*)(ws + WS_MERGED), (const bf16_t*)(ws + W_O), M2, 1024, 1024}; pg8::StaticOrder S; S.init(M2, 1024, I.G, I.bx);
            EpiF32 E{(float*)(ws + WS_Y), 1024};
            pg8::gemm_phase<EpiF32, pg8::StaticOrder, true, true>(lds, g, S, E);
        }
        GSYNC();
        }
        {
            FRESH_IDS(I); const int M2 = (l == 1) ? ML : MA;
            const float* modl = (const float*)(ws + WS_MOD) + l * 5 * NMOD; float* outp = (float*)PTAB(26); float* ctxx = (float*)(ws + WS_CTX);
            norm_phase(M2, outp, ctxx, outp, ctxx, (const float*)(ws + WS_Y), modl, 2, PTAB(7) + l * 1024, (bf16*)(ws + WS_HF), PTAB(8) + l * 1024, modl, 3, 4, I.gw, I.NGW, I.lane);
        }
        GSYNC();
        REPEAT(REP_P7) {
        {
            FRESH_IDS(I); const int M2 = (l == 1) ? ML : MA;
            pg8::Gemm g{(const bf16_t*)(ws + WS_HF), (const bf16_t*)(ws + W_1), M2, DFF, 1024}; pg8::StaticOrder S; S.init(M2, DFF, I.G, I.bx);
            EpiAct<2> E{(bf16_t*)(ws + WS_U), DFF};
            pg8::gemm_phase<EpiAct<2>, pg8::StaticOrder, true, true>(lds, g, S, E);
        }
        GSYNC();
        }
        REPEAT(REP_P8) {
        {
            FRESH_IDS(I); const int M2 = (l == 1) ? ML : MA;
            pg8::Gemm g{(const bf16_t*)(ws + WS_U), (const bf16_t*)(ws + W_2), M2, 1024, DFF}; pg8::StaticOrder S; S.init(M2, 1024, I.G, I.bx);
            EpiF32 E{(float*)(ws + WS_Z), 1024};
            pg8::gemm_phase<EpiF32, pg8::StaticOrder, true, true>(lds, g, S, E);
        }
        GSYNC();
        }
        {
            FRESH_IDS(I);
            const float* modl = (const float*)(ws + WS_MOD) + l * 5 * NMOD; float* outp = (float*)PTAB(26); float* ctxx = (float*)(ws + WS_CTX);
            if (l == 0) {
                WPtrs wp{PTAB(10), PTAB(11), PTAB(12), PTAB(20), PTAB(21), PTAB(22), PTAB(23), PTAB(24), PTAB(25)};
                convert_weights(wp, 1, ws, lds, I.gw, I.NGW, I.wave, I.lane, I.gtid, I.NTH);
                norm_phase(MA, outp, ctxx, outp, ctxx, (const float*)(ws + WS_Z), modl, 5, PTAB(9) + l * 1024, (bf16*)(ws + WS_H), PTAB(6) + 1024, modl + 5 * NMOD, 0, 1, I.gw, I.NGW, I.lane);
            } else {
                norm_phase(ML, outp, ctxx, outp, ctxx, (const float*)(ws + WS_Z), modl, 5, PTAB(9) + l * 1024, nullptr, nullptr, nullptr, 0, 0, I.gw, I.NGW, I.lane);
            }
        }
        if (l == 0) GSYNC();
    }
#undef GSYNC
}

extern "C" void kernel_launch(void* const* d_in, const int* in_sizes, int n_in, void* d_out, int out_size, void* d_ws, size_t ws_size, hipStream_t stream) {
    static int grid = 0;
    if (grid == 0) {
        if (n_in != 26 || out_size != ML * DMODEL || ws_size < WS_TOTAL) { fprintf(stderr, "kernel_launch: unexpected shapes (n_in %d out %d ws %zu)\n", n_in, out_size, ws_size); grid = -1; return; }
        int dev = 0, cus = 0, per_cu = 0;
        if (hipGetDevice(&dev) != hipSuccess || hipDeviceGetAttribute(&cus, hipDeviceAttributeMultiprocessorCount, dev) != hipSuccess) { grid = -1; return; }
        if (hipFuncSetAttribute((const void*)mk_fwd, hipFuncAttributeMaxDynamicSharedMemorySize, LDS_BYTES) != hipSuccess) { fprintf(stderr, "kernel_launch: hipFuncSetAttribute failed\n"); grid = -1; return; }
        if (hipOccupancyMaxActiveBlocksPerMultiprocessor(&per_cu, (const void*)mk_fwd, NTHR, LDS_BYTES) != hipSuccess || per_cu < 1) per_cu = 1;
        (void)hipGetLastError();
        grid = cus * per_cu;
    }
    if (grid < 0) return;
    Args a{};
    for (int i = 0; i < 26; ++i) a.in[i] = (const float*)d_in[i];
    a.out = (float*)d_out; a.ws = (unsigned char*)d_ws;
    void* args[] = {&a};
    hipError_t e = hipLaunchCooperativeKernel((const void*)mk_fwd, dim3(grid), dim3(NTHR), args, LDS_BYTES, stream);
    if (e != hipSuccess) fprintf(stderr, "kernel_launch: cooperative launch failed: %s (grid %d)\n", hipGetErrorString(e), grid);
}
```

```cpp
#include <hip/hip_runtime.h>
#include <hip/hip_cooperative_groups.h>
#include <cstdio>
#include <cstdint>

namespace pg8 {
#define PG8_LAS __attribute__((address_space(3)))
typedef unsigned short bf16_t;
typedef short bf16x8 __attribute__((ext_vector_type(8)));
typedef float f32x4 __attribute__((ext_vector_type(4)));
typedef unsigned u32x4 __attribute__((ext_vector_type(4)));
constexpr int BM = 256, BK = 64, HALF = 128, HTB = HALF * BK * 2  , STAGE_BYTES = 8 * HTB, NXCD = 8, WGM = 8;

__host__ __device__ __forceinline__ int lds_byte(int r, int c) { const int st = (r >> 4) * 2 + (c >> 5), rr = r & 15, cc = c & 31, ob = rr * 64 + cc * 2; return st * 1024 + (ob ^ (((ob >> 9) & 1) << 5)); }
__host__ __device__ __forceinline__ void stage_rc(int b, int& R, int& C) { const int st = b / 1024, sb = b % 1024, swz = sb ^ (((sb >> 9) & 1) << 5); R = (st >> 1) * 16 + swz / 64; C = (st & 1) * 32 + (swz % 64) / 2; }
__host__ __device__ __forceinline__ int perm32(int rho) { const int n = rho >> 4, i = rho & 15; return 8 * (i >> 2) + 4 * n + (i & 3); }

struct Unit { int pm, pn; };
struct Gemm { const bf16_t* A; const bf16_t* Bt; int M, N, K; };

struct StaticOrder {
    int nM, nN, nwg, G, c;
    __host__ __device__ void init(int M, int N, int G_, int c_) { nM = M / BM; nN = N / BM; nwg = nM * nN; G = G_; c = c_; }
    __host__ __device__ bool next(int i, Unit& u) const {
        const long L = (long)i * G + c; if (L >= nwg) return false;
        int wgid = (int)L; { const int q = nwg / NXCD, r = nwg % NXCD, xcd = wgid % NXCD, off = wgid / NXCD; wgid = (xcd < r ? xcd * (q + 1) : r * (q + 1) + (xcd - r) * q) + off; }
        const int nig = WGM * nN, gid = wgid / nig, fm = gid * WGM, gsz = (nM - fm) < WGM ? (nM - fm) : WGM;
        u.pm = fm + ((wgid % nig) % gsz); u.pn = (wgid % nig) / gsz; return true;
    }
    __device__ __forceinline__ void a_ready(const Unit&) const {}
    __device__ __forceinline__ void done(const Unit&) const {}
};

__device__ __forceinline__ unsigned cvt_pk_bf16(float lo, float hi) { unsigned r; asm volatile("v_cvt_pk_bf16_f32 %0, %1, %2" : "=v"(r) : "v"(lo), "v"(hi)); return r; }
typedef float f32x2 __attribute__((ext_vector_type(2)));
template <class Epi, class Sched, bool ALIGN_EPI = false, bool SP2 = false>
__device__ __forceinline__ void gemm_phase(PG8_LAS unsigned char* lds, const Gemm g, const Sched& S, const Epi& E) {
    int tid_l = threadIdx.x; asm volatile("" : "+v"(tid_l)); const int tid = tid_l, wid = __builtin_amdgcn_readfirstlane(tid >> 6), lane = tid & 63, wr = wid >> 2, wc = wid & 3, fr = lane & 15, fq = lane >> 4;
    const int K = g.K, nt = K / BK;
    unsigned voffA[2], voffB[2];
#pragma unroll
    for (int i = 0; i < 2; ++i) { int R, C; stage_rc(tid * 16 + i * 8192, R, C); const int Rb = Epi::PERM ? ((R & ~31) + perm32(R & 31)) : R;
        voffA[i] = (unsigned)(R * K + C) * 2u; voffB[i] = (unsigned)(Rb * K + C) * 2u; }
    const size_t kstep = (size_t)(BK * 2);
    const size_t hstep = (size_t)HALF * K * 2;
    const size_t tstep = 2 * hstep;
    const unsigned ldsw = (unsigned)wid * 1024u;
    const int aoff = lds_byte(wr * 64 + fr, fq * 8), boff = lds_byte(wc * 32 + fr, fq * 8);
#define PG8_SA(b, h) (((b) * 2 + (h)) * HTB)
#define PG8_SB(b, h) ((4 + (b) * 2 + (h)) * HTB)
#define PG8_STAGE(bufoff, gbase, voff) do { _Pragma("unroll") for (int _i = 0; _i < 2; ++_i) \
        __builtin_amdgcn_global_load_lds((const unsigned*)((const char*)(gbase) + (voff)[_i]), (PG8_LAS unsigned*)(lds + (bufoff) + ldsw + _i * 8192), 16, 0, 0); } while (0)
#define PG8_LDA(dst, b, h) do { _Pragma("unroll") for (int m = 0; m < 4; ++m) _Pragma("unroll") for (int k = 0; k < 2; ++k) dst[m][k] = *(const PG8_LAS bf16x8*)(lds + PG8_SA(b, h) + aoff + m * 2048 + k * 1024); } while (0)
#define PG8_LDB(dst, b, h) do { _Pragma("unroll") for (int n = 0; n < 2; ++n) _Pragma("unroll") for (int k = 0; k < 2; ++k) dst[n][k] = *(const PG8_LAS bf16x8*)(lds + PG8_SB(b, h) + boff + n * 2048 + k * 1024); } while (0)
#define PG8_MMA(ai, bj, At, Bt) do { __builtin_amdgcn_s_setprio(1); _Pragma("unroll") for (int m = 0; m < 4; ++m) _Pragma("unroll") for (int n = 0; n < 2; ++n) _Pragma("unroll") for (int k = 0; k < 2; ++k) \
        acc[ai][bj][m][n] = __builtin_amdgcn_mfma_f32_16x16x32_bf16(Bt[n][k], At[m][k], acc[ai][bj][m][n], 0, 0, 0); __builtin_amdgcn_s_setprio(0); } while (0)
#define PG8_WAIT_V(n) asm volatile("s_waitcnt vmcnt(" #n ")" ::: "memory")
#define PG8_WAIT_L(n) asm volatile("s_waitcnt lgkmcnt(" #n ")" ::: "memory")
#define PG8_BAR __builtin_amdgcn_s_barrier()
#define PG8_SCHED __builtin_amdgcn_sched_barrier(0)
    Unit cur, nxt; int ui = 0;
    if (!S.next(0, cur)) return;
    f32x4 acc[2][2][4][2];
#pragma unroll
    for (int a = 0; a < 2; ++a)
#pragma unroll
        for (int b = 0; b < 2; ++b)
#pragma unroll
            for (int m = 0; m < 4; ++m)
#pragma unroll
                for (int n = 0; n < 2; ++n) acc[a][b][m][n] = (f32x4){0.f, 0.f, 0.f, 0.f};
    bf16x8 At[4][2], B0[2][2], B1[2][2];
    const char* cA = (const char*)g.A + (size_t)cur.pm * tstep; const char* cB = (const char*)g.Bt + (size_t)cur.pn * tstep;
    S.a_ready(cur);
    if constexpr (SP2) {
        PG8_STAGE(PG8_SB(0, 0), cB, voffB); PG8_STAGE(PG8_SB(0, 1), cB + hstep, voffB); PG8_STAGE(PG8_SA(0, 0), cA, voffA); PG8_STAGE(PG8_SA(0, 1), cA + hstep, voffA);
        if (wr == 1) PG8_BAR;
        PG8_WAIT_V(2); PG8_BAR;
        PG8_STAGE(PG8_SB(1, 0), cB + kstep, voffB); PG8_STAGE(PG8_SA(1, 0), cA + kstep, voffA); PG8_STAGE(PG8_SB(1, 1), cB + hstep + kstep, voffB);
        PG8_WAIT_V(6); PG8_BAR;
    } else {
        PG8_STAGE(PG8_SB(0, 0), cB, voffB); PG8_STAGE(PG8_SA(0, 0), cA, voffA); PG8_STAGE(PG8_SB(0, 1), cB + hstep, voffB); PG8_STAGE(PG8_SA(0, 1), cA + hstep, voffA);
        if (wr == 1) PG8_BAR;
        PG8_WAIT_V(4); PG8_BAR;
        PG8_STAGE(PG8_SB(1, 0), cB + kstep, voffB); PG8_STAGE(PG8_SA(1, 0), cA + kstep, voffA); PG8_STAGE(PG8_SB(1, 1), cB + hstep + kstep, voffB);
        PG8_WAIT_V(6); PG8_BAR;
    }
    for (;;) {
        const bool has_next = S.next(ui + 1, nxt);
        const char* nA = has_next ? (const char*)g.A + (size_t)nxt.pm * tstep : cA; const char* nB = has_next ? (const char*)g.Bt + (size_t)nxt.pn * tstep : cB;
        for (int t = 0; t < nt; t += 2) {
            const bool last = (t == nt - 2);
            const char* a1 = cA + (size_t)(t + 1) * kstep;
            const char* a2 = last ? nA : cA + (size_t)(t + 2) * kstep; const char* b2 = last ? nB : cB + (size_t)(t + 2) * kstep;
            const char* a3 = a2 + kstep; const char* b3 = b2 + kstep;
            if (last && has_next) S.a_ready(nxt);
            if constexpr (SP2) {
            PG8_LDB(B0, 0, 0); PG8_LDB(B1, 0, 1); PG8_SCHED; PG8_LDA(At, 0, 0); PG8_STAGE(PG8_SA(1, 1), a1 + hstep, voffA);
            PG8_WAIT_V(8); PG8_WAIT_L(0); PG8_BAR; PG8_MMA(0, 0, At, B0); PG8_MMA(0, 1, At, B1); PG8_BAR; PG8_SCHED;
            PG8_LDA(At, 0, 1); PG8_STAGE(PG8_SB(0, 0), b2, voffB); PG8_STAGE(PG8_SB(0, 1), b2 + hstep, voffB); PG8_STAGE(PG8_SA(0, 0), a2, voffA);
            PG8_WAIT_V(8); PG8_WAIT_L(0); PG8_BAR; PG8_MMA(1, 0, At, B0); PG8_MMA(1, 1, At, B1); PG8_BAR; PG8_SCHED;
            PG8_LDB(B0, 1, 0); PG8_LDB(B1, 1, 1); PG8_SCHED; PG8_LDA(At, 1, 0); PG8_STAGE(PG8_SA(0, 1), a2 + hstep, voffA);
            PG8_WAIT_V(8); PG8_WAIT_L(0); PG8_BAR; PG8_MMA(0, 0, At, B0); PG8_MMA(0, 1, At, B1); PG8_BAR; PG8_SCHED;
            PG8_LDA(At, 1, 1); PG8_STAGE(PG8_SB(1, 0), b3, voffB); PG8_STAGE(PG8_SB(1, 1), b3 + hstep, voffB); PG8_STAGE(PG8_SA(1, 0), a3, voffA);
            PG8_WAIT_V(8); PG8_WAIT_L(0); PG8_BAR; PG8_MMA(1, 0, At, B0); PG8_MMA(1, 1, At, B1); PG8_BAR; PG8_SCHED;
            } else {
            PG8_LDB(B0, 0, 0); PG8_SCHED; PG8_LDA(At, 0, 0); PG8_STAGE(PG8_SA(1, 1), a1 + hstep, voffA);
            PG8_WAIT_L(8); PG8_BAR; PG8_WAIT_L(0); PG8_MMA(0, 0, At, B0); PG8_BAR; PG8_SCHED;
            PG8_LDB(B1, 0, 1); PG8_STAGE(PG8_SB(0, 0), b2, voffB);
            PG8_BAR; PG8_WAIT_L(0); PG8_MMA(0, 1, At, B1); PG8_BAR;
            PG8_LDA(At, 0, 1); PG8_STAGE(PG8_SA(0, 0), a2, voffA);
            PG8_BAR; PG8_WAIT_L(0); PG8_MMA(1, 0, At, B0); PG8_BAR; PG8_SCHED;
            PG8_STAGE(PG8_SB(0, 1), b2 + hstep, voffB);
            PG8_WAIT_V(6); PG8_BAR; PG8_MMA(1, 1, At, B1); PG8_BAR;
            PG8_LDB(B0, 1, 0); PG8_SCHED; PG8_LDA(At, 1, 0); PG8_STAGE(PG8_SA(0, 1), a2 + hstep, voffA);
            PG8_WAIT_L(8); PG8_BAR; PG8_WAIT_L(0); PG8_MMA(0, 0, At, B0); PG8_BAR; PG8_SCHED;
            PG8_LDB(B1, 1, 1); PG8_STAGE(PG8_SB(1, 0), b3, voffB);
            PG8_BAR; PG8_WAIT_L(0); PG8_MMA(0, 1, At, B1); PG8_BAR;
            PG8_LDA(At, 1, 1); PG8_STAGE(PG8_SA(1, 0), a3, voffA);
            PG8_BAR; PG8_WAIT_L(0); PG8_MMA(1, 0, At, B0); PG8_BAR; PG8_SCHED;
            PG8_STAGE(PG8_SB(1, 1), b3 + hstep, voffB);
            PG8_WAIT_V(6); PG8_BAR; PG8_MMA(1, 1, At, B1); PG8_BAR;
            }
        }
        if constexpr (ALIGN_EPI) { if (wr == 0) PG8_BAR; }
        if constexpr (!Epi::AFTER_DRAIN) { E(acc, cur, wr, wc, fr, fq); S.done(cur); }
        if (!has_next) break;
#pragma unroll
        for (int a = 0; a < 2; ++a)
#pragma unroll
            for (int b = 0; b < 2; ++b)
#pragma unroll
                for (int m = 0; m < 4; ++m)
#pragma unroll
                    for (int n = 0; n < 2; ++n) acc[a][b][m][n] = (f32x4){0.f, 0.f, 0.f, 0.f};
        cur = nxt; cA = nA; cB = nB; ++ui;
        if constexpr (ALIGN_EPI) { if (wr == 1) PG8_BAR; }
    }
    PG8_WAIT_V(0);
    if constexpr (!ALIGN_EPI) { if (wr == 0) PG8_BAR; }
    PG8_BAR;
    if constexpr (Epi::AFTER_DRAIN) { E.fused(acc, cur, wr, wc, fr, fq, lds, wid, lane); S.done(cur); }
#undef PG8_SA
#undef PG8_SB
#undef PG8_STAGE
#undef PG8_LDA
#undef PG8_LDB
#undef PG8_MMA
#undef PG8_WAIT_V
#undef PG8_WAIT_L
#undef PG8_BAR
#undef PG8_SCHED
}
}
#include <hip/hip_bf16.h>
#include <cmath>
namespace attn_body {
using bf16=__hip_bfloat16;
using bf16x8=__attribute__((ext_vector_type(8)))short;
using s16x4=__attribute__((ext_vector_type(4)))short;
using f32x16=__attribute__((ext_vector_type(16)))float;
using u32x4=__attribute__((ext_vector_type(4)))unsigned;
constexpr int D=64;
constexpr int NW=8,QBLK=32,QB=QBLK*NW,KVBLK=64;
constexpr int ATTN_UNIT_ROWS=QB;
__device__ __forceinline__ int crow(int r,int hi){return (r&3)+8*(r>>2)+4*hi;}
#define SBAR() __builtin_amdgcn_sched_barrier(0)
__device__ __forceinline__ void cmask(f32x16&p0,f32x16&p1,int jb,int qrel,int hi){
  const float NEG=-INFINITY; int kb=64*jb+4*hi;
  #pragma unroll
  for(int r=0;r<16;++r){int kv=kb+(r&3)+8*(r>>2); if(kv>qrel)p0[r]=NEG; if(kv+32>qrel)p1[r]=NEG;}
}

constexpr int NSLOT=3, SLOTB=8192;
constexpr int LDS_K=0, LDS_V=NSLOT*SLOTB, LDS_WS=2*NSLOT*SLOTB, LDS_OST=LDS_WS+NW*64*4, LDS_BYTES=LDS_OST+NW*4096;
constexpr float C2=0.125f*1.4426950408889634f;
__device__ __forceinline__ void glds16(const void*gsrc,unsigned lds_dst){unsigned keep;
  asm volatile("s_mov_b32 %0, m0\n\ts_mov_b32 m0, %2\n\ts_nop 0\n\tglobal_load_lds_dwordx4 %1, off\n\ts_mov_b32 m0, %0":"=&s"(keep):"v"(gsrc),"s"(lds_dst):"memory");}
__device__ __forceinline__ float max3f(float a,float b,float c){float r;asm("v_max3_f32 %0, %1, %2, %3":"=v"(r):"v"(a),"v"(b),"v"(c));return r;}
__device__ __forceinline__ float max2f(float a,float b){float r;asm("v_max_f32_e32 %0, %1, %2":"=v"(r):"v"(a),"v"(b));return r;}
__device__ __forceinline__ float fadd_s(float a,float b){float r;asm("v_add_f32_e32 %0, %1, %2":"=v"(r):"v"(a),"v"(b));return r;}
__device__ __forceinline__ float fsub_s(float a,float b){float r;asm("v_sub_f32_e32 %0, %1, %2":"=v"(r):"v"(a),"v"(b));return r;}
typedef float f32x2_t __attribute__((ext_vector_type(2))); typedef __bf16 bf16x2_t __attribute__((ext_vector_type(2)));
__device__ __forceinline__ unsigned cvtpk_s(float lo,float hi){f32x2_t v={lo,hi};bf16x2_t b=__builtin_convertvector(v,bf16x2_t);return __builtin_bit_cast(unsigned,b);}
#define WAIT_BAR(N) asm volatile("s_waitcnt vmcnt(" #N ") lgkmcnt(0)\n\ts_barrier":::"memory")

__device__ __forceinline__ void qkt(f32x16&p0,f32x16&p1,const char*Kslot,const bf16x8*qr,const f32x16&negm,int r32,int hi){
  const char*kb=Kslot+hi*1024+r32*16;
  #pragma unroll
  for(int d0=0;d0<4;++d0){
    const bf16x8 b0=*reinterpret_cast<const bf16x8*>(kb+d0*2048);
    const bf16x8 b1=*reinterpret_cast<const bf16x8*>(kb+d0*2048+512);
    if(d0==0){p0=__builtin_amdgcn_mfma_f32_32x32x16_bf16(b0,qr[0],negm,0,0,0);p1=__builtin_amdgcn_mfma_f32_32x32x16_bf16(b1,qr[0],negm,0,0,0);}
    else{p0=__builtin_amdgcn_mfma_f32_32x32x16_bf16(b0,qr[d0],p0,0,0,0);p1=__builtin_amdgcn_mfma_f32_32x32x16_bf16(b1,qr[d0],p1,0,0,0);}}
}
typedef __attribute__((address_space(3))) const char* lds_cptr;
typedef short v4i16_t __attribute__((ext_vector_type(4)));
__device__ __forceinline__ void kload8(bf16x8*kf,lds_cptr kp){
  kf[0]=*(const __attribute__((address_space(3))) bf16x8*)(kp);      kf[1]=*(const __attribute__((address_space(3))) bf16x8*)(kp+512);
  kf[2]=*(const __attribute__((address_space(3))) bf16x8*)(kp+2048); kf[3]=*(const __attribute__((address_space(3))) bf16x8*)(kp+2560);
  kf[4]=*(const __attribute__((address_space(3))) bf16x8*)(kp+4096); kf[5]=*(const __attribute__((address_space(3))) bf16x8*)(kp+4608);
  kf[6]=*(const __attribute__((address_space(3))) bf16x8*)(kp+6144); kf[7]=*(const __attribute__((address_space(3))) bf16x8*)(kp+6656);
}
__device__ __forceinline__ void kload2(bf16x8*kf,lds_cptr kp,int j){ kf[2*j]=*(const __attribute__((address_space(3))) bf16x8*)(kp+j*2048); kf[2*j+1]=*(const __attribute__((address_space(3))) bf16x8*)(kp+j*2048+512); }
__device__ __forceinline__ s16x4 vtr(lds_cptr p){ return __builtin_bit_cast(s16x4,__builtin_amdgcn_ds_read_tr16_b64_v4i16((__attribute__((address_space(3))) v4i16_t*)p)); }
__device__ __forceinline__ float rowmax(const f32x16&p0,const f32x16&p1){
  float a=max3f(p0[0],p0[1],p1[0]),b=max3f(p0[2],p0[3],p1[1]);a=max3f(a,p1[2],p1[3]);
  #pragma unroll
  for(int r=4;r<16;r+=4){a=max3f(a,p0[r],p0[r+1]);b=max3f(b,p0[r+2],p0[r+3]);a=max3f(a,p1[r],p1[r+1]);b=max3f(b,p1[r+2],p1[r+3]);}
  const float m=max2f(a,b);
  auto rr=__builtin_amdgcn_permlane32_swap(__float_as_uint(m),__float_as_uint(m),false,false);
  return max2f(__uint_as_float(rr[0]),__uint_as_float(rr[1]));
}
__device__ __forceinline__ void pv(f32x16*o,int vb,bf16x8 pa0,bf16x8 pa1,bf16x8 pa2,bf16x8 pa3){
  #pragma unroll
  for(int d0=0;d0<2;++d0){s16x4 lo[4],hi[4];
    #pragma unroll
    for(int ks=0;ks<4;++ks){
      asm volatile("ds_read_b64_tr_b16 %0,%1 offset:%c2":"=&v"(lo[ks]):"v"(vb),"i"(d0*4096+ks*1024):"memory");
      asm volatile("ds_read_b64_tr_b16 %0,%1 offset:%c2":"=&v"(hi[ks]):"v"(vb),"i"(d0*4096+ks*1024+512):"memory");}
    asm volatile("s_waitcnt lgkmcnt(0)":::"memory");SBAR();
    #define PK(k) (bf16x8){lo[k][0],lo[k][1],lo[k][2],lo[k][3],hi[k][0],hi[k][1],hi[k][2],hi[k][3]}
    o[d0]=__builtin_amdgcn_mfma_f32_32x32x16_bf16(pa0,PK(0),o[d0],0,0,0);
    o[d0]=__builtin_amdgcn_mfma_f32_32x32x16_bf16(pa1,PK(1),o[d0],0,0,0);
    o[d0]=__builtin_amdgcn_mfma_f32_32x32x16_bf16(pa2,PK(2),o[d0],0,0,0);
    o[d0]=__builtin_amdgcn_mfma_f32_32x32x16_bf16(pa3,PK(3),o[d0],0,0,0);
    #undef PK
  }
}

#ifndef ATTN_STORE16
#define ATTN_STORE16(p,v) (*(u32x4*)(p)=(v))
#endif
template<int THRL> __device__ __forceinline__ void attn_unit(const bf16*Qw0,int pqs,const bf16*__restrict__ Kh,int pks,const bf16*__restrict__ Vh,int pvs,bf16*Ow0,int pos_,const int NT,char*shm){
  int tid_l=threadIdx.x; asm volatile("":"+v"(tid_l)); const int tid=tid_l,lane=tid&63,r32=lane&31,hi=lane>>5; const int wid=__builtin_amdgcn_readfirstlane(tid>>6);
  const bf16*Qw=Qw0+(long)(wid*QBLK)*pqs;
  const unsigned lds0=(unsigned)(uintptr_t)shm;
  float*wsf=(float*)(shm+LDS_WS)+wid*64;
  const bf16*ksrc=Kh+(long)lane*pks+wid*8;
  const bf16*vsrc=Vh+(long)(16*(wid&3)+(lane>>2))*pvs+(wid>>2)*32+(lane&3)*8;
  const unsigned kdst=lds0+LDS_K+wid*1024, vdst=lds0+LDS_V+wid*1024;
  #define DMA_K(t,slot) glds16(ksrc+(long)(t)*KVBLK*pks,(unsigned)__builtin_amdgcn_readfirstlane(kdst+(slot)))
  #define DMA_V(t,slot) glds16(vsrc+(long)(t)*KVBLK*pvs,(unsigned)__builtin_amdgcn_readfirstlane(vdst+(slot)))
  const int vb0=(int)(lds0+LDS_V)+((lane>>4)&1)*32+(lane&3)*8+(4*hi+((lane&15)>>2))*64;
  const char*Kbase=shm+LDS_K; bf16x8 kf[8];
  const lds_cptr shm3=(lds_cptr)shm; const lds_cptr kp0=shm3+LDS_K+hi*1024+r32*16; const lds_cptr vp0=shm3+LDS_V+((lane>>4)&1)*32+(lane&3)*8+(4*hi+((lane&15)>>2))*64;
  DMA_K(0,0);DMA_V(0,0);DMA_K(1,SLOTB);
  bf16x8 qr[4];
  #pragma unroll
  for(int d0=0;d0<4;++d0)qr[d0]=*reinterpret_cast<const bf16x8*>(&Qw[(long)r32*pqs+d0*16+hi*8]);
  float mhat=0.f,l_reg=0.f;f32x16 o[2];o[0]=f32x16{};o[1]=f32x16{};f32x16 negm=f32x16{};asm volatile("":"+v"(negm));
  #define CMASK(P0,P1,t) do{}while(0)
  bool resc=false;
  #define START(P0,P1) do{ const float rm=rowmax(P0,P1); resc=false; \
    { const float dl=rm; mhat=fadd_s(mhat,dl); \
      _Pragma("unroll") for(int r=0;r<16;++r){P0[r]=fsub_s(P0[r],dl);P1[r]=fsub_s(P1[r],dl);} \
      _Pragma("unroll") for(int r=0;r<16;++r)negm[r]=-mhat; asm volatile("":"+v"(negm)); } \
    _Pragma("unroll") for(int r=0;r<16;++r)P0[r]=__builtin_amdgcn_exp2f(P0[r]); }while(0)
  #define RESC() do{ if(resc){ asm volatile("s_waitcnt lgkmcnt(0)":::"memory"); \
      _Pragma("unroll") for(int d_=0;d_<2;++d_) _Pragma("unroll") for(int r=0;r<16;++r)o[d_][r]*=wsf[crow(r,hi)]; } }while(0)
  f32x16 pA0,pA1,pB0,pB1;
  int sl_prev=0,sl_cur=0,sl_next=SLOTB;
  #define ROT() do{sl_prev=sl_cur;sl_cur=sl_next;sl_next=(sl_next==(NSLOT-1)*SLOTB)?0:sl_next+SLOTB;}while(0)
  DMA_K(2,2*SLOTB);
  WAIT_BAR(3);
  qkt(pA0,pA1,Kbase,qr,negm,r32,hi);asm volatile("s_nop 15\n\ts_nop 7":"+v"(pA0),"+v"(pA1));CMASK(pA0,pA1,0);
  START(pA0,pA1);
  _Pragma("unroll") for(int r=0;r<16;++r)pA1[r]=__builtin_amdgcn_exp2f(pA1[r]);
  WAIT_BAR(0);
  DMA_K(3,0);DMA_V(1,SLOTB);
  ROT();
  kload8(kf,kp0+sl_cur);
  WAIT_BAR(2);
  s16x4 vlo[8],vhi[8]; u32x4 pw0,pw1,pw2,pw3;
  #define PKW(P,B) cvtpk_s(P[B],P[B+1])
  #define PAF(k) __builtin_bit_cast(bf16x8,pw##k)
  #define VFR(i) (bf16x8){vlo[i][0],vlo[i][1],vlo[i][2],vlo[i][3],vhi[i][0],vhi[i][1],vhi[i][2],vhi[i][3]}
  #define PIN(x) asm volatile("":"+v"(x))
  #define MX3(a,b,c) __builtin_fmaxf(__builtin_fmaxf((a),(b)),(c))
  #define GAPA(MF,A0,A1,A2,A3,W0,W1,PW) do{ MF; sacc+=A0; sacc+=A1; sacc+=A2; sacc+=A3; PIN(sacc); W0; W1; PIN(PW); SBAR(); }while(0)
  #define EX(v) __builtin_amdgcn_exp2f(v)
  #define GAPB(MF,X,B) do{ MF; X[B]=EX(X[B]); X[B+1]=EX(X[B+1]); X[B+2]=EX(X[B+2]); X[B+3]=EX(X[B+3]); PIN(X); SBAR(); }while(0)
  #define VRD(i) do{ vlo[i]=vtr(vp_+(((i)>>2)*4096+((i)&3)*1024)); vhi[i]=vtr(vp_+(((i)>>2)*4096+((i)&3)*1024+512)); }while(0)
  #define KRD(G,j) do{ if(G){ kload2(kf,kp0+sl_next,j); SBAR(); } }while(0)
  #define STEP(C0,C1,P0,P1,t,GK,GV,GL) do{ SBAR(); \
    const lds_cptr vp_=vp0+sl_prev; \
    VRD(0); SBAR(); float sacc=(P0[0]+P0[1]); \
    GAPA(C0=__builtin_amdgcn_mfma_f32_32x32x16_bf16(kf[0],qr[0],negm,0,0,0), P0[2],P0[3],P0[4],P0[5],     pw0[0]=PKW(P0,0), pw0[1]=PKW(P0,2), pw0); \
    VRD(4); SBAR(); GAPA(C1=__builtin_amdgcn_mfma_f32_32x32x16_bf16(kf[1],qr[0],negm,0,0,0), P0[6],P0[7],P0[8],P0[9],     pw0[2]=PKW(P0,4), pw0[3]=PKW(P0,6), pw0); \
    VRD(1); SBAR(); GAPA(C0=__builtin_amdgcn_mfma_f32_32x32x16_bf16(kf[2],qr[1],C0,0,0,0),   P0[10],P0[11],P0[12],P0[13], pw1[0]=PKW(P0,8), pw1[1]=PKW(P0,10), pw1); \
    VRD(5); SBAR(); GAPA(C1=__builtin_amdgcn_mfma_f32_32x32x16_bf16(kf[3],qr[1],C1,0,0,0),   P0[14],P0[15],P1[0],P1[1],   pw1[2]=PKW(P0,12),pw1[3]=PKW(P0,14), pw1); \
    VRD(2); SBAR(); GAPA(C0=__builtin_amdgcn_mfma_f32_32x32x16_bf16(kf[4],qr[2],C0,0,0,0),   P1[2],P1[3],P1[4],P1[5],     pw2[0]=PKW(P1,0), pw2[1]=PKW(P1,2), pw2); \
    VRD(6); SBAR(); GAPA(C1=__builtin_amdgcn_mfma_f32_32x32x16_bf16(kf[5],qr[2],C1,0,0,0),   P1[6],P1[7],P1[8],P1[9],     pw2[2]=PKW(P1,4), pw2[3]=PKW(P1,6), pw2); \
    VRD(3); SBAR(); GAPA(C0=__builtin_amdgcn_mfma_f32_32x32x16_bf16(kf[6],qr[3],C0,0,0,0),   P1[10],P1[11],P1[12],P1[13], pw3[0]=PKW(P1,8), pw3[1]=PKW(P1,10), pw3); \
    VRD(7); SBAR(); GAPA(C1=__builtin_amdgcn_mfma_f32_32x32x16_bf16(kf[7],qr[3],C1,0,0,0),   P1[14],P1[15],0.f,0.f,       pw3[2]=PKW(P1,12),pw3[3]=PKW(P1,14), pw3); \
    l_reg+=sacc; \
    if(GK){DMA_K((t)+3,sl_cur);} if(GV){DMA_V((t)+1,sl_next);} \
    CMASK(C0,C1,t); \
    { float a=MX3(C0[0],C0[1],C1[0]),b=MX3(C0[2],C0[3],C1[1]); a=MX3(a,C1[2],C1[3]); \
      _Pragma("unroll") for(int r=4;r<16;r+=4){a=MX3(a,C0[r],C0[r+1]);b=MX3(b,C0[r+2],C0[r+3]);a=MX3(a,C1[r],C1[r+1]);b=MX3(b,C1[r+2],C1[r+3]);} \
      float rm=__builtin_fmaxf(a,b); { auto rr=__builtin_amdgcn_permlane32_swap(__float_as_uint(rm),__float_as_uint(rm),false,false); rm=__builtin_fmaxf(__uint_as_float(rr[0]),__uint_as_float(rr[1])); } \
      resc=false; \
      if(__builtin_expect(__any(rm>(float)THRL),0)){ const float dl=__builtin_fmaxf(rm,0.f); mhat+=dl; \
        _Pragma("unroll") for(int r=0;r<16;++r){C0[r]-=dl;C1[r]-=dl;} \
        _Pragma("unroll") for(int r=0;r<16;++r)negm[r]=-mhat; asm volatile("":"+v"(negm)); \
        const float f=__builtin_amdgcn_exp2f(-dl); l_reg*=f; if(hi==0)wsf[r32]=f; resc=true; } } \
    SBAR(); \
    GAPB(o[0]=__builtin_amdgcn_mfma_f32_32x32x16_bf16(PAF(0),VFR(0),o[0],0,0,0), C0,0); \
    GAPB(o[1]=__builtin_amdgcn_mfma_f32_32x32x16_bf16(PAF(0),VFR(4),o[1],0,0,0), C0,4); \
    KRD(GL,0); GAPB(o[0]=__builtin_amdgcn_mfma_f32_32x32x16_bf16(PAF(1),VFR(1),o[0],0,0,0), C0,8); \
    KRD(GL,1); GAPB(o[1]=__builtin_amdgcn_mfma_f32_32x32x16_bf16(PAF(1),VFR(5),o[1],0,0,0), C0,12); \
    KRD(GL,2); GAPB(o[0]=__builtin_amdgcn_mfma_f32_32x32x16_bf16(PAF(2),VFR(2),o[0],0,0,0), C1,0); \
    KRD(GL,3); GAPB(o[1]=__builtin_amdgcn_mfma_f32_32x32x16_bf16(PAF(2),VFR(6),o[1],0,0,0), C1,4); \
    GAPB(o[0]=__builtin_amdgcn_mfma_f32_32x32x16_bf16(PAF(3),VFR(3),o[0],0,0,0), C1,8); \
    GAPB(o[1]=__builtin_amdgcn_mfma_f32_32x32x16_bf16(PAF(3),VFR(7),o[1],0,0,0), C1,12); \
    }while(0)
  int t=1;
  #undef CMASK
  #define CMASK(P0,P1,t) do{}while(0)
  for(;t+5<NT;t+=2){
    STEP(pB0,pB1,pA0,pA1,t,true,true,true);     WAIT_BAR(2); RESC(); ROT();
    STEP(pA0,pA1,pB0,pB1,t+1,true,true,true);   WAIT_BAR(2); RESC(); ROT();
  }
  #undef CMASK
  #define CMASK(P0,P1,t) do{}while(0)
  #define ENDW(tt) do{ if((tt)+3<NT){WAIT_BAR(2);} else if((tt)+2<NT){WAIT_BAR(1);} else {WAIT_BAR(0);} }while(0)
  for(;t+1<NT;t+=2){
    STEP(pB0,pB1,pA0,pA1,t,(t+3<NT),(t+1<NT),(t+1<NT));       ENDW(t);   RESC(); ROT();
    STEP(pA0,pA1,pB0,pB1,t+1,(t+4<NT),(t+2<NT),(t+2<NT));     ENDW(t+1); RESC(); ROT();
  }
  STEP(pB0,pB1,pA0,pA1,NT-1,false,false,false); RESC();
  { float sacc=pB0[0]+pB0[1]; _Pragma("unroll") for(int r=2;r<16;++r)sacc+=pB0[r]; _Pragma("unroll") for(int r=0;r<16;++r)sacc+=pB1[r]; l_reg+=sacc;
    pw0=(u32x4){PKW(pB0,0),PKW(pB0,2),PKW(pB0,4),PKW(pB0,6)};pw1=(u32x4){PKW(pB0,8),PKW(pB0,10),PKW(pB0,12),PKW(pB0,14)};pw2=(u32x4){PKW(pB1,0),PKW(pB1,2),PKW(pB1,4),PKW(pB1,6)};pw3=(u32x4){PKW(pB1,8),PKW(pB1,10),PKW(pB1,12),PKW(pB1,14)};
    SBAR(); pv(o,vb0+sl_cur,PAF(0),PAF(1),PAF(2),PAF(3)); }
  #undef PKW
  #undef PAF
  #undef VFR
  #undef PIN
  #undef MX3
  #undef GAPA
  #undef GAPB
  #undef EX
  #undef VRD
  #undef KRD
  #undef STEP
  #undef ENDW
  {auto rr=__builtin_amdgcn_permlane32_swap(__float_as_uint(l_reg),__float_as_uint(l_reg),false,false);l_reg=__uint_as_float(rr[0])+__uint_as_float(rr[1]);}
  if(hi==0)wsf[32+r32]=l_reg;asm volatile("s_waitcnt lgkmcnt(0)":::"memory");
  float rli[16];
  #pragma unroll
  for(int r=0;r<16;++r)rli[r]=__builtin_amdgcn_rcpf(wsf[32+crow(r,hi)]);
  bf16*Ow=Ow0+(long)(wid*QBLK)*pos_;
  { bf16*stg=(bf16*)(shm+LDS_OST)+wid*2048;
    #pragma unroll
    for(int r=0;r<16;++r){const int orow=crow(r,hi);
      #pragma unroll
      for(int d0=0;d0<2;++d0)stg[orow*64+d0*32+r32]=__float2bfloat16(o[d0][r]*rli[r]);}
    asm volatile("s_waitcnt lgkmcnt(0)":::"memory");
    #pragma unroll
    for(int i=0;i<4;++i){const int row=i*8+(lane>>3),ch=lane&7; const u32x4 v=*(const u32x4*)(stg+row*64+ch*8); ATTN_STORE16(Ow+(long)row*pos_+ch*8,v);} }
  asm volatile("s_waitcnt lgkmcnt(0)\n\ts_barrier":::"memory");
  #undef DMA_K
  #undef DMA_V
  #undef CMASK
  #undef START
  #undef RESC
  #undef ROT
}
constexpr int ATTN_LDS_BYTES=LDS_BYTES;
#undef SBAR
#undef WAIT_BAR
}
namespace cg = cooperative_groups;
#define LAS __attribute__((address_space(3)))
typedef unsigned short bf16;
typedef unsigned v4u __attribute__((ext_vector_type(4)));
typedef unsigned v2u __attribute__((ext_vector_type(2)));
typedef float f32x4 __attribute__((ext_vector_type(4)));
using pg8::bf16_t;

constexpr int DMODEL = 1024, NBATCH = 4, SEQL = 4096, CTXL = 256, LKV = SEQL + CTXL, ML = NBATCH * SEQL, MC = NBATCH * CTXL, MA = ML + MC, DFF = 4096, N1 = 2816, NMOD = 6 * DMODEL;
constexpr float EPSN = 1e-6f;
constexpr float QC2 = 0.125f * 1.4426950408889634f;
constexpr int NTHR = 512;
constexpr int LDS_BYTES = 147456;

constexpr size_t MiB = 1u << 20;
constexpr size_t WS_MOD = 0, WS_ROPE = 256 * 1024;
constexpr size_t W_IN = 2 * MiB, W_POOL = W_IN + (size_t)5888 * 1024 * 2, W_PO = W_POOL + 512 * 512 * 2, W_DO = W_PO + 1024 * 512 * 2, W_GO = W_DO + 1024 * 512 * 2,
                 W_O = W_GO + 1024 * 512 * 2, W_1 = W_O + 1024 * 1024 * 2, W_2 = W_1 + (size_t)4096 * 1024 * 2, W_END = W_2 + (size_t)4096 * 1024 * 2;
static_assert(W_END <= 36 * MiB, "weights");
constexpr size_t WS_CTX = 36 * MiB, WS_H = 40 * MiB;
constexpr size_t WS_POOLIN = 74 * MiB, WS_QD = 91 * MiB, WS_QG = 108 * MiB, WS_KD = 125 * MiB, WS_VD = 142 * MiB, WS_KG = 159 * MiB, WS_VG = WS_KG + (size_t)MA * 128 * 2;
constexpr size_t WS_OD = 176 * MiB, WS_GQAO = 210 * MiB, WS_POOLED = 227 * MiB;
constexpr size_t WS_DIFFO = 74 * MiB, WS_POOLO = 91 * MiB, WS_MERGED = 108 * MiB, WS_ACC = 142 * MiB, WS_Y = 142 * MiB, WS_HF = 210 * MiB, WS_U = 40 * MiB, WS_Z = 176 * MiB;
constexpr size_t WS_TOTAL = 244 * MiB;
static_assert(WS_VG + (size_t)MA * 128 * 2 <= 176 * MiB, "p1 outs");

struct Args { const float* in[26]; float* out; unsigned char* ws; };

__device__ __forceinline__ unsigned f2bf(float f) { unsigned u = __builtin_bit_cast(unsigned, f); return (u + 0x7fffu + ((u >> 16) & 1u)) >> 16; }
__device__ __forceinline__ unsigned pk2(float lo, float hi) { return f2bf(lo) | (f2bf(hi) << 16); }
__device__ __forceinline__ float bflo(unsigned w) { return __builtin_bit_cast(float, w << 16); }
__device__ __forceinline__ float bfhi(unsigned w) { return __builtin_bit_cast(float, w & 0xffff0000u); }
__device__ __forceinline__ float wave_sum(float v) {
#pragma unroll
    for (int o = 1; o < 64; o <<= 1) v += __shfl_xor(v, o);
    return v;
}

template <int ACT  > struct EpiAct {
    static constexpr bool PERM = true, AFTER_DRAIN = false;
    bf16_t* O; int ldc;
    __device__ __forceinline__ void operator()(const pg8::f32x4 (&acc)[2][2][4][2], const pg8::Unit& u, int wr, int wc, int fr, int fq) const {
        const int row0 = u.pm * 256 + wr * 64 + fr, col0 = u.pn * 256 + wc * 32 + 8 * fq;
#pragma unroll
        for (int ai = 0; ai < 2; ++ai)
#pragma unroll
            for (int m = 0; m < 4; ++m) { bf16_t* rowp = O + (size_t)(row0 + ai * 128 + m * 16) * ldc + col0;
#pragma unroll
                for (int bj = 0; bj < 2; ++bj) { float v[8];
#pragma unroll
                    for (int i = 0; i < 4; ++i) { v[i] = acc[ai][bj][m][0][i]; v[4 + i] = acc[ai][bj][m][1][i]; }
#pragma unroll
                    for (int i = 0; i < 8; ++i) {
                        if (ACT == 1) v[i] = 1.f / (1.f + __expf(-v[i]));
                        if (ACT == 2) { const float r = fmaxf(v[i], 0.f); v[i] = r * r; } }
                    pg8::u32x4 w; w.x = pk2(v[0], v[1]); w.y = pk2(v[2], v[3]); w.z = pk2(v[4], v[5]); w.w = pk2(v[6], v[7]);
                    *(pg8::u32x4*)(rowp + bj * 128) = w; } }
    }
};
struct EpiF32 {
    static constexpr bool PERM = true, AFTER_DRAIN = false;
    float* O; int ldc;
    __device__ __forceinline__ void operator()(const pg8::f32x4 (&acc)[2][2][4][2], const pg8::Unit& u, int wr, int wc, int fr, int fq) const {
        const int row0 = u.pm * 256 + wr * 64 + fr, col0 = u.pn * 256 + wc * 32 + 8 * fq;
#pragma unroll
        for (int ai = 0; ai < 2; ++ai)
#pragma unroll
            for (int m = 0; m < 4; ++m) { float* rowp = O + (size_t)(row0 + ai * 128 + m * 16) * ldc + col0;
#pragma unroll
                for (int bj = 0; bj < 2; ++bj) { *(pg8::f32x4*)(rowp + bj * 128) = acc[ai][bj][m][0]; *(pg8::f32x4*)(rowp + bj * 128 + 4) = acc[ai][bj][m][1]; } }
    }
};
struct EpiBranch {
    static constexpr bool PERM = true, AFTER_DRAIN = false;
    bf16_t* GO; float* ACC; int mode;
    __device__ __forceinline__ void operator()(const pg8::f32x4 (&acc)[2][2][4][2], const pg8::Unit& u, int wr, int wc, int fr, int fq) const {
        const int row0 = u.pm * 256 + wr * 64 + fr, col0 = u.pn * 256 + wc * 32 + 8 * fq;
#pragma unroll
        for (int ai = 0; ai < 2; ++ai)
#pragma unroll
            for (int m = 0; m < 4; ++m) { const size_t ro = (size_t)(row0 + ai * 128 + m * 16) * 1024 + col0;
#pragma unroll
                for (int bj = 0; bj < 2; ++bj) { const size_t idx = ro + bj * 128;
                    const pg8::u32x4 g = *(const pg8::u32x4*)(GO + idx);
                    pg8::f32x4 v0 = acc[ai][bj][m][0], v1 = acc[ai][bj][m][1];
                    v0[0] *= bflo(g.x); v0[1] *= bfhi(g.x); v0[2] *= bflo(g.y); v0[3] *= bfhi(g.y);
                    v1[0] *= bflo(g.z); v1[1] *= bfhi(g.z); v1[2] *= bflo(g.w); v1[3] *= bfhi(g.w);
                    if (mode > 0) { v0 += *(const pg8::f32x4*)(ACC + idx); v1 += *(const pg8::f32x4*)(ACC + idx + 4); }
                    if (mode < 2) { *(pg8::f32x4*)(ACC + idx) = v0; *(pg8::f32x4*)(ACC + idx + 4) = v1; }
                    else { pg8::u32x4 w; w.x = pk2(v0[0], v0[1]); w.y = pk2(v0[2], v0[3]); w.z = pk2(v1[0], v1[1]); w.w = pk2(v1[2], v1[3]); *(pg8::u32x4*)(GO + idx) = w; } } }
    }
};
__device__ __forceinline__ int kvrow_of(int row) { return row < ML ? (row >> 12) * LKV + CTXL + (row & 4095) : ((row - ML) >> 8) * LKV + ((row - ML) & 255); }
__device__ __forceinline__ void rope8(float (&v)[8], const float* tab, int d, int t) {
    const int p0 = d >> 1, pos = p0 < 16 ? (t >> 6) : (t & 63), j0 = p0 & 15;
    const f32x4* tp = (const f32x4*)(tab + (pos * 16 + j0) * 2);
    const f32x4 t0 = tp[0], t1 = tp[1];
    float o[8];
    o[0] = v[0] * t0[0] - v[1] * t0[1]; o[1] = v[0] * t0[1] + v[1] * t0[0];
    o[2] = v[2] * t0[2] - v[3] * t0[3]; o[3] = v[2] * t0[3] + v[3] * t0[2];
    o[4] = v[4] * t1[0] - v[5] * t1[1]; o[5] = v[4] * t1[1] + v[5] * t1[0];
    o[6] = v[6] * t1[2] - v[7] * t1[3]; o[7] = v[6] * t1[3] + v[7] * t1[2];
#pragma unroll
    for (int i = 0; i < 8; ++i) v[i] = o[i];
}
struct EpiIn {
    static constexpr bool PERM = true, AFTER_DRAIN = false;
    unsigned char* ws;
    __device__ __forceinline__ void operator()(const pg8::f32x4 (&acc)[2][2][4][2], const pg8::Unit& u, int wr, int wc, int fr, int fq) const {
        const bool latent = u.pm < (ML / 256);
        const int cw = wc * 32 + 8 * fq;
        bf16_t* const poolin = (bf16_t*)(ws + WS_POOLIN); bf16_t* const qd = (bf16_t*)(ws + WS_QD); bf16_t* const qg = (bf16_t*)(ws + WS_QG); bf16_t* const kd = (bf16_t*)(ws + WS_KD);
        bf16_t* const vd = (bf16_t*)(ws + WS_VD); bf16_t* const kg = (bf16_t*)(ws + WS_KG); bf16_t* const vg = (bf16_t*)(ws + WS_VG); const float* const rope = (const float*)(ws + WS_ROPE);
#pragma unroll
        for (int bj = 0; bj < 2; ++bj) {
            const int cb = u.pn * 2 + bj;
            bf16_t* base; int pitch, coff; bool kvmap = false, dorope = false; float sc = 1.f;
            if (cb < 4) { base = poolin; pitch = 512; coff = cb * 128; }
            else if (cb < 8) { base = qd; pitch = 512; coff = (cb - 4) * 128; dorope = latent; sc = QC2; }
            else if (cb < 12) { base = qg; pitch = 512; coff = (cb - 8) * 128; }
            else if (cb < 16) { base = kd; pitch = 512; coff = (cb - 12) * 128; kvmap = true; dorope = latent; }
            else if (cb < 20) { base = vd; pitch = 512; coff = (cb - 16) * 128; kvmap = true; }
            else if (cb == 20) { base = kg; pitch = 128; coff = 0; kvmap = true; }
            else { base = vg; pitch = 128; coff = 0; kvmap = true; }
#pragma unroll
            for (int ai = 0; ai < 2; ++ai)
#pragma unroll
                for (int m = 0; m < 4; ++m) {
                    const int row = u.pm * 256 + ai * 128 + wr * 64 + m * 16 + fr;
                    const int drow = kvmap ? kvrow_of(row) : row;
                    float v[8];
#pragma unroll
                    for (int i = 0; i < 4; ++i) { v[i] = acc[ai][bj][m][0][i]; v[4 + i] = acc[ai][bj][m][1][i]; }
                    if (dorope) rope8(v, rope, cw & 63, row & 4095);
#pragma unroll
                    for (int i = 0; i < 8; ++i) v[i] *= sc;
                    pg8::u32x4 w; w.x = pk2(v[0], v[1]); w.y = pk2(v[2], v[3]); w.z = pk2(v[4], v[5]); w.w = pk2(v[6], v[7]);
                    *(pg8::u32x4*)(base + (size_t)drow * pitch + coff + cw) = w;
                }
        }
    }
};
__device__ __forceinline__ void head_norm_fix(bf16_t* p, const float* gain, bool dorope, int t, float sc, const float* tab) {
    float ss = 0.f;
#pragma unroll
    for (int ch = 0; ch < 8; ++ch) { const v4u w = *(const v4u*)(p + ch * 8);
        const float a0 = bflo(w.x), a1 = bfhi(w.x), a2 = bflo(w.y), a3 = bfhi(w.y), a4 = bflo(w.z), a5 = bfhi(w.z), a6 = bflo(w.w), a7 = bfhi(w.w);
        ss += (a0 * a0 + a1 * a1) + (a2 * a2 + a3 * a3) + (a4 * a4 + a5 * a5) + (a6 * a6 + a7 * a7); }
    const float rstd = 1.0f / sqrtf(ss * (1.f / 64.f) + EPSN);
#pragma unroll
    for (int ch = 0; ch < 8; ++ch) { const v4u w = *(const v4u*)(p + ch * 8);
        float v[8] = {bflo(w.x), bfhi(w.x), bflo(w.y), bfhi(w.y), bflo(w.z), bfhi(w.z), bflo(w.w), bfhi(w.w)};
        const f32x4 g0 = *(const f32x4*)(gain + ch * 8), g1 = *(const f32x4*)(gain + ch * 8 + 4);
        v[0] *= rstd * g0[0]; v[1] *= rstd * g0[1]; v[2] *= rstd * g0[2]; v[3] *= rstd * g0[3];
        v[4] *= rstd * g1[0]; v[5] *= rstd * g1[1]; v[6] *= rstd * g1[2]; v[7] *= rstd * g1[3];
        if (dorope) rope8(v, tab, ch * 8, t);
        v4u o; o.x = pk2(v[0] * sc, v[1] * sc); o.y = pk2(v[2] * sc, v[3] * sc); o.z = pk2(v[4] * sc, v[5] * sc); o.w = pk2(v[6] * sc, v[7] * sc);
        *(v4u*)(p + ch * 8) = o; }
}

__device__ __forceinline__ void transpose_item(const float* W, int K, int N, bf16* WT, int k0, int n0, int drow0, LAS float* scr, int lane) {
#pragma unroll 8
    for (int i = 0; i < 32; ++i) { const int kk = 2 * i + (lane >> 5); scr[kk * 33 + (lane & 31)] = W[(size_t)(k0 + kk) * N + n0 + (lane & 31)]; }
    asm volatile("s_waitcnt lgkmcnt(0)" ::: "memory");
    const int c = lane & 7;
#pragma unroll
    for (int j = 0; j < 4; ++j) { const int n = (lane >> 3) + 8 * j; const LAS float* s = scr + (8 * c) * 33 + n;
        v4u o; o.x = pk2(s[0 * 33], s[1 * 33]); o.y = pk2(s[2 * 33], s[3 * 33]); o.z = pk2(s[4 * 33], s[5 * 33]); o.w = pk2(s[6 * 33], s[7 * 33]);
        *(v4u*)(WT + (size_t)(drow0 + n) * K + k0 + 8 * c) = o; }
    asm volatile("s_waitcnt lgkmcnt(0)" ::: "memory");
}
struct WPtrs { const float *w_in, *w_grp, *pscale, *w_po, *w_do, *w_go, *w_o, *w_1, *w_2; };
__device__ __forceinline__ void convert_weights(const WPtrs& p, int l, unsigned char* ws, LAS unsigned char* lds, int gw, int NGW, int wave, int lane, int gtid, int NTH) {
    LAS float* scr = (LAS float*)(lds + wave * 16384);
    constexpr int I_IN = (1024 / 64) * (5888 / 32), I_BR = (512 / 64) * (1024 / 32), I_O = (1024 / 64) * (1024 / 32), I_1 = (1024 / 64) * (4096 / 32), I_2 = (4096 / 64) * (1024 / 32);
    constexpr int NITEMS = I_IN + 3 * I_BR + I_O + I_1 + I_2;
    for (int it = gw; it < NITEMS; it += NGW) {
        int r = it;
        if (r < I_IN) { const int nblk = 5888 / 32, kb = r / nblk, nb = r % nblk, n0 = nb * 32;
            const int d0 = n0 < 1536 ? n0 : (n0 < 4608 ? n0 - 1536 + N1 : n0 - 4608 + 1536);
            transpose_item(p.w_in + (size_t)l * 1024 * 5888, 1024, 5888, (bf16*)(ws + W_IN), kb * 64, n0, d0, scr, lane); continue; } r -= I_IN;
        if (r < I_BR) { const int nblk = 1024 / 32, kb = r / nblk, nb = r % nblk;
            transpose_item(p.w_po + (size_t)l * 512 * 1024, 512, 1024, (bf16*)(ws + W_PO), kb * 64, nb * 32, nb * 32, scr, lane); continue; } r -= I_BR;
        if (r < I_BR) { const int nblk = 1024 / 32, kb = r / nblk, nb = r % nblk;
            transpose_item(p.w_do + (size_t)l * 512 * 1024, 512, 1024, (bf16*)(ws + W_DO), kb * 64, nb * 32, nb * 32, scr, lane); continue; } r -= I_BR;
        if (r < I_BR) { const int nblk = 1024 / 32, kb = r / nblk, nb = r % nblk;
            transpose_item(p.w_go + (size_t)l * 512 * 1024, 512, 1024, (bf16*)(ws + W_GO), kb * 64, nb * 32, nb * 32, scr, lane); continue; } r -= I_BR;
        if (r < I_O) { const int nblk = 1024 / 32, kb = r / nblk, nb = r % nblk;
            transpose_item(p.w_o + (size_t)l * 1024 * 1024, 1024, 1024, (bf16*)(ws + W_O), kb * 64, nb * 32, nb * 32, scr, lane); continue; } r -= I_O;
        if (r < I_1) { const int nblk = 4096 / 32, kb = r / nblk, nb = r % nblk;
            transpose_item(p.w_1 + (size_t)l * 1024 * 4096, 1024, 4096, (bf16*)(ws + W_1), kb * 64, nb * 32, nb * 32, scr, lane); continue; } r -= I_1;
        { const int nblk = 1024 / 32, kb = r / nblk, nb = r % nblk;
            transpose_item(p.w_2 + (size_t)l * 4096 * 1024, 4096, 1024, (bf16*)(ws + W_2), kb * 64, nb * 32, nb * 32, scr, lane); }
    }
    const float* wg = p.w_grp + (size_t)l * 4 * 128 * 128; const float* psc = p.pscale + l * 512;
    unsigned* PT = (unsigned*)(ws + W_POOL);
    for (int i = gtid; i < 512 * 256; i += NTH) { const int n = i >> 8, k = (i & 255) * 2, g = n >> 7; float v0 = 0.f, v1 = 0.f;
        if ((k >> 7) == g) { const float* q = wg + ((size_t)(g * 128 + (k & 127))) * 128 + (n & 127); const float s = psc[n]; v0 = q[0] * s; v1 = q[128] * s; }
        PT[i] = pk2(v0, v1); }
}
__device__ __forceinline__ void mod_gemv(const float* cvec, const float* cctx, const float* wmod, const float* bmod, float* modout, LAS unsigned char* lds, int tid, int lane, int wave, int bx) {
    LAS float* st = (LAS float*)lds;
    LAS float* red = (LAS float*)(lds + 32768);
    for (int i = tid; i < 5 * 1024; i += NTHR) { const int bb = i >> 10, k = i & 1023; const float v = bb < 4 ? cvec[bb * 1024 + k] : cctx[k]; st[i] = v / (1.f + expf(-v)); }
    __syncthreads();
    if (bx < 192) {
        const int l = bx / 96, n0 = (bx % 96) * 64;
        const float* w = wmod + (size_t)l * 1024 * NMOD + n0 + lane;
        float a0 = 0.f, a1 = 0.f, a2 = 0.f, a3 = 0.f, a4 = 0.f;
        const int k0 = wave * 128;
#pragma unroll 16
        for (int kk = 0; kk < 128; ++kk) { const float wv = w[(size_t)(k0 + kk) * NMOD]; const int k = k0 + kk;
            a0 += st[k] * wv; a1 += st[1024 + k] * wv; a2 += st[2048 + k] * wv; a3 += st[3072 + k] * wv; a4 += st[4096 + k] * wv; }
        red[(wave * 5 + 0) * 64 + lane] = a0; red[(wave * 5 + 1) * 64 + lane] = a1; red[(wave * 5 + 2) * 64 + lane] = a2; red[(wave * 5 + 3) * 64 + lane] = a3; red[(wave * 5 + 4) * 64 + lane] = a4;
        __syncthreads();
        if (tid < 320) { const int bb = tid >> 6; float s = bmod[l * NMOD + n0 + lane];
#pragma unroll
            for (int w8 = 0; w8 < 8; ++w8) s += red[(w8 * 5 + bb) * 64 + lane];
            modout[(l * 5 + bb) * NMOD + n0 + lane] = s; }
    }
    __syncthreads();
}
__device__ __forceinline__ void norm_phase(int M, const float* xs_lat, const float* xs_ctx, float* xd_lat, float* xd_ctx, const float* z, const float* modl, int gtc, const float* gpost,
                                           bf16* hdst, const float* gnext, const float* modn, int shc, int scc, int gw, int NGW, int lane) {
    for (int m = gw; m < M; m += NGW) {
        const bool lat = m < ML; const int bb = lat ? (m >> 12) : 4;
        const float* xs = lat ? xs_lat + (size_t)m * 1024 : xs_ctx + (size_t)(m - ML) * 1024;
        f32x4 v[4];
#pragma unroll
        for (int j = 0; j < 4; ++j) v[j] = *(const f32x4*)(xs + 4 * lane + 256 * j);
        float* xd = lat ? xd_lat + (size_t)m * 1024 : xd_ctx + (size_t)(m - ML) * 1024;
        if (!z) {
#pragma unroll
            for (int j = 0; j < 4; ++j) *(f32x4*)(xd + 4 * lane + 256 * j) = v[j];
        } else {
            f32x4 zz[4]; float ss = 0.f;
#pragma unroll
            for (int j = 0; j < 4; ++j) { zz[j] = *(const f32x4*)(z + (size_t)m * 1024 + 4 * lane + 256 * j); ss += (zz[j][0] * zz[j][0] + zz[j][1] * zz[j][1]) + (zz[j][2] * zz[j][2] + zz[j][3] * zz[j][3]); }
            const float rz = 1.0f / sqrtf(wave_sum(ss) * (1.f / 1024.f) + EPSN);
            const float* gt = modl + bb * NMOD + gtc * 1024;
#pragma unroll
            for (int j = 0; j < 4; ++j) { const int c = 4 * lane + 256 * j; const f32x4 g4 = *(const f32x4*)(gpost + c), t4 = *(const f32x4*)(gt + c);
                v[j] = v[j] + t4 * ((zz[j] * rz) * g4); *(f32x4*)(xd + c) = v[j]; }
        }
        if (hdst) {
            float ss = 0.f;
#pragma unroll
            for (int j = 0; j < 4; ++j) ss += (v[j][0] * v[j][0] + v[j][1] * v[j][1]) + (v[j][2] * v[j][2] + v[j][3] * v[j][3]);
            const float rx = 1.0f / sqrtf(wave_sum(ss) * (1.f / 1024.f) + EPSN);
            const float* sh = modn + bb * NMOD + shc * 1024; const float* sc = modn + bb * NMOD + scc * 1024;
#pragma unroll
            for (int j = 0; j < 4; ++j) { const int c = 4 * lane + 256 * j; const f32x4 g4 = *(const f32x4*)(gnext + c), s4 = *(const f32x4*)(sc + c), h4 = *(const f32x4*)(sh + c);
                const f32x4 o = ((v[j] * rx) * g4) * (s4 + 1.0f) + h4;
                v2u w; w.x = pk2(o[0], o[1]); w.y = pk2(o[2], o[3]); *(v2u*)(hdst + (size_t)m * 1024 + c) = w; }
        }
    }
}
__device__ __forceinline__ void pool_phase(int M, const bf16* zin, bf16* pooled, int gtid, int NTH) {
    for (int it = gtid; it < M * 64; it += NTH) {
        const int m = it >> 6, ch = it & 63, g = ch >> 4, w2 = 1 << g;
        int t, l;
        if (m < ML) { t = m & 4095; l = SEQL; } else { t = (m - ML) & 255; l = CTXL; }
        const int base = m - t, lo = max(t - w2, 0), hi = min(t + w2, l);
        float s[8];
#pragma unroll
        for (int i = 0; i < 8; ++i) s[i] = 0.f;
        for (int j = lo; j < hi; ++j) { const v4u w = *(const v4u*)(zin + (size_t)(base + j) * 512 + ch * 8);
            s[0] += bflo(w.x); s[1] += bfhi(w.x); s[2] += bflo(w.y); s[3] += bfhi(w.y); s[4] += bflo(w.z); s[5] += bfhi(w.z); s[6] += bflo(w.w); s[7] += bfhi(w.w); }
        const float inv = 1.0f / (float)(hi - lo);
        const v4u w = *(const v4u*)(zin + (size_t)m * 512 + ch * 8);
        v4u o; o.x = pk2(s[0] * inv - bflo(w.x), s[1] * inv - bfhi(w.x)); o.y = pk2(s[2] * inv - bflo(w.y), s[3] * inv - bfhi(w.y));
        o.z = pk2(s[4] * inv - bflo(w.z), s[5] * inv - bfhi(w.z)); o.w = pk2(s[6] * inv - bflo(w.w), s[7] * inv - bfhi(w.w));
        *(v4u*)(pooled + (size_t)m * 512 + ch * 8) = o;
    }
}
__device__ __forceinline__ void diff_combine_phase(int M, const bf16* od, bf16* diffo, const float* subln, float lam, float lam_init, int gtid, int NTH) {
    for (int it = gtid; it < M * 64; it += NTH) {
        const int l16 = it & 15, hd = (it >> 4) & 3, m = it >> 6;
        const bf16* p1 = od + (size_t)m * 1024 + hd * 256 + l16 * 8;
        const v4u a = *(const v4u*)p1, b = *(const v4u*)(p1 + 128);
        float d[8];
        d[0] = bflo(a.x) - lam * bflo(b.x); d[1] = bfhi(a.x) - lam * bfhi(b.x); d[2] = bflo(a.y) - lam * bflo(b.y); d[3] = bfhi(a.y) - lam * bfhi(b.y);
        d[4] = bflo(a.z) - lam * bflo(b.z); d[5] = bfhi(a.z) - lam * bfhi(b.z); d[6] = bflo(a.w) - lam * bflo(b.w); d[7] = bfhi(a.w) - lam * bfhi(b.w);
        float ss = 0.f;
#pragma unroll
        for (int i = 0; i < 8; ++i) ss += d[i] * d[i];
        ss += __shfl_xor(ss, 1); ss += __shfl_xor(ss, 2); ss += __shfl_xor(ss, 4); ss += __shfl_xor(ss, 8);
        const float rstd = 1.0f / sqrtf(ss * (1.f / 128.f) + EPSN), k1 = 1.0f - lam_init;
        const f32x4 g0 = *(const f32x4*)(subln + l16 * 8), g1 = *(const f32x4*)(subln + l16 * 8 + 4);
        v4u o; o.x = pk2(d[0] * rstd * g0[0] * k1, d[1] * rstd * g0[1] * k1); o.y = pk2(d[2] * rstd * g0[2] * k1, d[3] * rstd * g0[3] * k1);
        o.z = pk2(d[4] * rstd * g1[0] * k1, d[5] * rstd * g1[1] * k1); o.w = pk2(d[6] * rstd * g1[2] * k1, d[7] * rstd * g1[3] * k1);
        *(v4u*)(diffo + (size_t)m * 512 + hd * 128 + l16 * 8) = o;
    }
}

#define RLX_AGENT __ATOMIC_RELAXED, __HIP_MEMORY_SCOPE_AGENT
#define XB_TMO      128
#define XB_XCNT(j)  (256  + 64 * (j))
#define XB_XSUB(j)  (1280 + 64 * (j))
#define XB_XGEN(j)  (2304 + 64 * (j))
#define XB_TOP      3328
#define XB_TOPGEN   3392
#define XCD_BAR_WORDS 3456
#define XB_SPIN_CAP (1u << 22)

__device__ __forceinline__ unsigned xb_ld(unsigned* p)              { return __hip_atomic_load(p, __ATOMIC_RELAXED, __HIP_MEMORY_SCOPE_AGENT); }
__device__ __forceinline__ unsigned xb_add(unsigned* p, unsigned v) { return __hip_atomic_fetch_add(p, v, __ATOMIC_RELAXED, __HIP_MEMORY_SCOPE_AGENT); }
__device__ __forceinline__ unsigned xb_xcc_id() { return (unsigned)__builtin_amdgcn_s_getreg((3 << 11) | 20) & 0xFu; }
#define XB_SPIN(cond, bar) do { unsigned _sp = 0; while (cond) { __builtin_amdgcn_s_sleep(1); \
    if ((++_sp & 255u) == 0u) { if (xb_ld(&(bar)[XB_TMO])) break; if (_sp > XB_SPIN_CAP) { atomicAdd(&(bar)[XB_TMO], 1u); break; } } } } while (0)

struct XcdBarrier {
    unsigned* bar; unsigned x;
    volatile LAS unsigned* st;
};

__device__ __forceinline__ XcdBarrier xcd_barrier_post(unsigned* bar, volatile LAS unsigned* st) {
    XcdBarrier b; b.bar = bar; b.x = xb_xcc_id(); b.st = st;
    if (threadIdx.x == 0) (void)xb_add(&bar[XB_XCNT(b.x)], 1u);
    return b;
}
__device__ __forceinline__ void xcd_barrier_complete(unsigned* bar, unsigned x, unsigned& nloc, unsigned& nx) {
    const unsigned G = gridDim.x * gridDim.y * gridDim.z;
    unsigned sum, cnt, mine, sp = 0u;
    for (;;) {
        sum = 0u; cnt = 0u; mine = 0u;
#pragma unroll
        for (unsigned j = 0; j < 16; ++j) { const unsigned c = xb_ld(&bar[XB_XCNT(j)]); sum += c; cnt += (c > 0u) ? 1u : 0u; mine = (j == x) ? c : mine; }
        if (sum == G) break;
        __builtin_amdgcn_s_sleep(1);
        if ((++sp & 255u) == 0u) { if (xb_ld(&bar[XB_TMO])) break; if (sp > XB_SPIN_CAP) { atomicAdd(&bar[XB_TMO], 1u); break; } }
    }
    nloc = mine > 0u ? mine : 1u; nx = cnt > 0u ? cnt : 1u;
}

__device__ __forceinline__ void xcd_barrier(const XcdBarrier& b) {
    asm volatile("s_waitcnt vmcnt(0)" ::: "memory");
    __syncthreads();
    if (threadIdx.x == 0) {
        unsigned* bar = b.bar;
        __builtin_amdgcn_s_waitcnt(0);
        unsigned nloc = b.st[0], nx = b.st[1];
        if (nloc == 0u) { xcd_barrier_complete(bar, b.x, nloc, nx); b.st[0] = nloc; b.st[1] = nx; }
        const unsigned old = xb_add(&bar[XB_XSUB(b.x)], 1u);
        const unsigned gen = old / nloc;
        if (old + 1u == (gen + 1u) * nloc) {
            __builtin_amdgcn_fence(__ATOMIC_RELEASE, "agent");
            asm volatile("s_waitcnt vmcnt(0)" ::: "memory");
            const unsigned og = xb_add(&bar[XB_TOP], 1u);
            const unsigned tg = og / nx;
            if (og + 1u == (tg + 1u) * nx) xb_add(&bar[XB_TOPGEN], 1u);
            else XB_SPIN(xb_ld(&bar[XB_TOPGEN]) == tg, bar);
            __builtin_amdgcn_fence(__ATOMIC_ACQUIRE, "agent");
            xb_add(&bar[XB_XGEN(b.x)], 1u);
            asm volatile("s_waitcnt vmcnt(0)" ::: "memory");
        } else {
            XB_SPIN(xb_ld(&bar[XB_XGEN(b.x)]) == gen, bar);
            __builtin_amdgcn_fence(__ATOMIC_ACQUIRE, "agent");
            asm volatile("s_waitcnt vmcnt(0)" ::: "memory");
        }
    }
    __syncthreads();
}
constexpr size_t WS_BAR = 320 * 1024;
constexpr int LDS_CTL = 131072, LDS_BARST = LDS_CTL + 352;
constexpr size_t WS_PTR = 300 * 1024;
struct Ids { int tid, lane, wave, bx, G, vcu, gw, NGW, gtid, NTH; };
#define FRESH_IDS(I) Ids I; { int t_ = threadIdx.x; asm volatile("" : "+v"(t_)); int b_ = blockIdx.x; asm volatile("" : "+s"(b_)); int g_ = gridDim.x; asm volatile("" : "+s"(g_)); \
    I.tid = t_; I.lane = t_ & 63; I.wave = __builtin_amdgcn_readfirstlane(t_ >> 6); I.bx = b_; I.G = g_; I.vcu = (g_ % 8 == 0) ? (b_ % 8) * (g_ / 8) + b_ / 8 : b_; \
    I.gw = I.vcu * 8 + I.wave; I.NGW = g_ * 8; I.gtid = b_ * NTHR + t_; I.NTH = g_ * NTHR; }
#define PTAB(i) (((const float* const*)(ws + WS_PTR))[i])

__global__ void __launch_bounds__(NTHR, 2) mk_fwd(Args a) {
    extern __shared__ __attribute__((aligned(16))) unsigned char lds_raw[];
    cg::grid_group grid = cg::this_grid();
    LAS unsigned char* lds = (LAS unsigned char*)lds_raw;
    unsigned char* ws = a.ws;
#define GSYNC_CG() do { asm volatile("s_waitcnt vmcnt(0) lgkmcnt(0)" ::: "memory"); grid.sync(); asm volatile("" ::: "memory"); } while (0)
#define GSYNC() do { XcdBarrier b_; b_.bar = (unsigned*)(ws + WS_BAR); b_.x = xb_xcc_id(); b_.st = (volatile LAS unsigned*)(lds + LDS_BARST); xcd_barrier(b_); asm volatile("" ::: "memory"); } while (0)
#ifndef REP_P1
#define REP_P1 1
#endif
#ifndef REP_P2
#define REP_P2 1
#endif
#ifndef REP_P3
#define REP_P3 1
#endif
#ifndef REP_P4
#define REP_P4 1
#endif
#ifndef REP_P5
#define REP_P5 1
#endif
#ifndef REP_P7
#define REP_P7 1
#endif
#ifndef REP_P8
#define REP_P8 1
#endif
#ifndef EXTRA_SYNCS
#define EXTRA_SYNCS 0
#endif
#define REPEAT(n) _Pragma("unroll 1") for (int rep_ = 0; rep_ < (n); ++rep_)
    for (int u = threadIdx.x; u < (LDS_BYTES - LDS_CTL) / 4; u += NTHR) ((LAS unsigned*)(lds + LDS_CTL))[u] = 0u;
    if (blockIdx.x == 0) for (int i = threadIdx.x; i < XCD_BAR_WORDS; i += NTHR) ((unsigned*)(ws + WS_BAR))[i] = 0u;
    __syncthreads();

    {
        FRESH_IDS(I);
        if (I.bx == 0 && I.tid == 0) {
            const float** tab = (const float**)(ws + WS_PTR);
#pragma unroll
            for (int i = 0; i < 26; ++i) tab[i] = a.in[i];
            tab[26] = a.out;
        }
        mod_gemv(a.in[1], a.in[3], a.in[4], a.in[5], (float*)(ws + WS_MOD), lds, I.tid, I.lane, I.wave, I.bx);
        WPtrs wp{a.in[10], a.in[11], a.in[12], a.in[20], a.in[21], a.in[22], a.in[23], a.in[24], a.in[25]};
        convert_weights(wp, 0, ws, lds, I.gw, I.NGW, I.wave, I.lane, I.gtid, I.NTH);
        if (I.bx == I.G - 1) { float* ropet = (float*)(ws + WS_ROPE);
            for (int i = I.tid; i < 1024; i += NTHR) { const int pos = i >> 4, j = i & 15; const float inv = 1.0f / powf(10000.0f, (float)j * 2.0f / 32.0f); const float ang = (float)pos * inv;
                ropet[2 * i] = cosf(ang); ropet[2 * i + 1] = sinf(ang); } }
    }
    GSYNC_CG();
    (void)xcd_barrier_post((unsigned*)(ws + WS_BAR), (volatile LAS unsigned*)(lds + LDS_BARST));
    for (int e_ = 0; e_ < EXTRA_SYNCS; ++e_) GSYNC();
    {
        FRESH_IDS(I);
        float* modv = (float*)(ws + WS_MOD);
        norm_phase(MA, PTAB(0), PTAB(2), (float*)PTAB(26), (float*)(ws + WS_CTX), nullptr, nullptr, 0, nullptr, (bf16*)(ws + WS_H), PTAB(6), modv, 0, 1, I.gw, I.NGW, I.lane);
    }
    GSYNC();

#pragma unroll 1
    for (int l = 0; l < 2; ++l) {
        REPEAT(REP_P1) {
        {
            FRESH_IDS(I);
            const float* ropet = (const float*)(ws + WS_ROPE);
            pg8::Gemm g{(const bf16_t*)(ws + WS_H), (const bf16_t*)(ws + W_IN), MA, N1, 1024}; pg8::StaticOrder S; S.init(MA, N1, I.G, I.bx);
            EpiIn E{ws};
            pg8::gemm_phase<EpiIn, pg8::StaticOrder, true, true>(lds, g, S, E);
        }
        {
            asm volatile("s_waitcnt vmcnt(0)" ::: "memory"); __syncthreads(); __builtin_amdgcn_fence(__ATOMIC_ACQUIRE, "agent"); asm volatile("s_waitcnt vmcnt(0)" ::: "memory");
            FRESH_IDS(I);
            const float* ropet = (const float*)(ws + WS_ROPE);
            const float* qn = PTAB(18) + l * 64; const float* kn = PTAB(19) + l * 64;
            pg8::StaticOrder S; S.init(MA, N1, I.G, I.bx);
            pg8::Unit u;
            for (int i = 0; S.next(i, u); ++i) {
                const bool latent = u.pm < (ML / 256);
                if (u.pn == 4 || u.pn == 5) {
                    for (int it = I.tid; it < 1024; it += NTHR) { const int hh = it & 3, rl = it >> 2, row = u.pm * 256 + rl;
                        head_norm_fix((bf16_t*)(ws + WS_QG) + (size_t)row * 512 + (u.pn - 4) * 256 + hh * 64, qn, latent, row & 4095, QC2, ropet); }
                } else if (u.pn == 10) {
                    const int hh = I.tid & 1, rl = I.tid >> 1, row = u.pm * 256 + rl;
                    head_norm_fix((bf16_t*)(ws + WS_KG) + (size_t)kvrow_of(row) * 128 + hh * 64, kn, latent, row & 4095, 1.0f, ropet);
                }
            }
        }
        GSYNC();
        }
        REPEAT(REP_P2) {
        {
            FRESH_IDS(I);
            const bool last = (l == 1); const int M2 = last ? ML : MA;
            pool_phase(M2, (const bf16*)(ws + WS_POOLIN), (bf16*)(ws + WS_POOLED), I.gtid, I.NTH);
            const int total = 1536 + (last ? 0 : 96);
            for (int i = 0;; ++i) {
                const int L = i * I.G + I.vcu; if (L >= total) break;
                int b, r, m0, NT;
                if (L < 1536) { const int qb = L & 15, pair = L >> 4; b = pair / 24; r = pair % 24; m0 = b * SEQL + qb * 256; NT = LKV / 64; }
                else { const int L2 = L - 1536; b = L2 / 24; r = L2 % 24; m0 = ML + b * CTXL; NT = CTXL / 64; }
                const attn_body::bf16 *Q, *K, *V; attn_body::bf16* O; int pq, pk, pv, po;
                if (r < 16) { const int hd = r >> 2, qs = (r >> 1) & 1, vh = r & 1;
                    Q = (const attn_body::bf16*)(ws + WS_QD) + (size_t)m0 * 512 + hd * 128 + qs * 64; pq = 512;
                    K = (const attn_body::bf16*)(ws + WS_KD) + (size_t)(b * LKV) * 512 + hd * 128 + qs * 64; pk = 512;
                    V = (const attn_body::bf16*)(ws + WS_VD) + (size_t)(b * LKV) * 512 + hd * 128 + vh * 64; pv = 512;
                    O = (attn_body::bf16*)(ws + WS_OD) + (size_t)m0 * 1024 + hd * 256 + qs * 128 + vh * 64; po = 1024; }
                else { const int h = r - 16;
                    Q = (const attn_body::bf16*)(ws + WS_QG) + (size_t)m0 * 512 + h * 64; pq = 512;
                    K = (const attn_body::bf16*)(ws + WS_KG) + (size_t)(b * LKV) * 128 + (h >> 2) * 64; pk = 128;
                    V = (const attn_body::bf16*)(ws + WS_VG) + (size_t)(b * LKV) * 128 + (h >> 2) * 64; pv = 128;
                    O = (attn_body::bf16*)(ws + WS_GQAO) + (size_t)m0 * 512 + h * 64; po = 512; }
#ifndef NO_ATTN
                attn_body::attn_unit<8>(Q, pq, K, pk, V, pv, O, po, NT, (char*)lds_raw);
#endif
            }
        }
        GSYNC();
        }
        REPEAT(REP_P3) {
        {
            FRESH_IDS(I);
            const bool last = (l == 1); const int M2 = last ? ML : MA; const float lam_init = last ? 0.35550906759f : 0.2f;
            const float *lq1 = PTAB(13) + l * 64, *lk1 = PTAB(14) + l * 64, *lq2 = PTAB(15) + l * 64, *lk2 = PTAB(16) + l * 64;
            float d1 = 0.f, d2 = 0.f;
            for (int i = 0; i < 64; ++i) { d1 += lq1[i] * lk1[i]; d2 += lq2[i] * lk2[i]; }
            const float lam = expf(d1) - expf(d2) + lam_init;
            diff_combine_phase(M2, (const bf16*)(ws + WS_OD), (bf16*)(ws + WS_DIFFO), PTAB(17) + l * 128, lam, lam_init, I.gtid, I.NTH);
            pg8::Gemm g{(const bf16_t*)(ws + WS_POOLED), (const bf16_t*)(ws + W_POOL), M2, 512, 512}; pg8::StaticOrder S; S.init(M2, 512, I.G, I.bx);
            EpiAct<0> E{(bf16_t*)(ws + WS_POOLO), 512};
            pg8::gemm_phase<EpiAct<0>, pg8::StaticOrder, true, true>(lds, g, S, E);
        }
        GSYNC();
        }
        REPEAT(REP_P4) {
#pragma unroll 1
        for (int b = 0; b < 3; ++b) {
            { FRESH_IDS(I); const int M2 = (l == 1) ? ML : MA;
              pg8::Gemm g{(const bf16_t*)(ws + WS_H), (const bf16_t*)(ws + W_IN) + (size_t)(N1 + b * 1024) * 1024, M2, 1024, 1024}; pg8::StaticOrder S; S.init(M2, 1024, I.G, I.bx);
              EpiAct<1> E{(bf16_t*)(ws + WS_MERGED), 1024};
              pg8::gemm_phase<EpiAct<1>, pg8::StaticOrder, true, true>(lds, g, S, E); }
            { FRESH_IDS(I); const int M2 = (l == 1) ? ML : MA;
              const bf16_t* A = (const bf16_t*)(ws + (b == 0 ? WS_POOLO : b == 1 ? WS_DIFFO : WS_GQAO)); const bf16_t* Bt = (const bf16_t*)(ws + (b == 0 ? W_PO : b == 1 ? W_DO : W_GO));
              pg8::Gemm g{A, Bt, M2, 1024, 512}; pg8::StaticOrder S; S.init(M2, 1024, I.G, I.bx);
              EpiBranch E{(bf16_t*)(ws + WS_MERGED), (float*)(ws + WS_ACC), b};
              pg8::gemm_phase<EpiBranch, pg8::StaticOrder, true, true>(lds, g, S, E); }
        }
        GSYNC();
        }
        REPEAT(REP_P5) {
        {
            FRESH_IDS(I); const int M2 = (l == 1) ? ML : MA;
            pg8::Gemm g{(const bf16_t*)(ws + WS_MERGED), (const bf16_t*)(ws + W_O), M2, 1024, 1024}; pg8::StaticOrder S; S.init(M2, 1024, I.G, I.bx);
            EpiF32 E{(float*)(ws + WS_Y), 1024};
            pg8::gemm_phase<EpiF32, pg8::StaticOrder, true, true>(lds, g, S, E);
        }
        GSYNC();
        }
        {
            FRESH_IDS(I); const int M2 = (l == 1) ? ML : MA;
            const float* modl = (const float*)(ws + WS_MOD) + l * 5 * NMOD; float* outp = (float*)PTAB(26); float* ctxx = (float*)(ws + WS_CTX);
            norm_phase(M2, outp, ctxx, outp, ctxx, (const float*)(ws + WS_Y), modl, 2, PTAB(7) + l * 1024, (bf16*)(ws + WS_HF), PTAB(8) + l * 1024, modl, 3, 4, I.gw, I.NGW, I.lane);
        }
        GSYNC();
        REPEAT(REP_P7) {
        {
            FRESH_IDS(I); const int M2 = (l == 1) ? ML : MA;
            pg8::Gemm g{(const bf16_t*)(ws + WS_HF), (const bf16_t*)(ws + W_1), M2, DFF, 1024}; pg8::StaticOrder S; S.init(M2, DFF, I.G, I.bx);
            EpiAct<2> E{(bf16_t*)(ws + WS_U), DFF};
            pg8::gemm_phase<EpiAct<2>, pg8::StaticOrder, true, true>(lds, g, S, E);
        }
        GSYNC();
        }
        REPEAT(REP_P8) {
        {
            FRESH_IDS(I); const int M2 = (l == 1) ? ML : MA;
            pg8::Gemm g{(const bf16_t*)(ws + WS_U), (const bf16_t*)(ws + W_2), M2, 1024, DFF}; pg8::StaticOrder S; S.init(M2, 1024, I.G, I.bx);
            EpiF32 E{(float*)(ws + WS_Z), 1024};
            pg8::gemm_phase<EpiF32, pg8::StaticOrder, true, true>(lds, g, S, E);
        }
        GSYNC();
        }
        {
            FRESH_IDS(I);
            const float* modl = (const float*)(ws + WS_MOD) + l * 5 * NMOD; float* outp = (float*)PTAB(26); float* ctxx = (float*)(ws + WS_CTX);
            if (l == 0) {
                WPtrs wp{PTAB(10), PTAB(11), PTAB(12), PTAB(20), PTAB(21), PTAB(22), PTAB(23), PTAB(24), PTAB(25)};
                convert_weights(wp, 1, ws, lds, I.gw, I.NGW, I.wave, I.lane, I.gtid, I.NTH);
                norm_phase(MA, outp, ctxx, outp, ctxx, (const float*)(ws + WS_Z), modl, 5, PTAB(9) + l * 1024, (bf16*)(ws + WS_H), PTAB(6) + 1024, modl + 5 * NMOD, 0, 1, I.gw, I.NGW, I.lane);
            } else {
                norm_phase(ML, outp, ctxx, outp, ctxx, (const float*)(ws + WS_Z), modl, 5, PTAB(9) + l * 1024, nullptr, nullptr, nullptr, 0, 0, I.gw, I.NGW, I.lane);
            }
        }
        if (l == 0) GSYNC();
    }
#undef GSYNC
}

extern "C" void kernel_launch(void* const* d_in, const int* in_sizes, int n_in, void* d_out, int out_size, void* d_ws, size_t ws_size, hipStream_t stream) {
    static int grid = 0;
    if (grid == 0) {
        if (n_in != 26 || out_size != ML * DMODEL || ws_size < WS_TOTAL) { fprintf(stderr, "kernel_launch: unexpected shapes (n_in %d out %d ws %zu)\n", n_in, out_size, ws_size); grid = -1; return; }
        int dev = 0, cus = 0, per_cu = 0;
        if (hipGetDevice(&dev) != hipSuccess || hipDeviceGetAttribute(&cus, hipDeviceAttributeMultiprocessorCount, dev) != hipSuccess) { grid = -1; return; }
        if (hipFuncSetAttribute((const void*)mk_fwd, hipFuncAttributeMaxDynamicSharedMemorySize, LDS_BYTES) != hipSuccess) { fprintf(stderr, "kernel_launch: hipFuncSetAttribute failed\n"); grid = -1; return; }
        if (hipOccupancyMaxActiveBlocksPerMultiprocessor(&per_cu, (const void*)mk_fwd, NTHR, LDS_BYTES) != hipSuccess || per_cu < 1) per_cu = 1;
        (void)hipGetLastError();
        grid = cus * per_cu;
    }
    if (grid < 0) return;
    Args a{};
    for (int i = 0; i < 26; ++i) a.in[i] = (const float*)d_in[i];
    a.out = (float*)d_out; a.ws = (unsigned char*)d_ws;
    void* args[] = {&a};
    hipError_t e = hipLaunchCooperativeKernel((const void*)mk_fwd, dim3(grid), dim3(NTHR), args, LDS_BYTES, stream);
    if (e != hipSuccess) fprintf(stderr, "kernel_launch: cooperative launch failed: %s (grid %d)\n", hipGetErrorString(e), grid);
}
```

```cpp
#include <hip/hip_runtime.h>
#include <hip/hip_cooperative_groups.h>
#include <cstdio>
#include <cstdint>

namespace pg8 {
#define PG8_LAS __attribute__((address_space(3)))
typedef unsigned short bf16_t;
typedef short bf16x8 __attribute__((ext_vector_type(8)));
typedef float f32x4 __attribute__((ext_vector_type(4)));
typedef unsigned u32x4 __attribute__((ext_vector_type(4)));
constexpr int BM = 256, BK = 64, HALF = 128, HTB = HALF * BK * 2  , STAGE_BYTES = 8 * HTB, NXCD = 8, WGM = 8;

__host__ __device__ __forceinline__ int lds_byte(int r, int c) { const int st = (r >> 4) * 2 + (c >> 5), rr = r & 15, cc = c & 31, ob = rr * 64 + cc * 2; return st * 1024 + (ob ^ (((ob >> 9) & 1) << 5)); }
__host__ __device__ __forceinline__ void stage_rc(int b, int& R, int& C) { const int st = b / 1024, sb = b % 1024, swz = sb ^ (((sb >> 9) & 1) << 5); R = (st >> 1) * 16 + swz / 64; C = (st & 1) * 32 + (swz % 64) / 2; }
__host__ __device__ __forceinline__ int perm32(int rho) { const int n = rho >> 4, i = rho & 15; return 8 * (i >> 2) + 4 * n + (i & 3); }

struct Unit { int pm, pn; };
struct Gemm { const bf16_t* A; const bf16_t* Bt; int M, N, K; };

struct StaticOrder {
    int nM, nN, nwg, G, c;
    __host__ __device__ void init(int M, int N, int G_, int c_) { nM = M / BM; nN = N / BM; nwg = nM * nN; G = G_; c = c_; }
    __host__ __device__ bool next(int i, Unit& u) const {
        const long L = (long)i * G + c; if (L >= nwg) return false;
        int wgid = (int)L; { const int q = nwg / NXCD, r = nwg % NXCD, xcd = wgid % NXCD, off = wgid / NXCD; wgid = (xcd < r ? xcd * (q + 1) : r * (q + 1) + (xcd - r) * q) + off; }
        const int nig = WGM * nN, gid = wgid / nig, fm = gid * WGM, gsz = (nM - fm) < WGM ? (nM - fm) : WGM;
        u.pm = fm + ((wgid % nig) % gsz); u.pn = (wgid % nig) / gsz; return true;
    }
    __device__ __forceinline__ void a_ready(const Unit&) const {}
    __device__ __forceinline__ void done(const Unit&) const {}
};

__device__ __forceinline__ unsigned cvt_pk_bf16(float lo, float hi) { unsigned r; asm volatile("v_cvt_pk_bf16_f32 %0, %1, %2" : "=v"(r) : "v"(lo), "v"(hi)); return r; }
typedef float f32x2 __attribute__((ext_vector_type(2)));
template <class Epi, class Sched, bool ALIGN_EPI = false, bool SP2 = false>
__device__ __forceinline__ void gemm_phase(PG8_LAS unsigned char* lds, const Gemm g, const Sched& S, const Epi& E) {
    int tid_l = threadIdx.x; asm volatile("" : "+v"(tid_l)); const int tid = tid_l, wid = __builtin_amdgcn_readfirstlane(tid >> 6), lane = tid & 63, wr = wid >> 2, wc = wid & 3, fr = lane & 15, fq = lane >> 4;
    const int K = g.K, nt = K / BK;
    unsigned voffA[2], voffB[2];
#pragma unroll
    for (int i = 0; i < 2; ++i) { int R, C; stage_rc(tid * 16 + i * 8192, R, C); const int Rb = Epi::PERM ? ((R & ~31) + perm32(R & 31)) : R;
        voffA[i] = (unsigned)(R * K + C) * 2u; voffB[i] = (unsigned)(Rb * K + C) * 2u; }
    const size_t kstep = (size_t)(BK * 2);
    const size_t hstep = (size_t)HALF * K * 2;
    const size_t tstep = 2 * hstep;
    const unsigned ldsw = (unsigned)wid * 1024u;
    const int aoff = lds_byte(wr * 64 + fr, fq * 8), boff = lds_byte(wc * 32 + fr, fq * 8);
#define PG8_SA(b, h) (((b) * 2 + (h)) * HTB)
#define PG8_SB(b, h) ((4 + (b) * 2 + (h)) * HTB)
#define PG8_STAGE(bufoff, gbase, voff) do { _Pragma("unroll") for (int _i = 0; _i < 2; ++_i) \
        __builtin_amdgcn_global_load_lds((const unsigned*)((const char*)(gbase) + (voff)[_i]), (PG8_LAS unsigned*)(lds + (bufoff) + ldsw + _i * 8192), 16, 0, 0); } while (0)
#define PG8_LDA(dst, b, h) do { _Pragma("unroll") for (int m = 0; m < 4; ++m) _Pragma("unroll") for (int k = 0; k < 2; ++k) dst[m][k] = *(const PG8_LAS bf16x8*)(lds + PG8_SA(b, h) + aoff + m * 2048 + k * 1024); } while (0)
#define PG8_LDB(dst, b, h) do { _Pragma("unroll") for (int n = 0; n < 2; ++n) _Pragma("unroll") for (int k = 0; k < 2; ++k) dst[n][k] = *(const PG8_LAS bf16x8*)(lds + PG8_SB(b, h) + boff + n * 2048 + k * 1024); } while (0)
#define PG8_MMA(ai, bj, At, Bt) do { __builtin_amdgcn_s_setprio(1); _Pragma("unroll") for (int m = 0; m < 4; ++m) _Pragma("unroll") for (int n = 0; n < 2; ++n) _Pragma("unroll") for (int k = 0; k < 2; ++k) \
        acc[ai][bj][m][n] = __builtin_amdgcn_mfma_f32_16x16x32_bf16(Bt[n][k], At[m][k], acc[ai][bj][m][n], 0, 0, 0); __builtin_amdgcn_s_setprio(0); } while (0)
#define PG8_WAIT_V(n) asm volatile("s_waitcnt vmcnt(" #n ")" ::: "memory")
#define PG8_WAIT_L(n) asm volatile("s_waitcnt lgkmcnt(" #n ")" ::: "memory")
#define PG8_BAR __builtin_amdgcn_s_barrier()
#define PG8_SCHED __builtin_amdgcn_sched_barrier(0)
    Unit cur, nxt; int ui = 0;
    if (!S.next(0, cur)) return;
    f32x4 acc[2][2][4][2];
#pragma unroll
    for (int a = 0; a < 2; ++a)
#pragma unroll
        for (int b = 0; b < 2; ++b)
#pragma unroll
            for (int m = 0; m < 4; ++m)
#pragma unroll
                for (int n = 0; n < 2; ++n) acc[a][b][m][n] = (f32x4){0.f, 0.f, 0.f, 0.f};
    bf16x8 At[4][2], B0[2][2], B1[2][2];
    const char* cA = (const char*)g.A + (size_t)cur.pm * tstep; const char* cB = (const char*)g.Bt + (size_t)cur.pn * tstep;
    S.a_ready(cur);
    if constexpr (SP2) {
        PG8_STAGE(PG8_SB(0, 0), cB, voffB); PG8_STAGE(PG8_SB(0, 1), cB + hstep, voffB); PG8_STAGE(PG8_SA(0, 0), cA, voffA); PG8_STAGE(PG8_SA(0, 1), cA + hstep, voffA);
        if (wr == 1) PG8_BAR;
        PG8_WAIT_V(2); PG8_BAR;
        PG8_STAGE(PG8_SB(1, 0), cB + kstep, voffB); PG8_STAGE(PG8_SA(1, 0), cA + kstep, voffA); PG8_STAGE(PG8_SB(1, 1), cB + hstep + kstep, voffB);
        PG8_WAIT_V(6); PG8_BAR;
    } else {
        PG8_STAGE(PG8_SB(0, 0), cB, voffB); PG8_STAGE(PG8_SA(0, 0), cA, voffA); PG8_STAGE(PG8_SB(0, 1), cB + hstep, voffB); PG8_STAGE(PG8_SA(0, 1), cA + hstep, voffA);
        if (wr == 1) PG8_BAR;
        PG8_WAIT_V(4); PG8_BAR;
        PG8_STAGE(PG8_SB(1, 0), cB + kstep, voffB); PG8_STAGE(PG8_SA(1, 0), cA + kstep, voffA); PG8_STAGE(PG8_SB(1, 1), cB + hstep + kstep, voffB);
        PG8_WAIT_V(6); PG8_BAR;
    }
    for (;;) {
        const bool has_next = S.next(ui + 1, nxt);
        const char* nA = has_next ? (const char*)g.A + (size_t)nxt.pm * tstep : cA; const char* nB = has_next ? (const char*)g.Bt + (size_t)nxt.pn * tstep : cB;
        for (int t = 0; t < nt; t += 2) {
            const bool last = (t == nt - 2);
            const char* a1 = cA + (size_t)(t + 1) * kstep;
            const char* a2 = last ? nA : cA + (size_t)(t + 2) * kstep; const char* b2 = last ? nB : cB + (size_t)(t + 2) * kstep;
            const char* a3 = a2 + kstep; const char* b3 = b2 + kstep;
            if (last && has_next) S.a_ready(nxt);
            if constexpr (SP2) {
            PG8_LDB(B0, 0, 0); PG8_LDB(B1, 0, 1); PG8_SCHED; PG8_LDA(At, 0, 0); PG8_STAGE(PG8_SA(1, 1), a1 + hstep, voffA);
            PG8_WAIT_V(8); PG8_WAIT_L(0); PG8_BAR; PG8_MMA(0, 0, At, B0); PG8_MMA(0, 1, At, B1); PG8_BAR; PG8_SCHED;
            PG8_LDA(At, 0, 1); PG8_STAGE(PG8_SB(0, 0), b2, voffB); PG8_STAGE(PG8_SB(0, 1), b2 + hstep, voffB); PG8_STAGE(PG8_SA(0, 0), a2, voffA);
            PG8_WAIT_V(8); PG8_WAIT_L(0); PG8_BAR; PG8_MMA(1, 0, At, B0); PG8_MMA(1, 1, At, B1); PG8_BAR; PG8_SCHED;
            PG8_LDB(B0, 1, 0); PG8_LDB(B1, 1, 1); PG8_SCHED; PG8_LDA(At, 1, 0); PG8_STAGE(PG8_SA(0, 1), a2 + hstep, voffA);
            PG8_WAIT_V(8); PG8_WAIT_L(0); PG8_BAR; PG8_MMA(0, 0, At, B0); PG8_MMA(0, 1, At, B1); PG8_BAR; PG8_SCHED;
            PG8_LDA(At, 1, 1); PG8_STAGE(PG8_SB(1, 0), b3, voffB); PG8_STAGE(PG8_SB(1, 1), b3 + hstep, voffB); PG8_STAGE(PG8_SA(1, 0), a3, voffA);
            PG8_WAIT_V(8); PG8_WAIT_L(0); PG8_BAR; PG8_MMA(1, 0, At, B0); PG8_MMA(1, 1, At, B1); PG8_BAR; PG8_SCHED;
            } else {
            PG8_LDB(B0, 0, 0); PG8_SCHED; PG8_LDA(At, 0, 0); PG8_STAGE(PG8_SA(1, 1), a1 + hstep, voffA);
            PG8_WAIT_L(8); PG8_BAR; PG8_WAIT_L(0); PG8_MMA(0, 0, At, B0); PG8_BAR; PG8_SCHED;
            PG8_LDB(B1, 0, 1); PG8_STAGE(PG8_SB(0, 0), b2, voffB);
            PG8_BAR; PG8_WAIT_L(0); PG8_MMA(0, 1, At, B1); PG8_BAR;
            PG8_LDA(At, 0, 1); PG8_STAGE(PG8_SA(0, 0), a2, voffA);
            PG8_BAR; PG8_WAIT_L(0); PG8_MMA(1, 0, At, B0); PG8_BAR; PG8_SCHED;
            PG8_STAGE(PG8_SB(0, 1), b2 + hstep, voffB);
            PG8_WAIT_V(6); PG8_BAR; PG8_MMA(1, 1, At, B1); PG8_BAR;
            PG8_LDB(B0, 1, 0); PG8_SCHED; PG8_LDA(At, 1, 0); PG8_STAGE(PG8_SA(0, 1), a2 + hstep, voffA);
            PG8_WAIT_L(8); PG8_BAR; PG8_WAIT_L(0); PG8_MMA(0, 0, At, B0); PG8_BAR; PG8_SCHED;
            PG8_LDB(B1, 1, 1); PG8_STAGE(PG8_SB(1, 0), b3, voffB);
            PG8_BAR; PG8_WAIT_L(0); PG8_MMA(0, 1, At, B1); PG8_BAR;
            PG8_LDA(At, 1, 1); PG8_STAGE(PG8_SA(1, 0), a3, voffA);
            PG8_BAR; PG8_WAIT_L(0); PG8_MMA(1, 0, At, B0); PG8_BAR; PG8_SCHED;
            PG8_STAGE(PG8_SB(1, 1), b3 + hstep, voffB);
            PG8_WAIT_V(6); PG8_BAR; PG8_MMA(1, 1, At, B1); PG8_BAR;
            }
        }
        if constexpr (ALIGN_EPI) { if (wr == 0) PG8_BAR; }
        if constexpr (!Epi::AFTER_DRAIN) { E(acc, cur, wr, wc, fr, fq); S.done(cur); }
        if (!has_next) break;
#pragma unroll
        for (int a = 0; a < 2; ++a)
#pragma unroll
            for (int b = 0; b < 2; ++b)
#pragma unroll
                for (int m = 0; m < 4; ++m)
#pragma unroll
                    for (int n = 0; n < 2; ++n) acc[a][b][m][n] = (f32x4){0.f, 0.f, 0.f, 0.f};
        cur = nxt; cA = nA; cB = nB; ++ui;
        if constexpr (ALIGN_EPI) { if (wr == 1) PG8_BAR; }
    }
    PG8_WAIT_V(0);
    if constexpr (!ALIGN_EPI) { if (wr == 0) PG8_BAR; }
    PG8_BAR;
    if constexpr (Epi::AFTER_DRAIN) { E.fused(acc, cur, wr, wc, fr, fq, lds, wid, lane); S.done(cur); }
#undef PG8_SA
#undef PG8_SB
#undef PG8_STAGE
#undef PG8_LDA
#undef PG8_LDB
#undef PG8_MMA
#undef PG8_WAIT_V
#undef PG8_WAIT_L
#undef PG8_BAR
#undef PG8_SCHED
}
}
namespace cg = cooperative_groups;
#define LAS __attribute__((address_space(3)))
typedef unsigned short bf16;
typedef unsigned v4u __attribute__((ext_vector_type(4)));
typedef unsigned v2u __attribute__((ext_vector_type(2)));
typedef float f32x4 __attribute__((ext_vector_type(4)));
using pg8::bf16_t;

constexpr int DMODEL = 1024, NBATCH = 4, SEQL = 4096, CTXL = 256, LKV = SEQL + CTXL, ML = NBATCH * SEQL, MC = NBATCH * CTXL, MA = ML + MC, DFF = 4096, N1 = 2816, NMOD = 6 * DMODEL;
constexpr float EPSN = 1e-6f;
constexpr float QC2 = 0.125f * 1.4426950408889634f;
constexpr int NTHR = 512;
constexpr int LDS_BYTES = 147456;

constexpr size_t MiB = 1u << 20;
constexpr size_t WS_MOD = 0, WS_ROPE = 256 * 1024;
constexpr size_t W_IN = 2 * MiB, W_POOL = W_IN + (size_t)5888 * 1024 * 2, W_PO = W_POOL + 512 * 512 * 2, W_DO = W_PO + 1024 * 512 * 2, W_GO = W_DO + 1024 * 512 * 2,
                 W_O = W_GO + 1024 * 512 * 2, W_1 = W_O + 1024 * 1024 * 2, W_2 = W_1 + (size_t)4096 * 1024 * 2, W_END = W_2 + (size_t)4096 * 1024 * 2;
static_assert(W_END <= 36 * MiB, "weights");
constexpr size_t WS_CTX = 36 * MiB, WS_H = 40 * MiB;
constexpr size_t WS_POOLIN = 74 * MiB, WS_QD = 91 * MiB, WS_QG = 108 * MiB, WS_KD = 125 * MiB, WS_VD = 142 * MiB, WS_KG = 159 * MiB, WS_VG = WS_KG + (size_t)MA * 128 * 2;
constexpr size_t WS_OD = 176 * MiB, WS_GQAO = 210 * MiB, WS_POOLED = 227 * MiB;
constexpr size_t WS_DIFFO = 74 * MiB, WS_POOLO = 91 * MiB, WS_MERGED = 108 * MiB, WS_ACC = 142 * MiB, WS_Y = 142 * MiB, WS_HF = 210 * MiB, WS_U = 40 * MiB, WS_Z = 176 * MiB;
constexpr size_t WS_TOTAL = 244 * MiB;
static_assert(WS_VG + (size_t)MA * 128 * 2 <= 176 * MiB, "p1 outs");

__device__ __forceinline__ unsigned f2bf(float f) { unsigned u = __builtin_bit_cast(unsigned, f); return (u + 0x7fffu + ((u >> 16) & 1u)) >> 16; }
__device__ __forceinline__ unsigned pk2(float lo, float hi) { return f2bf(lo) | (f2bf(hi) << 16); }
__device__ __forceinline__ float bflo(unsigned w) { return __builtin_bit_cast(float, w << 16); }
__device__ __forceinline__ float bfhi(unsigned w) { return __builtin_bit_cast(float, w & 0xffff0000u); }
__device__ __forceinline__ float wave_sum(float v) {
#pragma unroll
    for (int o = 1; o < 64; o <<= 1) v += __shfl_xor(v, o);
    return v;
}

__device__ __forceinline__ int kvrow_of(int row) { return row < ML ? (row >> 12) * LKV + CTXL + (row & 4095) : ((row - ML) >> 8) * LKV + ((row - ML) & 255); }
__device__ __forceinline__ void rope8(float (&v)[8], const float* tab, int d, int t) {
    const int p0 = d >> 1, pos = p0 < 16 ? (t >> 6) : (t & 63), j0 = p0 & 15;
    const f32x4* tp = (const f32x4*)(tab + (pos * 16 + j0) * 2);
    const f32x4 t0 = tp[0], t1 = tp[1];
    float o[8];
    o[0] = v[0] * t0[0] - v[1] * t0[1]; o[1] = v[0] * t0[1] + v[1] * t0[0];
    o[2] = v[2] * t0[2] - v[3] * t0[3]; o[3] = v[2] * t0[3] + v[3] * t0[2];
    o[4] = v[4] * t1[0] - v[5] * t1[1]; o[5] = v[4] * t1[1] + v[5] * t1[0];
    o[6] = v[6] * t1[2] - v[7] * t1[3]; o[7] = v[6] * t1[3] + v[7] * t1[2];
#pragma unroll
    for (int i = 0; i < 8; ++i) v[i] = o[i];
}

#include <hip/hip_bf16.h>
#include <cmath>
namespace attn_body {
using bf16=__hip_bfloat16;
using bf16x8=__attribute__((ext_vector_type(8)))short;
using s16x4=__attribute__((ext_vector_type(4)))short;
using f32x16=__attribute__((ext_vector_type(16)))float;
using u32x4=__attribute__((ext_vector_type(4)))unsigned;
constexpr int D=64;
constexpr int NW=8,QBLK=32,QB=QBLK*NW,KVBLK=64;
constexpr int ATTN_UNIT_ROWS=QB;
__device__ __forceinline__ int crow(int r,int hi){return (r&3)+8*(r>>2)+4*hi;}
#define SBAR() __builtin_amdgcn_sched_barrier(0)
__device__ __forceinline__ void cmask(f32x16&p0,f32x16&p1,int jb,int qrel,int hi){
  const float NEG=-INFINITY; int kb=64*jb+4*hi;
  #pragma unroll
  for(int r=0;r<16;++r){int kv=kb+(r&3)+8*(r>>2); if(kv>qrel)p0[r]=NEG; if(kv+32>qrel)p1[r]=NEG;}
}

constexpr int NSLOT=3, SLOTB=8192;
constexpr int LDS_K=0, LDS_V=NSLOT*SLOTB, LDS_WS=2*NSLOT*SLOTB, LDS_OST=LDS_WS+NW*64*4, LDS_BYTES=LDS_OST+NW*4096;
constexpr float C2=0.125f*1.4426950408889634f;
__device__ __forceinline__ void glds16(const void*gsrc,unsigned lds_dst){unsigned keep;
  asm volatile("s_mov_b32 %0, m0\n\ts_mov_b32 m0, %2\n\ts_nop 0\n\tglobal_load_lds_dwordx4 %1, off\n\ts_mov_b32 m0, %0":"=&s"(keep):"v"(gsrc),"s"(lds_dst):"memory");}
__device__ __forceinline__ float max3f(float a,float b,float c){float r;asm("v_max3_f32 %0, %1, %2, %3":"=v"(r):"v"(a),"v"(b),"v"(c));return r;}
__device__ __forceinline__ float max2f(float a,float b){float r;asm("v_max_f32_e32 %0, %1, %2":"=v"(r):"v"(a),"v"(b));return r;}
__device__ __forceinline__ float fadd_s(float a,float b){float r;asm("v_add_f32_e32 %0, %1, %2":"=v"(r):"v"(a),"v"(b));return r;}
__device__ __forceinline__ float fsub_s(float a,float b){float r;asm("v_sub_f32_e32 %0, %1, %2":"=v"(r):"v"(a),"v"(b));return r;}
typedef float f32x2_t __attribute__((ext_vector_type(2))); typedef __bf16 bf16x2_t __attribute__((ext_vector_type(2)));
__device__ __forceinline__ unsigned cvtpk_s(float lo,float hi){f32x2_t v={lo,hi};bf16x2_t b=__builtin_convertvector(v,bf16x2_t);return __builtin_bit_cast(unsigned,b);}
#define WAIT_BAR(N) asm volatile("s_waitcnt vmcnt(" #N ") lgkmcnt(0)\n\ts_barrier":::"memory")

__device__ __forceinline__ void qkt(f32x16&p0,f32x16&p1,const char*Kslot,const bf16x8*qr,const f32x16&negm,int r32,int hi){
  const char*kb=Kslot+hi*1024+r32*16;
  #pragma unroll
  for(int d0=0;d0<4;++d0){
    const bf16x8 b0=*reinterpret_cast<const bf16x8*>(kb+d0*2048);
    const bf16x8 b1=*reinterpret_cast<const bf16x8*>(kb+d0*2048+512);
    if(d0==0){p0=__builtin_amdgcn_mfma_f32_32x32x16_bf16(b0,qr[0],negm,0,0,0);p1=__builtin_amdgcn_mfma_f32_32x32x16_bf16(b1,qr[0],negm,0,0,0);}
    else{p0=__builtin_amdgcn_mfma_f32_32x32x16_bf16(b0,qr[d0],p0,0,0,0);p1=__builtin_amdgcn_mfma_f32_32x32x16_bf16(b1,qr[d0],p1,0,0,0);}}
}
typedef __attribute__((address_space(3))) const char* lds_cptr;
typedef short v4i16_t __attribute__((ext_vector_type(4)));
__device__ __forceinline__ void kload8(bf16x8*kf,lds_cptr kp){
  kf[0]=*(const __attribute__((address_space(3))) bf16x8*)(kp);      kf[1]=*(const __attribute__((address_space(3))) bf16x8*)(kp+512);
  kf[2]=*(const __attribute__((address_space(3))) bf16x8*)(kp+2048); kf[3]=*(const __attribute__((address_space(3))) bf16x8*)(kp+2560);
  kf[4]=*(const __attribute__((address_space(3))) bf16x8*)(kp+4096); kf[5]=*(const __attribute__((address_space(3))) bf16x8*)(kp+4608);
  kf[6]=*(const __attribute__((address_space(3))) bf16x8*)(kp+6144); kf[7]=*(const __attribute__((address_space(3))) bf16x8*)(kp+6656);
}
__device__ __forceinline__ void kload2(bf16x8*kf,lds_cptr kp,int j){ kf[2*j]=*(const __attribute__((address_space(3))) bf16x8*)(kp+j*2048); kf[2*j+1]=*(const __attribute__((address_space(3))) bf16x8*)(kp+j*2048+512); }
__device__ __forceinline__ s16x4 vtr(lds_cptr p){ return __builtin_bit_cast(s16x4,__builtin_amdgcn_ds_read_tr16_b64_v4i16((__attribute__((address_space(3))) v4i16_t*)p)); }
__device__ __forceinline__ float rowmax(const f32x16&p0,const f32x16&p1){
  float a=max3f(p0[0],p0[1],p1[0]),b=max3f(p0[2],p0[3],p1[1]);a=max3f(a,p1[2],p1[3]);
  #pragma unroll
  for(int r=4;r<16;r+=4){a=max3f(a,p0[r],p0[r+1]);b=max3f(b,p0[r+2],p0[r+3]);a=max3f(a,p1[r],p1[r+1]);b=max3f(b,p1[r+2],p1[r+3]);}
  const float m=max2f(a,b);
  auto rr=__builtin_amdgcn_permlane32_swap(__float_as_uint(m),__float_as_uint(m),false,false);
  return max2f(__uint_as_float(rr[0]),__uint_as_float(rr[1]));
}
__device__ __forceinline__ void pv(f32x16*o,int vb,bf16x8 pa0,bf16x8 pa1,bf16x8 pa2,bf16x8 pa3){
  #pragma unroll
  for(int d0=0;d0<2;++d0){s16x4 lo[4],hi[4];
    #pragma unroll
    for(int ks=0;ks<4;++ks){
      asm volatile("ds_read_b64_tr_b16 %0,%1 offset:%c2":"=&v"(lo[ks]):"v"(vb),"i"(d0*4096+ks*1024):"memory");
      asm volatile("ds_read_b64_tr_b16 %0,%1 offset:%c2":"=&v"(hi[ks]):"v"(vb),"i"(d0*4096+ks*1024+512):"memory");}
    asm volatile("s_waitcnt lgkmcnt(0)":::"memory");SBAR();
    #define PK(k) (bf16x8){lo[k][0],lo[k][1],lo[k][2],lo[k][3],hi[k][0],hi[k][1],hi[k][2],hi[k][3]}
    o[d0]=__builtin_amdgcn_mfma_f32_32x32x16_bf16(pa0,PK(0),o[d0],0,0,0);
    o[d0]=__builtin_amdgcn_mfma_f32_32x32x16_bf16(pa1,PK(1),o[d0],0,0,0);
    o[d0]=__builtin_amdgcn_mfma_f32_32x32x16_bf16(pa2,PK(2),o[d0],0,0,0);
    o[d0]=__builtin_amdgcn_mfma_f32_32x32x16_bf16(pa3,PK(3),o[d0],0,0,0);
    #undef PK
  }
}

#ifndef ATTN_STORE16
#define ATTN_STORE16(p,v) (*(u32x4*)(p)=(v))
#endif
template<int THRL> __device__ __forceinline__ void attn_unit(const bf16*Qw0,int pqs,const bf16*__restrict__ Kh,int pks,const bf16*__restrict__ Vh,int pvs,bf16*Ow0,int pos_,const int NT,char*shm,const float*qgain,const float*rtab,const int qt0){
  int tid_l=threadIdx.x; asm volatile("":"+v"(tid_l)); const int tid=tid_l,lane=tid&63,r32=lane&31,hi=lane>>5; const int wid=__builtin_amdgcn_readfirstlane(tid>>6);
  const bf16*Qw=Qw0+(long)(wid*QBLK)*pqs;
  const unsigned lds0=(unsigned)(uintptr_t)shm;
  float*wsf=(float*)(shm+LDS_WS)+wid*64;
  const bf16*ksrc=Kh+(long)lane*pks+wid*8;
  const bf16*vsrc=Vh+(long)(16*(wid&3)+(lane>>2))*pvs+(wid>>2)*32+(lane&3)*8;
  const unsigned kdst=lds0+LDS_K+wid*1024, vdst=lds0+LDS_V+wid*1024;
  #define DMA_K(t,slot) glds16(ksrc+(long)(t)*KVBLK*pks,(unsigned)__builtin_amdgcn_readfirstlane(kdst+(slot)))
  #define DMA_V(t,slot) glds16(vsrc+(long)(t)*KVBLK*pvs,(unsigned)__builtin_amdgcn_readfirstlane(vdst+(slot)))
  const int vb0=(int)(lds0+LDS_V)+((lane>>4)&1)*32+(lane&3)*8+(4*hi+((lane&15)>>2))*64;
  const char*Kbase=shm+LDS_K; bf16x8 kf[8];
  const lds_cptr shm3=(lds_cptr)shm; const lds_cptr kp0=shm3+LDS_K+hi*1024+r32*16; const lds_cptr vp0=shm3+LDS_V+((lane>>4)&1)*32+(lane&3)*8+(4*hi+((lane&15)>>2))*64;
  DMA_K(0,0);DMA_V(0,0);DMA_K(1,SLOTB);
  bf16x8 qr[4];
  #pragma unroll
  for(int d0=0;d0<4;++d0)qr[d0]=*reinterpret_cast<const bf16x8*>(&Qw[(long)r32*pqs+d0*16+hi*8]);
  if(qgain){
    float f[4][8]; float ss=0.f;
    #pragma unroll
    for(int d0=0;d0<4;++d0){
      #pragma unroll
      for(int i=0;i<8;++i){ f[d0][i]=__builtin_bit_cast(float,((unsigned)(unsigned short)qr[d0][i])<<16); ss+=f[d0][i]*f[d0][i]; } }
    { auto rr=__builtin_amdgcn_permlane32_swap(__float_as_uint(ss),__float_as_uint(ss),false,false); ss=__uint_as_float(rr[0])+__uint_as_float(rr[1]); }
    const float rstd=1.0f/sqrtf(ss*(1.f/64.f)+1e-6f);
    #pragma unroll
    for(int d0=0;d0<4;++d0){ const int dd=d0*16+hi*8;
      #pragma unroll
      for(int i=0;i<8;++i) f[d0][i]*=rstd*qgain[dd+i];
      if(qt0>=0) rope8(f[d0],rtab,dd,qt0+wid*QBLK+r32);
      u32x4 w; w.x=pk2(f[d0][0]*C2,f[d0][1]*C2); w.y=pk2(f[d0][2]*C2,f[d0][3]*C2); w.z=pk2(f[d0][4]*C2,f[d0][5]*C2); w.w=pk2(f[d0][6]*C2,f[d0][7]*C2);
      qr[d0]=__builtin_bit_cast(bf16x8,w); }
  }
  float mhat=0.f,l_reg=0.f;f32x16 o[2];o[0]=f32x16{};o[1]=f32x16{};f32x16 negm=f32x16{};asm volatile("":"+v"(negm));
  #define CMASK(P0,P1,t) do{}while(0)
  bool resc=false;
  #define START(P0,P1) do{ const float rm=rowmax(P0,P1); resc=false; \
    { const float dl=rm; mhat=fadd_s(mhat,dl); \
      _Pragma("unroll") for(int r=0;r<16;++r){P0[r]=fsub_s(P0[r],dl);P1[r]=fsub_s(P1[r],dl);} \
      _Pragma("unroll") for(int r=0;r<16;++r)negm[r]=-mhat; asm volatile("":"+v"(negm)); } \
    _Pragma("unroll") for(int r=0;r<16;++r)P0[r]=__builtin_amdgcn_exp2f(P0[r]); }while(0)
  #define RESC() do{ if(resc){ asm volatile("s_waitcnt lgkmcnt(0)":::"memory"); \
      _Pragma("unroll") for(int d_=0;d_<2;++d_) _Pragma("unroll") for(int r=0;r<16;++r)o[d_][r]*=wsf[crow(r,hi)]; } }while(0)
  f32x16 pA0,pA1,pB0,pB1;
  int sl_prev=0,sl_cur=0,sl_next=SLOTB;
  #define ROT() do{sl_prev=sl_cur;sl_cur=sl_next;sl_next=(sl_next==(NSLOT-1)*SLOTB)?0:sl_next+SLOTB;}while(0)
  DMA_K(2,2*SLOTB);
  WAIT_BAR(3);
  qkt(pA0,pA1,Kbase,qr,negm,r32,hi);asm volatile("s_nop 15\n\ts_nop 7":"+v"(pA0),"+v"(pA1));CMASK(pA0,pA1,0);
  START(pA0,pA1);
  _Pragma("unroll") for(int r=0;r<16;++r)pA1[r]=__builtin_amdgcn_exp2f(pA1[r]);
  WAIT_BAR(0);
  DMA_K(3,0);DMA_V(1,SLOTB);
  ROT();
  kload8(kf,kp0+sl_cur);
  WAIT_BAR(2);
  s16x4 vlo[8],vhi[8]; u32x4 pw0,pw1,pw2,pw3;
  #define PKW(P,B) cvtpk_s(P[B],P[B+1])
  #define PAF(k) __builtin_bit_cast(bf16x8,pw##k)
  #define VFR(i) (bf16x8){vlo[i][0],vlo[i][1],vlo[i][2],vlo[i][3],vhi[i][0],vhi[i][1],vhi[i][2],vhi[i][3]}
  #define PIN(x) asm volatile("":"+v"(x))
  #define MX3(a,b,c) __builtin_fmaxf(__builtin_fmaxf((a),(b)),(c))
  #define GAPA(MF,A0,A1,A2,A3,W0,W1,PW) do{ MF; sacc+=A0; sacc+=A1; sacc+=A2; sacc+=A3; PIN(sacc); W0; W1; PIN(PW); SBAR(); }while(0)
  #define EX(v) __builtin_amdgcn_exp2f(v)
  #define GAPB(MF,X,B) do{ MF; X[B]=EX(X[B]); X[B+1]=EX(X[B+1]); X[B+2]=EX(X[B+2]); X[B+3]=EX(X[B+3]); PIN(X); SBAR(); }while(0)
  #define VRD(i) do{ vlo[i]=vtr(vp_+(((i)>>2)*4096+((i)&3)*1024)); vhi[i]=vtr(vp_+(((i)>>2)*4096+((i)&3)*1024+512)); }while(0)
  #define KRD(G,j) do{ if(G){ kload2(kf,kp0+sl_next,j); SBAR(); } }while(0)
  #define STEP(C0,C1,P0,P1,t,GK,GV,GL) do{ SBAR(); \
    const lds_cptr vp_=vp0+sl_prev; \
    VRD(0); SBAR(); float sacc=(P0[0]+P0[1]); \
    GAPA(C0=__builtin_amdgcn_mfma_f32_32x32x16_bf16(kf[0],qr[0],negm,0,0,0), P0[2],P0[3],P0[4],P0[5],     pw0[0]=PKW(P0,0), pw0[1]=PKW(P0,2), pw0); \
    VRD(4); SBAR(); GAPA(C1=__builtin_amdgcn_mfma_f32_32x32x16_bf16(kf[1],qr[0],negm,0,0,0), P0[6],P0[7],P0[8],P0[9],     pw0[2]=PKW(P0,4), pw0[3]=PKW(P0,6), pw0); \
    VRD(1); SBAR(); GAPA(C0=__builtin_amdgcn_mfma_f32_32x32x16_bf16(kf[2],qr[1],C0,0,0,0),   P0[10],P0[11],P0[12],P0[13], pw1[0]=PKW(P0,8), pw1[1]=PKW(P0,10), pw1); \
    VRD(5); SBAR(); GAPA(C1=__builtin_amdgcn_mfma_f32_32x32x16_bf16(kf[3],qr[1],C1,0,0,0),   P0[14],P0[15],P1[0],P1[1],   pw1[2]=PKW(P0,12),pw1[3]=PKW(P0,14), pw1); \
    VRD(2); SBAR(); GAPA(C0=__builtin_amdgcn_mfma_f32_32x32x16_bf16(kf[4],qr[2],C0,0,0,0),   P1[2],P1[3],P1[4],P1[5],     pw2[0]=PKW(P1,0), pw2[1]=PKW(P1,2), pw2); \
    VRD(6); SBAR(); GAPA(C1=__builtin_amdgcn_mfma_f32_32x32x16_bf16(kf[5],qr[2],C1,0,0,0),   P1[6],P1[7],P1[8],P1[9],     pw2[2]=PKW(P1,4), pw2[3]=PKW(P1,6), pw2); \
    VRD(3); SBAR(); GAPA(C0=__builtin_amdgcn_mfma_f32_32x32x16_bf16(kf[6],qr[3],C0,0,0,0),   P1[10],P1[11],P1[12],P1[13], pw3[0]=PKW(P1,8), pw3[1]=PKW(P1,10), pw3); \
    VRD(7); SBAR(); GAPA(C1=__builtin_amdgcn_mfma_f32_32x32x16_bf16(kf[7],qr[3],C1,0,0,0),   P1[14],P1[15],0.f,0.f,       pw3[2]=PKW(P1,12),pw3[3]=PKW(P1,14), pw3); \
    l_reg+=sacc; \
    if(GK){DMA_K((t)+3,sl_cur);} if(GV){DMA_V((t)+1,sl_next);} \
    CMASK(C0,C1,t); \
    { float a=MX3(C0[0],C0[1],C1[0]),b=MX3(C0[2],C0[3],C1[1]); a=MX3(a,C1[2],C1[3]); \
      _Pragma("unroll") for(int r=4;r<16;r+=4){a=MX3(a,C0[r],C0[r+1]);b=MX3(b,C0[r+2],C0[r+3]);a=MX3(a,C1[r],C1[r+1]);b=MX3(b,C1[r+2],C1[r+3]);} \
      float rm=__builtin_fmaxf(a,b); { auto rr=__builtin_amdgcn_permlane32_swap(__float_as_uint(rm),__float_as_uint(rm),false,false); rm=__builtin_fmaxf(__uint_as_float(rr[0]),__uint_as_float(rr[1])); } \
      resc=false; \
      if(__builtin_expect(__any(rm>(float)THRL),0)){ const float dl=__builtin_fmaxf(rm,0.f); mhat+=dl; \
        _Pragma("unroll") for(int r=0;r<16;++r){C0[r]-=dl;C1[r]-=dl;} \
        _Pragma("unroll") for(int r=0;r<16;++r)negm[r]=-mhat; asm volatile("":"+v"(negm)); \
        const float f=__builtin_amdgcn_exp2f(-dl); l_reg*=f; if(hi==0)wsf[r32]=f; resc=true; } } \
    SBAR(); \
    GAPB(o[0]=__builtin_amdgcn_mfma_f32_32x32x16_bf16(PAF(0),VFR(0),o[0],0,0,0), C0,0); \
    GAPB(o[1]=__builtin_amdgcn_mfma_f32_32x32x16_bf16(PAF(0),VFR(4),o[1],0,0,0), C0,4); \
    KRD(GL,0); GAPB(o[0]=__builtin_amdgcn_mfma_f32_32x32x16_bf16(PAF(1),VFR(1),o[0],0,0,0), C0,8); \
    KRD(GL,1); GAPB(o[1]=__builtin_amdgcn_mfma_f32_32x32x16_bf16(PAF(1),VFR(5),o[1],0,0,0), C0,12); \
    KRD(GL,2); GAPB(o[0]=__builtin_amdgcn_mfma_f32_32x32x16_bf16(PAF(2),VFR(2),o[0],0,0,0), C1,0); \
    KRD(GL,3); GAPB(o[1]=__builtin_amdgcn_mfma_f32_32x32x16_bf16(PAF(2),VFR(6),o[1],0,0,0), C1,4); \
    GAPB(o[0]=__builtin_amdgcn_mfma_f32_32x32x16_bf16(PAF(3),VFR(3),o[0],0,0,0), C1,8); \
    GAPB(o[1]=__builtin_amdgcn_mfma_f32_32x32x16_bf16(PAF(3),VFR(7),o[1],0,0,0), C1,12); \
    }while(0)
  int t=1;
  #undef CMASK
  #define CMASK(P0,P1,t) do{}while(0)
  for(;t+5<NT;t+=2){
    STEP(pB0,pB1,pA0,pA1,t,true,true,true);     WAIT_BAR(2); RESC(); ROT();
    STEP(pA0,pA1,pB0,pB1,t+1,true,true,true);   WAIT_BAR(2); RESC(); ROT();
  }
  #undef CMASK
  #define CMASK(P0,P1,t) do{}while(0)
  #define ENDW(tt) do{ if((tt)+3<NT){WAIT_BAR(2);} else if((tt)+2<NT){WAIT_BAR(1);} else {WAIT_BAR(0);} }while(0)
  for(;t+1<NT;t+=2){
    STEP(pB0,pB1,pA0,pA1,t,(t+3<NT),(t+1<NT),(t+1<NT));       ENDW(t);   RESC(); ROT();
    STEP(pA0,pA1,pB0,pB1,t+1,(t+4<NT),(t+2<NT),(t+2<NT));     ENDW(t+1); RESC(); ROT();
  }
  STEP(pB0,pB1,pA0,pA1,NT-1,false,false,false); RESC();
  { float sacc=pB0[0]+pB0[1]; _Pragma("unroll") for(int r=2;r<16;++r)sacc+=pB0[r]; _Pragma("unroll") for(int r=0;r<16;++r)sacc+=pB1[r]; l_reg+=sacc;
    pw0=(u32x4){PKW(pB0,0),PKW(pB0,2),PKW(pB0,4),PKW(pB0,6)};pw1=(u32x4){PKW(pB0,8),PKW(pB0,10),PKW(pB0,12),PKW(pB0,14)};pw2=(u32x4){PKW(pB1,0),PKW(pB1,2),PKW(pB1,4),PKW(pB1,6)};pw3=(u32x4){PKW(pB1,8),PKW(pB1,10),PKW(pB1,12),PKW(pB1,14)};
    SBAR(); pv(o,vb0+sl_cur,PAF(0),PAF(1),PAF(2),PAF(3)); }
  #undef PKW
  #undef PAF
  #undef VFR
  #undef PIN
  #undef MX3
  #undef GAPA
  #undef GAPB
  #undef EX
  #undef VRD
  #undef KRD
  #undef STEP
  #undef ENDW
  {auto rr=__builtin_amdgcn_permlane32_swap(__float_as_uint(l_reg),__float_as_uint(l_reg),false,false);l_reg=__uint_as_float(rr[0])+__uint_as_float(rr[1]);}
  if(hi==0)wsf[32+r32]=l_reg;asm volatile("s_waitcnt lgkmcnt(0)":::"memory");
  float rli[16];
  #pragma unroll
  for(int r=0;r<16;++r)rli[r]=__builtin_amdgcn_rcpf(wsf[32+crow(r,hi)]);
  bf16*Ow=Ow0+(long)(wid*QBLK)*pos_;
  { bf16*stg=(bf16*)(shm+LDS_OST)+wid*2048;
    #pragma unroll
    for(int r=0;r<16;++r){const int orow=crow(r,hi);
      #pragma unroll
      for(int d0=0;d0<2;++d0)stg[orow*64+d0*32+r32]=__float2bfloat16(o[d0][r]*rli[r]);}
    asm volatile("s_waitcnt lgkmcnt(0)":::"memory");
    #pragma unroll
    for(int i=0;i<4;++i){const int row=i*8+(lane>>3),ch=lane&7; const u32x4 v=*(const u32x4*)(stg+row*64+ch*8); ATTN_STORE16(Ow+(long)row*pos_+ch*8,v);} }
  asm volatile("s_waitcnt lgkmcnt(0)\n\ts_barrier":::"memory");
  #undef DMA_K
  #undef DMA_V
  #undef CMASK
  #undef START
  #undef RESC
  #undef ROT
}
constexpr int ATTN_LDS_BYTES=LDS_BYTES;
#undef SBAR
#undef WAIT_BAR
}
struct Args { const float* in[26]; float* out; unsigned char* ws; };

template <int ACT  > struct EpiAct {
    static constexpr bool PERM = true, AFTER_DRAIN = false;
    bf16_t* O; int ldc;
    __device__ __forceinline__ void operator()(const pg8::f32x4 (&acc)[2][2][4][2], const pg8::Unit& u, int wr, int wc, int fr, int fq) const {
        const int row0 = u.pm * 256 + wr * 64 + fr, col0 = u.pn * 256 + wc * 32 + 8 * fq;
#pragma unroll
        for (int ai = 0; ai < 2; ++ai)
#pragma unroll
            for (int m = 0; m < 4; ++m) { bf16_t* rowp = O + (size_t)(row0 + ai * 128 + m * 16) * ldc + col0;
#pragma unroll
                for (int bj = 0; bj < 2; ++bj) { float v[8];
#pragma unroll
                    for (int i = 0; i < 4; ++i) { v[i] = acc[ai][bj][m][0][i]; v[4 + i] = acc[ai][bj][m][1][i]; }
#pragma unroll
                    for (int i = 0; i < 8; ++i) {
                        if (ACT == 1) v[i] = 1.f / (1.f + __expf(-v[i]));
                        if (ACT == 2) { const float r = fmaxf(v[i], 0.f); v[i] = r * r; } }
                    pg8::u32x4 w; w.x = pk2(v[0], v[1]); w.y = pk2(v[2], v[3]); w.z = pk2(v[4], v[5]); w.w = pk2(v[6], v[7]);
                    *(pg8::u32x4*)(rowp + bj * 128) = w; } }
    }
};
struct EpiF32 {
    static constexpr bool PERM = true, AFTER_DRAIN = false;
    float* O; int ldc;
    __device__ __forceinline__ void operator()(const pg8::f32x4 (&acc)[2][2][4][2], const pg8::Unit& u, int wr, int wc, int fr, int fq) const {
        const int row0 = u.pm * 256 + wr * 64 + fr, col0 = u.pn * 256 + wc * 32 + 8 * fq;
#pragma unroll
        for (int ai = 0; ai < 2; ++ai)
#pragma unroll
            for (int m = 0; m < 4; ++m) { float* rowp = O + (size_t)(row0 + ai * 128 + m * 16) * ldc + col0;
#pragma unroll
                for (int bj = 0; bj < 2; ++bj) { *(pg8::f32x4*)(rowp + bj * 128) = acc[ai][bj][m][0]; *(pg8::f32x4*)(rowp + bj * 128 + 4) = acc[ai][bj][m][1]; } }
    }
};
struct EpiBranch {
    static constexpr bool PERM = true, AFTER_DRAIN = false;
    bf16_t* GO; float* ACC; int mode;
    __device__ __forceinline__ void operator()(const pg8::f32x4 (&acc)[2][2][4][2], const pg8::Unit& u, int wr, int wc, int fr, int fq) const {
        const int row0 = u.pm * 256 + wr * 64 + fr, col0 = u.pn * 256 + wc * 32 + 8 * fq;
#pragma unroll
        for (int ai = 0; ai < 2; ++ai)
#pragma unroll
            for (int m = 0; m < 4; ++m) { const size_t ro = (size_t)(row0 + ai * 128 + m * 16) * 1024 + col0;
#pragma unroll
                for (int bj = 0; bj < 2; ++bj) { const size_t idx = ro + bj * 128;
                    const pg8::u32x4 g = *(const pg8::u32x4*)(GO + idx);
                    pg8::f32x4 v0 = acc[ai][bj][m][0], v1 = acc[ai][bj][m][1];
                    v0[0] *= bflo(g.x); v0[1] *= bfhi(g.x); v0[2] *= bflo(g.y); v0[3] *= bfhi(g.y);
                    v1[0] *= bflo(g.z); v1[1] *= bfhi(g.z); v1[2] *= bflo(g.w); v1[3] *= bfhi(g.w);
                    if (mode > 0) { v0 += *(const pg8::f32x4*)(ACC + idx); v1 += *(const pg8::f32x4*)(ACC + idx + 4); }
                    if (mode < 2) { *(pg8::f32x4*)(ACC + idx) = v0; *(pg8::f32x4*)(ACC + idx + 4) = v1; }
                    else { pg8::u32x4 w; w.x = pk2(v0[0], v0[1]); w.y = pk2(v0[2], v0[3]); w.z = pk2(v1[0], v1[1]); w.w = pk2(v1[2], v1[3]); *(pg8::u32x4*)(GO + idx) = w; } } }
    }
};
struct EpiIn {
    static constexpr bool PERM = true, AFTER_DRAIN = false;
    unsigned char* ws;
    __device__ __forceinline__ void operator()(const pg8::f32x4 (&acc)[2][2][4][2], const pg8::Unit& u, int wr, int wc, int fr, int fq) const {
        const bool latent = u.pm < (ML / 256);
        const int cw = wc * 32 + 8 * fq;
        bf16_t* const poolin = (bf16_t*)(ws + WS_POOLIN); bf16_t* const qd = (bf16_t*)(ws + WS_QD); bf16_t* const qg = (bf16_t*)(ws + WS_QG); bf16_t* const kd = (bf16_t*)(ws + WS_KD);
        bf16_t* const vd = (bf16_t*)(ws + WS_VD); bf16_t* const kg = (bf16_t*)(ws + WS_KG); bf16_t* const vg = (bf16_t*)(ws + WS_VG); const float* const rope = (const float*)(ws + WS_ROPE);
#pragma unroll
        for (int bj = 0; bj < 2; ++bj) {
            const int cb = u.pn * 2 + bj;
            bf16_t* base; int pitch, coff; bool kvmap = false, dorope = false; float sc = 1.f;
            if (cb < 4) { base = poolin; pitch = 512; coff = cb * 128; }
            else if (cb < 8) { base = qd; pitch = 512; coff = (cb - 4) * 128; dorope = latent; sc = QC2; }
            else if (cb < 12) { base = qg; pitch = 512; coff = (cb - 8) * 128; }
            else if (cb < 16) { base = kd; pitch = 512; coff = (cb - 12) * 128; kvmap = true; dorope = latent; }
            else if (cb < 20) { base = vd; pitch = 512; coff = (cb - 16) * 128; kvmap = true; }
            else if (cb == 20) { base = kg; pitch = 128; coff = 0; kvmap = true; }
            else { base = vg; pitch = 128; coff = 0; kvmap = true; }
#pragma unroll
            for (int ai = 0; ai < 2; ++ai)
#pragma unroll
                for (int m = 0; m < 4; ++m) {
                    const int row = u.pm * 256 + ai * 128 + wr * 64 + m * 16 + fr;
                    const int drow = kvmap ? kvrow_of(row) : row;
                    float v[8];
#pragma unroll
                    for (int i = 0; i < 4; ++i) { v[i] = acc[ai][bj][m][0][i]; v[4 + i] = acc[ai][bj][m][1][i]; }
                    if (dorope) rope8(v, rope, cw & 63, row & 4095);
#pragma unroll
                    for (int i = 0; i < 8; ++i) v[i] *= sc;
                    pg8::u32x4 w; w.x = pk2(v[0], v[1]); w.y = pk2(v[2], v[3]); w.z = pk2(v[4], v[5]); w.w = pk2(v[6], v[7]);
                    *(pg8::u32x4*)(base + (size_t)drow * pitch + coff + cw) = w;
                }
        }
    }
};
__device__ __forceinline__ void head_norm_fix(bf16_t* p, const float* gain, bool dorope, int t, float sc, const float* tab) {
    float ss = 0.f;
#pragma unroll
    for (int ch = 0; ch < 8; ++ch) { const v4u w = *(const v4u*)(p + ch * 8);
        const float a0 = bflo(w.x), a1 = bfhi(w.x), a2 = bflo(w.y), a3 = bfhi(w.y), a4 = bflo(w.z), a5 = bfhi(w.z), a6 = bflo(w.w), a7 = bfhi(w.w);
        ss += (a0 * a0 + a1 * a1) + (a2 * a2 + a3 * a3) + (a4 * a4 + a5 * a5) + (a6 * a6 + a7 * a7); }
    const float rstd = 1.0f / sqrtf(ss * (1.f / 64.f) + EPSN);
#pragma unroll
    for (int ch = 0; ch < 8; ++ch) { const v4u w = *(const v4u*)(p + ch * 8);
        float v[8] = {bflo(w.x), bfhi(w.x), bflo(w.y), bfhi(w.y), bflo(w.z), bfhi(w.z), bflo(w.w), bfhi(w.w)};
        const f32x4 g0 = *(const f32x4*)(gain + ch * 8), g1 = *(const f32x4*)(gain + ch * 8 + 4);
        v[0] *= rstd * g0[0]; v[1] *= rstd * g0[1]; v[2] *= rstd * g0[2]; v[3] *= rstd * g0[3];
        v[4] *= rstd * g1[0]; v[5] *= rstd * g1[1]; v[6] *= rstd * g1[2]; v[7] *= rstd * g1[3];
        if (dorope) rope8(v, tab, ch * 8, t);
        v4u o; o.x = pk2(v[0] * sc, v[1] * sc); o.y = pk2(v[2] * sc, v[3] * sc); o.z = pk2(v[4] * sc, v[5] * sc); o.w = pk2(v[6] * sc, v[7] * sc);
        *(v4u*)(p + ch * 8) = o; }
}

__device__ __forceinline__ void transpose_item(const float* W, int K, int N, bf16* WT, int k0, int n0, int drow0, LAS float* scr, int lane) {
#pragma unroll 8
    for (int i = 0; i < 32; ++i) { const int kk = 2 * i + (lane >> 5); scr[kk * 33 + (lane & 31)] = W[(size_t)(k0 + kk) * N + n0 + (lane & 31)]; }
    asm volatile("s_waitcnt lgkmcnt(0)" ::: "memory");
    const int c = lane & 7;
#pragma unroll
    for (int j = 0; j < 4; ++j) { const int n = (lane >> 3) + 8 * j; const LAS float* s = scr + (8 * c) * 33 + n;
        v4u o; o.x = pk2(s[0 * 33], s[1 * 33]); o.y = pk2(s[2 * 33], s[3 * 33]); o.z = pk2(s[4 * 33], s[5 * 33]); o.w = pk2(s[6 * 33], s[7 * 33]);
        *(v4u*)(WT + (size_t)(drow0 + n) * K + k0 + 8 * c) = o; }
    asm volatile("s_waitcnt lgkmcnt(0)" ::: "memory");
}
struct WPtrs { const float *w_in, *w_grp, *pscale, *w_po, *w_do, *w_go, *w_o, *w_1, *w_2; };
__device__ __forceinline__ void convert_weights(const WPtrs& p, int l, unsigned char* ws, LAS unsigned char* lds, int gw, int NGW, int wave, int lane, int gtid, int NTH) {
    LAS float* scr = (LAS float*)(lds + wave * 16384);
    constexpr int I_IN = (1024 / 64) * (5888 / 32), I_BR = (512 / 64) * (1024 / 32), I_O = (1024 / 64) * (1024 / 32), I_1 = (1024 / 64) * (4096 / 32), I_2 = (4096 / 64) * (1024 / 32);
    constexpr int NITEMS = I_IN + 3 * I_BR + I_O + I_1 + I_2;
    for (int it = gw; it < NITEMS; it += NGW) {
        int r = it;
        if (r < I_IN) { const int nblk = 5888 / 32, kb = r / nblk, nb = r % nblk, n0 = nb * 32;
            const int d0 = n0 < 1536 ? n0 : (n0 < 4608 ? n0 - 1536 + N1 : n0 - 4608 + 1536);
            transpose_item(p.w_in + (size_t)l * 1024 * 5888, 1024, 5888, (bf16*)(ws + W_IN), kb * 64, n0, d0, scr, lane); continue; } r -= I_IN;
        if (r < I_BR) { const int nblk = 1024 / 32, kb = r / nblk, nb = r % nblk;
            transpose_item(p.w_po + (size_t)l * 512 * 1024, 512, 1024, (bf16*)(ws + W_PO), kb * 64, nb * 32, nb * 32, scr, lane); continue; } r -= I_BR;
        if (r < I_BR) { const int nblk = 1024 / 32, kb = r / nblk, nb = r % nblk;
            transpose_item(p.w_do + (size_t)l * 512 * 1024, 512, 1024, (bf16*)(ws + W_DO), kb * 64, nb * 32, nb * 32, scr, lane); continue; } r -= I_BR;
        if (r < I_BR) { const int nblk = 1024 / 32, kb = r / nblk, nb = r % nblk;
            transpose_item(p.w_go + (size_t)l * 512 * 1024, 512, 1024, (bf16*)(ws + W_GO), kb * 64, nb * 32, nb * 32, scr, lane); continue; } r -= I_BR;
        if (r < I_O) { const int nblk = 1024 / 32, kb = r / nblk, nb = r % nblk;
            transpose_item(p.w_o + (size_t)l * 1024 * 1024, 1024, 1024, (bf16*)(ws + W_O), kb * 64, nb * 32, nb * 32, scr, lane); continue; } r -= I_O;
        if (r < I_1) { const int nblk = 4096 / 32, kb = r / nblk, nb = r % nblk;
            transpose_item(p.w_1 + (size_t)l * 1024 * 4096, 1024, 4096, (bf16*)(ws + W_1), kb * 64, nb * 32, nb * 32, scr, lane); continue; } r -= I_1;
        { const int nblk = 1024 / 32, kb = r / nblk, nb = r % nblk;
            transpose_item(p.w_2 + (size_t)l * 4096 * 1024, 4096, 1024, (bf16*)(ws + W_2), kb * 64, nb * 32, nb * 32, scr, lane); }
    }
    const float* wg = p.w_grp + (size_t)l * 4 * 128 * 128; const float* psc = p.pscale + l * 512;
    unsigned* PT = (unsigned*)(ws + W_POOL);
    for (int i = gtid; i < 512 * 256; i += NTH) { const int n = i >> 8, k = (i & 255) * 2, g = n >> 7; float v0 = 0.f, v1 = 0.f;
        if ((k >> 7) == g) { const float* q = wg + ((size_t)(g * 128 + (k & 127))) * 128 + (n & 127); const float s = psc[n]; v0 = q[0] * s; v1 = q[128] * s; }
        PT[i] = pk2(v0, v1); }
}
__device__ __forceinline__ void mod_gemv(const float* cvec, const float* cctx, const float* wmod, const float* bmod, float* modout, LAS unsigned char* lds, int tid, int lane, int wave, int bx) {
    LAS float* st = (LAS float*)lds;
    LAS float* red = (LAS float*)(lds + 32768);
    for (int i = tid; i < 5 * 1024; i += NTHR) { const int bb = i >> 10, k = i & 1023; const float v = bb < 4 ? cvec[bb * 1024 + k] : cctx[k]; st[i] = v / (1.f + expf(-v)); }
    __syncthreads();
    if (bx < 192) {
        const int l = bx / 96, n0 = (bx % 96) * 64;
        const float* w = wmod + (size_t)l * 1024 * NMOD + n0 + lane;
        float a0 = 0.f, a1 = 0.f, a2 = 0.f, a3 = 0.f, a4 = 0.f;
        const int k0 = wave * 128;
#pragma unroll 16
        for (int kk = 0; kk < 128; ++kk) { const float wv = w[(size_t)(k0 + kk) * NMOD]; const int k = k0 + kk;
            a0 += st[k] * wv; a1 += st[1024 + k] * wv; a2 += st[2048 + k] * wv; a3 += st[3072 + k] * wv; a4 += st[4096 + k] * wv; }
        red[(wave * 5 + 0) * 64 + lane] = a0; red[(wave * 5 + 1) * 64 + lane] = a1; red[(wave * 5 + 2) * 64 + lane] = a2; red[(wave * 5 + 3) * 64 + lane] = a3; red[(wave * 5 + 4) * 64 + lane] = a4;
        __syncthreads();
        if (tid < 320) { const int bb = tid >> 6; float s = bmod[l * NMOD + n0 + lane];
#pragma unroll
            for (int w8 = 0; w8 < 8; ++w8) s += red[(w8 * 5 + bb) * 64 + lane];
            modout[(l * 5 + bb) * NMOD + n0 + lane] = s; }
    }
    __syncthreads();
}
__device__ __forceinline__ void norm_phase(int M, const float* xs_lat, const float* xs_ctx, float* xd_lat, float* xd_ctx, const float* z, const float* modl, int gtc, const float* gpost,
                                           bf16* hdst, const float* gnext, const float* modn, int shc, int scc, int gw, int NGW, int lane) {
    for (int m = gw; m < M; m += NGW) {
        const bool lat = m < ML; const int bb = lat ? (m >> 12) : 4;
        const float* xs = lat ? xs_lat + (size_t)m * 1024 : xs_ctx + (size_t)(m - ML) * 1024;
        f32x4 v[4];
#pragma unroll
        for (int j = 0; j < 4; ++j) v[j] = *(const f32x4*)(xs + 4 * lane + 256 * j);
        float* xd = lat ? xd_lat + (size_t)m * 1024 : xd_ctx + (size_t)(m - ML) * 1024;
        if (!z) {
#pragma unroll
            for (int j = 0; j < 4; ++j) *(f32x4*)(xd + 4 * lane + 256 * j) = v[j];
        } else {
            f32x4 zz[4]; float ss = 0.f;
#pragma unroll
            for (int j = 0; j < 4; ++j) { zz[j] = *(const f32x4*)(z + (size_t)m * 1024 + 4 * lane + 256 * j); ss += (zz[j][0] * zz[j][0] + zz[j][1] * zz[j][1]) + (zz[j][2] * zz[j][2] + zz[j][3] * zz[j][3]); }
            const float rz = 1.0f / sqrtf(wave_sum(ss) * (1.f / 1024.f) + EPSN);
            const float* gt = modl + bb * NMOD + gtc * 1024;
#pragma unroll
            for (int j = 0; j < 4; ++j) { const int c = 4 * lane + 256 * j; const f32x4 g4 = *(const f32x4*)(gpost + c), t4 = *(const f32x4*)(gt + c);
                v[j] = v[j] + t4 * ((zz[j] * rz) * g4); *(f32x4*)(xd + c) = v[j]; }
        }
        if (hdst) {
            float ss = 0.f;
#pragma unroll
            for (int j = 0; j < 4; ++j) ss += (v[j][0] * v[j][0] + v[j][1] * v[j][1]) + (v[j][2] * v[j][2] + v[j][3] * v[j][3]);
            const float rx = 1.0f / sqrtf(wave_sum(ss) * (1.f / 1024.f) + EPSN);
            const float* sh = modn + bb * NMOD + shc * 1024; const float* sc = modn + bb * NMOD + scc * 1024;
#pragma unroll
            for (int j = 0; j < 4; ++j) { const int c = 4 * lane + 256 * j; const f32x4 g4 = *(const f32x4*)(gnext + c), s4 = *(const f32x4*)(sc + c), h4 = *(const f32x4*)(sh + c);
                const f32x4 o = ((v[j] * rx) * g4) * (s4 + 1.0f) + h4;
                v2u w; w.x = pk2(o[0], o[1]); w.y = pk2(o[2], o[3]); *(v2u*)(hdst + (size_t)m * 1024 + c) = w; }
        }
    }
}
__device__ __forceinline__ void pool_phase(int M, const bf16* zin, bf16* pooled, int gtid, int NTH) {
    for (int it = gtid; it < M * 64; it += NTH) {
        const int m = it >> 6, ch = it & 63, g = ch >> 4, w2 = 1 << g;
        int t, l;
        if (m < ML) { t = m & 4095; l = SEQL; } else { t = (m - ML) & 255; l = CTXL; }
        const int base = m - t, lo = max(t - w2, 0), hi = min(t + w2, l);
        float s[8];
#pragma unroll
        for (int i = 0; i < 8; ++i) s[i] = 0.f;
        for (int j = lo; j < hi; ++j) { const v4u w = *(const v4u*)(zin + (size_t)(base + j) * 512 + ch * 8);
            s[0] += bflo(w.x); s[1] += bfhi(w.x); s[2] += bflo(w.y); s[3] += bfhi(w.y); s[4] += bflo(w.z); s[5] += bfhi(w.z); s[6] += bflo(w.w); s[7] += bfhi(w.w); }
        const float inv = 1.0f / (float)(hi - lo);
        const v4u w = *(const v4u*)(zin + (size_t)m * 512 + ch * 8);
        v4u o; o.x = pk2(s[0] * inv - bflo(w.x), s[1] * inv - bfhi(w.x)); o.y = pk2(s[2] * inv - bflo(w.y), s[3] * inv - bfhi(w.y));
        o.z = pk2(s[4] * inv - bflo(w.z), s[5] * inv - bfhi(w.z)); o.w = pk2(s[6] * inv - bflo(w.w), s[7] * inv - bfhi(w.w));
        *(v4u*)(pooled + (size_t)m * 512 + ch * 8) = o;
    }
}
__device__ __forceinline__ void diff_combine_phase(int M, const bf16* od, bf16* diffo, const float* subln, float lam, float lam_init, int gtid, int NTH) {
    for (int it = gtid; it < M * 64; it += NTH) {
        const int l16 = it & 15, hd = (it >> 4) & 3, m = it >> 6;
        const bf16* p1 = od + (size_t)m * 1024 + hd * 256 + l16 * 8;
        const v4u a = *(const v4u*)p1, b = *(const v4u*)(p1 + 128);
        float d[8];
        d[0] = bflo(a.x) - lam * bflo(b.x); d[1] = bfhi(a.x) - lam * bfhi(b.x); d[2] = bflo(a.y) - lam * bflo(b.y); d[3] = bfhi(a.y) - lam * bfhi(b.y);
        d[4] = bflo(a.z) - lam * bflo(b.z); d[5] = bfhi(a.z) - lam * bfhi(b.z); d[6] = bflo(a.w) - lam * bflo(b.w); d[7] = bfhi(a.w) - lam * bfhi(b.w);
        float ss = 0.f;
#pragma unroll
        for (int i = 0; i < 8; ++i) ss += d[i] * d[i];
        ss += __shfl_xor(ss, 1); ss += __shfl_xor(ss, 2); ss += __shfl_xor(ss, 4); ss += __shfl_xor(ss, 8);
        const float rstd = 1.0f / sqrtf(ss * (1.f / 128.f) + EPSN), k1 = 1.0f - lam_init;
        const f32x4 g0 = *(const f32x4*)(subln + l16 * 8), g1 = *(const f32x4*)(subln + l16 * 8 + 4);
        v4u o; o.x = pk2(d[0] * rstd * g0[0] * k1, d[1] * rstd * g0[1] * k1); o.y = pk2(d[2] * rstd * g0[2] * k1, d[3] * rstd * g0[3] * k1);
        o.z = pk2(d[4] * rstd * g1[0] * k1, d[5] * rstd * g1[1] * k1); o.w = pk2(d[6] * rstd * g1[2] * k1, d[7] * rstd * g1[3] * k1);
        *(v4u*)(diffo + (size_t)m * 512 + hd * 128 + l16 * 8) = o;
    }
}

#define RLX_AGENT __ATOMIC_RELAXED, __HIP_MEMORY_SCOPE_AGENT
#define XB_TMO      128
#define XB_XCNT(j)  (256  + 64 * (j))
#define XB_XSUB(j)  (1280 + 64 * (j))
#define XB_XGEN(j)  (2304 + 64 * (j))
#define XB_TOP      3328
#define XB_TOPGEN   3392
#define XCD_BAR_WORDS 3456
#define XB_SPIN_CAP (1u << 22)

__device__ __forceinline__ unsigned xb_ld(unsigned* p)              { return __hip_atomic_load(p, __ATOMIC_RELAXED, __HIP_MEMORY_SCOPE_AGENT); }
__device__ __forceinline__ unsigned xb_add(unsigned* p, unsigned v) { return __hip_atomic_fetch_add(p, v, __ATOMIC_RELAXED, __HIP_MEMORY_SCOPE_AGENT); }
__device__ __forceinline__ unsigned xb_xcc_id() { return (unsigned)__builtin_amdgcn_s_getreg((3 << 11) | 20) & 0xFu; }
#define XB_SPIN(cond, bar) do { unsigned _sp = 0; while (cond) { __builtin_amdgcn_s_sleep(1); \
    if ((++_sp & 255u) == 0u) { if (xb_ld(&(bar)[XB_TMO])) break; if (_sp > XB_SPIN_CAP) { atomicAdd(&(bar)[XB_TMO], 1u); break; } } } } while (0)

struct XcdBarrier {
    unsigned* bar; unsigned x;
    volatile LAS unsigned* st;
};

__device__ __forceinline__ XcdBarrier xcd_barrier_post(unsigned* bar, volatile LAS unsigned* st) {
    XcdBarrier b; b.bar = bar; b.x = xb_xcc_id(); b.st = st;
    if (threadIdx.x == 0) (void)xb_add(&bar[XB_XCNT(b.x)], 1u);
    return b;
}
__device__ __forceinline__ void xcd_barrier_complete(unsigned* bar, unsigned x, unsigned& nloc, unsigned& nx) {
    const unsigned G = gridDim.x * gridDim.y * gridDim.z;
    unsigned sum, cnt, mine, sp = 0u;
    for (;;) {
        sum = 0u; cnt = 0u; mine = 0u;
#pragma unroll
        for (unsigned j = 0; j < 16; ++j) { const unsigned c = xb_ld(&bar[XB_XCNT(j)]); sum += c; cnt += (c > 0u) ? 1u : 0u; mine = (j == x) ? c : mine; }
        if (sum == G) break;
        __builtin_amdgcn_s_sleep(1);
        if ((++sp & 255u) == 0u) { if (xb_ld(&bar[XB_TMO])) break; if (sp > XB_SPIN_CAP) { atomicAdd(&bar[XB_TMO], 1u); break; } }
    }
    nloc = mine > 0u ? mine : 1u; nx = cnt > 0u ? cnt : 1u;
}

__device__ __forceinline__ void xcd_barrier(const XcdBarrier& b) {
    asm volatile("s_waitcnt vmcnt(0)" ::: "memory");
    __syncthreads();
    if (threadIdx.x == 0) {
        unsigned* bar = b.bar;
        __builtin_amdgcn_s_waitcnt(0);
        unsigned nloc = b.st[0], nx = b.st[1];
        if (nloc == 0u) { xcd_barrier_complete(bar, b.x, nloc, nx); b.st[0] = nloc; b.st[1] = nx; }
        const unsigned old = xb_add(&bar[XB_XSUB(b.x)], 1u);
        const unsigned gen = old / nloc;
        if (old + 1u == (gen + 1u) * nloc) {
            __builtin_amdgcn_fence(__ATOMIC_RELEASE, "agent");
            asm volatile("s_waitcnt vmcnt(0)" ::: "memory");
            const unsigned og = xb_add(&bar[XB_TOP], 1u);
            const unsigned tg = og / nx;
            if (og + 1u == (tg + 1u) * nx) xb_add(&bar[XB_TOPGEN], 1u);
            else XB_SPIN(xb_ld(&bar[XB_TOPGEN]) == tg, bar);
            __builtin_amdgcn_fence(__ATOMIC_ACQUIRE, "agent");
            xb_add(&bar[XB_XGEN(b.x)], 1u);
            asm volatile("s_waitcnt vmcnt(0)" ::: "memory");
        } else {
            XB_SPIN(xb_ld(&bar[XB_XGEN(b.x)]) == gen, bar);
            __builtin_amdgcn_fence(__ATOMIC_ACQUIRE, "agent");
            asm volatile("s_waitcnt vmcnt(0)" ::: "memory");
        }
    }
    __syncthreads();
}
constexpr size_t WS_BAR = 320 * 1024;
constexpr int LDS_CTL = 131072, LDS_BARST = LDS_CTL + 352;
constexpr size_t WS_PTR = 300 * 1024;
struct Ids { int tid, lane, wave, bx, G, vcu, gw, NGW, gtid, NTH; };
#define FRESH_IDS(I) Ids I; { int t_ = threadIdx.x; asm volatile("" : "+v"(t_)); int b_ = blockIdx.x; asm volatile("" : "+s"(b_)); int g_ = gridDim.x; asm volatile("" : "+s"(g_)); \
    I.tid = t_; I.lane = t_ & 63; I.wave = __builtin_amdgcn_readfirstlane(t_ >> 6); I.bx = b_; I.G = g_; I.vcu = (g_ % 8 == 0) ? (b_ % 8) * (g_ / 8) + b_ / 8 : b_; \
    I.gw = I.vcu * 8 + I.wave; I.NGW = g_ * 8; I.gtid = b_ * NTHR + t_; I.NTH = g_ * NTHR; }
#define PTAB(i) (((const float* const*)(ws + WS_PTR))[i])

__global__ void __launch_bounds__(NTHR, 2) mk_fwd(Args a) {
    extern __shared__ __attribute__((aligned(16))) unsigned char lds_raw[];
    cg::grid_group grid = cg::this_grid();
    LAS unsigned char* lds = (LAS unsigned char*)lds_raw;
    unsigned char* ws = a.ws;
#define GSYNC_CG() do { asm volatile("s_waitcnt vmcnt(0) lgkmcnt(0)" ::: "memory"); grid.sync(); asm volatile("" ::: "memory"); } while (0)
#define GSYNC() do { XcdBarrier b_; b_.bar = (unsigned*)(ws + WS_BAR); b_.x = xb_xcc_id(); b_.st = (volatile LAS unsigned*)(lds + LDS_BARST); xcd_barrier(b_); asm volatile("" ::: "memory"); } while (0)
#ifndef REP_P1
#define REP_P1 1
#endif
#ifndef REP_P2
#define REP_P2 1
#endif
#ifndef REP_P3
#define REP_P3 1
#endif
#ifndef REP_P4
#define REP_P4 1
#endif
#ifndef REP_P5
#define REP_P5 1
#endif
#ifndef REP_P7
#define REP_P7 1
#endif
#ifndef REP_P8
#define REP_P8 1
#endif
#ifndef EXTRA_SYNCS
#define EXTRA_SYNCS 0
#endif
#define REPEAT(n) _Pragma("unroll 1") for (int rep_ = 0; rep_ < (n); ++rep_)
    for (int u = threadIdx.x; u < (LDS_BYTES - LDS_CTL) / 4; u += NTHR) ((LAS unsigned*)(lds + LDS_CTL))[u] = 0u;
    if (blockIdx.x == 0) for (int i = threadIdx.x; i < XCD_BAR_WORDS; i += NTHR) ((unsigned*)(ws + WS_BAR))[i] = 0u;
    __syncthreads();

    {
        FRESH_IDS(I);
        if (I.bx == 0 && I.tid == 0) {
            const float** tab = (const float**)(ws + WS_PTR);
#pragma unroll
            for (int i = 0; i < 26; ++i) tab[i] = a.in[i];
            tab[26] = a.out;
        }
        mod_gemv(a.in[1], a.in[3], a.in[4], a.in[5], (float*)(ws + WS_MOD), lds, I.tid, I.lane, I.wave, I.bx);
        WPtrs wp{a.in[10], a.in[11], a.in[12], a.in[20], a.in[21], a.in[22], a.in[23], a.in[24], a.in[25]};
        convert_weights(wp, 0, ws, lds, I.gw, I.NGW, I.wave, I.lane, I.gtid, I.NTH);
        if (I.bx == I.G - 1) { float* ropet = (float*)(ws + WS_ROPE);
            for (int i = I.tid; i < 1024; i += NTHR) { const int pos = i >> 4, j = i & 15; const float inv = 1.0f / powf(10000.0f, (float)j * 2.0f / 32.0f); const float ang = (float)pos * inv;
                ropet[2 * i] = cosf(ang); ropet[2 * i + 1] = sinf(ang); } }
    }
    GSYNC_CG();
    (void)xcd_barrier_post((unsigned*)(ws + WS_BAR), (volatile LAS unsigned*)(lds + LDS_BARST));
    for (int e_ = 0; e_ < EXTRA_SYNCS; ++e_) GSYNC();
    {
        FRESH_IDS(I);
        float* modv = (float*)(ws + WS_MOD);
        norm_phase(MA, PTAB(0), PTAB(2), (float*)PTAB(26), (float*)(ws + WS_CTX), nullptr, nullptr, 0, nullptr, (bf16*)(ws + WS_H), PTAB(6), modv, 0, 1, I.gw, I.NGW, I.lane);
    }
    GSYNC();

#pragma unroll 1
    for (int l = 0; l < 2; ++l) {
        REPEAT(REP_P1) {
        {
            FRESH_IDS(I);
            const float* ropet = (const float*)(ws + WS_ROPE);
            pg8::Gemm g{(const bf16_t*)(ws + WS_H), (const bf16_t*)(ws + W_IN), MA, N1, 1024}; pg8::StaticOrder S; S.init(MA, N1, I.G, I.bx);
            EpiIn E{ws};
            pg8::gemm_phase<EpiIn, pg8::StaticOrder, true, true>(lds, g, S, E);
        }
        {
            asm volatile("s_waitcnt vmcnt(0)" ::: "memory"); __syncthreads(); __builtin_amdgcn_fence(__ATOMIC_ACQUIRE, "agent"); asm volatile("s_waitcnt vmcnt(0)" ::: "memory");
            FRESH_IDS(I);
            const float* ropet = (const float*)(ws + WS_ROPE);
            const float* kn = PTAB(19) + l * 64;
            pg8::StaticOrder S; S.init(MA, N1, I.G, I.bx);
            pg8::Unit u;
            for (int i = 0; S.next(i, u); ++i) {
                const bool latent = u.pm < (ML / 256);
                if (u.pn == 10) {
                    const int hh = I.tid & 1, rl = I.tid >> 1, row = u.pm * 256 + rl;
                    head_norm_fix((bf16_t*)(ws + WS_KG) + (size_t)kvrow_of(row) * 128 + hh * 64, kn, latent, row & 4095, 1.0f, ropet);
                }
            }
        }
        GSYNC();
        }
        REPEAT(REP_P2) {
        {
            FRESH_IDS(I);
            const bool last = (l == 1); const int M2 = last ? ML : MA;
            pool_phase(M2, (const bf16*)(ws + WS_POOLIN), (bf16*)(ws + WS_POOLED), I.gtid, I.NTH);
            const int total = 1536 + (last ? 0 : 96);
            for (int i = 0;; ++i) {
                const int L = i * I.G + I.vcu; if (L >= total) break;
                int b, r, m0, NT;
                if (L < 1536) { const int qb = L & 15, pair = L >> 4; b = pair / 24; r = pair % 24; m0 = b * SEQL + qb * 256; NT = LKV / 64; }
                else { const int L2 = L - 1536; b = L2 / 24; r = L2 % 24; m0 = ML + b * CTXL; NT = CTXL / 64; }
                const attn_body::bf16 *Q, *K, *V; attn_body::bf16* O; int pq, pk, pv, po; const float* qgain = nullptr; int qt0 = -1;
                if (r < 16) { const int hd = r >> 2, qs = (r >> 1) & 1, vh = r & 1;
                    Q = (const attn_body::bf16*)(ws + WS_QD) + (size_t)m0 * 512 + hd * 128 + qs * 64; pq = 512;
                    K = (const attn_body::bf16*)(ws + WS_KD) + (size_t)(b * LKV) * 512 + hd * 128 + qs * 64; pk = 512;
                    V = (const attn_body::bf16*)(ws + WS_VD) + (size_t)(b * LKV) * 512 + hd * 128 + vh * 64; pv = 512;
                    O = (attn_body::bf16*)(ws + WS_OD) + (size_t)m0 * 1024 + hd * 256 + qs * 128 + vh * 64; po = 1024; }
                else { const int h = r - 16;
                    Q = (const attn_body::bf16*)(ws + WS_QG) + (size_t)m0 * 512 + h * 64; pq = 512;
                    K = (const attn_body::bf16*)(ws + WS_KG) + (size_t)(b * LKV) * 128 + (h >> 2) * 64; pk = 128;
                    V = (const attn_body::bf16*)(ws + WS_VG) + (size_t)(b * LKV) * 128 + (h >> 2) * 64; pv = 128;
                    O = (attn_body::bf16*)(ws + WS_GQAO) + (size_t)m0 * 512 + h * 64; po = 512; qgain = PTAB(18) + l * 64; qt0 = (L < 1536) ? (m0 & 4095) : -1; }
#ifndef NO_ATTN
                attn_body::attn_unit<8>(Q, pq, K, pk, V, pv, O, po, NT, (char*)lds_raw, qgain, (const float*)(ws + WS_ROPE), qt0);
#endif
            }
        }
        GSYNC();
        }
        REPEAT(REP_P3) {
        {
            FRESH_IDS(I);
            const bool last = (l == 1); const int M2 = last ? ML : MA; const float lam_init = last ? 0.35550906759f : 0.2f;
            const float *lq1 = PTAB(13) + l * 64, *lk1 = PTAB(14) + l * 64, *lq2 = PTAB(15) + l * 64, *lk2 = PTAB(16) + l * 64;
            float d1 = 0.f, d2 = 0.f;
            for (int i = 0; i < 64; ++i) { d1 += lq1[i] * lk1[i]; d2 += lq2[i] * lk2[i]; }
            const float lam = expf(d1) - expf(d2) + lam_init;
            diff_combine_phase(M2, (const bf16*)(ws + WS_OD), (bf16*)(ws + WS_DIFFO), PTAB(17) + l * 128, lam, lam_init, I.gtid, I.NTH);
            pg8::Gemm g{(const bf16_t*)(ws + WS_POOLED), (const bf16_t*)(ws + W_POOL), M2, 512, 512}; pg8::StaticOrder S; S.init(M2, 512, I.G, I.bx);
            EpiAct<0> E{(bf16_t*)(ws + WS_POOLO), 512};
            pg8::gemm_phase<EpiAct<0>, pg8::StaticOrder, true, true>(lds, g, S, E);
        }
        GSYNC();
        }
        REPEAT(REP_P4) {
#pragma unroll 1
        for (int b = 0; b < 3; ++b) {
            { FRESH_IDS(I); const int M2 = (l == 1) ? ML : MA;
              pg8::Gemm g{(const bf16_t*)(ws + WS_H), (const bf16_t*)(ws + W_IN) + (size_t)(N1 + b * 1024) * 1024, M2, 1024, 1024}; pg8::StaticOrder S; S.init(M2, 1024, I.G, I.bx);
              EpiAct<1> E{(bf16_t*)(ws + WS_MERGED), 1024};
              pg8::gemm_phase<EpiAct<1>, pg8::StaticOrder, true, true>(lds, g, S, E); }
            { FRESH_IDS(I); const int M2 = (l == 1) ? ML : MA;
              const bf16_t* A = (const bf16_t*)(ws + (b == 0 ? WS_POOLO : b == 1 ? WS_DIFFO : WS_GQAO)); const bf16_t* Bt = (const bf16_t*)(ws + (b == 0 ? W_PO : b == 1 ? W_DO : W_GO));
              pg8::Gemm g{A, Bt, M2, 1024, 512}; pg8::StaticOrder S; S.init(M2, 1024, I.G, I.bx);
              EpiBranch E{(bf16_t*)(ws + WS_MERGED), (float*)(ws + WS_ACC), b};
              pg8::gemm_phase<EpiBranch, pg8::StaticOrder, true, true>(lds, g, S, E); }
        }
        GSYNC();
        }
        REPEAT(REP_P5) {
        {
            FRESH_IDS(I); const int M2 = (l == 1) ? ML : MA;
            pg8::Gemm g{(const bf16_t*)(ws + WS_MERGED), (const bf16_t*)(ws + W_O), M2, 1024, 1024}; pg8::StaticOrder S; S.init(M2, 1024, I.G, I.bx);
            EpiF32 E{(float*)(ws + WS_Y), 1024};
            pg8::gemm_phase<EpiF32, pg8::StaticOrder, true, true>(lds, g, S, E);
        }
        GSYNC();
        }
        {
            FRESH_IDS(I); const int M2 = (l == 1) ? ML : MA;
            const float* modl = (const float*)(ws + WS_MOD) + l * 5 * NMOD; float* outp = (float*)PTAB(26); float* ctxx = (float*)(ws + WS_CTX);
            norm_phase(M2, outp, ctxx, outp, ctxx, (const float*)(ws + WS_Y), modl, 2, PTAB(7) + l * 1024, (bf16*)(ws + WS_HF), PTAB(8) + l * 1024, modl, 3, 4, I.gw, I.NGW, I.lane);
        }
        GSYNC();
        REPEAT(REP_P7) {
        {
            FRESH_IDS(I); const int M2 = (l == 1) ? ML : MA;
            pg8::Gemm g{(const bf16_t*)(ws + WS_HF), (const bf16_t*)(ws + W_1), M2, DFF, 1024}; pg8::StaticOrder S; S.init(M2, DFF, I.G, I.bx);
            EpiAct<2> E{(bf16_t*)(ws + WS_U), DFF};
            pg8::gemm_phase<EpiAct<2>, pg8::StaticOrder, true, true>(lds, g, S, E);
        }
        GSYNC();
        }
        REPEAT(REP_P8) {
        {
            FRESH_IDS(I); const int M2 = (l == 1) ? ML : MA;
            pg8::Gemm g{(const bf16_t*)(ws + WS_U), (const bf16_t*)(ws + W_2), M2, 1024, DFF}; pg8::StaticOrder S; S.init(M2, 1024, I.G, I.bx);
            EpiF32 E{(float*)(ws + WS_Z), 1024};
            pg8::gemm_phase<EpiF32, pg8::StaticOrder, true, true>(lds, g, S, E);
        }
        GSYNC();
        }
        {
            FRESH_IDS(I);
            const float* modl = (const float*)(ws + WS_MOD) + l * 5 * NMOD; float* outp = (float*)PTAB(26); float* ctxx = (float*)(ws + WS_CTX);
            if (l == 0) {
                WPtrs wp{PTAB(10), PTAB(11), PTAB(12), PTAB(20), PTAB(21), PTAB(22), PTAB(23), PTAB(24), PTAB(25)};
                convert_weights(wp, 1, ws, lds, I.gw, I.NGW, I.wave, I.lane, I.gtid, I.NTH);
                norm_phase(MA, outp, ctxx, outp, ctxx, (const float*)(ws + WS_Z), modl, 5, PTAB(9) + l * 1024, (bf16*)(ws + WS_H), PTAB(6) + 1024, modl + 5 * NMOD, 0, 1, I.gw, I.NGW, I.lane);
            } else {
                norm_phase(ML, outp, ctxx, outp, ctxx, (const float*)(ws + WS_Z), modl, 5, PTAB(9) + l * 1024, nullptr, nullptr, nullptr, 0, 0, I.gw, I.NGW, I.lane);
            }
        }
        if (l == 0) GSYNC();
    }
#undef GSYNC
}

extern "C" void kernel_launch(void* const* d_in, const int* in_sizes, int n_in, void* d_out, int out_size, void* d_ws, size_t ws_size, hipStream_t stream) {
    static int grid = 0;
    if (grid == 0) {
        if (n_in != 26 || out_size != ML * DMODEL || ws_size < WS_TOTAL) { fprintf(stderr, "kernel_launch: unexpected shapes (n_in %d out %d ws %zu)\n", n_in, out_size, ws_size); grid = -1; return; }
        int dev = 0, cus = 0, per_cu = 0;
        if (hipGetDevice(&dev) != hipSuccess || hipDeviceGetAttribute(&cus, hipDeviceAttributeMultiprocessorCount, dev) != hipSuccess) { grid = -1; return; }
        if (hipFuncSetAttribute((const void*)mk_fwd, hipFuncAttributeMaxDynamicSharedMemorySize, LDS_BYTES) != hipSuccess) { fprintf(stderr, "kernel_launch: hipFuncSetAttribute failed\n"); grid = -1; return; }
        if (hipOccupancyMaxActiveBlocksPerMultiprocessor(&per_cu, (const void*)mk_fwd, NTHR, LDS_BYTES) != hipSuccess || per_cu < 1) per_cu = 1;
        (void)hipGetLastError();
        grid = cus * per_cu;
    }
    if (grid < 0) return;
    Args a{};
    for (int i = 0; i < 26; ++i) a.in[i] = (const float*)d_in[i];
    a.out = (float*)d_out; a.ws = (unsigned char*)d_ws;
    void* args[] = {&a};
    hipError_t e = hipLaunchCooperativeKernel((const void*)mk_fwd, dim3(grid), dim3(NTHR), args, LDS_BYTES, stream);
    if (e != hipSuccess) fprintf(stderr, "kernel_launch: cooperative launch failed: %s (grid %d)\n", hipGetErrorString(e), grid);
}
```

```cpp
#include <hip/hip_runtime.h>
#include <hip/hip_cooperative_groups.h>
#include <cstdio>
#include <cstdint>

namespace pg8 {
#define PG8_LAS __attribute__((address_space(3)))
typedef unsigned short bf16_t;
typedef short bf16x8 __attribute__((ext_vector_type(8)));
typedef float f32x4 __attribute__((ext_vector_type(4)));
typedef unsigned u32x4 __attribute__((ext_vector_type(4)));
constexpr int BM = 256, BK = 64, HALF = 128, HTB = HALF * BK * 2  , STAGE_BYTES = 8 * HTB, NXCD = 8, WGM = 8;

__host__ __device__ __forceinline__ int lds_byte(int r, int c) { const int st = (r >> 4) * 2 + (c >> 5), rr = r & 15, cc = c & 31, ob = rr * 64 + cc * 2; return st * 1024 + (ob ^ (((ob >> 9) & 1) << 5)); }
__host__ __device__ __forceinline__ void stage_rc(int b, int& R, int& C) { const int st = b / 1024, sb = b % 1024, swz = sb ^ (((sb >> 9) & 1) << 5); R = (st >> 1) * 16 + swz / 64; C = (st & 1) * 32 + (swz % 64) / 2; }
__host__ __device__ __forceinline__ int perm32(int rho) { const int n = rho >> 4, i = rho & 15; return 8 * (i >> 2) + 4 * n + (i & 3); }

struct Unit { int pm, pn; };
struct Gemm { const bf16_t* A; const bf16_t* Bt; int M, N, K; };

struct StaticOrder {
    int nM, nN, nwg, G, c;
    __host__ __device__ void init(int M, int N, int G_, int c_) { nM = M / BM; nN = N / BM; nwg = nM * nN; G = G_; c = c_; }
    __host__ __device__ bool next(int i, Unit& u) const {
        const long L = (long)i * G + c; if (L >= nwg) return false;
        int wgid = (int)L; { const int q = nwg / NXCD, r = nwg % NXCD, xcd = wgid % NXCD, off = wgid / NXCD; wgid = (xcd < r ? xcd * (q + 1) : r * (q + 1) + (xcd - r) * q) + off; }
        const int nig = WGM * nN, gid = wgid / nig, fm = gid * WGM, gsz = (nM - fm) < WGM ? (nM - fm) : WGM;
        u.pm = fm + ((wgid % nig) % gsz); u.pn = (wgid % nig) / gsz; return true;
    }
    __device__ __forceinline__ void a_ready(const Unit&) const {}
    __device__ __forceinline__ void done(const Unit&) const {}
};

__device__ __forceinline__ unsigned cvt_pk_bf16(float lo, float hi) { unsigned r; asm volatile("v_cvt_pk_bf16_f32 %0, %1, %2" : "=v"(r) : "v"(lo), "v"(hi)); return r; }
typedef float f32x2 __attribute__((ext_vector_type(2)));
template <class Epi, class Sched, bool ALIGN_EPI = false, bool SP2 = false>
__device__ __forceinline__ void gemm_phase(PG8_LAS unsigned char* lds, const Gemm g, const Sched& S, const Epi& E) {
    int tid_l = threadIdx.x; asm volatile("" : "+v"(tid_l)); const int tid = tid_l, wid = __builtin_amdgcn_readfirstlane(tid >> 6), lane = tid & 63, wr = wid >> 2, wc = wid & 3, fr = lane & 15, fq = lane >> 4;
    const int K = g.K, nt = K / BK;
    unsigned voffA[2], voffB[2];
#pragma unroll
    for (int i = 0; i < 2; ++i) { int R, C; stage_rc(tid * 16 + i * 8192, R, C); const int Rb = Epi::PERM ? ((R & ~31) + perm32(R & 31)) : R;
        voffA[i] = (unsigned)(R * K + C) * 2u; voffB[i] = (unsigned)(Rb * K + C) * 2u; }
    const size_t kstep = (size_t)(BK * 2);
    const size_t hstep = (size_t)HALF * K * 2;
    const size_t tstep = 2 * hstep;
    const unsigned ldsw = (unsigned)wid * 1024u;
    const int aoff = lds_byte(wr * 64 + fr, fq * 8), boff = lds_byte(wc * 32 + fr, fq * 8);
#define PG8_SA(b, h) (((b) * 2 + (h)) * HTB)
#define PG8_SB(b, h) ((4 + (b) * 2 + (h)) * HTB)
#define PG8_STAGE(bufoff, gbase, voff) do { _Pragma("unroll") for (int _i = 0; _i < 2; ++_i) \
        __builtin_amdgcn_global_load_lds((const unsigned*)((const char*)(gbase) + (voff)[_i]), (PG8_LAS unsigned*)(lds + (bufoff) + ldsw + _i * 8192), 16, 0, 0); } while (0)
#define PG8_LDA(dst, b, h) do { _Pragma("unroll") for (int m = 0; m < 4; ++m) _Pragma("unroll") for (int k = 0; k < 2; ++k) dst[m][k] = *(const PG8_LAS bf16x8*)(lds + PG8_SA(b, h) + aoff + m * 2048 + k * 1024); } while (0)
#define PG8_LDB(dst, b, h) do { _Pragma("unroll") for (int n = 0; n < 2; ++n) _Pragma("unroll") for (int k = 0; k < 2; ++k) dst[n][k] = *(const PG8_LAS bf16x8*)(lds + PG8_SB(b, h) + boff + n * 2048 + k * 1024); } while (0)
#define PG8_MMA(ai, bj, At, Bt) do { __builtin_amdgcn_s_setprio(1); _Pragma("unroll") for (int m = 0; m < 4; ++m) _Pragma("unroll") for (int n = 0; n < 2; ++n) _Pragma("unroll") for (int k = 0; k < 2; ++k) \
        acc[ai][bj][m][n] = __builtin_amdgcn_mfma_f32_16x16x32_bf16(Bt[n][k], At[m][k], acc[ai][bj][m][n], 0, 0, 0); __builtin_amdgcn_s_setprio(0); } while (0)
#define PG8_WAIT_V(n) asm volatile("s_waitcnt vmcnt(" #n ")" ::: "memory")
#define PG8_WAIT_L(n) asm volatile("s_waitcnt lgkmcnt(" #n ")" ::: "memory")
#define PG8_BAR __builtin_amdgcn_s_barrier()
#define PG8_SCHED __builtin_amdgcn_sched_barrier(0)
    Unit cur, nxt; int ui = 0;
    if (!S.next(0, cur)) return;
    f32x4 acc[2][2][4][2];
#pragma unroll
    for (int a = 0; a < 2; ++a)
#pragma unroll
        for (int b = 0; b < 2; ++b)
#pragma unroll
            for (int m = 0; m < 4; ++m)
#pragma unroll
                for (int n = 0; n < 2; ++n) acc[a][b][m][n] = (f32x4){0.f, 0.f, 0.f, 0.f};
    bf16x8 At[4][2], B0[2][2], B1[2][2];
    const char* cA = (const char*)g.A + (size_t)cur.pm * tstep; const char* cB = (const char*)g.Bt + (size_t)cur.pn * tstep;
    S.a_ready(cur);
    if constexpr (SP2) {
        PG8_STAGE(PG8_SB(0, 0), cB, voffB); PG8_STAGE(PG8_SB(0, 1), cB + hstep, voffB); PG8_STAGE(PG8_SA(0, 0), cA, voffA); PG8_STAGE(PG8_SA(0, 1), cA + hstep, voffA);
        if (wr == 1) PG8_BAR;
        PG8_WAIT_V(2); PG8_BAR;
        PG8_STAGE(PG8_SB(1, 0), cB + kstep, voffB); PG8_STAGE(PG8_SA(1, 0), cA + kstep, voffA); PG8_STAGE(PG8_SB(1, 1), cB + hstep + kstep, voffB);
        PG8_WAIT_V(6); PG8_BAR;
    } else {
        PG8_STAGE(PG8_SB(0, 0), cB, voffB); PG8_STAGE(PG8_SA(0, 0), cA, voffA); PG8_STAGE(PG8_SB(0, 1), cB + hstep, voffB); PG8_STAGE(PG8_SA(0, 1), cA + hstep, voffA);
        if (wr == 1) PG8_BAR;
        PG8_WAIT_V(4); PG8_BAR;
        PG8_STAGE(PG8_SB(1, 0), cB + kstep, voffB); PG8_STAGE(PG8_SA(1, 0), cA + kstep, voffA); PG8_STAGE(PG8_SB(1, 1), cB + hstep + kstep, voffB);
        PG8_WAIT_V(6); PG8_BAR;
    }
    for (;;) {
        const bool has_next = S.next(ui + 1, nxt);
        const char* nA = has_next ? (const char*)g.A + (size_t)nxt.pm * tstep : cA; const char* nB = has_next ? (const char*)g.Bt + (size_t)nxt.pn * tstep : cB;
        for (int t = 0; t < nt; t += 2) {
            const bool last = (t == nt - 2);
            const char* a1 = cA + (size_t)(t + 1) * kstep;
            const char* a2 = last ? nA : cA + (size_t)(t + 2) * kstep; const char* b2 = last ? nB : cB + (size_t)(t + 2) * kstep;
            const char* a3 = a2 + kstep; const char* b3 = b2 + kstep;
            if (last && has_next) S.a_ready(nxt);
            if constexpr (SP2) {
            PG8_LDB(B0, 0, 0); PG8_LDB(B1, 0, 1); PG8_SCHED; PG8_LDA(At, 0, 0); PG8_STAGE(PG8_SA(1, 1), a1 + hstep, voffA);
            PG8_WAIT_V(8); PG8_WAIT_L(0); PG8_BAR; PG8_MMA(0, 0, At, B0); PG8_MMA(0, 1, At, B1); PG8_BAR; PG8_SCHED;
            PG8_LDA(At, 0, 1); PG8_STAGE(PG8_SB(0, 0), b2, voffB); PG8_STAGE(PG8_SB(0, 1), b2 + hstep, voffB); PG8_STAGE(PG8_SA(0, 0), a2, voffA);
            PG8_WAIT_V(8); PG8_WAIT_L(0); PG8_BAR; PG8_MMA(1, 0, At, B0); PG8_MMA(1, 1, At, B1); PG8_BAR; PG8_SCHED;
            PG8_LDB(B0, 1, 0); PG8_LDB(B1, 1, 1); PG8_SCHED; PG8_LDA(At, 1, 0); PG8_STAGE(PG8_SA(0, 1), a2 + hstep, voffA);
            PG8_WAIT_V(8); PG8_WAIT_L(0); PG8_BAR; PG8_MMA(0, 0, At, B0); PG8_MMA(0, 1, At, B1); PG8_BAR; PG8_SCHED;
            PG8_LDA(At, 1, 1); PG8_STAGE(PG8_SB(1, 0), b3, voffB); PG8_STAGE(PG8_SB(1, 1), b3 + hstep, voffB); PG8_STAGE(PG8_SA(1, 0), a3, voffA);
            PG8_WAIT_V(8); PG8_WAIT_L(0); PG8_BAR; PG8_MMA(1, 0, At, B0); PG8_MMA(1, 1, At, B1); PG8_BAR; PG8_SCHED;
            } else {
            PG8_LDB(B0, 0, 0); PG8_SCHED; PG8_LDA(At, 0, 0); PG8_STAGE(PG8_SA(1, 1), a1 + hstep, voffA);
            PG8_WAIT_L(8); PG8_BAR; PG8_WAIT_L(0); PG8_MMA(0, 0, At, B0); PG8_BAR; PG8_SCHED;
            PG8_LDB(B1, 0, 1); PG8_STAGE(PG8_SB(0, 0), b2, voffB);
            PG8_BAR; PG8_WAIT_L(0); PG8_MMA(0, 1, At, B1); PG8_BAR;
            PG8_LDA(At, 0, 1); PG8_STAGE(PG8_SA(0, 0), a2, voffA);
            PG8_BAR; PG8_WAIT_L(0); PG8_MMA(1, 0, At, B0); PG8_BAR; PG8_SCHED;
            PG8_STAGE(PG8_SB(0, 1), b2 + hstep, voffB);
            PG8_WAIT_V(6); PG8_BAR; PG8_MMA(1, 1, At, B1); PG8_BAR;
            PG8_LDB(B0, 1, 0); PG8_SCHED; PG8_LDA(At, 1, 0); PG8_STAGE(PG8_SA(0, 1), a2 + hstep, voffA);
            PG8_WAIT_L(8); PG8_BAR; PG8_WAIT_L(0); PG8_MMA(0, 0, At, B0); PG8_BAR; PG8_SCHED;
            PG8_LDB(B1, 1, 1); PG8_STAGE(PG8_SB(1, 0), b3, voffB);
            PG8_BAR; PG8_WAIT_L(0); PG8_MMA(0, 1, At, B1); PG8_BAR;
            PG8_LDA(At, 1, 1); PG8_STAGE(PG8_SA(1, 0), a3, voffA);
            PG8_BAR; PG8_WAIT_L(0); PG8_MMA(1, 0, At, B0); PG8_BAR; PG8_SCHED;
            PG8_STAGE(PG8_SB(1, 1), b3 + hstep, voffB);
            PG8_WAIT_V(6); PG8_BAR; PG8_MMA(1, 1, At, B1); PG8_BAR;
            }
        }
        if constexpr (ALIGN_EPI) { if (wr == 0) PG8_BAR; }
        if constexpr (!Epi::AFTER_DRAIN) { E(acc, cur, wr, wc, fr, fq); S.done(cur); }
        if (!has_next) break;
#pragma unroll
        for (int a = 0; a < 2; ++a)
#pragma unroll
            for (int b = 0; b < 2; ++b)
#pragma unroll
                for (int m = 0; m < 4; ++m)
#pragma unroll
                    for (int n = 0; n < 2; ++n) acc[a][b][m][n] = (f32x4){0.f, 0.f, 0.f, 0.f};
        cur = nxt; cA = nA; cB = nB; ++ui;
        if constexpr (ALIGN_EPI) { if (wr == 1) PG8_BAR; }
    }
    PG8_WAIT_V(0);
    if constexpr (!ALIGN_EPI) { if (wr == 0) PG8_BAR; }
    PG8_BAR;
    if constexpr (Epi::AFTER_DRAIN) { E.fused(acc, cur, wr, wc, fr, fq, lds, wid, lane); S.done(cur); }
#undef PG8_SA
#undef PG8_SB
#undef PG8_STAGE
#undef PG8_LDA
#undef PG8_LDB
#undef PG8_MMA
#undef PG8_WAIT_V
#undef PG8_WAIT_L
#undef PG8_BAR
#undef PG8_SCHED
}
}
namespace cg = cooperative_groups;
#define LAS __attribute__((address_space(3)))
typedef unsigned short bf16;
typedef unsigned v4u __attribute__((ext_vector_type(4)));
typedef unsigned v2u __attribute__((ext_vector_type(2)));
typedef float f32x4 __attribute__((ext_vector_type(4)));
using pg8::bf16_t;

constexpr int DMODEL = 1024, NBATCH = 4, SEQL = 4096, CTXL = 256, LKV = SEQL + CTXL, ML = NBATCH * SEQL, MC = NBATCH * CTXL, MA = ML + MC, DFF = 4096, N1 = 2816, NMOD = 6 * DMODEL;
constexpr float EPSN = 1e-6f;
constexpr float QC2 = 0.125f * 1.4426950408889634f;
constexpr int NTHR = 512;
constexpr int LDS_BYTES = 147456;

constexpr size_t MiB = 1u << 20;
constexpr size_t WS_MOD = 0, WS_ROPE = 256 * 1024;
constexpr size_t W_IN = 2 * MiB, W_POOL = W_IN + (size_t)5888 * 1024 * 2, W_PO = W_POOL + 512 * 512 * 2, W_DO = W_PO + 1024 * 512 * 2, W_GO = W_DO + 1024 * 512 * 2,
                 W_O = W_GO + 1024 * 512 * 2, W_1 = W_O + 1024 * 1024 * 2, W_2 = W_1 + (size_t)4096 * 1024 * 2, W_END = W_2 + (size_t)4096 * 1024 * 2;
static_assert(W_END <= 36 * MiB, "weights");
constexpr size_t WS_CTX = 36 * MiB, WS_H = 40 * MiB;
constexpr size_t WS_POOLIN = 74 * MiB, WS_QD = 91 * MiB, WS_QG = 108 * MiB, WS_KD = 125 * MiB, WS_VD = 142 * MiB, WS_KG = 159 * MiB, WS_VG = WS_KG + (size_t)MA * 128 * 2;
constexpr size_t WS_OD = 176 * MiB, WS_GQAO = 210 * MiB, WS_POOLED = 227 * MiB;
constexpr size_t WS_DIFFO = 74 * MiB, WS_POOLO = 91 * MiB, WS_MERGED = 108 * MiB, WS_ACC = 142 * MiB, WS_Y = 142 * MiB, WS_HF = 210 * MiB, WS_U = 40 * MiB, WS_Z = 176 * MiB;
constexpr size_t WS_TOTAL = 244 * MiB;
static_assert(WS_VG + (size_t)MA * 128 * 2 <= 176 * MiB, "p1 outs");

__device__ __forceinline__ unsigned f2bf(float f) { unsigned u = __builtin_bit_cast(unsigned, f); return (u + 0x7fffu + ((u >> 16) & 1u)) >> 16; }
__device__ __forceinline__ unsigned pk2(float lo, float hi) { return f2bf(lo) | (f2bf(hi) << 16); }
__device__ __forceinline__ float bflo(unsigned w) { return __builtin_bit_cast(float, w << 16); }
__device__ __forceinline__ float bfhi(unsigned w) { return __builtin_bit_cast(float, w & 0xffff0000u); }
__device__ __forceinline__ float wave_sum(float v) {
#pragma unroll
    for (int o = 1; o < 64; o <<= 1) v += __shfl_xor(v, o);
    return v;
}

__device__ __forceinline__ int kvrow_of(int row) { return row < ML ? (row >> 12) * LKV + CTXL + (row & 4095) : ((row - ML) >> 8) * LKV + ((row - ML) & 255); }
__device__ __forceinline__ void rope8(float (&v)[8], const float* tab, int d, int t) {
    const int p0 = d >> 1, pos = p0 < 16 ? (t >> 6) : (t & 63), j0 = p0 & 15;
    const f32x4* tp = (const f32x4*)(tab + (pos * 16 + j0) * 2);
    const f32x4 t0 = tp[0], t1 = tp[1];
    float o[8];
    o[0] = v[0] * t0[0] - v[1] * t0[1]; o[1] = v[0] * t0[1] + v[1] * t0[0];
    o[2] = v[2] * t0[2] - v[3] * t0[3]; o[3] = v[2] * t0[3] + v[3] * t0[2];
    o[4] = v[4] * t1[0] - v[5] * t1[1]; o[5] = v[4] * t1[1] + v[5] * t1[0];
    o[6] = v[6] * t1[2] - v[7] * t1[3]; o[7] = v[6] * t1[3] + v[7] * t1[2];
#pragma unroll
    for (int i = 0; i < 8; ++i) v[i] = o[i];
}

#include <hip/hip_bf16.h>
#include <cmath>
namespace attn_body {
using bf16=__hip_bfloat16;
using bf16x8=__attribute__((ext_vector_type(8)))short;
using s16x4=__attribute__((ext_vector_type(4)))short;
using f32x16=__attribute__((ext_vector_type(16)))float;
using u32x4=__attribute__((ext_vector_type(4)))unsigned;
constexpr int D=64;
constexpr int NW=8,QBLK=32,QB=QBLK*NW,KVBLK=64;
constexpr int ATTN_UNIT_ROWS=QB;
__device__ __forceinline__ int crow(int r,int hi){return (r&3)+8*(r>>2)+4*hi;}
#define SBAR() __builtin_amdgcn_sched_barrier(0)
__device__ __forceinline__ void cmask(f32x16&p0,f32x16&p1,int jb,int qrel,int hi){
  const float NEG=-INFINITY; int kb=64*jb+4*hi;
  #pragma unroll
  for(int r=0;r<16;++r){int kv=kb+(r&3)+8*(r>>2); if(kv>qrel)p0[r]=NEG; if(kv+32>qrel)p1[r]=NEG;}
}

constexpr int NSLOT=3, SLOTB=8192;
constexpr int LDS_K=0, LDS_V=NSLOT*SLOTB, LDS_WS=2*NSLOT*SLOTB, LDS_OST=LDS_WS+NW*64*4, LDS_BYTES=LDS_OST+NW*4096;
constexpr float C2=0.125f*1.4426950408889634f;
__device__ __forceinline__ void glds16(const void*gsrc,unsigned lds_dst){unsigned keep;
  asm volatile("s_mov_b32 %0, m0\n\ts_mov_b32 m0, %2\n\ts_nop 0\n\tglobal_load_lds_dwordx4 %1, off\n\ts_mov_b32 m0, %0":"=&s"(keep):"v"(gsrc),"s"(lds_dst):"memory");}
__device__ __forceinline__ float max3f(float a,float b,float c){float r;asm("v_max3_f32 %0, %1, %2, %3":"=v"(r):"v"(a),"v"(b),"v"(c));return r;}
__device__ __forceinline__ float max2f(float a,float b){float r;asm("v_max_f32_e32 %0, %1, %2":"=v"(r):"v"(a),"v"(b));return r;}
__device__ __forceinline__ float fadd_s(float a,float b){float r;asm("v_add_f32_e32 %0, %1, %2":"=v"(r):"v"(a),"v"(b));return r;}
__device__ __forceinline__ float fsub_s(float a,float b){float r;asm("v_sub_f32_e32 %0, %1, %2":"=v"(r):"v"(a),"v"(b));return r;}
typedef float f32x2_t __attribute__((ext_vector_type(2))); typedef __bf16 bf16x2_t __attribute__((ext_vector_type(2)));
__device__ __forceinline__ unsigned cvtpk_s(float lo,float hi){f32x2_t v={lo,hi};bf16x2_t b=__builtin_convertvector(v,bf16x2_t);return __builtin_bit_cast(unsigned,b);}
#define WAIT_BAR(N) asm volatile("s_waitcnt vmcnt(" #N ") lgkmcnt(0)\n\ts_barrier":::"memory")

__device__ __forceinline__ void qkt(f32x16&p0,f32x16&p1,const char*Kslot,const bf16x8*qr,const f32x16&negm,int r32,int hi){
  const char*kb=Kslot+hi*1024+r32*16;
  #pragma unroll
  for(int d0=0;d0<4;++d0){
    const bf16x8 b0=*reinterpret_cast<const bf16x8*>(kb+d0*2048);
    const bf16x8 b1=*reinterpret_cast<const bf16x8*>(kb+d0*2048+512);
    if(d0==0){p0=__builtin_amdgcn_mfma_f32_32x32x16_bf16(b0,qr[0],negm,0,0,0);p1=__builtin_amdgcn_mfma_f32_32x32x16_bf16(b1,qr[0],negm,0,0,0);}
    else{p0=__builtin_amdgcn_mfma_f32_32x32x16_bf16(b0,qr[d0],p0,0,0,0);p1=__builtin_amdgcn_mfma_f32_32x32x16_bf16(b1,qr[d0],p1,0,0,0);}}
}
typedef __attribute__((address_space(3))) const char* lds_cptr;
typedef short v4i16_t __attribute__((ext_vector_type(4)));
__device__ __forceinline__ void kload8(bf16x8*kf,lds_cptr kp){
  kf[0]=*(const __attribute__((address_space(3))) bf16x8*)(kp);      kf[1]=*(const __attribute__((address_space(3))) bf16x8*)(kp+512);
  kf[2]=*(const __attribute__((address_space(3))) bf16x8*)(kp+2048); kf[3]=*(const __attribute__((address_space(3))) bf16x8*)(kp+2560);
  kf[4]=*(const __attribute__((address_space(3))) bf16x8*)(kp+4096); kf[5]=*(const __attribute__((address_space(3))) bf16x8*)(kp+4608);
  kf[6]=*(const __attribute__((address_space(3))) bf16x8*)(kp+6144); kf[7]=*(const __attribute__((address_space(3))) bf16x8*)(kp+6656);
}
__device__ __forceinline__ void kload2(bf16x8*kf,lds_cptr kp,int j){ kf[2*j]=*(const __attribute__((address_space(3))) bf16x8*)(kp+j*2048); kf[2*j+1]=*(const __attribute__((address_space(3))) bf16x8*)(kp+j*2048+512); }
__device__ __forceinline__ s16x4 vtr(lds_cptr p){ return __builtin_bit_cast(s16x4,__builtin_amdgcn_ds_read_tr16_b64_v4i16((__attribute__((address_space(3))) v4i16_t*)p)); }
__device__ __forceinline__ float rowmax(const f32x16&p0,const f32x16&p1){
  float a=max3f(p0[0],p0[1],p1[0]),b=max3f(p0[2],p0[3],p1[1]);a=max3f(a,p1[2],p1[3]);
  #pragma unroll
  for(int r=4;r<16;r+=4){a=max3f(a,p0[r],p0[r+1]);b=max3f(b,p0[r+2],p0[r+3]);a=max3f(a,p1[r],p1[r+1]);b=max3f(b,p1[r+2],p1[r+3]);}
  const float m=max2f(a,b);
  auto rr=__builtin_amdgcn_permlane32_swap(__float_as_uint(m),__float_as_uint(m),false,false);
  return max2f(__uint_as_float(rr[0]),__uint_as_float(rr[1]));
}
__device__ __forceinline__ void pv(f32x16*o,int vb,bf16x8 pa0,bf16x8 pa1,bf16x8 pa2,bf16x8 pa3){
  #pragma unroll
  for(int d0=0;d0<2;++d0){s16x4 lo[4],hi[4];
    #pragma unroll
    for(int ks=0;ks<4;++ks){
      asm volatile("ds_read_b64_tr_b16 %0,%1 offset:%c2":"=&v"(lo[ks]):"v"(vb),"i"(d0*4096+ks*1024):"memory");
      asm volatile("ds_read_b64_tr_b16 %0,%1 offset:%c2":"=&v"(hi[ks]):"v"(vb),"i"(d0*4096+ks*1024+512):"memory");}
    asm volatile("s_waitcnt lgkmcnt(0)":::"memory");SBAR();
    #define PK(k) (bf16x8){lo[k][0],lo[k][1],lo[k][2],lo[k][3],hi[k][0],hi[k][1],hi[k][2],hi[k][3]}
    o[d0]=__builtin_amdgcn_mfma_f32_32x32x16_bf16(pa0,PK(0),o[d0],0,0,0);
    o[d0]=__builtin_amdgcn_mfma_f32_32x32x16_bf16(pa1,PK(1),o[d0],0,0,0);
    o[d0]=__builtin_amdgcn_mfma_f32_32x32x16_bf16(pa2,PK(2),o[d0],0,0,0);
    o[d0]=__builtin_amdgcn_mfma_f32_32x32x16_bf16(pa3,PK(3),o[d0],0,0,0);
    #undef PK
  }
}

#ifndef ATTN_STORE16
#define ATTN_STORE16(p,v) (*(u32x4*)(p)=(v))
#endif
template<int THRL> __device__ __forceinline__ void attn_unit(const bf16*Qw0,int pqs,const bf16*__restrict__ Kh,int pks,const bf16*__restrict__ Vh,int pvs,bf16*Ow0,int pos_,const int NT,char*shm,const float*qgain,const float*rtab,const int qt0){
  int tid_l=threadIdx.x; asm volatile("":"+v"(tid_l)); const int tid=tid_l,lane=tid&63,r32=lane&31,hi=lane>>5; const int wid=__builtin_amdgcn_readfirstlane(tid>>6);
  const bf16*Qw=Qw0+(long)(wid*QBLK)*pqs;
  const unsigned lds0=(unsigned)(uintptr_t)shm;
  float*wsf=(float*)(shm+LDS_WS)+wid*64;
  const bf16*ksrc=Kh+(long)lane*pks+wid*8;
  const bf16*vsrc=Vh+(long)(16*(wid&3)+(lane>>2))*pvs+(wid>>2)*32+(lane&3)*8;
  const unsigned kdst=lds0+LDS_K+wid*1024, vdst=lds0+LDS_V+wid*1024;
  #define DMA_K(t,slot) glds16(ksrc+(long)(t)*KVBLK*pks,(unsigned)__builtin_amdgcn_readfirstlane(kdst+(slot)))
  #define DMA_V(t,slot) glds16(vsrc+(long)(t)*KVBLK*pvs,(unsigned)__builtin_amdgcn_readfirstlane(vdst+(slot)))
  const int vb0=(int)(lds0+LDS_V)+((lane>>4)&1)*32+(lane&3)*8+(4*hi+((lane&15)>>2))*64;
  const char*Kbase=shm+LDS_K; bf16x8 kf[8];
  const lds_cptr shm3=(lds_cptr)shm; const lds_cptr kp0=shm3+LDS_K+hi*1024+r32*16; const lds_cptr vp0=shm3+LDS_V+((lane>>4)&1)*32+(lane&3)*8+(4*hi+((lane&15)>>2))*64;
  DMA_K(0,0);DMA_V(0,0);DMA_K(1,SLOTB);
  bf16x8 qr[4];
  #pragma unroll
  for(int d0=0;d0<4;++d0)qr[d0]=*reinterpret_cast<const bf16x8*>(&Qw[(long)r32*pqs+d0*16+hi*8]);
  if(qgain){
    float f[4][8]; float ss=0.f;
    #pragma unroll
    for(int d0=0;d0<4;++d0){
      #pragma unroll
      for(int i=0;i<8;++i){ f[d0][i]=__builtin_bit_cast(float,((unsigned)(unsigned short)qr[d0][i])<<16); ss+=f[d0][i]*f[d0][i]; } }
    { auto rr=__builtin_amdgcn_permlane32_swap(__float_as_uint(ss),__float_as_uint(ss),false,false); ss=__uint_as_float(rr[0])+__uint_as_float(rr[1]); }
    const float rstd=1.0f/sqrtf(ss*(1.f/64.f)+1e-6f);
    #pragma unroll
    for(int d0=0;d0<4;++d0){ const int dd=d0*16+hi*8;
      #pragma unroll
      for(int i=0;i<8;++i) f[d0][i]*=rstd*qgain[dd+i];
      if(qt0>=0) rope8(f[d0],rtab,dd,qt0+wid*QBLK+r32);
      u32x4 w; w.x=pk2(f[d0][0]*C2,f[d0][1]*C2); w.y=pk2(f[d0][2]*C2,f[d0][3]*C2); w.z=pk2(f[d0][4]*C2,f[d0][5]*C2); w.w=pk2(f[d0][6]*C2,f[d0][7]*C2);
      qr[d0]=__builtin_bit_cast(bf16x8,w); }
  }
  float mhat=0.f,l_reg=0.f;f32x16 o[2];o[0]=f32x16{};o[1]=f32x16{};f32x16 negm=f32x16{};asm volatile("":"+v"(negm));
  #define CMASK(P0,P1,t) do{}while(0)
  bool resc=false;
  #define START(P0,P1) do{ const float rm=rowmax(P0,P1); resc=false; \
    { const float dl=rm; mhat=fadd_s(mhat,dl); \
      _Pragma("unroll") for(int r=0;r<16;++r){P0[r]=fsub_s(P0[r],dl);P1[r]=fsub_s(P1[r],dl);} \
      _Pragma("unroll") for(int r=0;r<16;++r)negm[r]=-mhat; asm volatile("":"+v"(negm)); } \
    _Pragma("unroll") for(int r=0;r<16;++r)P0[r]=__builtin_amdgcn_exp2f(P0[r]); }while(0)
  #define RESC() do{ if(resc){ asm volatile("s_waitcnt lgkmcnt(0)":::"memory"); \
      _Pragma("unroll") for(int d_=0;d_<2;++d_) _Pragma("unroll") for(int r=0;r<16;++r)o[d_][r]*=wsf[crow(r,hi)]; } }while(0)
  f32x16 pA0,pA1,pB0,pB1;
  int sl_prev=0,sl_cur=0,sl_next=SLOTB;
  #define ROT() do{sl_prev=sl_cur;sl_cur=sl_next;sl_next=(sl_next==(NSLOT-1)*SLOTB)?0:sl_next+SLOTB;}while(0)
  DMA_K(2,2*SLOTB);
  WAIT_BAR(3);
  qkt(pA0,pA1,Kbase,qr,negm,r32,hi);asm volatile("s_nop 15\n\ts_nop 7":"+v"(pA0),"+v"(pA1));CMASK(pA0,pA1,0);
  START(pA0,pA1);
  _Pragma("unroll") for(int r=0;r<16;++r)pA1[r]=__builtin_amdgcn_exp2f(pA1[r]);
  WAIT_BAR(0);
  DMA_K(3,0);DMA_V(1,SLOTB);
  ROT();
  kload8(kf,kp0+sl_cur);
  WAIT_BAR(2);
  s16x4 vlo[8],vhi[8]; u32x4 pw0,pw1,pw2,pw3;
  #define PKW(P,B) cvtpk_s(P[B],P[B+1])
  #define PAF(k) __builtin_bit_cast(bf16x8,pw##k)
  #define VFR(i) (bf16x8){vlo[i][0],vlo[i][1],vlo[i][2],vlo[i][3],vhi[i][0],vhi[i][1],vhi[i][2],vhi[i][3]}
  #define PIN(x) asm volatile("":"+v"(x))
  #define MX3(a,b,c) __builtin_fmaxf(__builtin_fmaxf((a),(b)),(c))
  #define GAPA(MF,A0,A1,A2,A3,W0,W1,PW) do{ MF; sacc+=A0; sacc+=A1; sacc+=A2; sacc+=A3; PIN(sacc); W0; W1; PIN(PW); SBAR(); }while(0)
  #define EX(v) __builtin_amdgcn_exp2f(v)
  #define GAPB(MF,X,B) do{ MF; X[B]=EX(X[B]); X[B+1]=EX(X[B+1]); X[B+2]=EX(X[B+2]); X[B+3]=EX(X[B+3]); PIN(X); SBAR(); }while(0)
  #define VRD(i) do{ vlo[i]=vtr(vp_+(((i)>>2)*4096+((i)&3)*1024)); vhi[i]=vtr(vp_+(((i)>>2)*4096+((i)&3)*1024+512)); }while(0)
  #define KRD(G,j) do{ if(G){ kload2(kf,kp0+sl_next,j); SBAR(); } }while(0)
  #define STEP(C0,C1,P0,P1,t,GK,GV,GL) do{ SBAR(); \
    const lds_cptr vp_=vp0+sl_prev; \
    VRD(0); SBAR(); float sacc=(P0[0]+P0[1]); \
    GAPA(C0=__builtin_amdgcn_mfma_f32_32x32x16_bf16(kf[0],qr[0],negm,0,0,0), P0[2],P0[3],P0[4],P0[5],     pw0[0]=PKW(P0,0), pw0[1]=PKW(P0,2), pw0); \
    VRD(4); SBAR(); GAPA(C1=__builtin_amdgcn_mfma_f32_32x32x16_bf16(kf[1],qr[0],negm,0,0,0), P0[6],P0[7],P0[8],P0[9],     pw0[2]=PKW(P0,4), pw0[3]=PKW(P0,6), pw0); \
    VRD(1); SBAR(); GAPA(C0=__builtin_amdgcn_mfma_f32_32x32x16_bf16(kf[2],qr[1],C0,0,0,0),   P0[10],P0[11],P0[12],P0[13], pw1[0]=PKW(P0,8), pw1[1]=PKW(P0,10), pw1); \
    VRD(5); SBAR(); GAPA(C1=__builtin_amdgcn_mfma_f32_32x32x16_bf16(kf[3],qr[1],C1,0,0,0),   P0[14],P0[15],P1[0],P1[1],   pw1[2]=PKW(P0,12),pw1[3]=PKW(P0,14), pw1); \
    VRD(2); SBAR(); GAPA(C0=__builtin_amdgcn_mfma_f32_32x32x16_bf16(kf[4],qr[2],C0,0,0,0),   P1[2],P1[3],P1[4],P1[5],     pw2[0]=PKW(P1,0), pw2[1]=PKW(P1,2), pw2); \
    VRD(6); SBAR(); GAPA(C1=__builtin_amdgcn_mfma_f32_32x32x16_bf16(kf[5],qr[2],C1,0,0,0),   P1[6],P1[7],P1[8],P1[9],     pw2[2]=PKW(P1,4), pw2[3]=PKW(P1,6), pw2); \
    VRD(3); SBAR(); GAPA(C0=__builtin_amdgcn_mfma_f32_32x32x16_bf16(kf[6],qr[3],C0,0,0,0),   P1[10],P1[11],P1[12],P1[13], pw3[0]=PKW(P1,8), pw3[1]=PKW(P1,10), pw3); \
    VRD(7); SBAR(); GAPA(C1=__builtin_amdgcn_mfma_f32_32x32x16_bf16(kf[7],qr[3],C1,0,0,0),   P1[14],P1[15],0.f,0.f,       pw3[2]=PKW(P1,12),pw3[3]=PKW(P1,14), pw3); \
    l_reg+=sacc; \
    if(GK){DMA_K((t)+3,sl_cur);} if(GV){DMA_V((t)+1,sl_next);} \
    CMASK(C0,C1,t); \
    { float a=MX3(C0[0],C0[1],C1[0]),b=MX3(C0[2],C0[3],C1[1]); a=MX3(a,C1[2],C1[3]); \
      _Pragma("unroll") for(int r=4;r<16;r+=4){a=MX3(a,C0[r],C0[r+1]);b=MX3(b,C0[r+2],C0[r+3]);a=MX3(a,C1[r],C1[r+1]);b=MX3(b,C1[r+2],C1[r+3]);} \
      float rm=__builtin_fmaxf(a,b); { auto rr=__builtin_amdgcn_permlane32_swap(__float_as_uint(rm),__float_as_uint(rm),false,false); rm=__builtin_fmaxf(__uint_as_float(rr[0]),__uint_as_float(rr[1])); } \
      resc=false; \
      if(__builtin_expect(__any(rm>(float)THRL),0)){ const float dl=__builtin_fmaxf(rm,0.f); mhat+=dl; \
        _Pragma("unroll") for(int r=0;r<16;++r){C0[r]-=dl;C1[r]-=dl;} \
        _Pragma("unroll") for(int r=0;r<16;++r)negm[r]=-mhat; asm volatile("":"+v"(negm)); \
        const float f=__builtin_amdgcn_exp2f(-dl); l_reg*=f; if(hi==0)wsf[r32]=f; resc=true; } } \
    SBAR(); \
    GAPB(o[0]=__builtin_amdgcn_mfma_f32_32x32x16_bf16(PAF(0),VFR(0),o[0],0,0,0), C0,0); \
    GAPB(o[1]=__builtin_amdgcn_mfma_f32_32x32x16_bf16(PAF(0),VFR(4),o[1],0,0,0), C0,4); \
    KRD(GL,0); GAPB(o[0]=__builtin_amdgcn_mfma_f32_32x32x16_bf16(PAF(1),VFR(1),o[0],0,0,0), C0,8); \
    KRD(GL,1); GAPB(o[1]=__builtin_amdgcn_mfma_f32_32x32x16_bf16(PAF(1),VFR(5),o[1],0,0,0), C0,12); \
    KRD(GL,2); GAPB(o[0]=__builtin_amdgcn_mfma_f32_32x32x16_bf16(PAF(2),VFR(2),o[0],0,0,0), C1,0); \
    KRD(GL,3); GAPB(o[1]=__builtin_amdgcn_mfma_f32_32x32x16_bf16(PAF(2),VFR(6),o[1],0,0,0), C1,4); \
    GAPB(o[0]=__builtin_amdgcn_mfma_f32_32x32x16_bf16(PAF(3),VFR(3),o[0],0,0,0), C1,8); \
    GAPB(o[1]=__builtin_amdgcn_mfma_f32_32x32x16_bf16(PAF(3),VFR(7),o[1],0,0,0), C1,12); \
    }while(0)
  int t=1;
  #undef CMASK
  #define CMASK(P0,P1,t) do{}while(0)
  for(;t+5<NT;t+=2){
    STEP(pB0,pB1,pA0,pA1,t,true,true,true);     WAIT_BAR(2); RESC(); ROT();
    STEP(pA0,pA1,pB0,pB1,t+1,true,true,true);   WAIT_BAR(2); RESC(); ROT();
  }
  #undef CMASK
  #define CMASK(P0,P1,t) do{}while(0)
  #define ENDW(tt) do{ if((tt)+3<NT){WAIT_BAR(2);} else if((tt)+2<NT){WAIT_BAR(1);} else {WAIT_BAR(0);} }while(0)
  for(;t+1<NT;t+=2){
    STEP(pB0,pB1,pA0,pA1,t,(t+3<NT),(t+1<NT),(t+1<NT));       ENDW(t);   RESC(); ROT();
    STEP(pA0,pA1,pB0,pB1,t+1,(t+4<NT),(t+2<NT),(t+2<NT));     ENDW(t+1); RESC(); ROT();
  }
  STEP(pB0,pB1,pA0,pA1,NT-1,false,false,false); RESC();
  { float sacc=pB0[0]+pB0[1]; _Pragma("unroll") for(int r=2;r<16;++r)sacc+=pB0[r]; _Pragma("unroll") for(int r=0;r<16;++r)sacc+=pB1[r]; l_reg+=sacc;
    pw0=(u32x4){PKW(pB0,0),PKW(pB0,2),PKW(pB0,4),PKW(pB0,6)};pw1=(u32x4){PKW(pB0,8),PKW(pB0,10),PKW(pB0,12),PKW(pB0,14)};pw2=(u32x4){PKW(pB1,0),PKW(pB1,2),PKW(pB1,4),PKW(pB1,6)};pw3=(u32x4){PKW(pB1,8),PKW(pB1,10),PKW(pB1,12),PKW(pB1,14)};
    SBAR(); pv(o,vb0+sl_cur,PAF(0),PAF(1),PAF(2),PAF(3)); }
  #undef PKW
  #undef PAF
  #undef VFR
  #undef PIN
  #undef MX3
  #undef GAPA
  #undef GAPB
  #undef EX
  #undef VRD
  #undef KRD
  #undef STEP
  #undef ENDW
  {auto rr=__builtin_amdgcn_permlane32_swap(__float_as_uint(l_reg),__float_as_uint(l_reg),false,false);l_reg=__uint_as_float(rr[0])+__uint_as_float(rr[1]);}
  if(hi==0)wsf[32+r32]=l_reg;asm volatile("s_waitcnt lgkmcnt(0)":::"memory");
  float rli[16];
  #pragma unroll
  for(int r=0;r<16;++r)rli[r]=__builtin_amdgcn_rcpf(wsf[32+crow(r,hi)]);
  bf16*Ow=Ow0+(long)(wid*QBLK)*pos_;
  { bf16*stg=(bf16*)(shm+LDS_OST)+wid*2048;
    #pragma unroll
    for(int r=0;r<16;++r){const int orow=crow(r,hi);
      #pragma unroll
      for(int d0=0;d0<2;++d0)stg[orow*64+d0*32+r32]=__float2bfloat16(o[d0][r]*rli[r]);}
    asm volatile("s_waitcnt lgkmcnt(0)":::"memory");
    #pragma unroll
    for(int i=0;i<4;++i){const int row=i*8+(lane>>3),ch=lane&7; const u32x4 v=*(const u32x4*)(stg+row*64+ch*8); ATTN_STORE16(Ow+(long)row*pos_+ch*8,v);} }
  asm volatile("s_waitcnt lgkmcnt(0)\n\ts_barrier":::"memory");
  #undef DMA_K
  #undef DMA_V
  #undef CMASK
  #undef START
  #undef RESC
  #undef ROT
}
constexpr int ATTN_LDS_BYTES=LDS_BYTES;
#undef SBAR
#undef WAIT_BAR
}
struct Args { const float* in[26]; float* out; unsigned char* ws; };

template <int ACT  > struct EpiAct {
    static constexpr bool PERM = true, AFTER_DRAIN = false;
    bf16_t* O; int ldc;
    __device__ __forceinline__ void operator()(const pg8::f32x4 (&acc)[2][2][4][2], const pg8::Unit& u, int wr, int wc, int fr, int fq) const {
        const int row0 = u.pm * 256 + wr * 64 + fr, col0 = u.pn * 256 + wc * 32 + 8 * fq;
#pragma unroll
        for (int ai = 0; ai < 2; ++ai)
#pragma unroll
            for (int m = 0; m < 4; ++m) { bf16_t* rowp = O + (size_t)(row0 + ai * 128 + m * 16) * ldc + col0;
#pragma unroll
                for (int bj = 0; bj < 2; ++bj) { float v[8];
#pragma unroll
                    for (int i = 0; i < 4; ++i) { v[i] = acc[ai][bj][m][0][i]; v[4 + i] = acc[ai][bj][m][1][i]; }
#pragma unroll
                    for (int i = 0; i < 8; ++i) {
                        if (ACT == 1) v[i] = 1.f / (1.f + __expf(-v[i]));
                        if (ACT == 2) { const float r = fmaxf(v[i], 0.f); v[i] = r * r; } }
                    pg8::u32x4 w; w.x = pk2(v[0], v[1]); w.y = pk2(v[2], v[3]); w.z = pk2(v[4], v[5]); w.w = pk2(v[6], v[7]);
                    *(pg8::u32x4*)(rowp + bj * 128) = w; } }
    }
};
struct EpiF32 {
    static constexpr bool PERM = true, AFTER_DRAIN = false;
    float* O; int ldc;
    __device__ __forceinline__ void operator()(const pg8::f32x4 (&acc)[2][2][4][2], const pg8::Unit& u, int wr, int wc, int fr, int fq) const {
        const int row0 = u.pm * 256 + wr * 64 + fr, col0 = u.pn * 256 + wc * 32 + 8 * fq;
#pragma unroll
        for (int ai = 0; ai < 2; ++ai)
#pragma unroll
            for (int m = 0; m < 4; ++m) { float* rowp = O + (size_t)(row0 + ai * 128 + m * 16) * ldc + col0;
#pragma unroll
                for (int bj = 0; bj < 2; ++bj) { *(pg8::f32x4*)(rowp + bj * 128) = acc[ai][bj][m][0]; *(pg8::f32x4*)(rowp + bj * 128 + 4) = acc[ai][bj][m][1]; } }
    }
};
struct EpiBranch {
    static constexpr bool PERM = true, AFTER_DRAIN = false;
    bf16_t* GO; float* ACC; int mode;
    __device__ __forceinline__ void operator()(const pg8::f32x4 (&acc)[2][2][4][2], const pg8::Unit& u, int wr, int wc, int fr, int fq) const {
        const int row0 = u.pm * 256 + wr * 64 + fr, col0 = u.pn * 256 + wc * 32 + 8 * fq;
#pragma unroll
        for (int ai = 0; ai < 2; ++ai)
#pragma unroll
            for (int m = 0; m < 4; ++m) { const size_t ro = (size_t)(row0 + ai * 128 + m * 16) * 1024 + col0;
#pragma unroll
                for (int bj = 0; bj < 2; ++bj) { const size_t idx = ro + bj * 128;
                    const pg8::u32x4 g = *(const pg8::u32x4*)(GO + idx);
                    pg8::f32x4 v0 = acc[ai][bj][m][0], v1 = acc[ai][bj][m][1];
                    v0[0] *= bflo(g.x); v0[1] *= bfhi(g.x); v0[2] *= bflo(g.y); v0[3] *= bfhi(g.y);
                    v1[0] *= bflo(g.z); v1[1] *= bfhi(g.z); v1[2] *= bflo(g.w); v1[3] *= bfhi(g.w);
                    if (mode > 0) { v0 += *(const pg8::f32x4*)(ACC + idx); v1 += *(const pg8::f32x4*)(ACC + idx + 4); }
                    if (mode < 2) { *(pg8::f32x4*)(ACC + idx) = v0; *(pg8::f32x4*)(ACC + idx + 4) = v1; }
                    else { pg8::u32x4 w; w.x = pk2(v0[0], v0[1]); w.y = pk2(v0[2], v0[3]); w.z = pk2(v1[0], v1[1]); w.w = pk2(v1[2], v1[3]); *(pg8::u32x4*)(GO + idx) = w; } } }
    }
};
struct EpiIn {
    static constexpr bool PERM = true, AFTER_DRAIN = false;
    unsigned char* ws;
    __device__ __forceinline__ void operator()(const pg8::f32x4 (&acc)[2][2][4][2], const pg8::Unit& u, int wr, int wc, int fr, int fq) const {
        const bool latent = u.pm < (ML / 256);
        const int cw = wc * 32 + 8 * fq;
        bf16_t* const poolin = (bf16_t*)(ws + WS_POOLIN); bf16_t* const qd = (bf16_t*)(ws + WS_QD); bf16_t* const qg = (bf16_t*)(ws + WS_QG); bf16_t* const kd = (bf16_t*)(ws + WS_KD);
        bf16_t* const vd = (bf16_t*)(ws + WS_VD); bf16_t* const kg = (bf16_t*)(ws + WS_KG); bf16_t* const vg = (bf16_t*)(ws + WS_VG); const float* const rope = (const float*)(ws + WS_ROPE);
#pragma unroll
        for (int bj = 0; bj < 2; ++bj) {
            const int cb = u.pn * 2 + bj;
            bf16_t* base; int pitch, coff; bool kvmap = false, dorope = false; float sc = 1.f;
            if (cb < 4) { base = poolin; pitch = 512; coff = cb * 128; }
            else if (cb < 8) { base = qd; pitch = 512; coff = (cb - 4) * 128; dorope = latent; sc = QC2; }
            else if (cb < 12) { base = qg; pitch = 512; coff = (cb - 8) * 128; }
            else if (cb < 16) { base = kd; pitch = 512; coff = (cb - 12) * 128; kvmap = true; dorope = latent; }
            else if (cb < 20) { base = vd; pitch = 512; coff = (cb - 16) * 128; kvmap = true; }
            else if (cb == 20) { base = kg; pitch = 128; coff = 0; kvmap = true; }
            else { base = vg; pitch = 128; coff = 0; kvmap = true; }
#pragma unroll
            for (int ai = 0; ai < 2; ++ai)
#pragma unroll
                for (int m = 0; m < 4; ++m) {
                    const int row = u.pm * 256 + ai * 128 + wr * 64 + m * 16 + fr;
                    const int drow = kvmap ? kvrow_of(row) : row;
                    float v[8];
#pragma unroll
                    for (int i = 0; i < 4; ++i) { v[i] = acc[ai][bj][m][0][i]; v[4 + i] = acc[ai][bj][m][1][i]; }
                    if (dorope) rope8(v, rope, cw & 63, row & 4095);
#pragma unroll
                    for (int i = 0; i < 8; ++i) v[i] *= sc;
                    pg8::u32x4 w; w.x = pk2(v[0], v[1]); w.y = pk2(v[2], v[3]); w.z = pk2(v[4], v[5]); w.w = pk2(v[6], v[7]);
                    *(pg8::u32x4*)(base + (size_t)drow * pitch + coff + cw) = w;
                }
        }
    }
};
__device__ __forceinline__ void head_norm_fix(bf16_t* p, const float* gain, bool dorope, int t, float sc, const float* tab) {
    float ss = 0.f;
#pragma unroll
    for (int ch = 0; ch < 8; ++ch) { const v4u w = *(const v4u*)(p + ch * 8);
        const float a0 = bflo(w.x), a1 = bfhi(w.x), a2 = bflo(w.y), a3 = bfhi(w.y), a4 = bflo(w.z), a5 = bfhi(w.z), a6 = bflo(w.w), a7 = bfhi(w.w);
        ss += (a0 * a0 + a1 * a1) + (a2 * a2 + a3 * a3) + (a4 * a4 + a5 * a5) + (a6 * a6 + a7 * a7); }
    const float rstd = 1.0f / sqrtf(ss * (1.f / 64.f) + EPSN);
#pragma unroll
    for (int ch = 0; ch < 8; ++ch) { const v4u w = *(const v4u*)(p + ch * 8);
        float v[8] = {bflo(w.x), bfhi(w.x), bflo(w.y), bfhi(w.y), bflo(w.z), bfhi(w.z), bflo(w.w), bfhi(w.w)};
        const f32x4 g0 = *(const f32x4*)(gain + ch * 8), g1 = *(const f32x4*)(gain + ch * 8 + 4);
        v[0] *= rstd * g0[0]; v[1] *= rstd * g0[1]; v[2] *= rstd * g0[2]; v[3] *= rstd * g0[3];
        v[4] *= rstd * g1[0]; v[5] *= rstd * g1[1]; v[6] *= rstd * g1[2]; v[7] *= rstd * g1[3];
        if (dorope) rope8(v, tab, ch * 8, t);
        v4u o; o.x = pk2(v[0] * sc, v[1] * sc); o.y = pk2(v[2] * sc, v[3] * sc); o.z = pk2(v[4] * sc, v[5] * sc); o.w = pk2(v[6] * sc, v[7] * sc);
        *(v4u*)(p + ch * 8) = o; }
}

__device__ __forceinline__ void transpose_item(const float* W, int K, int N, bf16* WT, int k0, int n0, int drow0, LAS float* scr, int lane) {
#pragma unroll 8
    for (int i = 0; i < 32; ++i) { const int kk = 2 * i + (lane >> 5); scr[kk * 33 + (lane & 31)] = W[(size_t)(k0 + kk) * N + n0 + (lane & 31)]; }
    asm volatile("s_waitcnt lgkmcnt(0)" ::: "memory");
    const int c = lane & 7;
#pragma unroll
    for (int j = 0; j < 4; ++j) { const int n = (lane >> 3) + 8 * j; const LAS float* s = scr + (8 * c) * 33 + n;
        v4u o; o.x = pk2(s[0 * 33], s[1 * 33]); o.y = pk2(s[2 * 33], s[3 * 33]); o.z = pk2(s[4 * 33], s[5 * 33]); o.w = pk2(s[6 * 33], s[7 * 33]);
        *(v4u*)(WT + (size_t)(drow0 + n) * K + k0 + 8 * c) = o; }
    asm volatile("s_waitcnt lgkmcnt(0)" ::: "memory");
}
struct WPtrs { const float *w_in, *w_grp, *pscale, *w_po, *w_do, *w_go, *w_o, *w_1, *w_2; };
__device__ __forceinline__ void convert_weights(const WPtrs& p, int l, unsigned char* ws, LAS unsigned char* lds, int gw, int NGW, int wave, int lane, int gtid, int NTH) {
    LAS float* scr = (LAS float*)(lds + wave * 16384);
    constexpr int I_IN = (1024 / 64) * (5888 / 32), I_BR = (512 / 64) * (1024 / 32), I_O = (1024 / 64) * (1024 / 32), I_1 = (1024 / 64) * (4096 / 32), I_2 = (4096 / 64) * (1024 / 32);
    constexpr int NITEMS = I_IN + 3 * I_BR + I_O + I_1 + I_2;
    for (int it = gw; it < NITEMS; it += NGW) {
        int r = it;
        if (r < I_IN) { const int nblk = 5888 / 32, kb = r / nblk, nb = r % nblk, n0 = nb * 32;
            const int d0 = n0 < 1536 ? n0 : (n0 < 4608 ? n0 - 1536 + N1 : n0 - 4608 + 1536);
            transpose_item(p.w_in + (size_t)l * 1024 * 5888, 1024, 5888, (bf16*)(ws + W_IN), kb * 64, n0, d0, scr, lane); continue; } r -= I_IN;
        if (r < I_BR) { const int nblk = 1024 / 32, kb = r / nblk, nb = r % nblk;
            transpose_item(p.w_po + (size_t)l * 512 * 1024, 512, 1024, (bf16*)(ws + W_PO), kb * 64, nb * 32, nb * 32, scr, lane); continue; } r -= I_BR;
        if (r < I_BR) { const int nblk = 1024 / 32, kb = r / nblk, nb = r % nblk;
            transpose_item(p.w_do + (size_t)l * 512 * 1024, 512, 1024, (bf16*)(ws + W_DO), kb * 64, nb * 32, nb * 32, scr, lane); continue; } r -= I_BR;
        if (r < I_BR) { const int nblk = 1024 / 32, kb = r / nblk, nb = r % nblk;
            transpose_item(p.w_go + (size_t)l * 512 * 1024, 512, 1024, (bf16*)(ws + W_GO), kb * 64, nb * 32, nb * 32, scr, lane); continue; } r -= I_BR;
        if (r < I_O) { const int nblk = 1024 / 32, kb = r / nblk, nb = r % nblk;
            transpose_item(p.w_o + (size_t)l * 1024 * 1024, 1024, 1024, (bf16*)(ws + W_O), kb * 64, nb * 32, nb * 32, scr, lane); continue; } r -= I_O;
        if (r < I_1) { const int nblk = 4096 / 32, kb = r / nblk, nb = r % nblk;
            transpose_item(p.w_1 + (size_t)l * 1024 * 4096, 1024, 4096, (bf16*)(ws + W_1), kb * 64, nb * 32, nb * 32, scr, lane); continue; } r -= I_1;
        { const int nblk = 1024 / 32, kb = r / nblk, nb = r % nblk;
            transpose_item(p.w_2 + (size_t)l * 4096 * 1024, 4096, 1024, (bf16*)(ws + W_2), kb * 64, nb * 32, nb * 32, scr, lane); }
    }
    const float* wg = p.w_grp + (size_t)l * 4 * 128 * 128; const float* psc = p.pscale + l * 512;
    unsigned* PT = (unsigned*)(ws + W_POOL);
    for (int i = gtid; i < 512 * 256; i += NTH) { const int n = i >> 8, k = (i & 255) * 2, g = n >> 7; float v0 = 0.f, v1 = 0.f;
        if ((k >> 7) == g) { const float* q = wg + ((size_t)(g * 128 + (k & 127))) * 128 + (n & 127); const float s = psc[n]; v0 = q[0] * s; v1 = q[128] * s; }
        PT[i] = pk2(v0, v1); }
}
__device__ __forceinline__ void mod_gemv(const float* cvec, const float* cctx, const float* wmod, const float* bmod, float* modout, LAS unsigned char* lds, int tid, int lane, int wave, int bx) {
    LAS float* st = (LAS float*)lds;
    LAS float* red = (LAS float*)(lds + 32768);
    for (int i = tid; i < 5 * 1024; i += NTHR) { const int bb = i >> 10, k = i & 1023; const float v = bb < 4 ? cvec[bb * 1024 + k] : cctx[k]; st[i] = v / (1.f + expf(-v)); }
    __syncthreads();
    if (bx < 192) {
        const int l = bx / 96, n0 = (bx % 96) * 64;
        const float* w = wmod + (size_t)l * 1024 * NMOD + n0 + lane;
        float a0 = 0.f, a1 = 0.f, a2 = 0.f, a3 = 0.f, a4 = 0.f;
        const int k0 = wave * 128;
#pragma unroll 16
        for (int kk = 0; kk < 128; ++kk) { const float wv = w[(size_t)(k0 + kk) * NMOD]; const int k = k0 + kk;
            a0 += st[k] * wv; a1 += st[1024 + k] * wv; a2 += st[2048 + k] * wv; a3 += st[3072 + k] * wv; a4 += st[4096 + k] * wv; }
        red[(wave * 5 + 0) * 64 + lane] = a0; red[(wave * 5 + 1) * 64 + lane] = a1; red[(wave * 5 + 2) * 64 + lane] = a2; red[(wave * 5 + 3) * 64 + lane] = a3; red[(wave * 5 + 4) * 64 + lane] = a4;
        __syncthreads();
        if (tid < 320) { const int bb = tid >> 6; float s = bmod[l * NMOD + n0 + lane];
#pragma unroll
            for (int w8 = 0; w8 < 8; ++w8) s += red[(w8 * 5 + bb) * 64 + lane];
            modout[(l * 5 + bb) * NMOD + n0 + lane] = s; }
    }
    __syncthreads();
}
__device__ __forceinline__ void norm_phase(int M, const float* xs_lat, const float* xs_ctx, float* xd_lat, float* xd_ctx, const float* z, const float* modl, int gtc, const float* gpost,
                                           bf16* hdst, const float* gnext, const float* modn, int shc, int scc, int gw, int NGW, int lane) {
    for (int m = gw; m < M; m += NGW) {
        const bool lat = m < ML; const int bb = lat ? (m >> 12) : 4;
        const float* xs = lat ? xs_lat + (size_t)m * 1024 : xs_ctx + (size_t)(m - ML) * 1024;
        f32x4 v[4];
#pragma unroll
        for (int j = 0; j < 4; ++j) v[j] = *(const f32x4*)(xs + 4 * lane + 256 * j);
        float* xd = lat ? xd_lat + (size_t)m * 1024 : xd_ctx + (size_t)(m - ML) * 1024;
        if (!z) {
#pragma unroll
            for (int j = 0; j < 4; ++j) *(f32x4*)(xd + 4 * lane + 256 * j) = v[j];
        } else {
            f32x4 zz[4]; float ss = 0.f;
#pragma unroll
            for (int j = 0; j < 4; ++j) { zz[j] = *(const f32x4*)(z + (size_t)m * 1024 + 4 * lane + 256 * j); ss += (zz[j][0] * zz[j][0] + zz[j][1] * zz[j][1]) + (zz[j][2] * zz[j][2] + zz[j][3] * zz[j][3]); }
            const float rz = 1.0f / sqrtf(wave_sum(ss) * (1.f / 1024.f) + EPSN);
            const float* gt = modl + bb * NMOD + gtc * 1024;
#pragma unroll
            for (int j = 0; j < 4; ++j) { const int c = 4 * lane + 256 * j; const f32x4 g4 = *(const f32x4*)(gpost + c), t4 = *(const f32x4*)(gt + c);
                v[j] = v[j] + t4 * ((zz[j] * rz) * g4); *(f32x4*)(xd + c) = v[j]; }
        }
        if (hdst) {
            float ss = 0.f;
#pragma unroll
            for (int j = 0; j < 4; ++j) ss += (v[j][0] * v[j][0] + v[j][1] * v[j][1]) + (v[j][2] * v[j][2] + v[j][3] * v[j][3]);
            const float rx = 1.0f / sqrtf(wave_sum(ss) * (1.f / 1024.f) + EPSN);
            const float* sh = modn + bb * NMOD + shc * 1024; const float* sc = modn + bb * NMOD + scc * 1024;
#pragma unroll
            for (int j = 0; j < 4; ++j) { const int c = 4 * lane + 256 * j; const f32x4 g4 = *(const f32x4*)(gnext + c), s4 = *(const f32x4*)(sc + c), h4 = *(const f32x4*)(sh + c);
                const f32x4 o = ((v[j] * rx) * g4) * (s4 + 1.0f) + h4;
                v2u w; w.x = pk2(o[0], o[1]); w.y = pk2(o[2], o[3]); *(v2u*)(hdst + (size_t)m * 1024 + c) = w; }
        }
    }
}
__device__ __forceinline__ void pool_phase(int M, const bf16* zin, bf16* pooled, int gtid, int NTH) {
    for (int it = gtid; it < M * 64; it += NTH) {
        const int m = it >> 6, ch = it & 63, g = ch >> 4, w2 = 1 << g;
        int t, l;
        if (m < ML) { t = m & 4095; l = SEQL; } else { t = (m - ML) & 255; l = CTXL; }
        const int base = m - t, lo = max(t - w2, 0), hi = min(t + w2, l);
        v4u w[16];
#pragma unroll
        for (int dj = 0; dj < 16; ++dj) { const int j = t + dj - 8; const int jj = min(max(j, lo), hi - 1);
            w[dj] = *(const v4u*)(zin + (size_t)(base + jj) * 512 + ch * 8); }
        float s[8];
#pragma unroll
        for (int i = 0; i < 8; ++i) s[i] = 0.f;
#pragma unroll
        for (int dj = 0; dj < 16; ++dj) { const int j = t + dj - 8; const float k = (j >= lo && j < hi) ? 1.0f : 0.0f;
            s[0] += k * bflo(w[dj].x); s[1] += k * bfhi(w[dj].x); s[2] += k * bflo(w[dj].y); s[3] += k * bfhi(w[dj].y);
            s[4] += k * bflo(w[dj].z); s[5] += k * bfhi(w[dj].z); s[6] += k * bflo(w[dj].w); s[7] += k * bfhi(w[dj].w); }
        const float inv = 1.0f / (float)(hi - lo);
        const v4u ws_ = w[8];
        v4u o; o.x = pk2(s[0] * inv - bflo(ws_.x), s[1] * inv - bfhi(ws_.x)); o.y = pk2(s[2] * inv - bflo(ws_.y), s[3] * inv - bfhi(ws_.y));
        o.z = pk2(s[4] * inv - bflo(ws_.z), s[5] * inv - bfhi(ws_.z)); o.w = pk2(s[6] * inv - bflo(ws_.w), s[7] * inv - bfhi(ws_.w));
        *(v4u*)(pooled + (size_t)m * 512 + ch * 8) = o;
    }
}
__device__ __forceinline__ void diff_combine_phase(int M, const bf16* od, bf16* diffo, const float* subln, float lam, float lam_init, int gtid, int NTH) {
    for (int it = gtid; it < M * 64; it += NTH) {
        const int l16 = it & 15, hd = (it >> 4) & 3, m = it >> 6;
        const bf16* p1 = od + (size_t)m * 1024 + hd * 256 + l16 * 8;
        const v4u a = *(const v4u*)p1, b = *(const v4u*)(p1 + 128);
        float d[8];
        d[0] = bflo(a.x) - lam * bflo(b.x); d[1] = bfhi(a.x) - lam * bfhi(b.x); d[2] = bflo(a.y) - lam * bflo(b.y); d[3] = bfhi(a.y) - lam * bfhi(b.y);
        d[4] = bflo(a.z) - lam * bflo(b.z); d[5] = bfhi(a.z) - lam * bfhi(b.z); d[6] = bflo(a.w) - lam * bflo(b.w); d[7] = bfhi(a.w) - lam * bfhi(b.w);
        float ss = 0.f;
#pragma unroll
        for (int i = 0; i < 8; ++i) ss += d[i] * d[i];
        ss += __shfl_xor(ss, 1); ss += __shfl_xor(ss, 2); ss += __shfl_xor(ss, 4); ss += __shfl_xor(ss, 8);
        const float rstd = 1.0f / sqrtf(ss * (1.f / 128.f) + EPSN), k1 = 1.0f - lam_init;
        const f32x4 g0 = *(const f32x4*)(subln + l16 * 8), g1 = *(const f32x4*)(subln + l16 * 8 + 4);
        v4u o; o.x = pk2(d[0] * rstd * g0[0] * k1, d[1] * rstd * g0[1] * k1); o.y = pk2(d[2] * rstd * g0[2] * k1, d[3] * rstd * g0[3] * k1);
        o.z = pk2(d[4] * rstd * g1[0] * k1, d[5] * rstd * g1[1] * k1); o.w = pk2(d[6] * rstd * g1[2] * k1, d[7] * rstd * g1[3] * k1);
        *(v4u*)(diffo + (size_t)m * 512 + hd * 128 + l16 * 8) = o;
    }
}

#define RLX_AGENT __ATOMIC_RELAXED, __HIP_MEMORY_SCOPE_AGENT
#define XB_TMO      128
#define XB_XCNT(j)  (256  + 64 * (j))
#define XB_XSUB(j)  (1280 + 64 * (j))
#define XB_XGEN(j)  (2304 + 64 * (j))
#define XB_TOP      3328
#define XB_TOPGEN   3392
#define XCD_BAR_WORDS 3456
#define XB_SPIN_CAP (1u << 22)

__device__ __forceinline__ unsigned xb_ld(unsigned* p)              { return __hip_atomic_load(p, __ATOMIC_RELAXED, __HIP_MEMORY_SCOPE_AGENT); }
__device__ __forceinline__ unsigned xb_add(unsigned* p, unsigned v) { return __hip_atomic_fetch_add(p, v, __ATOMIC_RELAXED, __HIP_MEMORY_SCOPE_AGENT); }
__device__ __forceinline__ unsigned xb_xcc_id() { return (unsigned)__builtin_amdgcn_s_getreg((3 << 11) | 20) & 0xFu; }
#define XB_SPIN(cond, bar) do { unsigned _sp = 0; while (cond) { __builtin_amdgcn_s_sleep(1); \
    if ((++_sp & 255u) == 0u) { if (xb_ld(&(bar)[XB_TMO])) break; if (_sp > XB_SPIN_CAP) { atomicAdd(&(bar)[XB_TMO], 1u); break; } } } } while (0)

struct XcdBarrier {
    unsigned* bar; unsigned x;
    volatile LAS unsigned* st;
};

__device__ __forceinline__ XcdBarrier xcd_barrier_post(unsigned* bar, volatile LAS unsigned* st) {
    XcdBarrier b; b.bar = bar; b.x = xb_xcc_id(); b.st = st;
    if (threadIdx.x == 0) (void)xb_add(&bar[XB_XCNT(b.x)], 1u);
    return b;
}
__device__ __forceinline__ void xcd_barrier_complete(unsigned* bar, unsigned x, unsigned& nloc, unsigned& nx) {
    const unsigned G = gridDim.x * gridDim.y * gridDim.z;
    unsigned sum, cnt, mine, sp = 0u;
    for (;;) {
        sum = 0u; cnt = 0u; mine = 0u;
#pragma unroll
        for (unsigned j = 0; j < 16; ++j) { const unsigned c = xb_ld(&bar[XB_XCNT(j)]); sum += c; cnt += (c > 0u) ? 1u : 0u; mine = (j == x) ? c : mine; }
        if (sum == G) break;
        __builtin_amdgcn_s_sleep(1);
        if ((++sp & 255u) == 0u) { if (xb_ld(&bar[XB_TMO])) break; if (sp > XB_SPIN_CAP) { atomicAdd(&bar[XB_TMO], 1u); break; } }
    }
    nloc = mine > 0u ? mine : 1u; nx = cnt > 0u ? cnt : 1u;
}

__device__ __forceinline__ void xcd_barrier(const XcdBarrier& b) {
    asm volatile("s_waitcnt vmcnt(0)" ::: "memory");
    __syncthreads();
    if (threadIdx.x == 0) {
        unsigned* bar = b.bar;
        __builtin_amdgcn_s_waitcnt(0);
        unsigned nloc = b.st[0], nx = b.st[1];
        if (nloc == 0u) { xcd_barrier_complete(bar, b.x, nloc, nx); b.st[0] = nloc; b.st[1] = nx; }
        const unsigned old = xb_add(&bar[XB_XSUB(b.x)], 1u);
        const unsigned gen = old / nloc;
        if (old + 1u == (gen + 1u) * nloc) {
            __builtin_amdgcn_fence(__ATOMIC_RELEASE, "agent");
            asm volatile("s_waitcnt vmcnt(0)" ::: "memory");
            const unsigned og = xb_add(&bar[XB_TOP], 1u);
            const unsigned tg = og / nx;
            if (og + 1u == (tg + 1u) * nx) xb_add(&bar[XB_TOPGEN], 1u);
            else XB_SPIN(xb_ld(&bar[XB_TOPGEN]) == tg, bar);
            __builtin_amdgcn_fence(__ATOMIC_ACQUIRE, "agent");
            xb_add(&bar[XB_XGEN(b.x)], 1u);
            asm volatile("s_waitcnt vmcnt(0)" ::: "memory");
        } else {
            XB_SPIN(xb_ld(&bar[XB_XGEN(b.x)]) == gen, bar);
            __builtin_amdgcn_fence(__ATOMIC_ACQUIRE, "agent");
            asm volatile("s_waitcnt vmcnt(0)" ::: "memory");
        }
    }
    __syncthreads();
}
constexpr size_t WS_BAR = 320 * 1024;
constexpr int LDS_CTL = 131072, LDS_BARST = LDS_CTL + 352;
constexpr size_t WS_PTR = 300 * 1024;
struct Ids { int tid, lane, wave, bx, G, vcu, gw, NGW, gtid, NTH; };
#define FRESH_IDS(I) Ids I; { int t_ = threadIdx.x; asm volatile("" : "+v"(t_)); int b_ = blockIdx.x; asm volatile("" : "+s"(b_)); int g_ = gridDim.x; asm volatile("" : "+s"(g_)); \
    I.tid = t_; I.lane = t_ & 63; I.wave = __builtin_amdgcn_readfirstlane(t_ >> 6); I.bx = b_; I.G = g_; I.vcu = (g_ % 8 == 0) ? (b_ % 8) * (g_ / 8) + b_ / 8 : b_; \
    I.gw = I.vcu * 8 + I.wave; I.NGW = g_ * 8; I.gtid = b_ * NTHR + t_; I.NTH = g_ * NTHR; }
#define PTAB(i) (((const float* const*)(ws + WS_PTR))[i])

__global__ void __launch_bounds__(NTHR, 2) mk_fwd(Args a) {
    extern __shared__ __attribute__((aligned(16))) unsigned char lds_raw[];
    cg::grid_group grid = cg::this_grid();
    LAS unsigned char* lds = (LAS unsigned char*)lds_raw;
    unsigned char* ws = a.ws;
#define GSYNC_CG() do { asm volatile("s_waitcnt vmcnt(0) lgkmcnt(0)" ::: "memory"); grid.sync(); asm volatile("" ::: "memory"); } while (0)
#define GSYNC() do { XcdBarrier b_; b_.bar = (unsigned*)(ws + WS_BAR); b_.x = xb_xcc_id(); b_.st = (volatile LAS unsigned*)(lds + LDS_BARST); xcd_barrier(b_); asm volatile("" ::: "memory"); } while (0)
#ifndef REP_P1
#define REP_P1 1
#endif
#ifndef REP_P2
#define REP_P2 1
#endif
#ifndef REP_P3
#define REP_P3 1
#endif
#ifndef REP_P4
#define REP_P4 1
#endif
#ifndef REP_P5
#define REP_P5 1
#endif
#ifndef REP_P7
#define REP_P7 1
#endif
#ifndef REP_P8
#define REP_P8 1
#endif
#ifndef EXTRA_SYNCS
#define EXTRA_SYNCS 0
#endif
#define REPEAT(n) _Pragma("unroll 1") for (int rep_ = 0; rep_ < (n); ++rep_)
    for (int u = threadIdx.x; u < (LDS_BYTES - LDS_CTL) / 4; u += NTHR) ((LAS unsigned*)(lds + LDS_CTL))[u] = 0u;
    if (blockIdx.x == 0) for (int i = threadIdx.x; i < XCD_BAR_WORDS; i += NTHR) ((unsigned*)(ws + WS_BAR))[i] = 0u;
    __syncthreads();

    {
        FRESH_IDS(I);
        if (I.bx == 0 && I.tid == 0) {
            const float** tab = (const float**)(ws + WS_PTR);
#pragma unroll
            for (int i = 0; i < 26; ++i) tab[i] = a.in[i];
            tab[26] = a.out;
        }
        mod_gemv(a.in[1], a.in[3], a.in[4], a.in[5], (float*)(ws + WS_MOD), lds, I.tid, I.lane, I.wave, I.bx);
        WPtrs wp{a.in[10], a.in[11], a.in[12], a.in[20], a.in[21], a.in[22], a.in[23], a.in[24], a.in[25]};
        convert_weights(wp, 0, ws, lds, I.gw, I.NGW, I.wave, I.lane, I.gtid, I.NTH);
        if (I.bx == I.G - 1) { float* ropet = (float*)(ws + WS_ROPE);
            for (int i = I.tid; i < 1024; i += NTHR) { const int pos = i >> 4, j = i & 15; const float inv = 1.0f / powf(10000.0f, (float)j * 2.0f / 32.0f); const float ang = (float)pos * inv;
                ropet[2 * i] = cosf(ang); ropet[2 * i + 1] = sinf(ang); } }
    }
    GSYNC_CG();
    (void)xcd_barrier_post((unsigned*)(ws + WS_BAR), (volatile LAS unsigned*)(lds + LDS_BARST));
    for (int e_ = 0; e_ < EXTRA_SYNCS; ++e_) GSYNC();
    {
        FRESH_IDS(I);
        float* modv = (float*)(ws + WS_MOD);
        norm_phase(MA, PTAB(0), PTAB(2), (float*)PTAB(26), (float*)(ws + WS_CTX), nullptr, nullptr, 0, nullptr, (bf16*)(ws + WS_H), PTAB(6), modv, 0, 1, I.gw, I.NGW, I.lane);
    }
    GSYNC();

#pragma unroll 1
    for (int l = 0; l < 2; ++l) {
        REPEAT(REP_P1) {
        {
            FRESH_IDS(I);
            const float* ropet = (const float*)(ws + WS_ROPE);
            pg8::Gemm g{(const bf16_t*)(ws + WS_H), (const bf16_t*)(ws + W_IN), MA, N1, 1024}; pg8::StaticOrder S; S.init(MA, N1, I.G, I.bx);
            EpiIn E{ws};
            pg8::gemm_phase<EpiIn, pg8::StaticOrder, true, true>(lds, g, S, E);
        }
        {
            asm volatile("s_waitcnt vmcnt(0)" ::: "memory"); __syncthreads(); __builtin_amdgcn_fence(__ATOMIC_ACQUIRE, "agent"); asm volatile("s_waitcnt vmcnt(0)" ::: "memory");
            FRESH_IDS(I);
            const float* ropet = (const float*)(ws + WS_ROPE);
            const float* kn = PTAB(19) + l * 64;
            pg8::StaticOrder S; S.init(MA, N1, I.G, I.bx);
            pg8::Unit u;
            for (int i = 0; S.next(i, u); ++i) {
                const bool latent = u.pm < (ML / 256);
                if (u.pn == 10) {
                    const int hh = I.tid & 1, rl = I.tid >> 1, row = u.pm * 256 + rl;
                    head_norm_fix((bf16_t*)(ws + WS_KG) + (size_t)kvrow_of(row) * 128 + hh * 64, kn, latent, row & 4095, 1.0f, ropet);
                }
            }
        }
        GSYNC();
        }
        REPEAT(REP_P2) {
        {
            FRESH_IDS(I);
            const bool last = (l == 1); const int M2 = last ? ML : MA;
            pool_phase(M2, (const bf16*)(ws + WS_POOLIN), (bf16*)(ws + WS_POOLED), I.gtid, I.NTH);
            const int total = 1536 + (last ? 0 : 96);
            for (int i = 0;; ++i) {
                const int L = i * I.G + I.vcu; if (L >= total) break;
                int b, r, m0, NT;
                if (L < 1536) { const int qb = L & 15, pair = L >> 4; b = pair / 24; r = pair % 24; m0 = b * SEQL + qb * 256; NT = LKV / 64; }
                else { const int L2 = L - 1536; b = L2 / 24; r = L2 % 24; m0 = ML + b * CTXL; NT = CTXL / 64; }
                const attn_body::bf16 *Q, *K, *V; attn_body::bf16* O; int pq, pk, pv, po; const float* qgain = nullptr; int qt0 = -1;
                if (r < 16) { const int hd = r >> 2, qs = (r >> 1) & 1, vh = r & 1;
                    Q = (const attn_body::bf16*)(ws + WS_QD) + (size_t)m0 * 512 + hd * 128 + qs * 64; pq = 512;
                    K = (const attn_body::bf16*)(ws + WS_KD) + (size_t)(b * LKV) * 512 + hd * 128 + qs * 64; pk = 512;
                    V = (const attn_body::bf16*)(ws + WS_VD) + (size_t)(b * LKV) * 512 + hd * 128 + vh * 64; pv = 512;
                    O = (attn_body::bf16*)(ws + WS_OD) + (size_t)m0 * 1024 + hd * 256 + qs * 128 + vh * 64; po = 1024; }
                else { const int h = r - 16;
                    Q = (const attn_body::bf16*)(ws + WS_QG) + (size_t)m0 * 512 + h * 64; pq = 512;
                    K = (const attn_body::bf16*)(ws + WS_KG) + (size_t)(b * LKV) * 128 + (h >> 2) * 64; pk = 128;
                    V = (const attn_body::bf16*)(ws + WS_VG) + (size_t)(b * LKV) * 128 + (h >> 2) * 64; pv = 128;
                    O = (attn_body::bf16*)(ws + WS_GQAO) + (size_t)m0 * 512 + h * 64; po = 512; qgain = PTAB(18) + l * 64; qt0 = (L < 1536) ? (m0 & 4095) : -1; }
#ifndef NO_ATTN
                attn_body::attn_unit<8>(Q, pq, K, pk, V, pv, O, po, NT, (char*)lds_raw, qgain, (const float*)(ws + WS_ROPE), qt0);
#endif
            }
        }
        GSYNC();
        }
        REPEAT(REP_P3) {
        {
            FRESH_IDS(I);
            const bool last = (l == 1); const int M2 = last ? ML : MA; const float lam_init = last ? 0.35550906759f : 0.2f;
            const float *lq1 = PTAB(13) + l * 64, *lk1 = PTAB(14) + l * 64, *lq2 = PTAB(15) + l * 64, *lk2 = PTAB(16) + l * 64;
            float d1 = 0.f, d2 = 0.f;
            for (int i = 0; i < 64; ++i) { d1 += lq1[i] * lk1[i]; d2 += lq2[i] * lk2[i]; }
            const float lam = expf(d1) - expf(d2) + lam_init;
            diff_combine_phase(M2, (const bf16*)(ws + WS_OD), (bf16*)(ws + WS_DIFFO), PTAB(17) + l * 128, lam, lam_init, I.gtid, I.NTH);
            pg8::Gemm g{(const bf16_t*)(ws + WS_POOLED), (const bf16_t*)(ws + W_POOL), M2, 512, 512}; pg8::StaticOrder S; S.init(M2, 512, I.G, I.bx);
            EpiAct<0> E{(bf16_t*)(ws + WS_POOLO), 512};
            pg8::gemm_phase<EpiAct<0>, pg8::StaticOrder, true, true>(lds, g, S, E);
        }
        GSYNC();
        }
        REPEAT(REP_P4) {
#pragma unroll 1
        for (int b = 0; b < 3; ++b) {
            { FRESH_IDS(I); const int M2 = (l == 1) ? ML : MA;
              pg8::Gemm g{(const bf16_t*)(ws + WS_H), (const bf16_t*)(ws + W_IN) + (size_t)(N1 + b * 1024) * 1024, M2, 1024, 1024}; pg8::StaticOrder S; S.init(M2, 1024, I.G, I.bx);
              EpiAct<1> E{(bf16_t*)(ws + WS_MERGED), 1024};
              pg8::gemm_phase<EpiAct<1>, pg8::StaticOrder, true, true>(lds, g, S, E); }
            { FRESH_IDS(I); const int M2 = (l == 1) ? ML : MA;
              const bf16_t* A = (const bf16_t*)(ws + (b == 0 ? WS_POOLO : b == 1 ? WS_DIFFO : WS_GQAO)); const bf16_t* Bt = (const bf16_t*)(ws + (b == 0 ? W_PO : b == 1 ? W_DO : W_GO));
              pg8::Gemm g{A, Bt, M2, 1024, 512}; pg8::StaticOrder S; S.init(M2, 1024, I.G, I.bx);
              EpiBranch E{(bf16_t*)(ws + WS_MERGED), (float*)(ws + WS_ACC), b};
              pg8::gemm_phase<EpiBranch, pg8::StaticOrder, true, true>(lds, g, S, E); }
        }
        GSYNC();
        }
        REPEAT(REP_P5) {
        {
            FRESH_IDS(I); const int M2 = (l == 1) ? ML : MA;
            pg8::Gemm g{(const bf16_t*)(ws + WS_MERGED), (const bf16_t*)(ws + W_O), M2, 1024, 1024}; pg8::StaticOrder S; S.init(M2, 1024, I.G, I.bx);
            EpiF32 E{(float*)(ws + WS_Y), 1024};
            pg8::gemm_phase<EpiF32, pg8::StaticOrder, true, true>(lds, g, S, E);
        }
        GSYNC();
        }
        {
            FRESH_IDS(I); const int M2 = (l == 1) ? ML : MA;
            const float* modl = (const float*)(ws + WS_MOD) + l * 5 * NMOD; float* outp = (float*)PTAB(26); float* ctxx = (float*)(ws + WS_CTX);
            norm_phase(M2, outp, ctxx, outp, ctxx, (const float*)(ws + WS_Y), modl, 2, PTAB(7) + l * 1024, (bf16*)(ws + WS_HF), PTAB(8) + l * 1024, modl, 3, 4, I.gw, I.NGW, I.lane);
        }
        GSYNC();
        REPEAT(REP_P7) {
        {
            FRESH_IDS(I); const int M2 = (l == 1) ? ML : MA;
            pg8::Gemm g{(const bf16_t*)(ws + WS_HF), (const bf16_t*)(ws + W_1), M2, DFF, 1024}; pg8::StaticOrder S; S.init(M2, DFF, I.G, I.bx);
            EpiAct<2> E{(bf16_t*)(ws + WS_U), DFF};
            pg8::gemm_phase<EpiAct<2>, pg8::StaticOrder, true, true>(lds, g, S, E);
        }
        GSYNC();
        }
        REPEAT(REP_P8) {
        {
            FRESH_IDS(I); const int M2 = (l == 1) ? ML : MA;
            pg8::Gemm g{(const bf16_t*)(ws + WS_U), (const bf16_t*)(ws + W_2), M2, 1024, DFF}; pg8::StaticOrder S; S.init(M2, 1024, I.G, I.bx);
            EpiF32 E{(float*)(ws + WS_Z), 1024};
            pg8::gemm_phase<EpiF32, pg8::StaticOrder, true, true>(lds, g, S, E);
        }
        GSYNC();
        }
        {
            FRESH_IDS(I);
            const float* modl = (const float*)(ws + WS_MOD) + l * 5 * NMOD; float* outp = (float*)PTAB(26); float* ctxx = (float*)(ws + WS_CTX);
            if (l == 0) {
                WPtrs wp{PTAB(10), PTAB(11), PTAB(12), PTAB(20), PTAB(21), PTAB(22), PTAB(23), PTAB(24), PTAB(25)};
                convert_weights(wp, 1, ws, lds, I.gw, I.NGW, I.wave, I.lane, I.gtid, I.NTH);
                norm_phase(MA, outp, ctxx, outp, ctxx, (const float*)(ws + WS_Z), modl, 5, PTAB(9) + l * 1024, (bf16*)(ws + WS_H), PTAB(6) + 1024, modl + 5 * NMOD, 0, 1, I.gw, I.NGW, I.lane);
            } else {
                norm_phase(ML, outp, ctxx, outp, ctxx, (const float*)(ws + WS_Z), modl, 5, PTAB(9) + l * 1024, nullptr, nullptr, nullptr, 0, 0, I.gw, I.NGW, I.lane);
            }
        }
        if (l == 0) GSYNC();
    }
#undef GSYNC
}

extern "C" void kernel_launch(void* const* d_in, const int* in_sizes, int n_in, void* d_out, int out_size, void* d_ws, size_t ws_size, hipStream_t stream) {
    static int grid = 0;
    if (grid == 0) {
        if (n_in != 26 || out_size != ML * DMODEL || ws_size < WS_TOTAL) { fprintf(stderr, "kernel_launch: unexpected shapes (n_in %d out %d ws %zu)\n", n_in, out_size, ws_size); grid = -1; return; }
        int dev = 0, cus = 0, per_cu = 0;
        if (hipGetDevice(&dev) != hipSuccess || hipDeviceGetAttribute(&cus, hipDeviceAttributeMultiprocessorCount, dev) != hipSuccess) { grid = -1; return; }
        if (hipFuncSetAttribute((const void*)mk_fwd, hipFuncAttributeMaxDynamicSharedMemorySize, LDS_BYTES) != hipSuccess) { fprintf(stderr, "kernel_launch: hipFuncSetAttribute failed\n"); grid = -1; return; }
        if (hipOccupancyMaxActiveBlocksPerMultiprocessor(&per_cu, (const void*)mk_fwd, NTHR, LDS_BYTES) != hipSuccess || per_cu < 1) per_cu = 1;
        (void)hipGetLastError();
        grid = cus * per_cu;
    }
    if (grid < 0) return;
    Args a{};
    for (int i = 0; i < 26; ++i) a.in[i] = (const float*)d_in[i];
    a.out = (float*)d_out; a.ws = (unsigned char*)d_ws;
    void* args[] = {&a};
    hipError_t e = hipLaunchCooperativeKernel((const void*)mk_fwd, dim3(grid), dim3(NTHR), args, LDS_BYTES, stream);
    if (e != hipSuccess) fprintf(stderr, "kernel_launch: cooperative launch failed: %s (grid %d)\n", hipGetErrorString(e), grid);
}
```

```cpp
#include <hip/hip_runtime.h>
#include <hip/hip_cooperative_groups.h>
#include <cstdio>
#include <cstdint>

namespace pg8 {
#define PG8_LAS __attribute__((address_space(3)))
typedef unsigned short bf16_t;
typedef short bf16x8 __attribute__((ext_vector_type(8)));
typedef float f32x4 __attribute__((ext_vector_type(4)));
typedef unsigned u32x4 __attribute__((ext_vector_type(4)));
constexpr int BM = 256, BK = 64, HALF = 128, HTB = HALF * BK * 2  , STAGE_BYTES = 8 * HTB, NXCD = 8, WGM = 8;

__host__ __device__ __forceinline__ int lds_byte(int r, int c) { const int st = (r >> 4) * 2 + (c >> 5), rr = r & 15, cc = c & 31, ob = rr * 64 + cc * 2; return st * 1024 + (ob ^ (((ob >> 9) & 1) << 5)); }
__host__ __device__ __forceinline__ void stage_rc(int b, int& R, int& C) { const int st = b / 1024, sb = b % 1024, swz = sb ^ (((sb >> 9) & 1) << 5); R = (st >> 1) * 16 + swz / 64; C = (st & 1) * 32 + (swz % 64) / 2; }
__host__ __device__ __forceinline__ int perm32(int rho) { const int n = rho >> 4, i = rho & 15; return 8 * (i >> 2) + 4 * n + (i & 3); }

struct Unit { const char* A; const char* B; int lda, ldb, nt, pm, pn, seg; };
struct Gemm { const bf16_t* A; const bf16_t* Bt; int M, N, K; };

struct StaticOrder {
    int nM, nN, nwg, G, c;
    __host__ __device__ void init(int M, int N, int G_, int c_) { nM = M / BM; nN = N / BM; nwg = nM * nN; G = G_; c = c_; }
    __host__ __device__ bool next(int i, Unit& u) const {
        const long L = (long)i * G + c; if (L >= nwg) return false;
        int wgid = (int)L; { const int q = nwg / NXCD, r = nwg % NXCD, xcd = wgid % NXCD, off = wgid / NXCD; wgid = (xcd < r ? xcd * (q + 1) : r * (q + 1) + (xcd - r) * q) + off; }
        const int nig = WGM * nN, gid = wgid / nig, fm = gid * WGM, gsz = (nM - fm) < WGM ? (nM - fm) : WGM;
        u.pm = fm + ((wgid % nig) % gsz); u.pn = (wgid % nig) / gsz; return true;
    }
    __device__ __forceinline__ void a_ready(const Unit&) const {}
    __device__ __forceinline__ void done(const Unit&) const {}
};

__device__ __forceinline__ unsigned cvt_pk_bf16(float lo, float hi) { unsigned r; asm volatile("v_cvt_pk_bf16_f32 %0, %1, %2" : "=v"(r) : "v"(lo), "v"(hi)); return r; }
typedef float f32x2 __attribute__((ext_vector_type(2)));
template <class Epi, class Sched, bool ALIGN_EPI = false, bool SP2 = false>
__device__ __forceinline__ void gemm_phase(PG8_LAS unsigned char* lds, const Sched& S, const Epi& E) {
    int tid_l = threadIdx.x; asm volatile("" : "+v"(tid_l)); const int tid = tid_l, wid = __builtin_amdgcn_readfirstlane(tid >> 6), lane = tid & 63, wr = wid >> 2, wc = wid & 3, fr = lane & 15, fq = lane >> 4;
    unsigned rA[2], rB[2], c2[2];
#pragma unroll
    for (int i = 0; i < 2; ++i) { int R, C; stage_rc(tid * 16 + i * 8192, R, C); const int Rb = Epi::PERM ? ((R & ~31) + perm32(R & 31)) : R;
        rA[i] = (unsigned)R; rB[i] = (unsigned)Rb; c2[i] = (unsigned)C * 2u; }
    const size_t kstep = (size_t)(BK * 2);
    const unsigned ldsw = (unsigned)wid * 1024u;
    const int aoff = lds_byte(wr * 64 + fr, fq * 8), boff = lds_byte(wc * 32 + fr, fq * 8);
#define PG8_SA(b, h) (((b) * 2 + (h)) * HTB)
#define PG8_SB(b, h) ((4 + (b) * 2 + (h)) * HTB)
#define PG8_STAGE(bufoff, gbase, voff) do { _Pragma("unroll") for (int _i = 0; _i < 2; ++_i) \
        __builtin_amdgcn_global_load_lds((const unsigned*)((const char*)(gbase) + (voff)[_i]), (PG8_LAS unsigned*)(lds + (bufoff) + ldsw + _i * 8192), 16, 0, 0); } while (0)
#define PG8_LDA(dst, b, h) do { _Pragma("unroll") for (int m = 0; m < 4; ++m) _Pragma("unroll") for (int k = 0; k < 2; ++k) dst[m][k] = *(const PG8_LAS bf16x8*)(lds + PG8_SA(b, h) + aoff + m * 2048 + k * 1024); } while (0)
#define PG8_LDB(dst, b, h) do { _Pragma("unroll") for (int n = 0; n < 2; ++n) _Pragma("unroll") for (int k = 0; k < 2; ++k) dst[n][k] = *(const PG8_LAS bf16x8*)(lds + PG8_SB(b, h) + boff + n * 2048 + k * 1024); } while (0)
#define PG8_MMA(ai, bj, At, Bt) do { __builtin_amdgcn_s_setprio(1); _Pragma("unroll") for (int m = 0; m < 4; ++m) _Pragma("unroll") for (int n = 0; n < 2; ++n) _Pragma("unroll") for (int k = 0; k < 2; ++k) \
        acc[ai][bj][m][n] = __builtin_amdgcn_mfma_f32_16x16x32_bf16(Bt[n][k], At[m][k], acc[ai][bj][m][n], 0, 0, 0); __builtin_amdgcn_s_setprio(0); } while (0)
#define PG8_WAIT_V(n) asm volatile("s_waitcnt vmcnt(" #n ")" ::: "memory")
#define PG8_WAIT_L(n) asm volatile("s_waitcnt lgkmcnt(" #n ")" ::: "memory")
#define PG8_BAR __builtin_amdgcn_s_barrier()
#define PG8_SCHED __builtin_amdgcn_sched_barrier(0)
    Unit cur, nxt; int ui = 0;
    if (!S.next(0, cur)) return;
    f32x4 acc[2][2][4][2];
#pragma unroll
    for (int a = 0; a < 2; ++a)
#pragma unroll
        for (int b = 0; b < 2; ++b)
#pragma unroll
            for (int m = 0; m < 4; ++m)
#pragma unroll
                for (int n = 0; n < 2; ++n) acc[a][b][m][n] = (f32x4){0.f, 0.f, 0.f, 0.f};
    bf16x8 At[4][2], B0[2][2], B1[2][2];
    unsigned voA_c[2], voB_c[2], voA_n[2], voB_n[2]; size_t hA_c, hB_c, hA_n, hB_n; int nt_c;
#define PG8_UPARAMS(u, vA, vB, hA, hB) do { _Pragma("unroll") for (int _i = 0; _i < 2; ++_i) { vA[_i] = rA[_i] * (unsigned)(u).lda + c2[_i]; vB[_i] = rB[_i] * (unsigned)(u).ldb + c2[_i]; } hA = (size_t)HALF * (u).lda; hB = (size_t)HALF * (u).ldb; } while (0)
    PG8_UPARAMS(cur, voA_c, voB_c, hA_c, hB_c); nt_c = cur.nt;
    const char* cA = cur.A; const char* cB = cur.B;
    S.a_ready(cur);
    if constexpr (SP2) {
        PG8_STAGE(PG8_SB(0, 0), cB, voB_c); PG8_STAGE(PG8_SB(0, 1), cB + hB_c, voB_c); PG8_STAGE(PG8_SA(0, 0), cA, voA_c); PG8_STAGE(PG8_SA(0, 1), cA + hA_c, voA_c);
        if (wr == 1) PG8_BAR;
        PG8_WAIT_V(2); PG8_BAR;
        PG8_STAGE(PG8_SB(1, 0), cB + kstep, voB_c); PG8_STAGE(PG8_SA(1, 0), cA + kstep, voA_c); PG8_STAGE(PG8_SB(1, 1), cB + hB_c + kstep, voB_c);
        PG8_WAIT_V(6); PG8_BAR;
    } else {
        PG8_STAGE(PG8_SB(0, 0), cB, voB_c); PG8_STAGE(PG8_SA(0, 0), cA, voA_c); PG8_STAGE(PG8_SB(0, 1), cB + hB_c, voB_c); PG8_STAGE(PG8_SA(0, 1), cA + hA_c, voA_c);
        if (wr == 1) PG8_BAR;
        PG8_WAIT_V(4); PG8_BAR;
        PG8_STAGE(PG8_SB(1, 0), cB + kstep, voB_c); PG8_STAGE(PG8_SA(1, 0), cA + kstep, voA_c); PG8_STAGE(PG8_SB(1, 1), cB + hB_c + kstep, voB_c);
        PG8_WAIT_V(6); PG8_BAR;
    }
    for (;;) {
        const bool has_next = S.next(ui + 1, nxt);
        const char* nA = has_next ? nxt.A : cA; const char* nB = has_next ? nxt.B : cB;
        if (has_next) { PG8_UPARAMS(nxt, voA_n, voB_n, hA_n, hB_n); } else { voA_n[0] = voA_c[0]; voA_n[1] = voA_c[1]; voB_n[0] = voB_c[0]; voB_n[1] = voB_c[1]; hA_n = hA_c; hB_n = hB_c; }
        for (int t = 0; t < nt_c; t += 2) {
            const bool last = (t == nt_c - 2);
            const size_t hA2 = last ? hA_n : hA_c, hB2 = last ? hB_n : hB_c;
            unsigned vA2[2], vB2[2]; vA2[0] = last ? voA_n[0] : voA_c[0]; vA2[1] = last ? voA_n[1] : voA_c[1]; vB2[0] = last ? voB_n[0] : voB_c[0]; vB2[1] = last ? voB_n[1] : voB_c[1];
            const char* a1 = cA + (size_t)(t + 1) * kstep;
            const char* a2 = last ? nA : cA + (size_t)(t + 2) * kstep; const char* b2 = last ? nB : cB + (size_t)(t + 2) * kstep;
            const char* a3 = a2 + kstep; const char* b3 = b2 + kstep;
            if (last && has_next) S.a_ready(nxt);
            if constexpr (SP2) {
            PG8_LDB(B0, 0, 0); PG8_LDB(B1, 0, 1); PG8_SCHED; PG8_LDA(At, 0, 0); PG8_STAGE(PG8_SA(1, 1), a1 + hA_c, voA_c);
            PG8_WAIT_V(8); PG8_WAIT_L(0); PG8_BAR; PG8_MMA(0, 0, At, B0); PG8_MMA(0, 1, At, B1); PG8_BAR; PG8_SCHED;
            PG8_LDA(At, 0, 1); PG8_STAGE(PG8_SB(0, 0), b2, vB2); PG8_STAGE(PG8_SB(0, 1), b2 + hB2, vB2); PG8_STAGE(PG8_SA(0, 0), a2, vA2);
            PG8_WAIT_V(8); PG8_WAIT_L(0); PG8_BAR; PG8_MMA(1, 0, At, B0); PG8_MMA(1, 1, At, B1); PG8_BAR; PG8_SCHED;
            PG8_LDB(B0, 1, 0); PG8_LDB(B1, 1, 1); PG8_SCHED; PG8_LDA(At, 1, 0); PG8_STAGE(PG8_SA(0, 1), a2 + hA2, vA2);
            PG8_WAIT_V(8); PG8_WAIT_L(0); PG8_BAR; PG8_MMA(0, 0, At, B0); PG8_MMA(0, 1, At, B1); PG8_BAR; PG8_SCHED;
            PG8_LDA(At, 1, 1); PG8_STAGE(PG8_SB(1, 0), b3, vB2); PG8_STAGE(PG8_SB(1, 1), b3 + hB2, vB2); PG8_STAGE(PG8_SA(1, 0), a3, vA2);
            PG8_WAIT_V(8); PG8_WAIT_L(0); PG8_BAR; PG8_MMA(1, 0, At, B0); PG8_MMA(1, 1, At, B1); PG8_BAR; PG8_SCHED;
            } else {
            PG8_LDB(B0, 0, 0); PG8_SCHED; PG8_LDA(At, 0, 0); PG8_STAGE(PG8_SA(1, 1), a1 + hA_c, voA_c);
            PG8_WAIT_L(8); PG8_BAR; PG8_WAIT_L(0); PG8_MMA(0, 0, At, B0); PG8_BAR; PG8_SCHED;
            PG8_LDB(B1, 0, 1); PG8_STAGE(PG8_SB(0, 0), b2, vB2);
            PG8_BAR; PG8_WAIT_L(0); PG8_MMA(0, 1, At, B1); PG8_BAR;
            PG8_LDA(At, 0, 1); PG8_STAGE(PG8_SA(0, 0), a2, vA2);
            PG8_BAR; PG8_WAIT_L(0); PG8_MMA(1, 0, At, B0); PG8_BAR; PG8_SCHED;
            PG8_STAGE(PG8_SB(0, 1), b2 + hB2, vB2);
            PG8_WAIT_V(6); PG8_BAR; PG8_MMA(1, 1, At, B1); PG8_BAR;
            PG8_LDB(B0, 1, 0); PG8_SCHED; PG8_LDA(At, 1, 0); PG8_STAGE(PG8_SA(0, 1), a2 + hA2, vA2);
            PG8_WAIT_L(8); PG8_BAR; PG8_WAIT_L(0); PG8_MMA(0, 0, At, B0); PG8_BAR; PG8_SCHED;
            PG8_LDB(B1, 1, 1); PG8_STAGE(PG8_SB(1, 0), b3, vB2);
            PG8_BAR; PG8_WAIT_L(0); PG8_MMA(0, 1, At, B1); PG8_BAR;
            PG8_LDA(At, 1, 1); PG8_STAGE(PG8_SA(1, 0), a3, vA2);
            PG8_BAR; PG8_WAIT_L(0); PG8_MMA(1, 0, At, B0); PG8_BAR; PG8_SCHED;
            PG8_STAGE(PG8_SB(1, 1), b3 + hB2, vB2);
            PG8_WAIT_V(6); PG8_BAR; PG8_MMA(1, 1, At, B1); PG8_BAR;
            }
        }
        if constexpr (ALIGN_EPI) { if (wr == 0) PG8_BAR; }
        if constexpr (!Epi::AFTER_DRAIN) { E(acc, cur, wr, wc, fr, fq); S.done(cur); }
        if (!has_next) break;
#pragma unroll
        for (int a = 0; a < 2; ++a)
#pragma unroll
            for (int b = 0; b < 2; ++b)
#pragma unroll
                for (int m = 0; m < 4; ++m)
#pragma unroll
                    for (int n = 0; n < 2; ++n) acc[a][b][m][n] = (f32x4){0.f, 0.f, 0.f, 0.f};
        cur = nxt; cA = nA; cB = nB; ++ui; voA_c[0] = voA_n[0]; voA_c[1] = voA_n[1]; voB_c[0] = voB_n[0]; voB_c[1] = voB_n[1]; hA_c = hA_n; hB_c = hB_n; nt_c = cur.nt;
        if constexpr (ALIGN_EPI) { if (wr == 1) PG8_BAR; }
    }
    PG8_WAIT_V(0);
    if constexpr (!ALIGN_EPI) { if (wr == 0) PG8_BAR; }
    PG8_BAR;
    if constexpr (Epi::AFTER_DRAIN) { E.fused(acc, cur, wr, wc, fr, fq, lds, wid, lane); S.done(cur); }
#undef PG8_UPARAMS
#undef PG8_SA
#undef PG8_SB
#undef PG8_STAGE
#undef PG8_LDA
#undef PG8_LDB
#undef PG8_MMA
#undef PG8_WAIT_V
#undef PG8_WAIT_L
#undef PG8_BAR
#undef PG8_SCHED
}
}
namespace cg = cooperative_groups;
#define LAS __attribute__((address_space(3)))
typedef unsigned short bf16;
typedef unsigned v4u __attribute__((ext_vector_type(4)));
typedef unsigned v2u __attribute__((ext_vector_type(2)));
typedef float f32x4 __attribute__((ext_vector_type(4)));
using pg8::bf16_t;

constexpr int DMODEL = 1024, NBATCH = 4, SEQL = 4096, CTXL = 256, LKV = SEQL + CTXL, ML = NBATCH * SEQL, MC = NBATCH * CTXL, MA = ML + MC, DFF = 4096, N1 = 2816, NMOD = 6 * DMODEL;
constexpr float EPSN = 1e-6f;
constexpr float QC2 = 0.125f * 1.4426950408889634f;
constexpr int NTHR = 512;
constexpr int LDS_BYTES = 147456;

constexpr size_t MiB = 1u << 20;
constexpr size_t WS_MOD = 0, WS_ROPE = 256 * 1024;
constexpr size_t W_IN = 2 * MiB, W_POOL = W_IN + (size_t)5888 * 1024 * 2, W_PO = W_POOL + 512 * 512 * 2, W_DO = W_PO + 1024 * 512 * 2, W_GO = W_DO + 1024 * 512 * 2,
                 W_O = W_GO + 1024 * 512 * 2, W_1 = W_O + 1024 * 1024 * 2, W_2 = W_1 + (size_t)4096 * 1024 * 2, W_END = W_2 + (size_t)4096 * 1024 * 2;
static_assert(W_END <= 36 * MiB, "weights");
constexpr size_t WS_CTX = 36 * MiB, WS_H = 40 * MiB;
constexpr size_t WS_POOLIN = 74 * MiB, WS_QD = 91 * MiB, WS_QG = 108 * MiB, WS_KD = 125 * MiB, WS_VD = 142 * MiB, WS_KG = 159 * MiB, WS_VG = WS_KG + (size_t)MA * 128 * 2;
constexpr size_t WS_OD = 176 * MiB, WS_GQAO = 210 * MiB, WS_POOLED = 227 * MiB;
constexpr size_t WS_DIFFO = 74 * MiB, WS_POOLO = 91 * MiB, WS_MERGED = 108 * MiB, WS_ACC = 142 * MiB, WS_Y = 142 * MiB, WS_HF = 210 * MiB, WS_U = 40 * MiB, WS_Z = 176 * MiB;
constexpr size_t WS_TOTAL = 256 * MiB;
static_assert(WS_VG + (size_t)MA * 128 * 2 <= 176 * MiB, "p1 outs");

__device__ __forceinline__ unsigned f2bf(float f) { unsigned u = __builtin_bit_cast(unsigned, f); return (u + 0x7fffu + ((u >> 16) & 1u)) >> 16; }
__device__ __forceinline__ unsigned pk2(float lo, float hi) { return f2bf(lo) | (f2bf(hi) << 16); }
__device__ __forceinline__ float bflo(unsigned w) { return __builtin_bit_cast(float, w << 16); }
__device__ __forceinline__ float bfhi(unsigned w) { return __builtin_bit_cast(float, w & 0xffff0000u); }
__device__ __forceinline__ float wave_sum(float v) {
#pragma unroll
    for (int o = 1; o < 64; o <<= 1) v += __shfl_xor(v, o);
    return v;
}

__device__ __forceinline__ int kvrow_of(int row) { return row < ML ? (row >> 12) * LKV + CTXL + (row & 4095) : ((row - ML) >> 8) * LKV + ((row - ML) & 255); }
__device__ __forceinline__ void rope8(float (&v)[8], const float* tab, int d, int t) {
    const int p0 = d >> 1, pos = p0 < 16 ? (t >> 6) : (t & 63), j0 = p0 & 15;
    const f32x4* tp = (const f32x4*)(tab + (pos * 16 + j0) * 2);
    const f32x4 t0 = tp[0], t1 = tp[1];
    float o[8];
    o[0] = v[0] * t0[0] - v[1] * t0[1]; o[1] = v[0] * t0[1] + v[1] * t0[0];
    o[2] = v[2] * t0[2] - v[3] * t0[3]; o[3] = v[2] * t0[3] + v[3] * t0[2];
    o[4] = v[4] * t1[0] - v[5] * t1[1]; o[5] = v[4] * t1[1] + v[5] * t1[0];
    o[6] = v[6] * t1[2] - v[7] * t1[3]; o[7] = v[6] * t1[3] + v[7] * t1[2];
#pragma unroll
    for (int i = 0; i < 8; ++i) v[i] = o[i];
}

#include <hip/hip_bf16.h>
#include <cmath>
namespace attn_body {
using bf16=__hip_bfloat16;
using bf16x8=__attribute__((ext_vector_type(8)))short;
using s16x4=__attribute__((ext_vector_type(4)))short;
using f32x16=__attribute__((ext_vector_type(16)))float;
using u32x4=__attribute__((ext_vector_type(4)))unsigned;
constexpr int D=64;
constexpr int NW=8,QBLK=32,QB=QBLK*NW,KVBLK=64;
constexpr int ATTN_UNIT_ROWS=QB;
__device__ __forceinline__ int crow(int r,int hi){return (r&3)+8*(r>>2)+4*hi;}
#define SBAR() __builtin_amdgcn_sched_barrier(0)
__device__ __forceinline__ void cmask(f32x16&p0,f32x16&p1,int jb,int qrel,int hi){
  const float NEG=-INFINITY; int kb=64*jb+4*hi;
  #pragma unroll
  for(int r=0;r<16;++r){int kv=kb+(r&3)+8*(r>>2); if(kv>qrel)p0[r]=NEG; if(kv+32>qrel)p1[r]=NEG;}
}

constexpr int NSLOT=3, SLOTB=8192;
constexpr int LDS_K=0, LDS_V=NSLOT*SLOTB, LDS_WS=2*NSLOT*SLOTB, LDS_OST=LDS_WS+NW*64*4, LDS_BYTES=LDS_OST+NW*4096;
constexpr float C2=0.125f*1.4426950408889634f;
__device__ __forceinline__ void glds16(const void*gsrc,unsigned lds_dst){unsigned keep;
  asm volatile("s_mov_b32 %0, m0\n\ts_mov_b32 m0, %2\n\ts_nop 0\n\tglobal_load_lds_dwordx4 %1, off\n\ts_mov_b32 m0, %0":"=&s"(keep):"v"(gsrc),"s"(lds_dst):"memory");}
__device__ __forceinline__ float max3f(float a,float b,float c){float r;asm("v_max3_f32 %0, %1, %2, %3":"=v"(r):"v"(a),"v"(b),"v"(c));return r;}
__device__ __forceinline__ float max2f(float a,float b){float r;asm("v_max_f32_e32 %0, %1, %2":"=v"(r):"v"(a),"v"(b));return r;}
__device__ __forceinline__ float fadd_s(float a,float b){float r;asm("v_add_f32_e32 %0, %1, %2":"=v"(r):"v"(a),"v"(b));return r;}
__device__ __forceinline__ float fsub_s(float a,float b){float r;asm("v_sub_f32_e32 %0, %1, %2":"=v"(r):"v"(a),"v"(b));return r;}
typedef float f32x2_t __attribute__((ext_vector_type(2))); typedef __bf16 bf16x2_t __attribute__((ext_vector_type(2)));
__device__ __forceinline__ unsigned cvtpk_s(float lo,float hi){f32x2_t v={lo,hi};bf16x2_t b=__builtin_convertvector(v,bf16x2_t);return __builtin_bit_cast(unsigned,b);}
#define WAIT_BAR(N) asm volatile("s_waitcnt vmcnt(" #N ") lgkmcnt(0)\n\ts_barrier":::"memory")

__device__ __forceinline__ void qkt(f32x16&p0,f32x16&p1,const char*Kslot,const bf16x8*qr,const f32x16&negm,int r32,int hi){
  const char*kb=Kslot+hi*1024+r32*16;
  #pragma unroll
  for(int d0=0;d0<4;++d0){
    const bf16x8 b0=*reinterpret_cast<const bf16x8*>(kb+d0*2048);
    const bf16x8 b1=*reinterpret_cast<const bf16x8*>(kb+d0*2048+512);
    if(d0==0){p0=__builtin_amdgcn_mfma_f32_32x32x16_bf16(b0,qr[0],negm,0,0,0);p1=__builtin_amdgcn_mfma_f32_32x32x16_bf16(b1,qr[0],negm,0,0,0);}
    else{p0=__builtin_amdgcn_mfma_f32_32x32x16_bf16(b0,qr[d0],p0,0,0,0);p1=__builtin_amdgcn_mfma_f32_32x32x16_bf16(b1,qr[d0],p1,0,0,0);}}
}
typedef __attribute__((address_space(3))) const char* lds_cptr;
typedef short v4i16_t __attribute__((ext_vector_type(4)));
__device__ __forceinline__ void kload8(bf16x8*kf,lds_cptr kp){
  kf[0]=*(const __attribute__((address_space(3))) bf16x8*)(kp);      kf[1]=*(const __attribute__((address_space(3))) bf16x8*)(kp+512);
  kf[2]=*(const __attribute__((address_space(3))) bf16x8*)(kp+2048); kf[3]=*(const __attribute__((address_space(3))) bf16x8*)(kp+2560);
  kf[4]=*(const __attribute__((address_space(3))) bf16x8*)(kp+4096); kf[5]=*(const __attribute__((address_space(3))) bf16x8*)(kp+4608);
  kf[6]=*(const __attribute__((address_space(3))) bf16x8*)(kp+6144); kf[7]=*(const __attribute__((address_space(3))) bf16x8*)(kp+6656);
}
__device__ __forceinline__ void kload2(bf16x8*kf,lds_cptr kp,int j){ kf[2*j]=*(const __attribute__((address_space(3))) bf16x8*)(kp+j*2048); kf[2*j+1]=*(const __attribute__((address_space(3))) bf16x8*)(kp+j*2048+512); }
__device__ __forceinline__ s16x4 vtr(lds_cptr p){ return __builtin_bit_cast(s16x4,__builtin_amdgcn_ds_read_tr16_b64_v4i16((__attribute__((address_space(3))) v4i16_t*)p)); }
__device__ __forceinline__ float rowmax(const f32x16&p0,const f32x16&p1){
  float a=max3f(p0[0],p0[1],p1[0]),b=max3f(p0[2],p0[3],p1[1]);a=max3f(a,p1[2],p1[3]);
  #pragma unroll
  for(int r=4;r<16;r+=4){a=max3f(a,p0[r],p0[r+1]);b=max3f(b,p0[r+2],p0[r+3]);a=max3f(a,p1[r],p1[r+1]);b=max3f(b,p1[r+2],p1[r+3]);}
  const float m=max2f(a,b);
  auto rr=__builtin_amdgcn_permlane32_swap(__float_as_uint(m),__float_as_uint(m),false,false);
  return max2f(__uint_as_float(rr[0]),__uint_as_float(rr[1]));
}
__device__ __forceinline__ void pv(f32x16*o,int vb,bf16x8 pa0,bf16x8 pa1,bf16x8 pa2,bf16x8 pa3){
  #pragma unroll
  for(int d0=0;d0<2;++d0){s16x4 lo[4],hi[4];
    #pragma unroll
    for(int ks=0;ks<4;++ks){
      asm volatile("ds_read_b64_tr_b16 %0,%1 offset:%c2":"=&v"(lo[ks]):"v"(vb),"i"(d0*4096+ks*1024):"memory");
      asm volatile("ds_read_b64_tr_b16 %0,%1 offset:%c2":"=&v"(hi[ks]):"v"(vb),"i"(d0*4096+ks*1024+512):"memory");}
    asm volatile("s_waitcnt lgkmcnt(0)":::"memory");SBAR();
    #define PK(k) (bf16x8){lo[k][0],lo[k][1],lo[k][2],lo[k][3],hi[k][0],hi[k][1],hi[k][2],hi[k][3]}
    o[d0]=__builtin_amdgcn_mfma_f32_32x32x16_bf16(pa0,PK(0),o[d0],0,0,0);
    o[d0]=__builtin_amdgcn_mfma_f32_32x32x16_bf16(pa1,PK(1),o[d0],0,0,0);
    o[d0]=__builtin_amdgcn_mfma_f32_32x32x16_bf16(pa2,PK(2),o[d0],0,0,0);
    o[d0]=__builtin_amdgcn_mfma_f32_32x32x16_bf16(pa3,PK(3),o[d0],0,0,0);
    #undef PK
  }
}

#ifndef ATTN_STORE16
#define ATTN_STORE16(p,v) (*(u32x4*)(p)=(v))
#endif
template<int THRL> __device__ __forceinline__ void attn_unit(const bf16*Qw0,int pqs,const bf16*__restrict__ Kh,int pks,const bf16*__restrict__ Vh,int pvs,bf16*Ow0,int pos_,const int NT,char*shm,const float*qgain,const float*rtab,const int qt0){
  int tid_l=threadIdx.x; asm volatile("":"+v"(tid_l)); const int tid=tid_l,lane=tid&63,r32=lane&31,hi=lane>>5; const int wid=__builtin_amdgcn_readfirstlane(tid>>6);
  const bf16*Qw=Qw0+(long)(wid*QBLK)*pqs;
  const unsigned lds0=(unsigned)(uintptr_t)shm;
  float*wsf=(float*)(shm+LDS_WS)+wid*64;
  const bf16*ksrc=Kh+(long)lane*pks+wid*8;
  const bf16*vsrc=Vh+(long)(16*(wid&3)+(lane>>2))*pvs+(wid>>2)*32+(lane&3)*8;
  const unsigned kdst=lds0+LDS_K+wid*1024, vdst=lds0+LDS_V+wid*1024;
  #define DMA_K(t,slot) glds16(ksrc+(long)(t)*KVBLK*pks,(unsigned)__builtin_amdgcn_readfirstlane(kdst+(slot)))
  #define DMA_V(t,slot) glds16(vsrc+(long)(t)*KVBLK*pvs,(unsigned)__builtin_amdgcn_readfirstlane(vdst+(slot)))
  const int vb0=(int)(lds0+LDS_V)+((lane>>4)&1)*32+(lane&3)*8+(4*hi+((lane&15)>>2))*64;
  const char*Kbase=shm+LDS_K; bf16x8 kf[8];
  const lds_cptr shm3=(lds_cptr)shm; const lds_cptr kp0=shm3+LDS_K+hi*1024+r32*16; const lds_cptr vp0=shm3+LDS_V+((lane>>4)&1)*32+(lane&3)*8+(4*hi+((lane&15)>>2))*64;
  DMA_K(0,0);DMA_V(0,0);DMA_K(1,SLOTB);
  bf16x8 qr[4];
  #pragma unroll
  for(int d0=0;d0<4;++d0)qr[d0]=*reinterpret_cast<const bf16x8*>(&Qw[(long)r32*pqs+d0*16+hi*8]);
  if(qgain){
    float f[4][8]; float ss=0.f;
    #pragma unroll
    for(int d0=0;d0<4;++d0){
      #pragma unroll
      for(int i=0;i<8;++i){ f[d0][i]=__builtin_bit_cast(float,((unsigned)(unsigned short)qr[d0][i])<<16); ss+=f[d0][i]*f[d0][i]; } }
    { auto rr=__builtin_amdgcn_permlane32_swap(__float_as_uint(ss),__float_as_uint(ss),false,false); ss=__uint_as_float(rr[0])+__uint_as_float(rr[1]); }
    const float rstd=1.0f/sqrtf(ss*(1.f/64.f)+1e-6f);
    #pragma unroll
    for(int d0=0;d0<4;++d0){ const int dd=d0*16+hi*8;
      #pragma unroll
      for(int i=0;i<8;++i) f[d0][i]*=rstd*qgain[dd+i];
      if(qt0>=0) rope8(f[d0],rtab,dd,qt0+wid*QBLK+r32);
      u32x4 w; w.x=pk2(f[d0][0]*C2,f[d0][1]*C2); w.y=pk2(f[d0][2]*C2,f[d0][3]*C2); w.z=pk2(f[d0][4]*C2,f[d0][5]*C2); w.w=pk2(f[d0][6]*C2,f[d0][7]*C2);
      qr[d0]=__builtin_bit_cast(bf16x8,w); }
  }
  float mhat=0.f,l_reg=0.f;f32x16 o[2];o[0]=f32x16{};o[1]=f32x16{};f32x16 negm=f32x16{};asm volatile("":"+v"(negm));
  #define CMASK(P0,P1,t) do{}while(0)
  bool resc=false;
  #define START(P0,P1) do{ const float rm=rowmax(P0,P1); resc=false; \
    { const float dl=rm; mhat=fadd_s(mhat,dl); \
      _Pragma("unroll") for(int r=0;r<16;++r){P0[r]=fsub_s(P0[r],dl);P1[r]=fsub_s(P1[r],dl);} \
      _Pragma("unroll") for(int r=0;r<16;++r)negm[r]=-mhat; asm volatile("":"+v"(negm)); } \
    _Pragma("unroll") for(int r=0;r<16;++r)P0[r]=__builtin_amdgcn_exp2f(P0[r]); }while(0)
  #define RESC() do{ if(resc){ asm volatile("s_waitcnt lgkmcnt(0)":::"memory"); \
      _Pragma("unroll") for(int d_=0;d_<2;++d_) _Pragma("unroll") for(int r=0;r<16;++r)o[d_][r]*=wsf[crow(r,hi)]; } }while(0)
  f32x16 pA0,pA1,pB0,pB1;
  int sl_prev=0,sl_cur=0,sl_next=SLOTB;
  #define ROT() do{sl_prev=sl_cur;sl_cur=sl_next;sl_next=(sl_next==(NSLOT-1)*SLOTB)?0:sl_next+SLOTB;}while(0)
  DMA_K(2,2*SLOTB);
  WAIT_BAR(3);
  qkt(pA0,pA1,Kbase,qr,negm,r32,hi);asm volatile("s_nop 15\n\ts_nop 7":"+v"(pA0),"+v"(pA1));CMASK(pA0,pA1,0);
  START(pA0,pA1);
  _Pragma("unroll") for(int r=0;r<16;++r)pA1[r]=__builtin_amdgcn_exp2f(pA1[r]);
  WAIT_BAR(0);
  DMA_K(3,0);DMA_V(1,SLOTB);
  ROT();
  kload8(kf,kp0+sl_cur);
  WAIT_BAR(2);
  s16x4 vlo[8],vhi[8]; u32x4 pw0,pw1,pw2,pw3;
  #define PKW(P,B) cvtpk_s(P[B],P[B+1])
  #define PAF(k) __builtin_bit_cast(bf16x8,pw##k)
  #define VFR(i) (bf16x8){vlo[i][0],vlo[i][1],vlo[i][2],vlo[i][3],vhi[i][0],vhi[i][1],vhi[i][2],vhi[i][3]}
  #define PIN(x) asm volatile("":"+v"(x))
  #define MX3(a,b,c) __builtin_fmaxf(__builtin_fmaxf((a),(b)),(c))
  #define GAPA(MF,A0,A1,A2,A3,W0,W1,PW) do{ MF; sacc+=A0; sacc+=A1; sacc+=A2; sacc+=A3; PIN(sacc); W0; W1; PIN(PW); SBAR(); }while(0)
  #define EX(v) __builtin_amdgcn_exp2f(v)
  #define GAPB(MF,X,B) do{ MF; X[B]=EX(X[B]); X[B+1]=EX(X[B+1]); X[B+2]=EX(X[B+2]); X[B+3]=EX(X[B+3]); PIN(X); SBAR(); }while(0)
  #define VRD(i) do{ vlo[i]=vtr(vp_+(((i)>>2)*4096+((i)&3)*1024)); vhi[i]=vtr(vp_+(((i)>>2)*4096+((i)&3)*1024+512)); }while(0)
  #define KRD(G,j) do{ if(G){ kload2(kf,kp0+sl_next,j); SBAR(); } }while(0)
  #define STEP(C0,C1,P0,P1,t,GK,GV,GL) do{ SBAR(); \
    const lds_cptr vp_=vp0+sl_prev; \
    VRD(0); SBAR(); float sacc=(P0[0]+P0[1]); \
    GAPA(C0=__builtin_amdgcn_mfma_f32_32x32x16_bf16(kf[0],qr[0],negm,0,0,0), P0[2],P0[3],P0[4],P0[5],     pw0[0]=PKW(P0,0), pw0[1]=PKW(P0,2), pw0); \
    VRD(4); SBAR(); GAPA(C1=__builtin_amdgcn_mfma_f32_32x32x16_bf16(kf[1],qr[0],negm,0,0,0), P0[6],P0[7],P0[8],P0[9],     pw0[2]=PKW(P0,4), pw0[3]=PKW(P0,6), pw0); \
    VRD(1); SBAR(); GAPA(C0=__builtin_amdgcn_mfma_f32_32x32x16_bf16(kf[2],qr[1],C0,0,0,0),   P0[10],P0[11],P0[12],P0[13], pw1[0]=PKW(P0,8), pw1[1]=PKW(P0,10), pw1); \
    VRD(5); SBAR(); GAPA(C1=__builtin_amdgcn_mfma_f32_32x32x16_bf16(kf[3],qr[1],C1,0,0,0),   P0[14],P0[15],P1[0],P1[1],   pw1[2]=PKW(P0,12),pw1[3]=PKW(P0,14), pw1); \
    VRD(2); SBAR(); GAPA(C0=__builtin_amdgcn_mfma_f32_32x32x16_bf16(kf[4],qr[2],C0,0,0,0),   P1[2],P1[3],P1[4],P1[5],     pw2[0]=PKW(P1,0), pw2[1]=PKW(P1,2), pw2); \
    VRD(6); SBAR(); GAPA(C1=__builtin_amdgcn_mfma_f32_32x32x16_bf16(kf[5],qr[2],C1,0,0,0),   P1[6],P1[7],P1[8],P1[9],     pw2[2]=PKW(P1,4), pw2[3]=PKW(P1,6), pw2); \
    VRD(3); SBAR(); GAPA(C0=__builtin_amdgcn_mfma_f32_32x32x16_bf16(kf[6],qr[3],C0,0,0,0),   P1[10],P1[11],P1[12],P1[13], pw3[0]=PKW(P1,8), pw3[1]=PKW(P1,10), pw3); \
    VRD(7); SBAR(); GAPA(C1=__builtin_amdgcn_mfma_f32_32x32x16_bf16(kf[7],qr[3],C1,0,0,0),   P1[14],P1[15],0.f,0.f,       pw3[2]=PKW(P1,12),pw3[3]=PKW(P1,14), pw3); \
    l_reg+=sacc; \
    if(GK){DMA_K((t)+3,sl_cur);} if(GV){DMA_V((t)+1,sl_next);} \
    CMASK(C0,C1,t); \
    { float a=MX3(C0[0],C0[1],C1[0]),b=MX3(C0[2],C0[3],C1[1]); a=MX3(a,C1[2],C1[3]); \
      _Pragma("unroll") for(int r=4;r<16;r+=4){a=MX3(a,C0[r],C0[r+1]);b=MX3(b,C0[r+2],C0[r+3]);a=MX3(a,C1[r],C1[r+1]);b=MX3(b,C1[r+2],C1[r+3]);} \
      float rm=__builtin_fmaxf(a,b); { auto rr=__builtin_amdgcn_permlane32_swap(__float_as_uint(rm),__float_as_uint(rm),false,false); rm=__builtin_fmaxf(__uint_as_float(rr[0]),__uint_as_float(rr[1])); } \
      resc=false; \
      if(__builtin_expect(__any(rm>(float)THRL),0)){ const float dl=__builtin_fmaxf(rm,0.f); mhat+=dl; \
        _Pragma("unroll") for(int r=0;r<16;++r){C0[r]-=dl;C1[r]-=dl;} \
        _Pragma("unroll") for(int r=0;r<16;++r)negm[r]=-mhat; asm volatile("":"+v"(negm)); \
        const float f=__builtin_amdgcn_exp2f(-dl); l_reg*=f; if(hi==0)wsf[r32]=f; resc=true; } } \
    SBAR(); \
    GAPB(o[0]=__builtin_amdgcn_mfma_f32_32x32x16_bf16(PAF(0),VFR(0),o[0],0,0,0), C0,0); \
    GAPB(o[1]=__builtin_amdgcn_mfma_f32_32x32x16_bf16(PAF(0),VFR(4),o[1],0,0,0), C0,4); \
    KRD(GL,0); GAPB(o[0]=__builtin_amdgcn_mfma_f32_32x32x16_bf16(PAF(1),VFR(1),o[0],0,0,0), C0,8); \
    KRD(GL,1); GAPB(o[1]=__builtin_amdgcn_mfma_f32_32x32x16_bf16(PAF(1),VFR(5),o[1],0,0,0), C0,12); \
    KRD(GL,2); GAPB(o[0]=__builtin_amdgcn_mfma_f32_32x32x16_bf16(PAF(2),VFR(2),o[0],0,0,0), C1,0); \
    KRD(GL,3); GAPB(o[1]=__builtin_amdgcn_mfma_f32_32x32x16_bf16(PAF(2),VFR(6),o[1],0,0,0), C1,4); \
    GAPB(o[0]=__builtin_amdgcn_mfma_f32_32x32x16_bf16(PAF(3),VFR(3),o[0],0,0,0), C1,8); \
    GAPB(o[1]=__builtin_amdgcn_mfma_f32_32x32x16_bf16(PAF(3),VFR(7),o[1],0,0,0), C1,12); \
    }while(0)
  int t=1;
  #undef CMASK
  #define CMASK(P0,P1,t) do{}while(0)
  for(;t+5<NT;t+=2){
    STEP(pB0,pB1,pA0,pA1,t,true,true,true);     WAIT_BAR(2); RESC(); ROT();
    STEP(pA0,pA1,pB0,pB1,t+1,true,true,true);   WAIT_BAR(2); RESC(); ROT();
  }
  #undef CMASK
  #define CMASK(P0,P1,t) do{}while(0)
  #define ENDW(tt) do{ if((tt)+3<NT){WAIT_BAR(2);} else if((tt)+2<NT){WAIT_BAR(1);} else {WAIT_BAR(0);} }while(0)
  for(;t+1<NT;t+=2){
    STEP(pB0,pB1,pA0,pA1,t,(t+3<NT),(t+1<NT),(t+1<NT));       ENDW(t);   RESC(); ROT();
    STEP(pA0,pA1,pB0,pB1,t+1,(t+4<NT),(t+2<NT),(t+2<NT));     ENDW(t+1); RESC(); ROT();
  }
  STEP(pB0,pB1,pA0,pA1,NT-1,false,false,false); RESC();
  { float sacc=pB0[0]+pB0[1]; _Pragma("unroll") for(int r=2;r<16;++r)sacc+=pB0[r]; _Pragma("unroll") for(int r=0;r<16;++r)sacc+=pB1[r]; l_reg+=sacc;
    pw0=(u32x4){PKW(pB0,0),PKW(pB0,2),PKW(pB0,4),PKW(pB0,6)};pw1=(u32x4){PKW(pB0,8),PKW(pB0,10),PKW(pB0,12),PKW(pB0,14)};pw2=(u32x4){PKW(pB1,0),PKW(pB1,2),PKW(pB1,4),PKW(pB1,6)};pw3=(u32x4){PKW(pB1,8),PKW(pB1,10),PKW(pB1,12),PKW(pB1,14)};
    SBAR(); pv(o,vb0+sl_cur,PAF(0),PAF(1),PAF(2),PAF(3)); }
  #undef PKW
  #undef PAF
  #undef VFR
  #undef PIN
  #undef MX3
  #undef GAPA
  #undef GAPB
  #undef EX
  #undef VRD
  #undef KRD
  #undef STEP
  #undef ENDW
  {auto rr=__builtin_amdgcn_permlane32_swap(__float_as_uint(l_reg),__float_as_uint(l_reg),false,false);l_reg=__uint_as_float(rr[0])+__uint_as_float(rr[1]);}
  if(hi==0)wsf[32+r32]=l_reg;asm volatile("s_waitcnt lgkmcnt(0)":::"memory");
  float rli[16];
  #pragma unroll
  for(int r=0;r<16;++r)rli[r]=__builtin_amdgcn_rcpf(wsf[32+crow(r,hi)]);
  bf16*Ow=Ow0+(long)(wid*QBLK)*pos_;
  { bf16*stg=(bf16*)(shm+LDS_OST)+wid*2048;
    #pragma unroll
    for(int r=0;r<16;++r){const int orow=crow(r,hi);
      #pragma unroll
      for(int d0=0;d0<2;++d0)stg[orow*64+d0*32+r32]=__float2bfloat16(o[d0][r]*rli[r]);}
    asm volatile("s_waitcnt lgkmcnt(0)":::"memory");
    #pragma unroll
    for(int i=0;i<4;++i){const int row=i*8+(lane>>3),ch=lane&7; const u32x4 v=*(const u32x4*)(stg+row*64+ch*8); ATTN_STORE16(Ow+(long)row*pos_+ch*8,v);} }
  asm volatile("s_waitcnt lgkmcnt(0)\n\ts_barrier":::"memory");
  #undef DMA_K
  #undef DMA_V
  #undef CMASK
  #undef START
  #undef RESC
  #undef ROT
}
constexpr int ATTN_LDS_BYTES=LDS_BYTES;
#undef SBAR
#undef WAIT_BAR
}
struct Args { const float* in[26]; float* out; unsigned char* ws; };

template <int ACT  > struct EpiAct {
    static constexpr bool PERM = true, AFTER_DRAIN = false;
    bf16_t* O; int ldc;
    __device__ __forceinline__ void operator()(const pg8::f32x4 (&acc)[2][2][4][2], const pg8::Unit& u, int wr, int wc, int fr, int fq) const {
        const int row0 = u.pm * 256 + wr * 64 + fr, col0 = u.pn * 256 + wc * 32 + 8 * fq;
#pragma unroll
        for (int ai = 0; ai < 2; ++ai)
#pragma unroll
            for (int m = 0; m < 4; ++m) { bf16_t* rowp = O + (size_t)(row0 + ai * 128 + m * 16) * ldc + col0;
#pragma unroll
                for (int bj = 0; bj < 2; ++bj) { float v[8];
#pragma unroll
                    for (int i = 0; i < 4; ++i) { v[i] = acc[ai][bj][m][0][i]; v[4 + i] = acc[ai][bj][m][1][i]; }
#pragma unroll
                    for (int i = 0; i < 8; ++i) {
                        if (ACT == 1) v[i] = 1.f / (1.f + __expf(-v[i]));
                        if (ACT == 2) { const float r = fmaxf(v[i], 0.f); v[i] = r * r; } }
                    pg8::u32x4 w; w.x = pk2(v[0], v[1]); w.y = pk2(v[2], v[3]); w.z = pk2(v[4], v[5]); w.w = pk2(v[6], v[7]);
                    *(pg8::u32x4*)(rowp + bj * 128) = w; } }
    }
};
struct EpiF32 {
    static constexpr bool PERM = true, AFTER_DRAIN = false;
    float* O; int ldc;
    __device__ __forceinline__ void operator()(const pg8::f32x4 (&acc)[2][2][4][2], const pg8::Unit& u, int wr, int wc, int fr, int fq) const {
        const int row0 = u.pm * 256 + wr * 64 + fr, col0 = u.pn * 256 + wc * 32 + 8 * fq;
#pragma unroll
        for (int ai = 0; ai < 2; ++ai)
#pragma unroll
            for (int m = 0; m < 4; ++m) { float* rowp = O + (size_t)(row0 + ai * 128 + m * 16) * ldc + col0;
#pragma unroll
                for (int bj = 0; bj < 2; ++bj) { *(pg8::f32x4*)(rowp + bj * 128) = acc[ai][bj][m][0]; *(pg8::f32x4*)(rowp + bj * 128 + 4) = acc[ai][bj][m][1]; } }
    }
};
struct EpiBranch {
    static constexpr bool PERM = true, AFTER_DRAIN = false;
    bf16_t* GO; float* ACC; int mode;
    __device__ __forceinline__ void operator()(const pg8::f32x4 (&acc)[2][2][4][2], const pg8::Unit& u, int wr, int wc, int fr, int fq) const {
        const int row0 = u.pm * 256 + wr * 64 + fr, col0 = u.pn * 256 + wc * 32 + 8 * fq;
#pragma unroll
        for (int ai = 0; ai < 2; ++ai)
#pragma unroll
            for (int m = 0; m < 4; ++m) { const size_t ro = (size_t)(row0 + ai * 128 + m * 16) * 1024 + col0;
#pragma unroll
                for (int bj = 0; bj < 2; ++bj) { const size_t idx = ro + bj * 128;
                    const pg8::u32x4 g = *(const pg8::u32x4*)(GO + idx);
                    pg8::f32x4 v0 = acc[ai][bj][m][0], v1 = acc[ai][bj][m][1];
                    v0[0] *= bflo(g.x); v0[1] *= bfhi(g.x); v0[2] *= bflo(g.y); v0[3] *= bfhi(g.y);
                    v1[0] *= bflo(g.z); v1[1] *= bfhi(g.z); v1[2] *= bflo(g.w); v1[3] *= bfhi(g.w);
                    if (mode > 0) { v0 += *(const pg8::f32x4*)(ACC + idx); v1 += *(const pg8::f32x4*)(ACC + idx + 4); }
                    if (mode < 2) { *(pg8::f32x4*)(ACC + idx) = v0; *(pg8::f32x4*)(ACC + idx + 4) = v1; }
                    else { pg8::u32x4 w; w.x = pk2(v0[0], v0[1]); w.y = pk2(v0[2], v0[3]); w.z = pk2(v1[0], v1[1]); w.w = pk2(v1[2], v1[3]); *(pg8::u32x4*)(GO + idx) = w; } } }
    }
};
struct EpiIn {
    static constexpr bool PERM = true, AFTER_DRAIN = false;
    unsigned char* ws;
    __device__ __forceinline__ void operator()(const pg8::f32x4 (&acc)[2][2][4][2], const pg8::Unit& u, int wr, int wc, int fr, int fq) const {
        const bool latent = u.pm < (ML / 256);
        const int cw = wc * 32 + 8 * fq;
        bf16_t* const poolin = (bf16_t*)(ws + WS_POOLIN); bf16_t* const qd = (bf16_t*)(ws + WS_QD); bf16_t* const qg = (bf16_t*)(ws + WS_QG); bf16_t* const kd = (bf16_t*)(ws + WS_KD);
        bf16_t* const vd = (bf16_t*)(ws + WS_VD); bf16_t* const kg = (bf16_t*)(ws + WS_KG); bf16_t* const vg = (bf16_t*)(ws + WS_VG); const float* const rope = (const float*)(ws + WS_ROPE);
#pragma unroll
        for (int bj = 0; bj < 2; ++bj) {
            const int cb = u.pn * 2 + bj;
            bf16_t* base; int pitch, coff; bool kvmap = false, dorope = false; float sc = 1.f;
            if (cb < 4) { base = poolin; pitch = 512; coff = cb * 128; }
            else if (cb < 8) { base = qd; pitch = 512; coff = (cb - 4) * 128; dorope = latent; sc = QC2; }
            else if (cb < 12) { base = qg; pitch = 512; coff = (cb - 8) * 128; }
            else if (cb < 16) { base = kd; pitch = 512; coff = (cb - 12) * 128; kvmap = true; dorope = latent; }
            else if (cb < 20) { base = vd; pitch = 512; coff = (cb - 16) * 128; kvmap = true; }
            else if (cb == 20) { base = kg; pitch = 128; coff = 0; kvmap = true; }
            else { base = vg; pitch = 128; coff = 0; kvmap = true; }
#pragma unroll
            for (int ai = 0; ai < 2; ++ai)
#pragma unroll
                for (int m = 0; m < 4; ++m) {
                    const int row = u.pm * 256 + ai * 128 + wr * 64 + m * 16 + fr;
                    const int drow = kvmap ? kvrow_of(row) : row;
                    float v[8];
#pragma unroll
                    for (int i = 0; i < 4; ++i) { v[i] = acc[ai][bj][m][0][i]; v[4 + i] = acc[ai][bj][m][1][i]; }
                    if (dorope) rope8(v, rope, cw & 63, row & 4095);
#pragma unroll
                    for (int i = 0; i < 8; ++i) v[i] *= sc;
                    pg8::u32x4 w; w.x = pk2(v[0], v[1]); w.y = pk2(v[2], v[3]); w.z = pk2(v[4], v[5]); w.w = pk2(v[6], v[7]);
                    *(pg8::u32x4*)(base + (size_t)drow * pitch + coff + cw) = w;
                }
        }
    }
};
struct SchedG {
    pg8::StaticOrder so; const char* A; const char* Bt; int ld, nt;
    __device__ __forceinline__ void init(const void* A_, const void* Bt_, int M, int N, int K, int G, int c) { so.init(M, N, G, c); A = (const char*)A_; Bt = (const char*)Bt_; ld = K * 2; nt = K / 64; }
    __device__ __forceinline__ bool next(int i, pg8::Unit& u) const { if (!so.next(i, u)) return false;
        u.A = A + (size_t)u.pm * 256 * ld; u.B = Bt + (size_t)u.pn * 256 * ld; u.lda = ld; u.ldb = ld; u.nt = nt; u.seg = 0; return true; }
    __device__ __forceinline__ void a_ready(const pg8::Unit&) const {}
    __device__ __forceinline__ void done(const pg8::Unit&) const {}
};
struct SchedP4 {
    pg8::StaticOrder so; const char* ws;
    __device__ __forceinline__ void init(const unsigned char* ws_, int M, int G, int c) { so.init(M, 1024, G, c); ws = (const char*)ws_; }
    __device__ __forceinline__ bool next(int i, pg8::Unit& u) const { const int job = i / 6, seg = i - job * 6, b = seg >> 1; if (!so.next(job, u)) return false;
        if ((seg & 1) == 0) { u.A = ws + WS_H + (size_t)u.pm * 256 * 2048; u.lda = 2048; u.B = ws + W_IN + (size_t)(N1 + b * 1024 + u.pn * 256) * 2048; u.ldb = 2048; u.nt = 16; }
        else { const size_t ao = b == 0 ? WS_POOLO : b == 1 ? WS_DIFFO : WS_GQAO, bo = b == 0 ? W_PO : b == 1 ? W_DO : W_GO;
            u.A = ws + ao + (size_t)u.pm * 256 * 1024; u.lda = 1024; u.B = ws + bo + (size_t)u.pn * 256 * 1024; u.ldb = 1024; u.nt = 8; }
        u.seg = seg; return true; }
    __device__ __forceinline__ void a_ready(const pg8::Unit&) const {}
    __device__ __forceinline__ void done(const pg8::Unit&) const {}
};
constexpr size_t WS_ZP = 244 * MiB;
struct SchedP8C {
    pg8::StaticOrder so; const char* ws; int G, c;
    __device__ __forceinline__ void init(const unsigned char* ws_, int G_, int c_) { so.init(ML, 1024, G_, c_); ws = (const char*)ws_; G = G_; c = c_; }
    __device__ __forceinline__ bool next(int i, pg8::Unit& u) const { const long L = (long)i * G + c;
        if (L < 256) { so.next(i, u); u.A = ws + WS_U + (size_t)u.pm * 256 * 8192; u.B = ws + W_2 + (size_t)u.pn * 256 * 8192; u.lda = 8192; u.ldb = 8192; u.nt = 64; u.seg = 0; return true; }
        if (L < 320) { const int p = (int)L - 256, kc = p & 3; u.pn = (p >> 2) & 3; u.pm = ML / 256 + (p >> 4);
            u.A = ws + WS_U + (size_t)u.pm * 256 * 8192 + kc * 2048; u.B = ws + W_2 + (size_t)u.pn * 256 * 8192 + kc * 2048; u.lda = 8192; u.ldb = 8192; u.nt = 16; u.seg = 1 + kc; return true; }
        return false; }
    __device__ __forceinline__ void a_ready(const pg8::Unit&) const {}
    __device__ __forceinline__ void done(const pg8::Unit&) const {}
};
struct EpiP4 {
    static constexpr bool PERM = true, AFTER_DRAIN = false;
    bf16_t* GO; float* ACC;
    __device__ __forceinline__ void operator()(const pg8::f32x4 (&acc)[2][2][4][2], const pg8::Unit& u, int wr, int wc, int fr, int fq) const {
        if ((u.seg & 1) == 0) { EpiAct<1> e{GO, 1024}; e(acc, u, wr, wc, fr, fq); }
        else { EpiBranch e{GO, ACC, u.seg >> 1}; e(acc, u, wr, wc, fr, fq); }
    }
};
struct EpiP8 {
    static constexpr bool PERM = true, AFTER_DRAIN = false;
    float* Z; float* ZP;
    __device__ __forceinline__ void operator()(const pg8::f32x4 (&acc)[2][2][4][2], const pg8::Unit& u, int wr, int wc, int fr, int fq) const {
        float* base = Z; pg8::Unit v = u;
        if (u.seg > 1) { base = ZP + (size_t)(u.seg - 2) * MC * 1024; v.pm = u.pm - ML / 256; }
        EpiF32 e{base, 1024}; e(acc, v, wr, wc, fr, fq);
    }
};
__device__ __forceinline__ void head_norm_fix(bf16_t* p, const float* gain, bool dorope, int t, float sc, const float* tab) {
    float ss = 0.f;
#pragma unroll
    for (int ch = 0; ch < 8; ++ch) { const v4u w = *(const v4u*)(p + ch * 8);
        const float a0 = bflo(w.x), a1 = bfhi(w.x), a2 = bflo(w.y), a3 = bfhi(w.y), a4 = bflo(w.z), a5 = bfhi(w.z), a6 = bflo(w.w), a7 = bfhi(w.w);
        ss += (a0 * a0 + a1 * a1) + (a2 * a2 + a3 * a3) + (a4 * a4 + a5 * a5) + (a6 * a6 + a7 * a7); }
    const float rstd = 1.0f / sqrtf(ss * (1.f / 64.f) + EPSN);
#pragma unroll
    for (int ch = 0; ch < 8; ++ch) { const v4u w = *(const v4u*)(p + ch * 8);
        float v[8] = {bflo(w.x), bfhi(w.x), bflo(w.y), bfhi(w.y), bflo(w.z), bfhi(w.z), bflo(w.w), bfhi(w.w)};
        const f32x4 g0 = *(const f32x4*)(gain + ch * 8), g1 = *(const f32x4*)(gain + ch * 8 + 4);
        v[0] *= rstd * g0[0]; v[1] *= rstd * g0[1]; v[2] *= rstd * g0[2]; v[3] *= rstd * g0[3];
        v[4] *= rstd * g1[0]; v[5] *= rstd * g1[1]; v[6] *= rstd * g1[2]; v[7] *= rstd * g1[3];
        if (dorope) rope8(v, tab, ch * 8, t);
        v4u o; o.x = pk2(v[0] * sc, v[1] * sc); o.y = pk2(v[2] * sc, v[3] * sc); o.z = pk2(v[4] * sc, v[5] * sc); o.w = pk2(v[6] * sc, v[7] * sc);
        *(v4u*)(p + ch * 8) = o; }
}

__device__ __forceinline__ void transpose_item(const float* W, int K, int N, bf16* WT, int k0, int n0, int drow0, LAS float* scr, int lane) {
#pragma unroll 8
    for (int i = 0; i < 32; ++i) { const int kk = 2 * i + (lane >> 5); scr[kk * 33 + (lane & 31)] = W[(size_t)(k0 + kk) * N + n0 + (lane & 31)]; }
    asm volatile("s_waitcnt lgkmcnt(0)" ::: "memory");
    const int c = lane & 7;
#pragma unroll
    for (int j = 0; j < 4; ++j) { const int n = (lane >> 3) + 8 * j; const LAS float* s = scr + (8 * c) * 33 + n;
        v4u o; o.x = pk2(s[0 * 33], s[1 * 33]); o.y = pk2(s[2 * 33], s[3 * 33]); o.z = pk2(s[4 * 33], s[5 * 33]); o.w = pk2(s[6 * 33], s[7 * 33]);
        *(v4u*)(WT + (size_t)(drow0 + n) * K + k0 + 8 * c) = o; }
    asm volatile("s_waitcnt lgkmcnt(0)" ::: "memory");
}
struct WPtrs { const float *w_in, *w_grp, *pscale, *w_po, *w_do, *w_go, *w_o, *w_1, *w_2; };
__device__ __forceinline__ void convert_weights(const WPtrs& p, int l, unsigned char* ws, LAS unsigned char* lds, int gw, int NGW, int wave, int lane, int gtid, int NTH) {
    LAS float* scr = (LAS float*)(lds + wave * 16384);
    constexpr int I_IN = (1024 / 64) * (5888 / 32), I_BR = (512 / 64) * (1024 / 32), I_O = (1024 / 64) * (1024 / 32), I_1 = (1024 / 64) * (4096 / 32), I_2 = (4096 / 64) * (1024 / 32);
    constexpr int NITEMS = I_IN + 3 * I_BR + I_O + I_1 + I_2;
    for (int it = gw; it < NITEMS; it += NGW) {
        int r = it;
        if (r < I_IN) { const int nblk = 5888 / 32, kb = r / nblk, nb = r % nblk, n0 = nb * 32;
            const int d0 = n0 < 1536 ? n0 : (n0 < 4608 ? n0 - 1536 + N1 : n0 - 4608 + 1536);
            transpose_item(p.w_in + (size_t)l * 1024 * 5888, 1024, 5888, (bf16*)(ws + W_IN), kb * 64, n0, d0, scr, lane); continue; } r -= I_IN;
        if (r < I_BR) { const int nblk = 1024 / 32, kb = r / nblk, nb = r % nblk;
            transpose_item(p.w_po + (size_t)l * 512 * 1024, 512, 1024, (bf16*)(ws + W_PO), kb * 64, nb * 32, nb * 32, scr, lane); continue; } r -= I_BR;
        if (r < I_BR) { const int nblk = 1024 / 32, kb = r / nblk, nb = r % nblk;
            transpose_item(p.w_do + (size_t)l * 512 * 1024, 512, 1024, (bf16*)(ws + W_DO), kb * 64, nb * 32, nb * 32, scr, lane); continue; } r -= I_BR;
        if (r < I_BR) { const int nblk = 1024 / 32, kb = r / nblk, nb = r % nblk;
            transpose_item(p.w_go + (size_t)l * 512 * 1024, 512, 1024, (bf16*)(ws + W_GO), kb * 64, nb * 32, nb * 32, scr, lane); continue; } r -= I_BR;
        if (r < I_O) { const int nblk = 1024 / 32, kb = r / nblk, nb = r % nblk;
            transpose_item(p.w_o + (size_t)l * 1024 * 1024, 1024, 1024, (bf16*)(ws + W_O), kb * 64, nb * 32, nb * 32, scr, lane); continue; } r -= I_O;
        if (r < I_1) { const int nblk = 4096 / 32, kb = r / nblk, nb = r % nblk;
            transpose_item(p.w_1 + (size_t)l * 1024 * 4096, 1024, 4096, (bf16*)(ws + W_1), kb * 64, nb * 32, nb * 32, scr, lane); continue; } r -= I_1;
        { const int nblk = 1024 / 32, kb = r / nblk, nb = r % nblk;
            transpose_item(p.w_2 + (size_t)l * 4096 * 1024, 4096, 1024, (bf16*)(ws + W_2), kb * 64, nb * 32, nb * 32, scr, lane); }
    }
    const float* wg = p.w_grp + (size_t)l * 4 * 128 * 128; const float* psc = p.pscale + l * 512;
    unsigned* PT = (unsigned*)(ws + W_POOL);
    for (int i = gtid; i < 512 * 256; i += NTH) { const int n = i >> 8, k = (i & 255) * 2, g = n >> 7; float v0 = 0.f, v1 = 0.f;
        if ((k >> 7) == g) { const float* q = wg + ((size_t)(g * 128 + (k & 127))) * 128 + (n & 127); const float s = psc[n]; v0 = q[0] * s; v1 = q[128] * s; }
        PT[i] = pk2(v0, v1); }
}
__device__ __forceinline__ void mod_gemv(const float* cvec, const float* cctx, const float* wmod, const float* bmod, float* modout, LAS unsigned char* lds, int tid, int lane, int wave, int bx) {
    LAS float* st = (LAS float*)lds;
    LAS float* red = (LAS float*)(lds + 32768);
    for (int i = tid; i < 5 * 1024; i += NTHR) { const int bb = i >> 10, k = i & 1023; const float v = bb < 4 ? cvec[bb * 1024 + k] : cctx[k]; st[i] = v / (1.f + expf(-v)); }
    __syncthreads();
    if (bx < 192) {
        const int l = bx / 96, n0 = (bx % 96) * 64;
        const float* w = wmod + (size_t)l * 1024 * NMOD + n0 + lane;
        float a0 = 0.f, a1 = 0.f, a2 = 0.f, a3 = 0.f, a4 = 0.f;
        const int k0 = wave * 128;
#pragma unroll 16
        for (int kk = 0; kk < 128; ++kk) { const float wv = w[(size_t)(k0 + kk) * NMOD]; const int k = k0 + kk;
            a0 += st[k] * wv; a1 += st[1024 + k] * wv; a2 += st[2048 + k] * wv; a3 += st[3072 + k] * wv; a4 += st[4096 + k] * wv; }
        red[(wave * 5 + 0) * 64 + lane] = a0; red[(wave * 5 + 1) * 64 + lane] = a1; red[(wave * 5 + 2) * 64 + lane] = a2; red[(wave * 5 + 3) * 64 + lane] = a3; red[(wave * 5 + 4) * 64 + lane] = a4;
        __syncthreads();
        if (tid < 320) { const int bb = tid >> 6; float s = bmod[l * NMOD + n0 + lane];
#pragma unroll
            for (int w8 = 0; w8 < 8; ++w8) s += red[(w8 * 5 + bb) * 64 + lane];
            modout[(l * 5 + bb) * NMOD + n0 + lane] = s; }
    }
    __syncthreads();
}
__device__ __forceinline__ void norm_phase(int M, const float* xs_lat, const float* xs_ctx, float* xd_lat, float* xd_ctx, const float* z, const float* zp, const float* modl, int gtc, const float* gpost,
                                           bf16* hdst, const float* gnext, const float* modn, int shc, int scc, int gw, int NGW, int lane) {
    for (int m = gw; m < M; m += NGW) {
        const bool lat = m < ML; const int bb = lat ? (m >> 12) : 4;
        const float* xs = lat ? xs_lat + (size_t)m * 1024 : xs_ctx + (size_t)(m - ML) * 1024;
        f32x4 v[4];
#pragma unroll
        for (int j = 0; j < 4; ++j) v[j] = *(const f32x4*)(xs + 4 * lane + 256 * j);
        float* xd = lat ? xd_lat + (size_t)m * 1024 : xd_ctx + (size_t)(m - ML) * 1024;
        if (!z) {
#pragma unroll
            for (int j = 0; j < 4; ++j) *(f32x4*)(xd + 4 * lane + 256 * j) = v[j];
        } else {
            f32x4 zz[4]; float ss = 0.f;
#pragma unroll
            for (int j = 0; j < 4; ++j) { zz[j] = *(const f32x4*)(z + (size_t)m * 1024 + 4 * lane + 256 * j);
                if (zp && !lat) {
#pragma unroll
                    for (int kc = 0; kc < 3; ++kc) zz[j] += *(const f32x4*)(zp + ((size_t)kc * MC + (m - ML)) * 1024 + 4 * lane + 256 * j); }
                ss += (zz[j][0] * zz[j][0] + zz[j][1] * zz[j][1]) + (zz[j][2] * zz[j][2] + zz[j][3] * zz[j][3]); }
            const float rz = 1.0f / sqrtf(wave_sum(ss) * (1.f / 1024.f) + EPSN);
            const float* gt = modl + bb * NMOD + gtc * 1024;
#pragma unroll
            for (int j = 0; j < 4; ++j) { const int c = 4 * lane + 256 * j; const f32x4 g4 = *(const f32x4*)(gpost + c), t4 = *(const f32x4*)(gt + c);
                v[j] = v[j] + t4 * ((zz[j] * rz) * g4); *(f32x4*)(xd + c) = v[j]; }
        }
        if (hdst) {
            float ss = 0.f;
#pragma unroll
            for (int j = 0; j < 4; ++j) ss += (v[j][0] * v[j][0] + v[j][1] * v[j][1]) + (v[j][2] * v[j][2] + v[j][3] * v[j][3]);
            const float rx = 1.0f / sqrtf(wave_sum(ss) * (1.f / 1024.f) + EPSN);
            const float* sh = modn + bb * NMOD + shc * 1024; const float* sc = modn + bb * NMOD + scc * 1024;
#pragma unroll
            for (int j = 0; j < 4; ++j) { const int c = 4 * lane + 256 * j; const f32x4 g4 = *(const f32x4*)(gnext + c), s4 = *(const f32x4*)(sc + c), h4 = *(const f32x4*)(sh + c);
                const f32x4 o = ((v[j] * rx) * g4) * (s4 + 1.0f) + h4;
                v2u w; w.x = pk2(o[0], o[1]); w.y = pk2(o[2], o[3]); *(v2u*)(hdst + (size_t)m * 1024 + c) = w; }
        }
    }
}
__device__ __forceinline__ void pool_phase(int M, const bf16* zin, bf16* pooled, int gtid, int NTH) {
    for (int it = gtid; it < M * 64; it += NTH) {
        const int m = it >> 6, ch = it & 63, g = ch >> 4, w2 = 1 << g;
        int t, l;
        if (m < ML) { t = m & 4095; l = SEQL; } else { t = (m - ML) & 255; l = CTXL; }
        const int base = m - t, lo = max(t - w2, 0), hi = min(t + w2, l);
        v4u w[16];
#pragma unroll
        for (int dj = 0; dj < 16; ++dj) { const int j = t + dj - 8; const int jj = min(max(j, lo), hi - 1);
            w[dj] = *(const v4u*)(zin + (size_t)(base + jj) * 512 + ch * 8); }
        float s[8];
#pragma unroll
        for (int i = 0; i < 8; ++i) s[i] = 0.f;
#pragma unroll
        for (int dj = 0; dj < 16; ++dj) { const int j = t + dj - 8; const float k = (j >= lo && j < hi) ? 1.0f : 0.0f;
            s[0] += k * bflo(w[dj].x); s[1] += k * bfhi(w[dj].x); s[2] += k * bflo(w[dj].y); s[3] += k * bfhi(w[dj].y);
            s[4] += k * bflo(w[dj].z); s[5] += k * bfhi(w[dj].z); s[6] += k * bflo(w[dj].w); s[7] += k * bfhi(w[dj].w); }
        const float inv = 1.0f / (float)(hi - lo);
        const v4u ws_ = w[8];
        v4u o; o.x = pk2(s[0] * inv - bflo(ws_.x), s[1] * inv - bfhi(ws_.x)); o.y = pk2(s[2] * inv - bflo(ws_.y), s[3] * inv - bfhi(ws_.y));
        o.z = pk2(s[4] * inv - bflo(ws_.z), s[5] * inv - bfhi(ws_.z)); o.w = pk2(s[6] * inv - bflo(ws_.w), s[7] * inv - bfhi(ws_.w));
        *(v4u*)(pooled + (size_t)m * 512 + ch * 8) = o;
    }
}
__device__ __forceinline__ void diff_combine_phase(int M, const bf16* od, bf16* diffo, const float* subln, float lam, float lam_init, int gtid, int NTH) {
    for (int it = gtid; it < M * 64; it += NTH) {
        const int l16 = it & 15, hd = (it >> 4) & 3, m = it >> 6;
        const bf16* p1 = od + (size_t)m * 1024 + hd * 256 + l16 * 8;
        const v4u a = *(const v4u*)p1, b = *(const v4u*)(p1 + 128);
        float d[8];
        d[0] = bflo(a.x) - lam * bflo(b.x); d[1] = bfhi(a.x) - lam * bfhi(b.x); d[2] = bflo(a.y) - lam * bflo(b.y); d[3] = bfhi(a.y) - lam * bfhi(b.y);
        d[4] = bflo(a.z) - lam * bflo(b.z); d[5] = bfhi(a.z) - lam * bfhi(b.z); d[6] = bflo(a.w) - lam * bflo(b.w); d[7] = bfhi(a.w) - lam * bfhi(b.w);
        float ss = 0.f;
#pragma unroll
        for (int i = 0; i < 8; ++i) ss += d[i] * d[i];
        ss += __shfl_xor(ss, 1); ss += __shfl_xor(ss, 2); ss += __shfl_xor(ss, 4); ss += __shfl_xor(ss, 8);
        const float rstd = 1.0f / sqrtf(ss * (1.f / 128.f) + EPSN), k1 = 1.0f - lam_init;
        const f32x4 g0 = *(const f32x4*)(subln + l16 * 8), g1 = *(const f32x4*)(subln + l16 * 8 + 4);
        v4u o; o.x = pk2(d[0] * rstd * g0[0] * k1, d[1] * rstd * g0[1] * k1); o.y = pk2(d[2] * rstd * g0[2] * k1, d[3] * rstd * g0[3] * k1);
        o.z = pk2(d[4] * rstd * g1[0] * k1, d[5] * rstd * g1[1] * k1); o.w = pk2(d[6] * rstd * g1[2] * k1, d[7] * rstd * g1[3] * k1);
        *(v4u*)(diffo + (size_t)m * 512 + hd * 128 + l16 * 8) = o;
    }
}

#define RLX_AGENT __ATOMIC_RELAXED, __HIP_MEMORY_SCOPE_AGENT
#define XB_TMO      128
#define XB_XCNT(j)  (256  + 64 * (j))
#define XB_XSUB(j)  (1280 + 64 * (j))
#define XB_XGEN(j)  (2304 + 64 * (j))
#define XB_TOP      3328
#define XB_TOPGEN   3392
#define XCD_BAR_WORDS 3456
#define XB_SPIN_CAP (1u << 22)

__device__ __forceinline__ unsigned xb_ld(unsigned* p)              { return __hip_atomic_load(p, __ATOMIC_RELAXED, __HIP_MEMORY_SCOPE_AGENT); }
__device__ __forceinline__ unsigned xb_add(unsigned* p, unsigned v) { return __hip_atomic_fetch_add(p, v, __ATOMIC_RELAXED, __HIP_MEMORY_SCOPE_AGENT); }
__device__ __forceinline__ unsigned xb_xcc_id() { return (unsigned)__builtin_amdgcn_s_getreg((3 << 11) | 20) & 0xFu; }
#define XB_SPIN(cond, bar) do { unsigned _sp = 0; while (cond) { __builtin_amdgcn_s_sleep(1); \
    if ((++_sp & 255u) == 0u) { if (xb_ld(&(bar)[XB_TMO])) break; if (_sp > XB_SPIN_CAP) { atomicAdd(&(bar)[XB_TMO], 1u); break; } } } } while (0)

struct XcdBarrier {
    unsigned* bar; unsigned x;
    volatile LAS unsigned* st;
};

__device__ __forceinline__ XcdBarrier xcd_barrier_post(unsigned* bar, volatile LAS unsigned* st) {
    XcdBarrier b; b.bar = bar; b.x = xb_xcc_id(); b.st = st;
    if (threadIdx.x == 0) (void)xb_add(&bar[XB_XCNT(b.x)], 1u);
    return b;
}
__device__ __forceinline__ void xcd_barrier_complete(unsigned* bar, unsigned x, unsigned& nloc, unsigned& nx) {
    const unsigned G = gridDim.x * gridDim.y * gridDim.z;
    unsigned sum, cnt, mine, sp = 0u;
    for (;;) {
        sum = 0u; cnt = 0u; mine = 0u;
#pragma unroll
        for (unsigned j = 0; j < 16; ++j) { const unsigned c = xb_ld(&bar[XB_XCNT(j)]); sum += c; cnt += (c > 0u) ? 1u : 0u; mine = (j == x) ? c : mine; }
        if (sum == G) break;
        __builtin_amdgcn_s_sleep(1);
        if ((++sp & 255u) == 0u) { if (xb_ld(&bar[XB_TMO])) break; if (sp > XB_SPIN_CAP) { atomicAdd(&bar[XB_TMO], 1u); break; } }
    }
    nloc = mine > 0u ? mine : 1u; nx = cnt > 0u ? cnt : 1u;
}

__device__ __forceinline__ void xcd_barrier(const XcdBarrier& b) {
    asm volatile("s_waitcnt vmcnt(0)" ::: "memory");
    __syncthreads();
    if (threadIdx.x == 0) {
        unsigned* bar = b.bar;
        __builtin_amdgcn_s_waitcnt(0);
        unsigned nloc = b.st[0], nx = b.st[1];
        if (nloc == 0u) { xcd_barrier_complete(bar, b.x, nloc, nx); b.st[0] = nloc; b.st[1] = nx; }
        const unsigned old = xb_add(&bar[XB_XSUB(b.x)], 1u);
        const unsigned gen = old / nloc;
        if (old + 1u == (gen + 1u) * nloc) {
            __builtin_amdgcn_fence(__ATOMIC_RELEASE, "agent");
            asm volatile("s_waitcnt vmcnt(0)" ::: "memory");
            const unsigned og = xb_add(&bar[XB_TOP], 1u);
            const unsigned tg = og / nx;
            if (og + 1u == (tg + 1u) * nx) xb_add(&bar[XB_TOPGEN], 1u);
            else XB_SPIN(xb_ld(&bar[XB_TOPGEN]) == tg, bar);
            __builtin_amdgcn_fence(__ATOMIC_ACQUIRE, "agent");
            xb_add(&bar[XB_XGEN(b.x)], 1u);
            asm volatile("s_waitcnt vmcnt(0)" ::: "memory");
        } else {
            XB_SPIN(xb_ld(&bar[XB_XGEN(b.x)]) == gen, bar);
            __builtin_amdgcn_fence(__ATOMIC_ACQUIRE, "agent");
            asm volatile("s_waitcnt vmcnt(0)" ::: "memory");
        }
    }
    __syncthreads();
}
constexpr size_t WS_BAR = 320 * 1024;
constexpr int LDS_CTL = 131072, LDS_BARST = LDS_CTL + 352;
constexpr size_t WS_PTR = 300 * 1024;
struct Ids { int tid, lane, wave, bx, G, vcu, gw, NGW, gtid, NTH; };
#define FRESH_IDS(I) Ids I; { int t_ = threadIdx.x; asm volatile("" : "+v"(t_)); int b_ = blockIdx.x; asm volatile("" : "+s"(b_)); int g_ = gridDim.x; asm volatile("" : "+s"(g_)); \
    I.tid = t_; I.lane = t_ & 63; I.wave = __builtin_amdgcn_readfirstlane(t_ >> 6); I.bx = b_; I.G = g_; I.vcu = (g_ % 8 == 0) ? (b_ % 8) * (g_ / 8) + b_ / 8 : b_; \
    I.gw = I.vcu * 8 + I.wave; I.NGW = g_ * 8; I.gtid = b_ * NTHR + t_; I.NTH = g_ * NTHR; }
#define PTAB(i) (((const float* const*)(ws + WS_PTR))[i])

__global__ void __launch_bounds__(NTHR, 2) mk_fwd(Args a) {
    extern __shared__ __attribute__((aligned(16))) unsigned char lds_raw[];
    cg::grid_group grid = cg::this_grid();
    LAS unsigned char* lds = (LAS unsigned char*)lds_raw;
    unsigned char* ws = a.ws;
#define GSYNC_CG() do { asm volatile("s_waitcnt vmcnt(0) lgkmcnt(0)" ::: "memory"); grid.sync(); asm volatile("" ::: "memory"); } while (0)
#define GSYNC() do { XcdBarrier b_; b_.bar = (unsigned*)(ws + WS_BAR); b_.x = xb_xcc_id(); b_.st = (volatile LAS unsigned*)(lds + LDS_BARST); xcd_barrier(b_); asm volatile("" ::: "memory"); } while (0)
#ifndef REP_P1
#define REP_P1 1
#endif
#ifndef REP_P2
#define REP_P2 1
#endif
#ifndef REP_P3
#define REP_P3 1
#endif
#ifndef REP_P4
#define REP_P4 1
#endif
#ifndef REP_P5
#define REP_P5 1
#endif
#ifndef REP_P7
#define REP_P7 1
#endif
#ifndef REP_P8
#define REP_P8 1
#endif
#ifndef EXTRA_SYNCS
#define EXTRA_SYNCS 0
#endif
#define REPEAT(n) _Pragma("unroll 1") for (int rep_ = 0; rep_ < (n); ++rep_)
    for (int u = threadIdx.x; u < (LDS_BYTES - LDS_CTL) / 4; u += NTHR) ((LAS unsigned*)(lds + LDS_CTL))[u] = 0u;
    if (blockIdx.x == 0) for (int i = threadIdx.x; i < XCD_BAR_WORDS; i += NTHR) ((unsigned*)(ws + WS_BAR))[i] = 0u;
    __syncthreads();

    {
        FRESH_IDS(I);
        if (I.bx == 0 && I.tid == 0) {
            const float** tab = (const float**)(ws + WS_PTR);
#pragma unroll
            for (int i = 0; i < 26; ++i) tab[i] = a.in[i];
            tab[26] = a.out;
        }
        mod_gemv(a.in[1], a.in[3], a.in[4], a.in[5], (float*)(ws + WS_MOD), lds, I.tid, I.lane, I.wave, I.bx);
        WPtrs wp{a.in[10], a.in[11], a.in[12], a.in[20], a.in[21], a.in[22], a.in[23], a.in[24], a.in[25]};
        convert_weights(wp, 0, ws, lds, I.gw, I.NGW, I.wave, I.lane, I.gtid, I.NTH);
        if (I.bx == I.G - 1) { float* ropet = (float*)(ws + WS_ROPE);
            for (int i = I.tid; i < 1024; i += NTHR) { const int pos = i >> 4, j = i & 15; const float inv = 1.0f / powf(10000.0f, (float)j * 2.0f / 32.0f); const float ang = (float)pos * inv;
                ropet[2 * i] = cosf(ang); ropet[2 * i + 1] = sinf(ang); } }
    }
    GSYNC_CG();
    (void)xcd_barrier_post((unsigned*)(ws + WS_BAR), (volatile LAS unsigned*)(lds + LDS_BARST));
    for (int e_ = 0; e_ < EXTRA_SYNCS; ++e_) GSYNC();
    {
        FRESH_IDS(I);
        float* modv = (float*)(ws + WS_MOD);
        norm_phase(MA, PTAB(0), PTAB(2), (float*)PTAB(26), (float*)(ws + WS_CTX), nullptr, nullptr, nullptr, 0, nullptr, (bf16*)(ws + WS_H), PTAB(6), modv, 0, 1, I.gw, I.NGW, I.lane);
    }
    GSYNC();

#pragma unroll 1
    for (int l = 0; l < 2; ++l) {
        REPEAT(REP_P1) {
        {
            FRESH_IDS(I);
            const float* ropet = (const float*)(ws + WS_ROPE);
            SchedG S; S.init(ws + WS_H, ws + W_IN, MA, N1, 1024, I.G, I.bx);
            EpiIn E{ws};
            pg8::gemm_phase<EpiIn, SchedG, true, true>(lds, S, E);
        }
        {
            asm volatile("s_waitcnt vmcnt(0)" ::: "memory"); __syncthreads(); __builtin_amdgcn_fence(__ATOMIC_ACQUIRE, "agent"); asm volatile("s_waitcnt vmcnt(0)" ::: "memory");
            FRESH_IDS(I);
            const float* ropet = (const float*)(ws + WS_ROPE);
            const float* kn = PTAB(19) + l * 64;
            pg8::StaticOrder S; S.init(MA, N1, I.G, I.bx);
            pg8::Unit u;
            for (int i = 0; S.next(i, u); ++i) {
                const bool latent = u.pm < (ML / 256);
                if (u.pn == 10) {
                    const int hh = I.tid & 1, rl = I.tid >> 1, row = u.pm * 256 + rl;
                    head_norm_fix((bf16_t*)(ws + WS_KG) + (size_t)kvrow_of(row) * 128 + hh * 64, kn, latent, row & 4095, 1.0f, ropet);
                }
            }
        }
        GSYNC();
        }
        REPEAT(REP_P2) {
        {
            FRESH_IDS(I);
            const bool last = (l == 1); const int M2 = last ? ML : MA;
            pool_phase(M2, (const bf16*)(ws + WS_POOLIN), (bf16*)(ws + WS_POOLED), I.gtid, I.NTH);
            const int total = 1536 + (last ? 0 : 96);
            for (int i = 0;; ++i) {
                const int L = i * I.G + I.vcu; if (L >= total) break;
                int b, r, m0, NT;
                if (L < 1536) { const int qb = L & 15, pair = L >> 4; b = pair / 24; r = pair % 24; m0 = b * SEQL + qb * 256; NT = LKV / 64; }
                else { const int L2 = L - 1536; b = L2 / 24; r = L2 % 24; m0 = ML + b * CTXL; NT = CTXL / 64; }
                const attn_body::bf16 *Q, *K, *V; attn_body::bf16* O; int pq, pk, pv, po; const float* qgain = nullptr; int qt0 = -1;
                if (r < 16) { const int hd = r >> 2, qs = (r >> 1) & 1, vh = r & 1;
                    Q = (const attn_body::bf16*)(ws + WS_QD) + (size_t)m0 * 512 + hd * 128 + qs * 64; pq = 512;
                    K = (const attn_body::bf16*)(ws + WS_KD) + (size_t)(b * LKV) * 512 + hd * 128 + qs * 64; pk = 512;
                    V = (const attn_body::bf16*)(ws + WS_VD) + (size_t)(b * LKV) * 512 + hd * 128 + vh * 64; pv = 512;
                    O = (attn_body::bf16*)(ws + WS_OD) + (size_t)m0 * 1024 + hd * 256 + qs * 128 + vh * 64; po = 1024; }
                else { const int h = r - 16;
                    Q = (const attn_body::bf16*)(ws + WS_QG) + (size_t)m0 * 512 + h * 64; pq = 512;
                    K = (const attn_body::bf16*)(ws + WS_KG) + (size_t)(b * LKV) * 128 + (h >> 2) * 64; pk = 128;
                    V = (const attn_body::bf16*)(ws + WS_VG) + (size_t)(b * LKV) * 128 + (h >> 2) * 64; pv = 128;
                    O = (attn_body::bf16*)(ws + WS_GQAO) + (size_t)m0 * 512 + h * 64; po = 512; qgain = PTAB(18) + l * 64; qt0 = (L < 1536) ? (m0 & 4095) : -1; }
#ifndef NO_ATTN
                attn_body::attn_unit<8>(Q, pq, K, pk, V, pv, O, po, NT, (char*)lds_raw, qgain, (const float*)(ws + WS_ROPE), qt0);
#endif
            }
        }
        GSYNC();
        }
        REPEAT(REP_P3) {
        {
            FRESH_IDS(I);
            const bool last = (l == 1); const int M2 = last ? ML : MA; const float lam_init = last ? 0.35550906759f : 0.2f;
            const float *lq1 = PTAB(13) + l * 64, *lk1 = PTAB(14) + l * 64, *lq2 = PTAB(15) + l * 64, *lk2 = PTAB(16) + l * 64;
            float d1 = 0.f, d2 = 0.f;
            for (int i = 0; i < 64; ++i) { d1 += lq1[i] * lk1[i]; d2 += lq2[i] * lk2[i]; }
            const float lam = expf(d1) - expf(d2) + lam_init;
            diff_combine_phase(M2, (const bf16*)(ws + WS_OD), (bf16*)(ws + WS_DIFFO), PTAB(17) + l * 128, lam, lam_init, I.gtid, I.NTH);
            SchedG S; S.init(ws + WS_POOLED, ws + W_POOL, M2, 512, 512, I.G, I.bx);
            EpiAct<0> E{(bf16_t*)(ws + WS_POOLO), 512};
            pg8::gemm_phase<EpiAct<0>, SchedG, true, true>(lds, S, E);
        }
        GSYNC();
        }
        REPEAT(REP_P4) {
        { FRESH_IDS(I); const int M2 = (l == 1) ? ML : MA;
          SchedP4 S; S.init(ws, M2, I.G, I.bx);
          EpiP4 E{(bf16_t*)(ws + WS_MERGED), (float*)(ws + WS_ACC)};
          pg8::gemm_phase<EpiP4, SchedP4, true, true>(lds, S, E); }
        GSYNC();
        }
        REPEAT(REP_P5) {
        {
            FRESH_IDS(I); const int M2 = (l == 1) ? ML : MA;
            SchedG S; S.init(ws + WS_MERGED, ws + W_O, M2, 1024, 1024, I.G, I.bx);
            EpiF32 E{(float*)(ws + WS_Y), 1024};
            pg8::gemm_phase<EpiF32, SchedG, true, true>(lds, S, E);
        }
        GSYNC();
        }
        {
            FRESH_IDS(I); const int M2 = (l == 1) ? ML : MA;
            const float* modl = (const float*)(ws + WS_MOD) + l * 5 * NMOD; float* outp = (float*)PTAB(26); float* ctxx = (float*)(ws + WS_CTX);
            norm_phase(M2, outp, ctxx, outp, ctxx, (const float*)(ws + WS_Y), nullptr, modl, 2, PTAB(7) + l * 1024, (bf16*)(ws + WS_HF), PTAB(8) + l * 1024, modl, 3, 4, I.gw, I.NGW, I.lane);
        }
        GSYNC();
        REPEAT(REP_P7) {
        {
            FRESH_IDS(I); const int M2 = (l == 1) ? ML : MA;
            SchedG S; S.init(ws + WS_HF, ws + W_1, M2, DFF, 1024, I.G, I.bx);
            EpiAct<2> E{(bf16_t*)(ws + WS_U), DFF};
            pg8::gemm_phase<EpiAct<2>, SchedG, true, true>(lds, S, E);
        }
        GSYNC();
        }
        REPEAT(REP_P8) {
        {
            FRESH_IDS(I);
            EpiP8 E{(float*)(ws + WS_Z), (float*)(ws + WS_ZP)};
            if (l == 0) { SchedP8C S; S.init(ws, I.G, I.bx); pg8::gemm_phase<EpiP8, SchedP8C, true, true>(lds, S, E); }
            else { SchedG S; S.init(ws + WS_U, ws + W_2, ML, 1024, DFF, I.G, I.bx); pg8::gemm_phase<EpiP8, SchedG, true, true>(lds, S, E); }
        }
        GSYNC();
        }
        {
            FRESH_IDS(I);
            const float* modl = (const float*)(ws + WS_MOD) + l * 5 * NMOD; float* outp = (float*)PTAB(26); float* ctxx = (float*)(ws + WS_CTX);
            if (l == 0) {
                WPtrs wp{PTAB(10), PTAB(11), PTAB(12), PTAB(20), PTAB(21), PTAB(22), PTAB(23), PTAB(24), PTAB(25)};
                convert_weights(wp, 1, ws, lds, I.gw, I.NGW, I.wave, I.lane, I.gtid, I.NTH);
                norm_phase(MA, outp, ctxx, outp, ctxx, (const float*)(ws + WS_Z), (const float*)(ws + WS_ZP), modl, 5, PTAB(9) + l * 1024, (bf16*)(ws + WS_H), PTAB(6) + 1024, modl + 5 * NMOD, 0, 1, I.gw, I.NGW, I.lane);
            } else {
                norm_phase(ML, outp, ctxx, outp, ctxx, (const float*)(ws + WS_Z), nullptr, modl, 5, PTAB(9) + l * 1024, nullptr, nullptr, nullptr, 0, 0, I.gw, I.NGW, I.lane);
            }
        }
        if (l == 0) GSYNC();
    }
#undef GSYNC
}

extern "C" void kernel_launch(void* const* d_in, const int* in_sizes, int n_in, void* d_out, int out_size, void* d_ws, size_t ws_size, hipStream_t stream) {
    static int grid = 0;
    if (grid == 0) {
        if (n_in != 26 || out_size != ML * DMODEL || ws_size < WS_TOTAL) { fprintf(stderr, "kernel_launch: unexpected shapes (n_in %d out %d ws %zu)\n", n_in, out_size, ws_size); grid = -1; return; }
        int dev = 0, cus = 0, per_cu = 0;
        if (hipGetDevice(&dev) != hipSuccess || hipDeviceGetAttribute(&cus, hipDeviceAttributeMultiprocessorCount, dev) != hipSuccess) { grid = -1; return; }
        if (hipFuncSetAttribute((const void*)mk_fwd, hipFuncAttributeMaxDynamicSharedMemorySize, LDS_BYTES) != hipSuccess) { fprintf(stderr, "kernel_launch: hipFuncSetAttribute failed\n"); grid = -1; return; }
        if (hipOccupancyMaxActiveBlocksPerMultiprocessor(&per_cu, (const void*)mk_fwd, NTHR, LDS_BYTES) != hipSuccess || per_cu < 1) per_cu = 1;
        (void)hipGetLastError();
        grid = cus * per_cu;
    }
    if (grid < 0) return;
    Args a{};
    for (int i = 0; i < 26; ++i) a.in[i] = (const float*)d_in[i];
    a.out = (float*)d_out; a.ws = (unsigned char*)d_ws;
    void* args[] = {&a};
    hipError_t e = hipLaunchCooperativeKernel((const void*)mk_fwd, dim3(grid), dim3(NTHR), args, LDS_BYTES, stream);
    if (e != hipSuccess) fprintf(stderr, "kernel_launch: cooperative launch failed: %s (grid %d)\n", hipGetErrorString(e), grid);
}
```

```cpp
#include <hip/hip_runtime.h>
#include <hip/hip_cooperative_groups.h>
#include <cstdio>
#include <cstdint>

namespace pg8 {
#define PG8_LAS __attribute__((address_space(3)))
typedef unsigned short bf16_t;
typedef short bf16x8 __attribute__((ext_vector_type(8)));
typedef float f32x4 __attribute__((ext_vector_type(4)));
typedef unsigned u32x4 __attribute__((ext_vector_type(4)));
constexpr int BM = 256, BK = 64, HALF = 128, HTB = HALF * BK * 2  , STAGE_BYTES = 8 * HTB, NXCD = 8, WGM = 8;

__host__ __device__ __forceinline__ int lds_byte(int r, int c) { const int st = (r >> 4) * 2 + (c >> 5), rr = r & 15, cc = c & 31, ob = rr * 64 + cc * 2; return st * 1024 + (ob ^ (((ob >> 9) & 1) << 5)); }
__host__ __device__ __forceinline__ void stage_rc(int b, int& R, int& C) { const int st = b / 1024, sb = b % 1024, swz = sb ^ (((sb >> 9) & 1) << 5); R = (st >> 1) * 16 + swz / 64; C = (st & 1) * 32 + (swz % 64) / 2; }
__host__ __device__ __forceinline__ int perm32(int rho) { const int n = rho >> 4, i = rho & 15; return 8 * (i >> 2) + 4 * n + (i & 3); }

struct Unit { const char* A; const char* B; int lda, ldb, nt, pm, pn, seg; };
struct Gemm { const bf16_t* A; const bf16_t* Bt; int M, N, K; };

struct StaticOrder {
    int nM, nN, nwg, G, c;
    __host__ __device__ void init(int M, int N, int G_, int c_) { nM = M / BM; nN = N / BM; nwg = nM * nN; G = G_; c = c_; }
    __host__ __device__ bool next(int i, Unit& u) const {
        const long L = (long)i * G + c; if (L >= nwg) return false;
        int wgid = (int)L; { const int q = nwg / NXCD, r = nwg % NXCD, xcd = wgid % NXCD, off = wgid / NXCD; wgid = (xcd < r ? xcd * (q + 1) : r * (q + 1) + (xcd - r) * q) + off; }
        const int nig = WGM * nN, gid = wgid / nig, fm = gid * WGM, gsz = (nM - fm) < WGM ? (nM - fm) : WGM;
        u.pm = fm + ((wgid % nig) % gsz); u.pn = (wgid % nig) / gsz; return true;
    }
    __device__ __forceinline__ void a_ready(const Unit&) const {}
    __device__ __forceinline__ void done(const Unit&) const {}
};

__device__ __forceinline__ unsigned cvt_pk_bf16(float lo, float hi) { unsigned r; asm volatile("v_cvt_pk_bf16_f32 %0, %1, %2" : "=v"(r) : "v"(lo), "v"(hi)); return r; }
typedef float f32x2 __attribute__((ext_vector_type(2)));
template <class Epi, class Sched, bool ALIGN_EPI = false, bool SP2 = false>
__device__ __forceinline__ void gemm_phase(PG8_LAS unsigned char* lds, const Sched& S, const Epi& E) {
    int tid_l = threadIdx.x; asm volatile("" : "+v"(tid_l)); const int tid = tid_l, wid = __builtin_amdgcn_readfirstlane(tid >> 6), lane = tid & 63, wr = wid >> 2, wc = wid & 3, fr = lane & 15, fq = lane >> 4;
    unsigned rA[2], rB[2], c2[2];
#pragma unroll
    for (int i = 0; i < 2; ++i) { int R, C; stage_rc(tid * 16 + i * 8192, R, C); const int Rb = Epi::PERM ? ((R & ~31) + perm32(R & 31)) : R;
        rA[i] = (unsigned)R; rB[i] = (unsigned)Rb; c2[i] = (unsigned)C * 2u; }
    const size_t kstep = (size_t)(BK * 2);
    const unsigned ldsw = (unsigned)wid * 1024u;
    const int aoff = lds_byte(wr * 64 + fr, fq * 8), boff = lds_byte(wc * 32 + fr, fq * 8);
#define PG8_SA(b, h) (((b) * 2 + (h)) * HTB)
#define PG8_SB(b, h) ((4 + (b) * 2 + (h)) * HTB)
#define PG8_STAGE(bufoff, gbase, voff) do { _Pragma("unroll") for (int _i = 0; _i < 2; ++_i) \
        __builtin_amdgcn_global_load_lds((const unsigned*)((const char*)(gbase) + (voff)[_i]), (PG8_LAS unsigned*)(lds + (bufoff) + ldsw + _i * 8192), 16, 0, 0); } while (0)
#define PG8_LDA(dst, b, h) do { _Pragma("unroll") for (int m = 0; m < 4; ++m) _Pragma("unroll") for (int k = 0; k < 2; ++k) dst[m][k] = *(const PG8_LAS bf16x8*)(lds + PG8_SA(b, h) + aoff + m * 2048 + k * 1024); } while (0)
#define PG8_LDB(dst, b, h) do { _Pragma("unroll") for (int n = 0; n < 2; ++n) _Pragma("unroll") for (int k = 0; k < 2; ++k) dst[n][k] = *(const PG8_LAS bf16x8*)(lds + PG8_SB(b, h) + boff + n * 2048 + k * 1024); } while (0)
#define PG8_MMA(ai, bj, At, Bt) do { __builtin_amdgcn_s_setprio(1); _Pragma("unroll") for (int m = 0; m < 4; ++m) _Pragma("unroll") for (int n = 0; n < 2; ++n) _Pragma("unroll") for (int k = 0; k < 2; ++k) \
        acc[ai][bj][m][n] = __builtin_amdgcn_mfma_f32_16x16x32_bf16(Bt[n][k], At[m][k], acc[ai][bj][m][n], 0, 0, 0); __builtin_amdgcn_s_setprio(0); } while (0)
#define PG8_WAIT_V(n) asm volatile("s_waitcnt vmcnt(" #n ")" ::: "memory")
#define PG8_WAIT_L(n) asm volatile("s_waitcnt lgkmcnt(" #n ")" ::: "memory")
#define PG8_BAR __builtin_amdgcn_s_barrier()
#define PG8_SCHED __builtin_amdgcn_sched_barrier(0)
    Unit cur, nxt; int ui = 0;
    if (!S.next(0, cur)) return;
    f32x4 acc[2][2][4][2];
#pragma unroll
    for (int a = 0; a < 2; ++a)
#pragma unroll
        for (int b = 0; b < 2; ++b)
#pragma unroll
            for (int m = 0; m < 4; ++m)
#pragma unroll
                for (int n = 0; n < 2; ++n) acc[a][b][m][n] = (f32x4){0.f, 0.f, 0.f, 0.f};
    bf16x8 At[4][2], B0[2][2], B1[2][2];
    unsigned voA_c[2], voB_c[2], voA_n[2], voB_n[2]; size_t hA_c, hB_c, hA_n, hB_n; int nt_c;
#define PG8_UPARAMS(u, vA, vB, hA, hB) do { _Pragma("unroll") for (int _i = 0; _i < 2; ++_i) { vA[_i] = rA[_i] * (unsigned)(u).lda + c2[_i]; vB[_i] = rB[_i] * (unsigned)(u).ldb + c2[_i]; } hA = (size_t)HALF * (u).lda; hB = (size_t)HALF * (u).ldb; } while (0)
    PG8_UPARAMS(cur, voA_c, voB_c, hA_c, hB_c); nt_c = cur.nt;
    const char* cA = cur.A; const char* cB = cur.B;
    S.a_ready(cur);
    if constexpr (SP2) {
        PG8_STAGE(PG8_SB(0, 0), cB, voB_c); PG8_STAGE(PG8_SB(0, 1), cB + hB_c, voB_c); PG8_STAGE(PG8_SA(0, 0), cA, voA_c); PG8_STAGE(PG8_SA(0, 1), cA + hA_c, voA_c);
        if (wr == 1) PG8_BAR;
        PG8_WAIT_V(2); PG8_BAR;
        PG8_STAGE(PG8_SB(1, 0), cB + kstep, voB_c); PG8_STAGE(PG8_SA(1, 0), cA + kstep, voA_c); PG8_STAGE(PG8_SB(1, 1), cB + hB_c + kstep, voB_c);
        PG8_WAIT_V(6); PG8_BAR;
    } else {
        PG8_STAGE(PG8_SB(0, 0), cB, voB_c); PG8_STAGE(PG8_SA(0, 0), cA, voA_c); PG8_STAGE(PG8_SB(0, 1), cB + hB_c, voB_c); PG8_STAGE(PG8_SA(0, 1), cA + hA_c, voA_c);
        if (wr == 1) PG8_BAR;
        PG8_WAIT_V(4); PG8_BAR;
        PG8_STAGE(PG8_SB(1, 0), cB + kstep, voB_c); PG8_STAGE(PG8_SA(1, 0), cA + kstep, voA_c); PG8_STAGE(PG8_SB(1, 1), cB + hB_c + kstep, voB_c);
        PG8_WAIT_V(6); PG8_BAR;
    }
    for (;;) {
        const bool has_next = S.next(ui + 1, nxt);
        const char* nA = has_next ? nxt.A : cA; const char* nB = has_next ? nxt.B : cB;
        if (has_next) { PG8_UPARAMS(nxt, voA_n, voB_n, hA_n, hB_n); } else { voA_n[0] = voA_c[0]; voA_n[1] = voA_c[1]; voB_n[0] = voB_c[0]; voB_n[1] = voB_c[1]; hA_n = hA_c; hB_n = hB_c; }
        for (int t = 0; t < nt_c; t += 2) {
            const bool last = (t == nt_c - 2);
            const size_t hA2 = last ? hA_n : hA_c, hB2 = last ? hB_n : hB_c;
            unsigned vA2[2], vB2[2]; vA2[0] = last ? voA_n[0] : voA_c[0]; vA2[1] = last ? voA_n[1] : voA_c[1]; vB2[0] = last ? voB_n[0] : voB_c[0]; vB2[1] = last ? voB_n[1] : voB_c[1];
            const char* a1 = cA + (size_t)(t + 1) * kstep;
            const char* a2 = last ? nA : cA + (size_t)(t + 2) * kstep; const char* b2 = last ? nB : cB + (size_t)(t + 2) * kstep;
            const char* a3 = a2 + kstep; const char* b3 = b2 + kstep;
            if (last && has_next) S.a_ready(nxt);
            if constexpr (SP2) {
            PG8_LDB(B0, 0, 0); PG8_LDB(B1, 0, 1); PG8_SCHED; PG8_LDA(At, 0, 0); PG8_STAGE(PG8_SA(1, 1), a1 + hA_c, voA_c);
            PG8_WAIT_V(8); PG8_WAIT_L(0); PG8_BAR; PG8_MMA(0, 0, At, B0); PG8_MMA(0, 1, At, B1); PG8_BAR; PG8_SCHED;
            PG8_LDA(At, 0, 1); PG8_STAGE(PG8_SB(0, 0), b2, vB2); PG8_STAGE(PG8_SB(0, 1), b2 + hB2, vB2); PG8_STAGE(PG8_SA(0, 0), a2, vA2);
            PG8_WAIT_V(8); PG8_WAIT_L(0); PG8_BAR; PG8_MMA(1, 0, At, B0); PG8_MMA(1, 1, At, B1); PG8_BAR; PG8_SCHED;
            PG8_LDB(B0, 1, 0); PG8_LDB(B1, 1, 1); PG8_SCHED; PG8_LDA(At, 1, 0); PG8_STAGE(PG8_SA(0, 1), a2 + hA2, vA2);
            PG8_WAIT_V(8); PG8_WAIT_L(0); PG8_BAR; PG8_MMA(0, 0, At, B0); PG8_MMA(0, 1, At, B1); PG8_BAR; PG8_SCHED;
            PG8_LDA(At, 1, 1); PG8_STAGE(PG8_SB(1, 0), b3, vB2); PG8_STAGE(PG8_SB(1, 1), b3 + hB2, vB2); PG8_STAGE(PG8_SA(1, 0), a3, vA2);
            PG8_WAIT_V(8); PG8_WAIT_L(0); PG8_BAR; PG8_MMA(1, 0, At, B0); PG8_MMA(1, 1, At, B1); PG8_BAR; PG8_SCHED;
            } else {
            PG8_LDB(B0, 0, 0); PG8_SCHED; PG8_LDA(At, 0, 0); PG8_STAGE(PG8_SA(1, 1), a1 + hA_c, voA_c);
            PG8_WAIT_L(8); PG8_BAR; PG8_WAIT_L(0); PG8_MMA(0, 0, At, B0); PG8_BAR; PG8_SCHED;
            PG8_LDB(B1, 0, 1); PG8_STAGE(PG8_SB(0, 0), b2, vB2);
            PG8_BAR; PG8_WAIT_L(0); PG8_MMA(0, 1, At, B1); PG8_BAR;
            PG8_LDA(At, 0, 1); PG8_STAGE(PG8_SA(0, 0), a2, vA2);
            PG8_BAR; PG8_WAIT_L(0); PG8_MMA(1, 0, At, B0); PG8_BAR; PG8_SCHED;
            PG8_STAGE(PG8_SB(0, 1), b2 + hB2, vB2);
            PG8_WAIT_V(6); PG8_BAR; PG8_MMA(1, 1, At, B1); PG8_BAR;
            PG8_LDB(B0, 1, 0); PG8_SCHED; PG8_LDA(At, 1, 0); PG8_STAGE(PG8_SA(0, 1), a2 + hA2, vA2);
            PG8_WAIT_L(8); PG8_BAR; PG8_WAIT_L(0); PG8_MMA(0, 0, At, B0); PG8_BAR; PG8_SCHED;
            PG8_LDB(B1, 1, 1); PG8_STAGE(PG8_SB(1, 0), b3, vB2);
            PG8_BAR; PG8_WAIT_L(0); PG8_MMA(0, 1, At, B1); PG8_BAR;
            PG8_LDA(At, 1, 1); PG8_STAGE(PG8_SA(1, 0), a3, vA2);
            PG8_BAR; PG8_WAIT_L(0); PG8_MMA(1, 0, At, B0); PG8_BAR; PG8_SCHED;
            PG8_STAGE(PG8_SB(1, 1), b3 + hB2, vB2);
            PG8_WAIT_V(6); PG8_BAR; PG8_MMA(1, 1, At, B1); PG8_BAR;
            }
        }
        if constexpr (ALIGN_EPI) { if (wr == 0) PG8_BAR; }
        if constexpr (!Epi::AFTER_DRAIN) { E(acc, cur, wr, wc, fr, fq); S.done(cur); }
        if (!has_next) break;
#pragma unroll
        for (int a = 0; a < 2; ++a)
#pragma unroll
            for (int b = 0; b < 2; ++b)
#pragma unroll
                for (int m = 0; m < 4; ++m)
#pragma unroll
                    for (int n = 0; n < 2; ++n) acc[a][b][m][n] = (f32x4){0.f, 0.f, 0.f, 0.f};
        cur = nxt; cA = nA; cB = nB; ++ui; voA_c[0] = voA_n[0]; voA_c[1] = voA_n[1]; voB_c[0] = voB_n[0]; voB_c[1] = voB_n[1]; hA_c = hA_n; hB_c = hB_n; nt_c = cur.nt;
        if constexpr (ALIGN_EPI) { if (wr == 1) PG8_BAR; }
    }
    PG8_WAIT_V(0);
    if constexpr (!ALIGN_EPI) { if (wr == 0) PG8_BAR; }
    PG8_BAR;
    if constexpr (Epi::AFTER_DRAIN) { E.fused(acc, cur, wr, wc, fr, fq, lds, wid, lane); S.done(cur); }
#undef PG8_UPARAMS
#undef PG8_SA
#undef PG8_SB
#undef PG8_STAGE
#undef PG8_LDA
#undef PG8_LDB
#undef PG8_MMA
#undef PG8_WAIT_V
#undef PG8_WAIT_L
#undef PG8_BAR
#undef PG8_SCHED
}
}
namespace cg = cooperative_groups;
#define LAS __attribute__((address_space(3)))
typedef unsigned short bf16;
typedef unsigned v4u __attribute__((ext_vector_type(4)));
typedef unsigned v2u __attribute__((ext_vector_type(2)));
typedef float f32x4 __attribute__((ext_vector_type(4)));
using pg8::bf16_t;

constexpr int DMODEL = 1024, NBATCH = 4, SEQL = 4096, CTXL = 256, LKV = SEQL + CTXL, ML = NBATCH * SEQL, MC = NBATCH * CTXL, MA = ML + MC, DFF = 4096, N1 = 2816, NMOD = 6 * DMODEL;
constexpr float EPSN = 1e-6f;
constexpr float QC2 = 0.125f * 1.4426950408889634f;
constexpr int NTHR = 512;
constexpr int LDS_BYTES = 147456;

constexpr size_t MiB = 1u << 20;
constexpr size_t WS_MOD = 0, WS_ROPE = 256 * 1024;
constexpr size_t W_IN = 2 * MiB, W_POOL = W_IN + (size_t)5888 * 1024 * 2, W_PO = W_POOL + 512 * 512 * 2, W_DO = W_PO + 1024 * 512 * 2, W_GO = W_DO + 1024 * 512 * 2,
                 W_O = W_GO + 1024 * 512 * 2, W_1 = W_O + 1024 * 1024 * 2, W_2 = W_1 + (size_t)4096 * 1024 * 2, W_END = W_2 + (size_t)4096 * 1024 * 2;
static_assert(W_END <= 36 * MiB, "weights");
constexpr size_t WS_CTX = 36 * MiB, WS_H = 40 * MiB;
constexpr size_t WS_POOLIN = 74 * MiB, WS_QD = 91 * MiB, WS_QG = 108 * MiB, WS_KD = 125 * MiB, WS_VD = 142 * MiB, WS_KG = 159 * MiB, WS_VG = WS_KG + (size_t)MA * 128 * 2;
constexpr size_t WS_OD = 176 * MiB, WS_GQAO = 210 * MiB, WS_POOLED = 227 * MiB;
constexpr size_t WS_DIFFO = 74 * MiB, WS_POOLO = 91 * MiB, WS_MERGED = 108 * MiB, WS_ACC = 142 * MiB, WS_Y = 142 * MiB, WS_HF = 210 * MiB, WS_U = 40 * MiB, WS_Z = 176 * MiB;
constexpr size_t WS_TOTAL = 256 * MiB;
static_assert(WS_VG + (size_t)MA * 128 * 2 <= 176 * MiB, "p1 outs");

__device__ __forceinline__ unsigned f2bf(float f) { unsigned u = __builtin_bit_cast(unsigned, f); return (u + 0x7fffu + ((u >> 16) & 1u)) >> 16; }
__device__ __forceinline__ unsigned pk2(float lo, float hi) { return f2bf(lo) | (f2bf(hi) << 16); }
__device__ __forceinline__ float bflo(unsigned w) { return __builtin_bit_cast(float, w << 16); }
__device__ __forceinline__ float bfhi(unsigned w) { return __builtin_bit_cast(float, w & 0xffff0000u); }
__device__ __forceinline__ float wave_sum(float v) {
#pragma unroll
    for (int o = 1; o < 64; o <<= 1) v += __shfl_xor(v, o);
    return v;
}

__device__ __forceinline__ int kvrow_of(int row) { return row < ML ? (row >> 12) * LKV + CTXL + (row & 4095) : ((row - ML) >> 8) * LKV + ((row - ML) & 255); }
__device__ __forceinline__ void rope8(float (&v)[8], const float* tab, int d, int t) {
    const int p0 = d >> 1, pos = p0 < 16 ? (t >> 6) : (t & 63), j0 = p0 & 15;
    const f32x4* tp = (const f32x4*)(tab + (pos * 16 + j0) * 2);
    const f32x4 t0 = tp[0], t1 = tp[1];
    float o[8];
    o[0] = v[0] * t0[0] - v[1] * t0[1]; o[1] = v[0] * t0[1] + v[1] * t0[0];
    o[2] = v[2] * t0[2] - v[3] * t0[3]; o[3] = v[2] * t0[3] + v[3] * t0[2];
    o[4] = v[4] * t1[0] - v[5] * t1[1]; o[5] = v[4] * t1[1] + v[5] * t1[0];
    o[6] = v[6] * t1[2] - v[7] * t1[3]; o[7] = v[6] * t1[3] + v[7] * t1[2];
#pragma unroll
    for (int i = 0; i < 8; ++i) v[i] = o[i];
}

#include <hip/hip_bf16.h>
#include <cmath>
namespace attn_body {
using bf16=__hip_bfloat16;
using bf16x8=__attribute__((ext_vector_type(8)))short;
using s16x4=__attribute__((ext_vector_type(4)))short;
using f32x16=__attribute__((ext_vector_type(16)))float;
using u32x4=__attribute__((ext_vector_type(4)))unsigned;
constexpr int D=64;
constexpr int NW=8,QBLK=32,QB=QBLK*NW,KVBLK=64;
constexpr int ATTN_UNIT_ROWS=QB;
__device__ __forceinline__ int crow(int r,int hi){return (r&3)+8*(r>>2)+4*hi;}
#define SBAR() __builtin_amdgcn_sched_barrier(0)
__device__ __forceinline__ void cmask(f32x16&p0,f32x16&p1,int jb,int qrel,int hi){
  const float NEG=-INFINITY; int kb=64*jb+4*hi;
  #pragma unroll
  for(int r=0;r<16;++r){int kv=kb+(r&3)+8*(r>>2); if(kv>qrel)p0[r]=NEG; if(kv+32>qrel)p1[r]=NEG;}
}

constexpr int NSLOT=3, SLOTB=8192;
constexpr int LDS_K=0, LDS_V=NSLOT*SLOTB, LDS_WS=2*NSLOT*SLOTB, LDS_OST=LDS_WS+NW*64*4, LDS_BYTES=LDS_OST+NW*4096;
constexpr float C2=0.125f*1.4426950408889634f;
__device__ __forceinline__ void glds16(const void*gsrc,unsigned lds_dst){unsigned keep;
  asm volatile("s_mov_b32 %0, m0\n\ts_mov_b32 m0, %2\n\ts_nop 0\n\tglobal_load_lds_dwordx4 %1, off\n\ts_mov_b32 m0, %0":"=&s"(keep):"v"(gsrc),"s"(lds_dst):"memory");}
__device__ __forceinline__ float max3f(float a,float b,float c){float r;asm("v_max3_f32 %0, %1, %2, %3":"=v"(r):"v"(a),"v"(b),"v"(c));return r;}
__device__ __forceinline__ float max2f(float a,float b){float r;asm("v_max_f32_e32 %0, %1, %2":"=v"(r):"v"(a),"v"(b));return r;}
__device__ __forceinline__ float fadd_s(float a,float b){float r;asm("v_add_f32_e32 %0, %1, %2":"=v"(r):"v"(a),"v"(b));return r;}
__device__ __forceinline__ float fsub_s(float a,float b){float r;asm("v_sub_f32_e32 %0, %1, %2":"=v"(r):"v"(a),"v"(b));return r;}
typedef float f32x2_t __attribute__((ext_vector_type(2))); typedef __bf16 bf16x2_t __attribute__((ext_vector_type(2)));
__device__ __forceinline__ unsigned cvtpk_s(float lo,float hi){f32x2_t v={lo,hi};bf16x2_t b=__builtin_convertvector(v,bf16x2_t);return __builtin_bit_cast(unsigned,b);}
#define WAIT_BAR(N) asm volatile("s_waitcnt vmcnt(" #N ") lgkmcnt(0)\n\ts_barrier":::"memory")

__device__ __forceinline__ void qkt(f32x16&p0,f32x16&p1,const char*Kslot,const bf16x8*qr,const f32x16&negm,int r32,int hi){
  const char*kb=Kslot+hi*1024+r32*16;
  #pragma unroll
  for(int d0=0;d0<4;++d0){
    const bf16x8 b0=*reinterpret_cast<const bf16x8*>(kb+d0*2048);
    const bf16x8 b1=*reinterpret_cast<const bf16x8*>(kb+d0*2048+512);
    if(d0==0){p0=__builtin_amdgcn_mfma_f32_32x32x16_bf16(b0,qr[0],negm,0,0,0);p1=__builtin_amdgcn_mfma_f32_32x32x16_bf16(b1,qr[0],negm,0,0,0);}
    else{p0=__builtin_amdgcn_mfma_f32_32x32x16_bf16(b0,qr[d0],p0,0,0,0);p1=__builtin_amdgcn_mfma_f32_32x32x16_bf16(b1,qr[d0],p1,0,0,0);}}
}
typedef __attribute__((address_space(3))) const char* lds_cptr;
typedef short v4i16_t __attribute__((ext_vector_type(4)));
__device__ __forceinline__ void kload8(bf16x8*kf,lds_cptr kp){
  kf[0]=*(const __attribute__((address_space(3))) bf16x8*)(kp);      kf[1]=*(const __attribute__((address_space(3))) bf16x8*)(kp+512);
  kf[2]=*(const __attribute__((address_space(3))) bf16x8*)(kp+2048); kf[3]=*(const __attribute__((address_space(3))) bf16x8*)(kp+2560);
  kf[4]=*(const __attribute__((address_space(3))) bf16x8*)(kp+4096); kf[5]=*(const __attribute__((address_space(3))) bf16x8*)(kp+4608);
  kf[6]=*(const __attribute__((address_space(3))) bf16x8*)(kp+6144); kf[7]=*(const __attribute__((address_space(3))) bf16x8*)(kp+6656);
}
__device__ __forceinline__ void kload2(bf16x8*kf,lds_cptr kp,int j){ kf[2*j]=*(const __attribute__((address_space(3))) bf16x8*)(kp+j*2048); kf[2*j+1]=*(const __attribute__((address_space(3))) bf16x8*)(kp+j*2048+512); }
__device__ __forceinline__ s16x4 vtr(lds_cptr p){ return __builtin_bit_cast(s16x4,__builtin_amdgcn_ds_read_tr16_b64_v4i16((__attribute__((address_space(3))) v4i16_t*)p)); }
__device__ __forceinline__ float rowmax(const f32x16&p0,const f32x16&p1){
  float a=max3f(p0[0],p0[1],p1[0]),b=max3f(p0[2],p0[3],p1[1]);a=max3f(a,p1[2],p1[3]);
  #pragma unroll
  for(int r=4;r<16;r+=4){a=max3f(a,p0[r],p0[r+1]);b=max3f(b,p0[r+2],p0[r+3]);a=max3f(a,p1[r],p1[r+1]);b=max3f(b,p1[r+2],p1[r+3]);}
  const float m=max2f(a,b);
  auto rr=__builtin_amdgcn_permlane32_swap(__float_as_uint(m),__float_as_uint(m),false,false);
  return max2f(__uint_as_float(rr[0]),__uint_as_float(rr[1]));
}
__device__ __forceinline__ void pv(f32x16*o,int vb,bf16x8 pa0,bf16x8 pa1,bf16x8 pa2,bf16x8 pa3){
  #pragma unroll
  for(int d0=0;d0<2;++d0){s16x4 lo[4],hi[4];
    #pragma unroll
    for(int ks=0;ks<4;++ks){
      asm volatile("ds_read_b64_tr_b16 %0,%1 offset:%c2":"=&v"(lo[ks]):"v"(vb),"i"(d0*4096+ks*1024):"memory");
      asm volatile("ds_read_b64_tr_b16 %0,%1 offset:%c2":"=&v"(hi[ks]):"v"(vb),"i"(d0*4096+ks*1024+512):"memory");}
    asm volatile("s_waitcnt lgkmcnt(0)":::"memory");SBAR();
    #define PK(k) (bf16x8){lo[k][0],lo[k][1],lo[k][2],lo[k][3],hi[k][0],hi[k][1],hi[k][2],hi[k][3]}
    o[d0]=__builtin_amdgcn_mfma_f32_32x32x16_bf16(pa0,PK(0),o[d0],0,0,0);
    o[d0]=__builtin_amdgcn_mfma_f32_32x32x16_bf16(pa1,PK(1),o[d0],0,0,0);
    o[d0]=__builtin_amdgcn_mfma_f32_32x32x16_bf16(pa2,PK(2),o[d0],0,0,0);
    o[d0]=__builtin_amdgcn_mfma_f32_32x32x16_bf16(pa3,PK(3),o[d0],0,0,0);
    #undef PK
  }
}

#ifndef ATTN_STORE16
#define ATTN_STORE16(p,v) (*(u32x4*)(p)=(v))
#endif
template<int THRL> __device__ __forceinline__ void attn_unit(const bf16*Qw0,int pqs,const bf16*__restrict__ Kh,int pks,const bf16*__restrict__ Vh,int pvs,bf16*Ow0,int pos_,const int NT,char*shm,const float*qgain,const float*rtab,const int qt0){
  int tid_l=threadIdx.x; asm volatile("":"+v"(tid_l)); const int tid=tid_l,lane=tid&63,r32=lane&31,hi=lane>>5; const int wid=__builtin_amdgcn_readfirstlane(tid>>6);
  const bf16*Qw=Qw0+(long)(wid*QBLK)*pqs;
  const unsigned lds0=(unsigned)(uintptr_t)shm;
  float*wsf=(float*)(shm+LDS_WS)+wid*64;
  const bf16*ksrc=Kh+(long)lane*pks+wid*8;
  const bf16*vsrc=Vh+(long)(16*(wid&3)+(lane>>2))*pvs+(wid>>2)*32+(lane&3)*8;
  const unsigned kdst=lds0+LDS_K+wid*1024, vdst=lds0+LDS_V+wid*1024;
  #define DMA_K(t,slot) glds16(ksrc+(long)(t)*KVBLK*pks,(unsigned)__builtin_amdgcn_readfirstlane(kdst+(slot)))
  #define DMA_V(t,slot) glds16(vsrc+(long)(t)*KVBLK*pvs,(unsigned)__builtin_amdgcn_readfirstlane(vdst+(slot)))
  const int vb0=(int)(lds0+LDS_V)+((lane>>4)&1)*32+(lane&3)*8+(4*hi+((lane&15)>>2))*64;
  const char*Kbase=shm+LDS_K; bf16x8 kf[8];
  const lds_cptr shm3=(lds_cptr)shm; const lds_cptr kp0=shm3+LDS_K+hi*1024+r32*16; const lds_cptr vp0=shm3+LDS_V+((lane>>4)&1)*32+(lane&3)*8+(4*hi+((lane&15)>>2))*64;
  DMA_K(0,0);DMA_V(0,0);DMA_K(1,SLOTB);
  bf16x8 qr[4];
  #pragma unroll
  for(int d0=0;d0<4;++d0)qr[d0]=*reinterpret_cast<const bf16x8*>(&Qw[(long)r32*pqs+d0*16+hi*8]);
  if(qgain){
    float f[4][8]; float ss=0.f;
    #pragma unroll
    for(int d0=0;d0<4;++d0){
      #pragma unroll
      for(int i=0;i<8;++i){ f[d0][i]=__builtin_bit_cast(float,((unsigned)(unsigned short)qr[d0][i])<<16); ss+=f[d0][i]*f[d0][i]; } }
    { auto rr=__builtin_amdgcn_permlane32_swap(__float_as_uint(ss),__float_as_uint(ss),false,false); ss=__uint_as_float(rr[0])+__uint_as_float(rr[1]); }
    const float rstd=1.0f/sqrtf(ss*(1.f/64.f)+1e-6f);
    #pragma unroll
    for(int d0=0;d0<4;++d0){ const int dd=d0*16+hi*8;
      #pragma unroll
      for(int i=0;i<8;++i) f[d0][i]*=rstd*qgain[dd+i];
      if(qt0>=0) rope8(f[d0],rtab,dd,qt0+wid*QBLK+r32);
      u32x4 w; w.x=pk2(f[d0][0]*C2,f[d0][1]*C2); w.y=pk2(f[d0][2]*C2,f[d0][3]*C2); w.z=pk2(f[d0][4]*C2,f[d0][5]*C2); w.w=pk2(f[d0][6]*C2,f[d0][7]*C2);
      qr[d0]=__builtin_bit_cast(bf16x8,w); }
  }
  float mhat=0.f,l_reg=0.f;f32x16 o[2];o[0]=f32x16{};o[1]=f32x16{};f32x16 negm=f32x16{};asm volatile("":"+v"(negm));
  #define CMASK(P0,P1,t) do{}while(0)
  bool resc=false;
  #define START(P0,P1) do{ const float rm=rowmax(P0,P1); resc=false; \
    { const float dl=rm; mhat=fadd_s(mhat,dl); \
      _Pragma("unroll") for(int r=0;r<16;++r){P0[r]=fsub_s(P0[r],dl);P1[r]=fsub_s(P1[r],dl);} \
      _Pragma("unroll") for(int r=0;r<16;++r)negm[r]=-mhat; asm volatile("":"+v"(negm)); } \
    _Pragma("unroll") for(int r=0;r<16;++r)P0[r]=__builtin_amdgcn_exp2f(P0[r]); }while(0)
  #define RESC() do{ if(resc){ asm volatile("s_waitcnt lgkmcnt(0)":::"memory"); \
      _Pragma("unroll") for(int d_=0;d_<2;++d_) _Pragma("unroll") for(int r=0;r<16;++r)o[d_][r]*=wsf[crow(r,hi)]; } }while(0)
  f32x16 pA0,pA1,pB0,pB1;
  int sl_prev=0,sl_cur=0,sl_next=SLOTB;
  #define ROT() do{sl_prev=sl_cur;sl_cur=sl_next;sl_next=(sl_next==(NSLOT-1)*SLOTB)?0:sl_next+SLOTB;}while(0)
  DMA_K(2,2*SLOTB);
  WAIT_BAR(3);
  qkt(pA0,pA1,Kbase,qr,negm,r32,hi);asm volatile("s_nop 15\n\ts_nop 7":"+v"(pA0),"+v"(pA1));CMASK(pA0,pA1,0);
  START(pA0,pA1);
  _Pragma("unroll") for(int r=0;r<16;++r)pA1[r]=__builtin_amdgcn_exp2f(pA1[r]);
  WAIT_BAR(0);
  DMA_K(3,0);DMA_V(1,SLOTB);
  ROT();
  kload8(kf,kp0+sl_cur);
  WAIT_BAR(2);
  s16x4 vlo[8],vhi[8]; u32x4 pw0,pw1,pw2,pw3;
  #define PKW(P,B) cvtpk_s(P[B],P[B+1])
  #define PAF(k) __builtin_bit_cast(bf16x8,pw##k)
  #define VFR(i) (bf16x8){vlo[i][0],vlo[i][1],vlo[i][2],vlo[i][3],vhi[i][0],vhi[i][1],vhi[i][2],vhi[i][3]}
  #define PIN(x) asm volatile("":"+v"(x))
  #define MX3(a,b,c) __builtin_fmaxf(__builtin_fmaxf((a),(b)),(c))
  #define GAPA(MF,A0,A1,A2,A3,W0,W1,PW) do{ MF; sacc+=A0; sacc+=A1; sacc+=A2; sacc+=A3; PIN(sacc); W0; W1; PIN(PW); SBAR(); }while(0)
  #define EX(v) __builtin_amdgcn_exp2f(v)
  #define GAPB(MF,X,B) do{ MF; X[B]=EX(X[B]); X[B+1]=EX(X[B+1]); X[B+2]=EX(X[B+2]); X[B+3]=EX(X[B+3]); PIN(X); SBAR(); }while(0)
  #define VRD(i) do{ vlo[i]=vtr(vp_+(((i)>>2)*4096+((i)&3)*1024)); vhi[i]=vtr(vp_+(((i)>>2)*4096+((i)&3)*1024+512)); }while(0)
  #define KRD(G,j) do{ if(G){ kload2(kf,kp0+sl_next,j); SBAR(); } }while(0)
  #define STEP(C0,C1,P0,P1,t,GK,GV,GL) do{ SBAR(); \
    const lds_cptr vp_=vp0+sl_prev; \
    VRD(0); SBAR(); float sacc=(P0[0]+P0[1]); \
    GAPA(C0=__builtin_amdgcn_mfma_f32_32x32x16_bf16(kf[0],qr[0],negm,0,0,0), P0[2],P0[3],P0[4],P0[5],     pw0[0]=PKW(P0,0), pw0[1]=PKW(P0,2), pw0); \
    VRD(4); SBAR(); GAPA(C1=__builtin_amdgcn_mfma_f32_32x32x16_bf16(kf[1],qr[0],negm,0,0,0), P0[6],P0[7],P0[8],P0[9],     pw0[2]=PKW(P0,4), pw0[3]=PKW(P0,6), pw0); \
    VRD(1); SBAR(); GAPA(C0=__builtin_amdgcn_mfma_f32_32x32x16_bf16(kf[2],qr[1],C0,0,0,0),   P0[10],P0[11],P0[12],P0[13], pw1[0]=PKW(P0,8), pw1[1]=PKW(P0,10), pw1); \
    VRD(5); SBAR(); GAPA(C1=__builtin_amdgcn_mfma_f32_32x32x16_bf16(kf[3],qr[1],C1,0,0,0),   P0[14],P0[15],P1[0],P1[1],   pw1[2]=PKW(P0,12),pw1[3]=PKW(P0,14), pw1); \
    VRD(2); SBAR(); GAPA(C0=__builtin_amdgcn_mfma_f32_32x32x16_bf16(kf[4],qr[2],C0,0,0,0),   P1[2],P1[3],P1[4],P1[5],     pw2[0]=PKW(P1,0), pw2[1]=PKW(P1,2), pw2); \
    VRD(6); SBAR(); GAPA(C1=__builtin_amdgcn_mfma_f32_32x32x16_bf16(kf[5],qr[2],C1,0,0,0),   P1[6],P1[7],P1[8],P1[9],     pw2[2]=PKW(P1,4), pw2[3]=PKW(P1,6), pw2); \
    VRD(3); SBAR(); GAPA(C0=__builtin_amdgcn_mfma_f32_32x32x16_bf16(kf[6],qr[3],C0,0,0,0),   P1[10],P1[11],P1[12],P1[13], pw3[0]=PKW(P1,8), pw3[1]=PKW(P1,10), pw3); \
    VRD(7); SBAR(); GAPA(C1=__builtin_amdgcn_mfma_f32_32x32x16_bf16(kf[7],qr[3],C1,0,0,0),   P1[14],P1[15],0.f,0.f,       pw3[2]=PKW(P1,12),pw3[3]=PKW(P1,14), pw3); \
    l_reg+=sacc; \
    if(GK){DMA_K((t)+3,sl_cur);} if(GV){DMA_V((t)+1,sl_next);} \
    CMASK(C0,C1,t); \
    { float a=MX3(C0[0],C0[1],C1[0]),b=MX3(C0[2],C0[3],C1[1]); a=MX3(a,C1[2],C1[3]); \
      _Pragma("unroll") for(int r=4;r<16;r+=4){a=MX3(a,C0[r],C0[r+1]);b=MX3(b,C0[r+2],C0[r+3]);a=MX3(a,C1[r],C1[r+1]);b=MX3(b,C1[r+2],C1[r+3]);} \
      float rm=__builtin_fmaxf(a,b); { auto rr=__builtin_amdgcn_permlane32_swap(__float_as_uint(rm),__float_as_uint(rm),false,false); rm=__builtin_fmaxf(__uint_as_float(rr[0]),__uint_as_float(rr[1])); } \
      resc=false; \
      if(__builtin_expect(__any(rm>(float)THRL),0)){ const float dl=__builtin_fmaxf(rm,0.f); mhat+=dl; \
        _Pragma("unroll") for(int r=0;r<16;++r){C0[r]-=dl;C1[r]-=dl;} \
        _Pragma("unroll") for(int r=0;r<16;++r)negm[r]=-mhat; asm volatile("":"+v"(negm)); \
        const float f=__builtin_amdgcn_exp2f(-dl); l_reg*=f; if(hi==0)wsf[r32]=f; resc=true; } } \
    SBAR(); \
    GAPB(o[0]=__builtin_amdgcn_mfma_f32_32x32x16_bf16(PAF(0),VFR(0),o[0],0,0,0), C0,0); \
    GAPB(o[1]=__builtin_amdgcn_mfma_f32_32x32x16_bf16(PAF(0),VFR(4),o[1],0,0,0), C0,4); \
    KRD(GL,0); GAPB(o[0]=__builtin_amdgcn_mfma_f32_32x32x16_bf16(PAF(1),VFR(1),o[0],0,0,0), C0,8); \
    KRD(GL,1); GAPB(o[1]=__builtin_amdgcn_mfma_f32_32x32x16_bf16(PAF(1),VFR(5),o[1],0,0,0), C0,12); \
    KRD(GL,2); GAPB(o[0]=__builtin_amdgcn_mfma_f32_32x32x16_bf16(PAF(2),VFR(2),o[0],0,0,0), C1,0); \
    KRD(GL,3); GAPB(o[1]=__builtin_amdgcn_mfma_f32_32x32x16_bf16(PAF(2),VFR(6),o[1],0,0,0), C1,4); \
    GAPB(o[0]=__builtin_amdgcn_mfma_f32_32x32x16_bf16(PAF(3),VFR(3),o[0],0,0,0), C1,8); \
    GAPB(o[1]=__builtin_amdgcn_mfma_f32_32x32x16_bf16(PAF(3),VFR(7),o[1],0,0,0), C1,12); \
    }while(0)
  int t=1;
  #undef CMASK
  #define CMASK(P0,P1,t) do{}while(0)
  for(;t+5<NT;t+=2){
    STEP(pB0,pB1,pA0,pA1,t,true,true,true);     WAIT_BAR(2); RESC(); ROT();
    STEP(pA0,pA1,pB0,pB1,t+1,true,true,true);   WAIT_BAR(2); RESC(); ROT();
  }
  #undef CMASK
  #define CMASK(P0,P1,t) do{}while(0)
  #define ENDW(tt) do{ if((tt)+3<NT){WAIT_BAR(2);} else if((tt)+2<NT){WAIT_BAR(1);} else {WAIT_BAR(0);} }while(0)
  for(;t+1<NT;t+=2){
    STEP(pB0,pB1,pA0,pA1,t,(t+3<NT),(t+1<NT),(t+1<NT));       ENDW(t);   RESC(); ROT();
    STEP(pA0,pA1,pB0,pB1,t+1,(t+4<NT),(t+2<NT),(t+2<NT));     ENDW(t+1); RESC(); ROT();
  }
  STEP(pB0,pB1,pA0,pA1,NT-1,false,false,false); RESC();
  { float sacc=pB0[0]+pB0[1]; _Pragma("unroll") for(int r=2;r<16;++r)sacc+=pB0[r]; _Pragma("unroll") for(int r=0;r<16;++r)sacc+=pB1[r]; l_reg+=sacc;
    pw0=(u32x4){PKW(pB0,0),PKW(pB0,2),PKW(pB0,4),PKW(pB0,6)};pw1=(u32x4){PKW(pB0,8),PKW(pB0,10),PKW(pB0,12),PKW(pB0,14)};pw2=(u32x4){PKW(pB1,0),PKW(pB1,2),PKW(pB1,4),PKW(pB1,6)};pw3=(u32x4){PKW(pB1,8),PKW(pB1,10),PKW(pB1,12),PKW(pB1,14)};
    SBAR(); pv(o,vb0+sl_cur,PAF(0),PAF(1),PAF(2),PAF(3)); }
  #undef PKW
  #undef PAF
  #undef VFR
  #undef PIN
  #undef MX3
  #undef GAPA
  #undef GAPB
  #undef EX
  #undef VRD
  #undef KRD
  #undef STEP
  #undef ENDW
  {auto rr=__builtin_amdgcn_permlane32_swap(__float_as_uint(l_reg),__float_as_uint(l_reg),false,false);l_reg=__uint_as_float(rr[0])+__uint_as_float(rr[1]);}
  if(hi==0)wsf[32+r32]=l_reg;asm volatile("s_waitcnt lgkmcnt(0)":::"memory");
  float rli[16];
  #pragma unroll
  for(int r=0;r<16;++r)rli[r]=__builtin_amdgcn_rcpf(wsf[32+crow(r,hi)]);
  bf16*Ow=Ow0+(long)(wid*QBLK)*pos_;
  { bf16*stg=(bf16*)(shm+LDS_OST)+wid*2048;
    #pragma unroll
    for(int r=0;r<16;++r){const int orow=crow(r,hi);
      #pragma unroll
      for(int d0=0;d0<2;++d0)stg[orow*64+d0*32+r32]=__float2bfloat16(o[d0][r]*rli[r]);}
    asm volatile("s_waitcnt lgkmcnt(0)":::"memory");
    #pragma unroll
    for(int i=0;i<4;++i){const int row=i*8+(lane>>3),ch=lane&7; const u32x4 v=*(const u32x4*)(stg+row*64+ch*8); ATTN_STORE16(Ow+(long)row*pos_+ch*8,v);} }
  asm volatile("s_waitcnt lgkmcnt(0)\n\ts_barrier":::"memory");
  #undef DMA_K
  #undef DMA_V
  #undef CMASK
  #undef START
  #undef RESC
  #undef ROT
}
constexpr int ATTN_LDS_BYTES=LDS_BYTES;
#undef SBAR
#undef WAIT_BAR
}
struct Args { const float* in[26]; float* out; unsigned char* ws; };

template <int ACT  > struct EpiAct {
    static constexpr bool PERM = true, AFTER_DRAIN = false;
    bf16_t* O; int ldc;
    __device__ __forceinline__ void operator()(const pg8::f32x4 (&acc)[2][2][4][2], const pg8::Unit& u, int wr, int wc, int fr, int fq) const {
        const int row0 = u.pm * 256 + wr * 64 + fr, col0 = u.pn * 256 + wc * 32 + 8 * fq;
#pragma unroll
        for (int ai = 0; ai < 2; ++ai)
#pragma unroll
            for (int m = 0; m < 4; ++m) { bf16_t* rowp = O + (size_t)(row0 + ai * 128 + m * 16) * ldc + col0;
#pragma unroll
                for (int bj = 0; bj < 2; ++bj) { float v[8];
#pragma unroll
                    for (int i = 0; i < 4; ++i) { v[i] = acc[ai][bj][m][0][i]; v[4 + i] = acc[ai][bj][m][1][i]; }
#pragma unroll
                    for (int i = 0; i < 8; ++i) {
                        if (ACT == 1) v[i] = 1.f / (1.f + __expf(-v[i]));
                        if (ACT == 2) { const float r = fmaxf(v[i], 0.f); v[i] = r * r; } }
                    pg8::u32x4 w; w.x = pg8::cvt_pk_bf16(v[0], v[1]); w.y = pg8::cvt_pk_bf16(v[2], v[3]); w.z = pg8::cvt_pk_bf16(v[4], v[5]); w.w = pg8::cvt_pk_bf16(v[6], v[7]);
                    *(pg8::u32x4*)(rowp + bj * 128) = w; } }
    }
};
struct EpiF32 {
    static constexpr bool PERM = true, AFTER_DRAIN = false;
    float* O; int ldc;
    __device__ __forceinline__ void operator()(const pg8::f32x4 (&acc)[2][2][4][2], const pg8::Unit& u, int wr, int wc, int fr, int fq) const {
        const int row0 = u.pm * 256 + wr * 64 + fr, col0 = u.pn * 256 + wc * 32 + 8 * fq;
#pragma unroll
        for (int ai = 0; ai < 2; ++ai)
#pragma unroll
            for (int m = 0; m < 4; ++m) { float* rowp = O + (size_t)(row0 + ai * 128 + m * 16) * ldc + col0;
#pragma unroll
                for (int bj = 0; bj < 2; ++bj) { *(pg8::f32x4*)(rowp + bj * 128) = acc[ai][bj][m][0]; *(pg8::f32x4*)(rowp + bj * 128 + 4) = acc[ai][bj][m][1]; } }
    }
};
struct EpiBranch {
    static constexpr bool PERM = true, AFTER_DRAIN = false;
    bf16_t* GO; float* ACC; int mode;
    __device__ __forceinline__ void fin(const pg8::u32x4 g, const pg8::f32x4 a0, const pg8::f32x4 a1, pg8::f32x4 v0, pg8::f32x4 v1, size_t idx) const {
        v0[0] *= bflo(g.x); v0[1] *= bfhi(g.x); v0[2] *= bflo(g.y); v0[3] *= bfhi(g.y);
        v1[0] *= bflo(g.z); v1[1] *= bfhi(g.z); v1[2] *= bflo(g.w); v1[3] *= bfhi(g.w);
        if (mode > 0) { v0 += a0; v1 += a1; }
        if (mode < 2) { *(pg8::f32x4*)(ACC + idx) = v0; *(pg8::f32x4*)(ACC + idx + 4) = v1; }
        else { pg8::u32x4 w; w.x = pg8::cvt_pk_bf16(v0[0], v0[1]); w.y = pg8::cvt_pk_bf16(v0[2], v0[3]); w.z = pg8::cvt_pk_bf16(v1[0], v1[1]); w.w = pg8::cvt_pk_bf16(v1[2], v1[3]); *(pg8::u32x4*)(GO + idx) = w; }
    }
    __device__ __forceinline__ void operator()(const pg8::f32x4 (&acc)[2][2][4][2], const pg8::Unit& u, int wr, int wc, int fr, int fq) const {
        const int row0 = u.pm * 256 + wr * 64 + fr, col0 = u.pn * 256 + wc * 32 + 8 * fq;
#pragma unroll
        for (int ai = 0; ai < 2; ++ai)
#pragma unroll
            for (int bj = 0; bj < 2; ++bj)
#pragma unroll
                for (int mh = 0; mh < 4; mh += 2) {
                    const size_t ia = (size_t)(row0 + ai * 128 + mh * 16) * 1024 + col0 + bj * 128, ib = ia + (size_t)16 * 1024;
                    const pg8::u32x4 ga = *(const pg8::u32x4*)(GO + ia), gb = *(const pg8::u32x4*)(GO + ib);
                    pg8::f32x4 aa0 = {0.f, 0.f, 0.f, 0.f}, aa1 = aa0, ab0 = aa0, ab1 = aa0;
                    if (mode > 0) { aa0 = *(const pg8::f32x4*)(ACC + ia); aa1 = *(const pg8::f32x4*)(ACC + ia + 4); ab0 = *(const pg8::f32x4*)(ACC + ib); ab1 = *(const pg8::f32x4*)(ACC + ib + 4); }
                    fin(ga, aa0, aa1, acc[ai][bj][mh][0], acc[ai][bj][mh][1], ia);
                    fin(gb, ab0, ab1, acc[ai][bj][mh + 1][0], acc[ai][bj][mh + 1][1], ib);
                }
    }
};
struct EpiIn {
    static constexpr bool PERM = true, AFTER_DRAIN = false;
    unsigned char* ws;
    __device__ __forceinline__ void operator()(const pg8::f32x4 (&acc)[2][2][4][2], const pg8::Unit& u, int wr, int wc, int fr, int fq) const {
        const bool latent = u.pm < (ML / 256);
        const int cw = wc * 32 + 8 * fq;
        bf16_t* const poolin = (bf16_t*)(ws + WS_POOLIN); bf16_t* const qd = (bf16_t*)(ws + WS_QD); bf16_t* const qg = (bf16_t*)(ws + WS_QG); bf16_t* const kd = (bf16_t*)(ws + WS_KD);
        bf16_t* const vd = (bf16_t*)(ws + WS_VD); bf16_t* const kg = (bf16_t*)(ws + WS_KG); bf16_t* const vg = (bf16_t*)(ws + WS_VG); const float* const rope = (const float*)(ws + WS_ROPE);
#pragma unroll
        for (int bj = 0; bj < 2; ++bj) {
            const int cb = u.pn * 2 + bj;
            bf16_t* base; int pitch, coff; bool kvmap = false, dorope = false; float sc = 1.f;
            if (cb < 4) { base = poolin; pitch = 512; coff = cb * 128; }
            else if (cb < 8) { base = qd; pitch = 512; coff = (cb - 4) * 128; dorope = latent; sc = QC2; }
            else if (cb < 12) { base = qg; pitch = 512; coff = (cb - 8) * 128; }
            else if (cb < 16) { base = kd; pitch = 512; coff = (cb - 12) * 128; kvmap = true; dorope = latent; }
            else if (cb < 20) { base = vd; pitch = 512; coff = (cb - 16) * 128; kvmap = true; }
            else if (cb == 20) { base = kg; pitch = 128; coff = 0; kvmap = true; }
            else { base = vg; pitch = 128; coff = 0; kvmap = true; }
#pragma unroll
            for (int ai = 0; ai < 2; ++ai)
#pragma unroll
                for (int mh = 0; mh < 4; mh += 2) {
                    const int rowa = u.pm * 256 + ai * 128 + wr * 64 + mh * 16 + fr, rowb = rowa + 16;
                    f32x4 ta0 = {1.f, 0.f, 1.f, 0.f}, ta1 = ta0, tb0 = ta0, tb1 = ta0;
                    if (dorope) { const int p0 = (cw & 63) >> 1, j0 = p0 & 15, ta = rowa & 4095, tb = rowb & 4095, posa = p0 < 16 ? (ta >> 6) : (ta & 63), posb = p0 < 16 ? (tb >> 6) : (tb & 63);
                        const f32x4* pa = (const f32x4*)(rope + (posa * 16 + j0) * 2); const f32x4* pb = (const f32x4*)(rope + (posb * 16 + j0) * 2);
                        ta0 = pa[0]; ta1 = pa[1]; tb0 = pb[0]; tb1 = pb[1]; }
#pragma unroll
                    for (int h2 = 0; h2 < 2; ++h2) {
                        const int m = mh + h2, row = h2 ? rowb : rowa;
                        const f32x4 t0 = h2 ? tb0 : ta0, t1 = h2 ? tb1 : ta1;
                        const int drow = kvmap ? kvrow_of(row) : row;
                        float v[8];
#pragma unroll
                        for (int i = 0; i < 4; ++i) { v[i] = acc[ai][bj][m][0][i]; v[4 + i] = acc[ai][bj][m][1][i]; }
                        if (dorope) { float o[8];
                            o[0] = v[0] * t0[0] - v[1] * t0[1]; o[1] = v[0] * t0[1] + v[1] * t0[0];
                            o[2] = v[2] * t0[2] - v[3] * t0[3]; o[3] = v[2] * t0[3] + v[3] * t0[2];
                            o[4] = v[4] * t1[0] - v[5] * t1[1]; o[5] = v[4] * t1[1] + v[5] * t1[0];
                            o[6] = v[6] * t1[2] - v[7] * t1[3]; o[7] = v[6] * t1[3] + v[7] * t1[2];
#pragma unroll
                            for (int i = 0; i < 8; ++i) v[i] = o[i]; }
#pragma unroll
                        for (int i = 0; i < 8; ++i) v[i] *= sc;
                        pg8::u32x4 w; w.x = pg8::cvt_pk_bf16(v[0], v[1]); w.y = pg8::cvt_pk_bf16(v[2], v[3]); w.z = pg8::cvt_pk_bf16(v[4], v[5]); w.w = pg8::cvt_pk_bf16(v[6], v[7]);
                        *(pg8::u32x4*)(base + (size_t)drow * pitch + coff + cw) = w;
                    }
                }
        }
    }
};
struct SchedG {
    pg8::StaticOrder so; const char* A; const char* Bt; int ld, nt;
    __device__ __forceinline__ void init(const void* A_, const void* Bt_, int M, int N, int K, int G, int c) { so.init(M, N, G, c); A = (const char*)A_; Bt = (const char*)Bt_; ld = K * 2; nt = K / 64; }
    __device__ __forceinline__ bool next(int i, pg8::Unit& u) const { if (!so.next(i, u)) return false;
        u.A = A + (size_t)u.pm * 256 * ld; u.B = Bt + (size_t)u.pn * 256 * ld; u.lda = ld; u.ldb = ld; u.nt = nt; u.seg = 0; return true; }
    __device__ __forceinline__ void a_ready(const pg8::Unit&) const {}
    __device__ __forceinline__ void done(const pg8::Unit&) const {}
};
struct SchedP4 {
    pg8::StaticOrder so; const char* ws;
    __device__ __forceinline__ void init(const unsigned char* ws_, int M, int G, int c) { so.init(M, 1024, G, c); ws = (const char*)ws_; }
    __device__ __forceinline__ bool next(int i, pg8::Unit& u) const { const int job = i / 6, seg = i - job * 6, b = seg >> 1; if (!so.next(job, u)) return false;
        if ((seg & 1) == 0) { u.A = ws + WS_H + (size_t)u.pm * 256 * 2048; u.lda = 2048; u.B = ws + W_IN + (size_t)(N1 + b * 1024 + u.pn * 256) * 2048; u.ldb = 2048; u.nt = 16; }
        else { const size_t ao = b == 0 ? WS_POOLO : b == 1 ? WS_DIFFO : WS_GQAO, bo = b == 0 ? W_PO : b == 1 ? W_DO : W_GO;
            u.A = ws + ao + (size_t)u.pm * 256 * 1024; u.lda = 1024; u.B = ws + bo + (size_t)u.pn * 256 * 1024; u.ldb = 1024; u.nt = 8; }
        u.seg = seg; return true; }
    __device__ __forceinline__ void a_ready(const pg8::Unit&) const {}
    __device__ __forceinline__ void done(const pg8::Unit&) const {}
};
constexpr size_t WS_ZP = 244 * MiB;
struct SchedP8C {
    pg8::StaticOrder so; const char* ws; int G, c;
    __device__ __forceinline__ void init(const unsigned char* ws_, int G_, int c_) { so.init(ML, 1024, G_, c_); ws = (const char*)ws_; G = G_; c = c_; }
    __device__ __forceinline__ bool next(int i, pg8::Unit& u) const { const long L = (long)i * G + c;
        if (L < 256) { so.next(i, u); u.A = ws + WS_U + (size_t)u.pm * 256 * 8192; u.B = ws + W_2 + (size_t)u.pn * 256 * 8192; u.lda = 8192; u.ldb = 8192; u.nt = 64; u.seg = 0; return true; }
        if (L < 320) { const int p = (int)L - 256, kc = p & 3; u.pn = (p >> 2) & 3; u.pm = ML / 256 + (p >> 4);
            u.A = ws + WS_U + (size_t)u.pm * 256 * 8192 + kc * 2048; u.B = ws + W_2 + (size_t)u.pn * 256 * 8192 + kc * 2048; u.lda = 8192; u.ldb = 8192; u.nt = 16; u.seg = 1 + kc; return true; }
        return false; }
    __device__ __forceinline__ void a_ready(const pg8::Unit&) const {}
    __device__ __forceinline__ void done(const pg8::Unit&) const {}
};
struct EpiP4 {
    static constexpr bool PERM = true, AFTER_DRAIN = false;
    bf16_t* GO; float* ACC;
    __device__ __forceinline__ void operator()(const pg8::f32x4 (&acc)[2][2][4][2], const pg8::Unit& u, int wr, int wc, int fr, int fq) const {
        if ((u.seg & 1) == 0) { EpiAct<1> e{GO, 1024}; e(acc, u, wr, wc, fr, fq); }
        else { EpiBranch e{GO, ACC, u.seg >> 1}; e(acc, u, wr, wc, fr, fq); }
    }
};
struct EpiP8 {
    static constexpr bool PERM = true, AFTER_DRAIN = false;
    float* Z; float* ZP;
    __device__ __forceinline__ void operator()(const pg8::f32x4 (&acc)[2][2][4][2], const pg8::Unit& u, int wr, int wc, int fr, int fq) const {
        float* base = Z; pg8::Unit v = u;
        if (u.seg > 1) { base = ZP + (size_t)(u.seg - 2) * MC * 1024; v.pm = u.pm - ML / 256; }
        EpiF32 e{base, 1024}; e(acc, v, wr, wc, fr, fq);
    }
};
__device__ __forceinline__ void head_norm_fix(bf16_t* p, const float* gain, bool dorope, int t, float sc, const float* tab) {
    float ss = 0.f;
#pragma unroll
    for (int ch = 0; ch < 8; ++ch) { const v4u w = *(const v4u*)(p + ch * 8);
        const float a0 = bflo(w.x), a1 = bfhi(w.x), a2 = bflo(w.y), a3 = bfhi(w.y), a4 = bflo(w.z), a5 = bfhi(w.z), a6 = bflo(w.w), a7 = bfhi(w.w);
        ss += (a0 * a0 + a1 * a1) + (a2 * a2 + a3 * a3) + (a4 * a4 + a5 * a5) + (a6 * a6 + a7 * a7); }
    const float rstd = 1.0f / sqrtf(ss * (1.f / 64.f) + EPSN);
#pragma unroll
    for (int ch = 0; ch < 8; ++ch) { const v4u w = *(const v4u*)(p + ch * 8);
        float v[8] = {bflo(w.x), bfhi(w.x), bflo(w.y), bfhi(w.y), bflo(w.z), bfhi(w.z), bflo(w.w), bfhi(w.w)};
        const f32x4 g0 = *(const f32x4*)(gain + ch * 8), g1 = *(const f32x4*)(gain + ch * 8 + 4);
        v[0] *= rstd * g0[0]; v[1] *= rstd * g0[1]; v[2] *= rstd * g0[2]; v[3] *= rstd * g0[3];
        v[4] *= rstd * g1[0]; v[5] *= rstd * g1[1]; v[6] *= rstd * g1[2]; v[7] *= rstd * g1[3];
        if (dorope) rope8(v, tab, ch * 8, t);
        v4u o; o.x = pk2(v[0] * sc, v[1] * sc); o.y = pk2(v[2] * sc, v[3] * sc); o.z = pk2(v[4] * sc, v[5] * sc); o.w = pk2(v[6] * sc, v[7] * sc);
        *(v4u*)(p + ch * 8) = o; }
}

__device__ __forceinline__ void transpose_item(const float* W, int K, int N, bf16* WT, int k0, int n0, int drow0, LAS float* scr, int lane) {
#pragma unroll 8
    for (int i = 0; i < 32; ++i) { const int kk = 2 * i + (lane >> 5); scr[kk * 33 + (lane & 31)] = W[(size_t)(k0 + kk) * N + n0 + (lane & 31)]; }
    asm volatile("s_waitcnt lgkmcnt(0)" ::: "memory");
    const int c = lane & 7;
#pragma unroll
    for (int j = 0; j < 4; ++j) { const int n = (lane >> 3) + 8 * j; const LAS float* s = scr + (8 * c) * 33 + n;
        v4u o; o.x = pk2(s[0 * 33], s[1 * 33]); o.y = pk2(s[2 * 33], s[3 * 33]); o.z = pk2(s[4 * 33], s[5 * 33]); o.w = pk2(s[6 * 33], s[7 * 33]);
        *(v4u*)(WT + (size_t)(drow0 + n) * K + k0 + 8 * c) = o; }
    asm volatile("s_waitcnt lgkmcnt(0)" ::: "memory");
}
struct WPtrs { const float *w_in, *w_grp, *pscale, *w_po, *w_do, *w_go, *w_o, *w_1, *w_2; };
__device__ __forceinline__ void convert_weights(const WPtrs& p, int l, unsigned char* ws, LAS unsigned char* lds, int gw, int NGW, int wave, int lane, int gtid, int NTH) {
    LAS float* scr = (LAS float*)(lds + wave * 16384);
    constexpr int I_IN = (1024 / 64) * (5888 / 32), I_BR = (512 / 64) * (1024 / 32), I_O = (1024 / 64) * (1024 / 32), I_1 = (1024 / 64) * (4096 / 32), I_2 = (4096 / 64) * (1024 / 32);
    constexpr int NITEMS = I_IN + 3 * I_BR + I_O + I_1 + I_2;
    for (int it = gw; it < NITEMS; it += NGW) {
        int r = it;
        if (r < I_IN) { const int nblk = 5888 / 32, kb = r / nblk, nb = r % nblk, n0 = nb * 32;
            const int d0 = n0 < 1536 ? n0 : (n0 < 4608 ? n0 - 1536 + N1 : n0 - 4608 + 1536);
            transpose_item(p.w_in + (size_t)l * 1024 * 5888, 1024, 5888, (bf16*)(ws + W_IN), kb * 64, n0, d0, scr, lane); continue; } r -= I_IN;
        if (r < I_BR) { const int nblk = 1024 / 32, kb = r / nblk, nb = r % nblk;
            transpose_item(p.w_po + (size_t)l * 512 * 1024, 512, 1024, (bf16*)(ws + W_PO), kb * 64, nb * 32, nb * 32, scr, lane); continue; } r -= I_BR;
        if (r < I_BR) { const int nblk = 1024 / 32, kb = r / nblk, nb = r % nblk;
            transpose_item(p.w_do + (size_t)l * 512 * 1024, 512, 1024, (bf16*)(ws + W_DO), kb * 64, nb * 32, nb * 32, scr, lane); continue; } r -= I_BR;
        if (r < I_BR) { const int nblk = 1024 / 32, kb = r / nblk, nb = r % nblk;
            transpose_item(p.w_go + (size_t)l * 512 * 1024, 512, 1024, (bf16*)(ws + W_GO), kb * 64, nb * 32, nb * 32, scr, lane); continue; } r -= I_BR;
        if (r < I_O) { const int nblk = 1024 / 32, kb = r / nblk, nb = r % nblk;
            transpose_item(p.w_o + (size_t)l * 1024 * 1024, 1024, 1024, (bf16*)(ws + W_O), kb * 64, nb * 32, nb * 32, scr, lane); continue; } r -= I_O;
        if (r < I_1) { const int nblk = 4096 / 32, kb = r / nblk, nb = r % nblk;
            transpose_item(p.w_1 + (size_t)l * 1024 * 4096, 1024, 4096, (bf16*)(ws + W_1), kb * 64, nb * 32, nb * 32, scr, lane); continue; } r -= I_1;
        { const int nblk = 1024 / 32, kb = r / nblk, nb = r % nblk;
            transpose_item(p.w_2 + (size_t)l * 4096 * 1024, 4096, 1024, (bf16*)(ws + W_2), kb * 64, nb * 32, nb * 32, scr, lane); }
    }
    const float* wg = p.w_grp + (size_t)l * 4 * 128 * 128; const float* psc = p.pscale + l * 512;
    unsigned* PT = (unsigned*)(ws + W_POOL);
    for (int i = gtid; i < 512 * 256; i += NTH) { const int n = i >> 8, k = (i & 255) * 2, g = n >> 7; float v0 = 0.f, v1 = 0.f;
        if ((k >> 7) == g) { const float* q = wg + ((size_t)(g * 128 + (k & 127))) * 128 + (n & 127); const float s = psc[n]; v0 = q[0] * s; v1 = q[128] * s; }
        PT[i] = pk2(v0, v1); }
}
__device__ __forceinline__ void mod_gemv(const float* cvec, const float* cctx, const float* wmod, const float* bmod, float* modout, LAS unsigned char* lds, int tid, int lane, int wave, int bx) {
    LAS float* st = (LAS float*)lds;
    LAS float* red = (LAS float*)(lds + 32768);
    for (int i = tid; i < 5 * 1024; i += NTHR) { const int bb = i >> 10, k = i & 1023; const float v = bb < 4 ? cvec[bb * 1024 + k] : cctx[k]; st[i] = v / (1.f + expf(-v)); }
    __syncthreads();
    if (bx < 192) {
        const int l = bx / 96, n0 = (bx % 96) * 64;
        const float* w = wmod + (size_t)l * 1024 * NMOD + n0 + lane;
        float a0 = 0.f, a1 = 0.f, a2 = 0.f, a3 = 0.f, a4 = 0.f;
        const int k0 = wave * 128;
#pragma unroll 16
        for (int kk = 0; kk < 128; ++kk) { const float wv = w[(size_t)(k0 + kk) * NMOD]; const int k = k0 + kk;
            a0 += st[k] * wv; a1 += st[1024 + k] * wv; a2 += st[2048 + k] * wv; a3 += st[3072 + k] * wv; a4 += st[4096 + k] * wv; }
        red[(wave * 5 + 0) * 64 + lane] = a0; red[(wave * 5 + 1) * 64 + lane] = a1; red[(wave * 5 + 2) * 64 + lane] = a2; red[(wave * 5 + 3) * 64 + lane] = a3; red[(wave * 5 + 4) * 64 + lane] = a4;
        __syncthreads();
        if (tid < 320) { const int bb = tid >> 6; float s = bmod[l * NMOD + n0 + lane];
#pragma unroll
            for (int w8 = 0; w8 < 8; ++w8) s += red[(w8 * 5 + bb) * 64 + lane];
            modout[(l * 5 + bb) * NMOD + n0 + lane] = s; }
    }
    __syncthreads();
}
__device__ __forceinline__ void norm_phase(int M, const float* xs_lat, const float* xs_ctx, float* xd_lat, float* xd_ctx, const float* z, const float* zp, const float* modl, int gtc, const float* gpost,
                                           bf16* hdst, const float* gnext, const float* modn, int shc, int scc, int gw, int NGW, int lane) {
    for (int m = gw; m < M; m += NGW) {
        const bool lat = m < ML; const int bb = lat ? (m >> 12) : 4;
        const float* xs = lat ? xs_lat + (size_t)m * 1024 : xs_ctx + (size_t)(m - ML) * 1024;
        f32x4 v[4];
#pragma unroll
        for (int j = 0; j < 4; ++j) v[j] = *(const f32x4*)(xs + 4 * lane + 256 * j);
        float* xd = lat ? xd_lat + (size_t)m * 1024 : xd_ctx + (size_t)(m - ML) * 1024;
        if (!z) {
#pragma unroll
            for (int j = 0; j < 4; ++j) *(f32x4*)(xd + 4 * lane + 256 * j) = v[j];
        } else {
            f32x4 zz[4]; float ss = 0.f;
#pragma unroll
            for (int j = 0; j < 4; ++j) { zz[j] = *(const f32x4*)(z + (size_t)m * 1024 + 4 * lane + 256 * j);
                if (zp && !lat) {
#pragma unroll
                    for (int kc = 0; kc < 3; ++kc) zz[j] += *(const f32x4*)(zp + ((size_t)kc * MC + (m - ML)) * 1024 + 4 * lane + 256 * j); }
                ss += (zz[j][0] * zz[j][0] + zz[j][1] * zz[j][1]) + (zz[j][2] * zz[j][2] + zz[j][3] * zz[j][3]); }
            const float rz = 1.0f / sqrtf(wave_sum(ss) * (1.f / 1024.f) + EPSN);
            const float* gt = modl + bb * NMOD + gtc * 1024;
#pragma unroll
            for (int j = 0; j < 4; ++j) { const int c = 4 * lane + 256 * j; const f32x4 g4 = *(const f32x4*)(gpost + c), t4 = *(const f32x4*)(gt + c);
                v[j] = v[j] + t4 * ((zz[j] * rz) * g4); *(f32x4*)(xd + c) = v[j]; }
        }
        if (hdst) {
            float ss = 0.f;
#pragma unroll
            for (int j = 0; j < 4; ++j) ss += (v[j][0] * v[j][0] + v[j][1] * v[j][1]) + (v[j][2] * v[j][2] + v[j][3] * v[j][3]);
            const float rx = 1.0f / sqrtf(wave_sum(ss) * (1.f / 1024.f) + EPSN);
            const float* sh = modn + bb * NMOD + shc * 1024; const float* sc = modn + bb * NMOD + scc * 1024;
#pragma unroll
            for (int j = 0; j < 4; ++j) { const int c = 4 * lane + 256 * j; const f32x4 g4 = *(const f32x4*)(gnext + c), s4 = *(const f32x4*)(sc + c), h4 = *(const f32x4*)(sh + c);
                const f32x4 o = ((v[j] * rx) * g4) * (s4 + 1.0f) + h4;
                v2u w; w.x = pk2(o[0], o[1]); w.y = pk2(o[2], o[3]); *(v2u*)(hdst + (size_t)m * 1024 + c) = w; }
        }
    }
}
__device__ __forceinline__ void pool_phase(int M, const bf16* zin, bf16* pooled, int gtid, int NTH) {
    for (int it = gtid; it < M * 64; it += NTH) {
        const int m = it >> 6, ch = it & 63, g = ch >> 4, w2 = 1 << g;
        int t, l;
        if (m < ML) { t = m & 4095; l = SEQL; } else { t = (m - ML) & 255; l = CTXL; }
        const int base = m - t, lo = max(t - w2, 0), hi = min(t + w2, l);
        v4u w[16];
#pragma unroll
        for (int dj = 0; dj < 16; ++dj) { const int j = t + dj - 8; const int jj = min(max(j, lo), hi - 1);
            w[dj] = *(const v4u*)(zin + (size_t)(base + jj) * 512 + ch * 8); }
        float s[8];
#pragma unroll
        for (int i = 0; i < 8; ++i) s[i] = 0.f;
#pragma unroll
        for (int dj = 0; dj < 16; ++dj) { const int j = t + dj - 8; const float k = (j >= lo && j < hi) ? 1.0f : 0.0f;
            s[0] += k * bflo(w[dj].x); s[1] += k * bfhi(w[dj].x); s[2] += k * bflo(w[dj].y); s[3] += k * bfhi(w[dj].y);
            s[4] += k * bflo(w[dj].z); s[5] += k * bfhi(w[dj].z); s[6] += k * bflo(w[dj].w); s[7] += k * bfhi(w[dj].w); }
        const float inv = 1.0f / (float)(hi - lo);
        const v4u ws_ = w[8];
        v4u o; o.x = pk2(s[0] * inv - bflo(ws_.x), s[1] * inv - bfhi(ws_.x)); o.y = pk2(s[2] * inv - bflo(ws_.y), s[3] * inv - bfhi(ws_.y));
        o.z = pk2(s[4] * inv - bflo(ws_.z), s[5] * inv - bfhi(ws_.z)); o.w = pk2(s[6] * inv - bflo(ws_.w), s[7] * inv - bfhi(ws_.w));
        *(v4u*)(pooled + (size_t)m * 512 + ch * 8) = o;
    }
}
__device__ __forceinline__ void diff_combine_phase(int M, const bf16* od, bf16* diffo, const float* subln, float lam, float lam_init, int gtid, int NTH) {
    for (int it = gtid; it < M * 64; it += NTH) {
        const int l16 = it & 15, hd = (it >> 4) & 3, m = it >> 6;
        const bf16* p1 = od + (size_t)m * 1024 + hd * 256 + l16 * 8;
        const v4u a = *(const v4u*)p1, b = *(const v4u*)(p1 + 128);
        float d[8];
        d[0] = bflo(a.x) - lam * bflo(b.x); d[1] = bfhi(a.x) - lam * bfhi(b.x); d[2] = bflo(a.y) - lam * bflo(b.y); d[3] = bfhi(a.y) - lam * bfhi(b.y);
        d[4] = bflo(a.z) - lam * bflo(b.z); d[5] = bfhi(a.z) - lam * bfhi(b.z); d[6] = bflo(a.w) - lam * bflo(b.w); d[7] = bfhi(a.w) - lam * bfhi(b.w);
        float ss = 0.f;
#pragma unroll
        for (int i = 0; i < 8; ++i) ss += d[i] * d[i];
        ss += __shfl_xor(ss, 1); ss += __shfl_xor(ss, 2); ss += __shfl_xor(ss, 4); ss += __shfl_xor(ss, 8);
        const float rstd = 1.0f / sqrtf(ss * (1.f / 128.f) + EPSN), k1 = 1.0f - lam_init;
        const f32x4 g0 = *(const f32x4*)(subln + l16 * 8), g1 = *(const f32x4*)(subln + l16 * 8 + 4);
        v4u o; o.x = pk2(d[0] * rstd * g0[0] * k1, d[1] * rstd * g0[1] * k1); o.y = pk2(d[2] * rstd * g0[2] * k1, d[3] * rstd * g0[3] * k1);
        o.z = pk2(d[4] * rstd * g1[0] * k1, d[5] * rstd * g1[1] * k1); o.w = pk2(d[6] * rstd * g1[2] * k1, d[7] * rstd * g1[3] * k1);
        *(v4u*)(diffo + (size_t)m * 512 + hd * 128 + l16 * 8) = o;
    }
}

#define RLX_AGENT __ATOMIC_RELAXED, __HIP_MEMORY_SCOPE_AGENT
#define XB_TMO      128
#define XB_XCNT(j)  (256  + 64 * (j))
#define XB_XSUB(j)  (1280 + 64 * (j))
#define XB_XGEN(j)  (2304 + 64 * (j))
#define XB_TOP      3328
#define XB_TOPGEN   3392
#define XCD_BAR_WORDS 3456
#define XB_SPIN_CAP (1u << 22)

__device__ __forceinline__ unsigned xb_ld(unsigned* p)              { return __hip_atomic_load(p, __ATOMIC_RELAXED, __HIP_MEMORY_SCOPE_AGENT); }
__device__ __forceinline__ unsigned xb_add(unsigned* p, unsigned v) { return __hip_atomic_fetch_add(p, v, __ATOMIC_RELAXED, __HIP_MEMORY_SCOPE_AGENT); }
__device__ __forceinline__ unsigned xb_xcc_id() { return (unsigned)__builtin_amdgcn_s_getreg((3 << 11) | 20) & 0xFu; }
#define XB_SPIN(cond, bar) do { unsigned _sp = 0; while (cond) { __builtin_amdgcn_s_sleep(1); \
    if ((++_sp & 255u) == 0u) { if (xb_ld(&(bar)[XB_TMO])) break; if (_sp > XB_SPIN_CAP) { atomicAdd(&(bar)[XB_TMO], 1u); break; } } } } while (0)

struct XcdBarrier {
    unsigned* bar; unsigned x;
    volatile LAS unsigned* st;
};

__device__ __forceinline__ XcdBarrier xcd_barrier_post(unsigned* bar, volatile LAS unsigned* st) {
    XcdBarrier b; b.bar = bar; b.x = xb_xcc_id(); b.st = st;
    if (threadIdx.x == 0) (void)xb_add(&bar[XB_XCNT(b.x)], 1u);
    return b;
}
__device__ __forceinline__ void xcd_barrier_complete(unsigned* bar, unsigned x, unsigned& nloc, unsigned& nx) {
    const unsigned G = gridDim.x * gridDim.y * gridDim.z;
    unsigned sum, cnt, mine, sp = 0u;
    for (;;) {
        sum = 0u; cnt = 0u; mine = 0u;
#pragma unroll
        for (unsigned j = 0; j < 16; ++j) { const unsigned c = xb_ld(&bar[XB_XCNT(j)]); sum += c; cnt += (c > 0u) ? 1u : 0u; mine = (j == x) ? c : mine; }
        if (sum == G) break;
        __builtin_amdgcn_s_sleep(1);
        if ((++sp & 255u) == 0u) { if (xb_ld(&bar[XB_TMO])) break; if (sp > XB_SPIN_CAP) { atomicAdd(&bar[XB_TMO], 1u); break; } }
    }
    nloc = mine > 0u ? mine : 1u; nx = cnt > 0u ? cnt : 1u;
}

__device__ __forceinline__ void xcd_barrier(const XcdBarrier& b) {
    asm volatile("s_waitcnt vmcnt(0)" ::: "memory");
    __syncthreads();
    if (threadIdx.x == 0) {
        unsigned* bar = b.bar;
        __builtin_amdgcn_s_waitcnt(0);
        unsigned nloc = b.st[0], nx = b.st[1];
        if (nloc == 0u) { xcd_barrier_complete(bar, b.x, nloc, nx); b.st[0] = nloc; b.st[1] = nx; }
        const unsigned old = xb_add(&bar[XB_XSUB(b.x)], 1u);
        const unsigned gen = old / nloc;
        if (old + 1u == (gen + 1u) * nloc) {
            __builtin_amdgcn_fence(__ATOMIC_RELEASE, "agent");
            asm volatile("s_waitcnt vmcnt(0)" ::: "memory");
            const unsigned og = xb_add(&bar[XB_TOP], 1u);
            const unsigned tg = og / nx;
            if (og + 1u == (tg + 1u) * nx) xb_add(&bar[XB_TOPGEN], 1u);
            else XB_SPIN(xb_ld(&bar[XB_TOPGEN]) == tg, bar);
            __builtin_amdgcn_fence(__ATOMIC_ACQUIRE, "agent");
            xb_add(&bar[XB_XGEN(b.x)], 1u);
            asm volatile("s_waitcnt vmcnt(0)" ::: "memory");
        } else {
            XB_SPIN(xb_ld(&bar[XB_XGEN(b.x)]) == gen, bar);
            __builtin_amdgcn_fence(__ATOMIC_ACQUIRE, "agent");
            asm volatile("s_waitcnt vmcnt(0)" ::: "memory");
        }
    }
    __syncthreads();
}
constexpr size_t WS_BAR = 320 * 1024;
constexpr int LDS_CTL = 131072, LDS_BARST = LDS_CTL + 352;
constexpr size_t WS_PTR = 300 * 1024;
struct Ids { int tid, lane, wave, bx, G, vcu, gw, NGW, gtid, NTH; };
#define FRESH_IDS(I) Ids I; { int t_ = threadIdx.x; asm volatile("" : "+v"(t_)); int b_ = blockIdx.x; asm volatile("" : "+s"(b_)); int g_ = gridDim.x; asm volatile("" : "+s"(g_)); \
    I.tid = t_; I.lane = t_ & 63; I.wave = __builtin_amdgcn_readfirstlane(t_ >> 6); I.bx = b_; I.G = g_; I.vcu = (g_ % 8 == 0) ? (b_ % 8) * (g_ / 8) + b_ / 8 : b_; \
    I.gw = I.vcu * 8 + I.wave; I.NGW = g_ * 8; I.gtid = b_ * NTHR + t_; I.NTH = g_ * NTHR; }
#define PTAB(i) (((const float* const*)(ws + WS_PTR))[i])

__global__ void __launch_bounds__(NTHR, 2) mk_fwd(Args a) {
    extern __shared__ __attribute__((aligned(16))) unsigned char lds_raw[];
    cg::grid_group grid = cg::this_grid();
    LAS unsigned char* lds = (LAS unsigned char*)lds_raw;
    unsigned char* ws = a.ws;
#define GSYNC_CG() do { asm volatile("s_waitcnt vmcnt(0) lgkmcnt(0)" ::: "memory"); grid.sync(); asm volatile("" ::: "memory"); } while (0)
#define GSYNC() do { XcdBarrier b_; b_.bar = (unsigned*)(ws + WS_BAR); b_.x = xb_xcc_id(); b_.st = (volatile LAS unsigned*)(lds + LDS_BARST); xcd_barrier(b_); asm volatile("" ::: "memory"); } while (0)
#ifndef REP_P1
#define REP_P1 1
#endif
#ifndef REP_P2
#define REP_P2 1
#endif
#ifndef REP_P3
#define REP_P3 1
#endif
#ifndef REP_P4
#define REP_P4 1
#endif
#ifndef REP_P5
#define REP_P5 1
#endif
#ifndef REP_P7
#define REP_P7 1
#endif
#ifndef REP_P8
#define REP_P8 1
#endif
#ifndef EXTRA_SYNCS
#define EXTRA_SYNCS 0
#endif
#define REPEAT(n) _Pragma("unroll 1") for (int rep_ = 0; rep_ < (n); ++rep_)
    for (int u = threadIdx.x; u < (LDS_BYTES - LDS_CTL) / 4; u += NTHR) ((LAS unsigned*)(lds + LDS_CTL))[u] = 0u;
    if (blockIdx.x == 0) for (int i = threadIdx.x; i < XCD_BAR_WORDS; i += NTHR) ((unsigned*)(ws + WS_BAR))[i] = 0u;
    __syncthreads();

    {
        FRESH_IDS(I);
        if (I.bx == 0 && I.tid == 0) {
            const float** tab = (const float**)(ws + WS_PTR);
#pragma unroll
            for (int i = 0; i < 26; ++i) tab[i] = a.in[i];
            tab[26] = a.out;
        }
        mod_gemv(a.in[1], a.in[3], a.in[4], a.in[5], (float*)(ws + WS_MOD), lds, I.tid, I.lane, I.wave, I.bx);
        WPtrs wp{a.in[10], a.in[11], a.in[12], a.in[20], a.in[21], a.in[22], a.in[23], a.in[24], a.in[25]};
        convert_weights(wp, 0, ws, lds, I.gw, I.NGW, I.wave, I.lane, I.gtid, I.NTH);
        if (I.bx == I.G - 1) { float* ropet = (float*)(ws + WS_ROPE);
            for (int i = I.tid; i < 1024; i += NTHR) { const int pos = i >> 4, j = i & 15; const float inv = 1.0f / powf(10000.0f, (float)j * 2.0f / 32.0f); const float ang = (float)pos * inv;
                ropet[2 * i] = cosf(ang); ropet[2 * i + 1] = sinf(ang); } }
    }
    GSYNC_CG();
    (void)xcd_barrier_post((unsigned*)(ws + WS_BAR), (volatile LAS unsigned*)(lds + LDS_BARST));
    for (int e_ = 0; e_ < EXTRA_SYNCS; ++e_) GSYNC();
    {
        FRESH_IDS(I);
        float* modv = (float*)(ws + WS_MOD);
        norm_phase(MA, PTAB(0), PTAB(2), (float*)PTAB(26), (float*)(ws + WS_CTX), nullptr, nullptr, nullptr, 0, nullptr, (bf16*)(ws + WS_H), PTAB(6), modv, 0, 1, I.gw, I.NGW, I.lane);
    }
    GSYNC();

#pragma unroll 1
    for (int l = 0; l < 2; ++l) {
        REPEAT(REP_P1) {
        {
            FRESH_IDS(I);
            const float* ropet = (const float*)(ws + WS_ROPE);
            SchedG S; S.init(ws + WS_H, ws + W_IN, MA, N1, 1024, I.G, I.bx);
            EpiIn E{ws};
            pg8::gemm_phase<EpiIn, SchedG, true, true>(lds, S, E);
        }
        {
            asm volatile("s_waitcnt vmcnt(0)" ::: "memory"); __syncthreads(); __builtin_amdgcn_fence(__ATOMIC_ACQUIRE, "agent"); asm volatile("s_waitcnt vmcnt(0)" ::: "memory");
            FRESH_IDS(I);
            const float* ropet = (const float*)(ws + WS_ROPE);
            const float* kn = PTAB(19) + l * 64;
            pg8::StaticOrder S; S.init(MA, N1, I.G, I.bx);
            pg8::Unit u;
            for (int i = 0; S.next(i, u); ++i) {
                const bool latent = u.pm < (ML / 256);
                if (u.pn == 10) {
                    const int hh = I.tid & 1, rl = I.tid >> 1, row = u.pm * 256 + rl;
                    head_norm_fix((bf16_t*)(ws + WS_KG) + (size_t)kvrow_of(row) * 128 + hh * 64, kn, latent, row & 4095, 1.0f, ropet);
                }
            }
        }
        GSYNC();
        }
        REPEAT(REP_P2) {
        {
            FRESH_IDS(I);
            const bool last = (l == 1); const int M2 = last ? ML : MA;
            pool_phase(M2, (const bf16*)(ws + WS_POOLIN), (bf16*)(ws + WS_POOLED), I.gtid, I.NTH);
            const int total = 1536 + (last ? 0 : 96);
            for (int i = 0;; ++i) {
                const int L = i * I.G + I.vcu; if (L >= total) break;
                int b, r, m0, NT;
                if (L < 1536) { const int qb = L & 15, pair = L >> 4; b = pair / 24; r = pair % 24; m0 = b * SEQL + qb * 256; NT = LKV / 64; }
                else { const int L2 = L - 1536; b = L2 / 24; r = L2 % 24; m0 = ML + b * CTXL; NT = CTXL / 64; }
                const attn_body::bf16 *Q, *K, *V; attn_body::bf16* O; int pq, pk, pv, po; const float* qgain = nullptr; int qt0 = -1;
                if (r < 16) { const int hd = r >> 2, qs = (r >> 1) & 1, vh = r & 1;
                    Q = (const attn_body::bf16*)(ws + WS_QD) + (size_t)m0 * 512 + hd * 128 + qs * 64; pq = 512;
                    K = (const attn_body::bf16*)(ws + WS_KD) + (size_t)(b * LKV) * 512 + hd * 128 + qs * 64; pk = 512;
                    V = (const attn_body::bf16*)(ws + WS_VD) + (size_t)(b * LKV) * 512 + hd * 128 + vh * 64; pv = 512;
                    O = (attn_body::bf16*)(ws + WS_OD) + (size_t)m0 * 1024 + hd * 256 + qs * 128 + vh * 64; po = 1024; }
                else { const int h = r - 16;
                    Q = (const attn_body::bf16*)(ws + WS_QG) + (size_t)m0 * 512 + h * 64; pq = 512;
                    K = (const attn_body::bf16*)(ws + WS_KG) + (size_t)(b * LKV) * 128 + (h >> 2) * 64; pk = 128;
                    V = (const attn_body::bf16*)(ws + WS_VG) + (size_t)(b * LKV) * 128 + (h >> 2) * 64; pv = 128;
                    O = (attn_body::bf16*)(ws + WS_GQAO) + (size_t)m0 * 512 + h * 64; po = 512; qgain = PTAB(18) + l * 64; qt0 = (L < 1536) ? (m0 & 4095) : -1; }
#ifndef NO_ATTN
                attn_body::attn_unit<8>(Q, pq, K, pk, V, pv, O, po, NT, (char*)lds_raw, qgain, (const float*)(ws + WS_ROPE), qt0);
#endif
            }
        }
        GSYNC();
        }
        REPEAT(REP_P3) {
        {
            FRESH_IDS(I);
            const bool last = (l == 1); const int M2 = last ? ML : MA; const float lam_init = last ? 0.35550906759f : 0.2f;
            const float *lq1 = PTAB(13) + l * 64, *lk1 = PTAB(14) + l * 64, *lq2 = PTAB(15) + l * 64, *lk2 = PTAB(16) + l * 64;
            float d1 = 0.f, d2 = 0.f;
            for (int i = 0; i < 64; ++i) { d1 += lq1[i] * lk1[i]; d2 += lq2[i] * lk2[i]; }
            const float lam = expf(d1) - expf(d2) + lam_init;
            diff_combine_phase(M2, (const bf16*)(ws + WS_OD), (bf16*)(ws + WS_DIFFO), PTAB(17) + l * 128, lam, lam_init, I.gtid, I.NTH);
            SchedG S; S.init(ws + WS_POOLED, ws + W_POOL, M2, 512, 512, I.G, I.bx);
            EpiAct<0> E{(bf16_t*)(ws + WS_POOLO), 512};
            pg8::gemm_phase<EpiAct<0>, SchedG, true, true>(lds, S, E);
        }
        GSYNC();
        }
        REPEAT(REP_P4) {
        { FRESH_IDS(I); const int M2 = (l == 1) ? ML : MA;
          SchedP4 S; S.init(ws, M2, I.G, I.bx);
          EpiP4 E{(bf16_t*)(ws + WS_MERGED), (float*)(ws + WS_ACC)};
          pg8::gemm_phase<EpiP4, SchedP4, true, true>(lds, S, E); }
        GSYNC();
        }
        REPEAT(REP_P5) {
        {
            FRESH_IDS(I); const int M2 = (l == 1) ? ML : MA;
            SchedG S; S.init(ws + WS_MERGED, ws + W_O, M2, 1024, 1024, I.G, I.bx);
            EpiF32 E{(float*)(ws + WS_Y), 1024};
            pg8::gemm_phase<EpiF32, SchedG, true, true>(lds, S, E);
        }
        GSYNC();
        }
        {
            FRESH_IDS(I); const int M2 = (l == 1) ? ML : MA;
            const float* modl = (const float*)(ws + WS_MOD) + l * 5 * NMOD; float* outp = (float*)PTAB(26); float* ctxx = (float*)(ws + WS_CTX);
            norm_phase(M2, outp, ctxx, outp, ctxx, (const float*)(ws + WS_Y), nullptr, modl, 2, PTAB(7) + l * 1024, (bf16*)(ws + WS_HF), PTAB(8) + l * 1024, modl, 3, 4, I.gw, I.NGW, I.lane);
        }
        GSYNC();
        REPEAT(REP_P7) {
        {
            FRESH_IDS(I); const int M2 = (l == 1) ? ML : MA;
            SchedG S; S.init(ws + WS_HF, ws + W_1, M2, DFF, 1024, I.G, I.bx);
            EpiAct<2> E{(bf16_t*)(ws + WS_U), DFF};
            pg8::gemm_phase<EpiAct<2>, SchedG, true, true>(lds, S, E);
        }
        GSYNC();
        }
        REPEAT(REP_P8) {
        {
            FRESH_IDS(I);
            EpiP8 E{(float*)(ws + WS_Z), (float*)(ws + WS_ZP)};
            if (l == 0) { SchedP8C S; S.init(ws, I.G, I.bx); pg8::gemm_phase<EpiP8, SchedP8C, true, true>(lds, S, E); }
            else { SchedG S; S.init(ws + WS_U, ws + W_2, ML, 1024, DFF, I.G, I.bx); pg8::gemm_phase<EpiP8, SchedG, true, true>(lds, S, E); }
        }
        GSYNC();
        }
        {
            FRESH_IDS(I);
            const float* modl = (const float*)(ws + WS_MOD) + l * 5 * NMOD; float* outp = (float*)PTAB(26); float* ctxx = (float*)(ws + WS_CTX);
            if (l == 0) {
                WPtrs wp{PTAB(10), PTAB(11), PTAB(12), PTAB(20), PTAB(21), PTAB(22), PTAB(23), PTAB(24), PTAB(25)};
                convert_weights(wp, 1, ws, lds, I.gw, I.NGW, I.wave, I.lane, I.gtid, I.NTH);
                norm_phase(MA, outp, ctxx, outp, ctxx, (const float*)(ws + WS_Z), (const float*)(ws + WS_ZP), modl, 5, PTAB(9) + l * 1024, (bf16*)(ws + WS_H), PTAB(6) + 1024, modl + 5 * NMOD, 0, 1, I.gw, I.NGW, I.lane);
            } else {
                norm_phase(ML, outp, ctxx, outp, ctxx, (const float*)(ws + WS_Z), nullptr, modl, 5, PTAB(9) + l * 1024, nullptr, nullptr, nullptr, 0, 0, I.gw, I.NGW, I.lane);
            }
        }
        if (l == 0) GSYNC();
    }
#undef GSYNC
}

extern "C" void kernel_launch(void* const* d_in, const int* in_sizes, int n_in, void* d_out, int out_size, void* d_ws, size_t ws_size, hipStream_t stream) {
    static int grid = 0;
    if (grid == 0) {
        if (n_in != 26 || out_size != ML * DMODEL || ws_size < WS_TOTAL) { fprintf(stderr, "kernel_launch: unexpected shapes (n_in %d out %d ws %zu)\n", n_in, out_size, ws_size); grid = -1; return; }
        int dev = 0, cus = 0, per_cu = 0;
        if (hipGetDevice(&dev) != hipSuccess || hipDeviceGetAttribute(&cus, hipDeviceAttributeMultiprocessorCount, dev) != hipSuccess) { grid = -1; return; }
        if (hipFuncSetAttribute((const void*)mk_fwd, hipFuncAttributeMaxDynamicSharedMemorySize, LDS_BYTES) != hipSuccess) { fprintf(stderr, "kernel_launch: hipFuncSetAttribute failed\n"); grid = -1; return; }
        if (hipOccupancyMaxActiveBlocksPerMultiprocessor(&per_cu, (const void*)mk_fwd, NTHR, LDS_BYTES) != hipSuccess || per_cu < 1) per_cu = 1;
        (void)hipGetLastError();
        grid = cus * per_cu;
    }
    if (grid < 0) return;
    Args a{};
    for (int i = 0; i < 26; ++i) a.in[i] = (const float*)d_in[i];
    a.out = (float*)d_out; a.ws = (unsigned char*)d_ws;
    void* args[] = {&a};
    hipError_t e = hipLaunchCooperativeKernel((const void*)mk_fwd, dim3(grid), dim3(NTHR), args, LDS_BYTES, stream);
    if (e != hipSuccess) fprintf(stderr, "kernel_launch: cooperative launch failed: %s (grid %d)\n", hipGetErrorString(e), grid);
}
```

```cpp
#include <hip/hip_runtime.h>
#include <hip/hip_cooperative_groups.h>
#include <cstdio>
#include <cstdint>

namespace pg8 {
#define PG8_LAS __attribute__((address_space(3)))
typedef unsigned short bf16_t;
typedef short bf16x8 __attribute__((ext_vector_type(8)));
typedef float f32x4 __attribute__((ext_vector_type(4)));
typedef unsigned u32x4 __attribute__((ext_vector_type(4)));
constexpr int BM = 256, BK = 64, HALF = 128, HTB = HALF * BK * 2  , STAGE_BYTES = 8 * HTB, NXCD = 8, WGM = 8;

__host__ __device__ __forceinline__ int lds_byte(int r, int c) { const int st = (r >> 4) * 2 + (c >> 5), rr = r & 15, cc = c & 31, ob = rr * 64 + cc * 2; return st * 1024 + (ob ^ (((ob >> 9) & 1) << 5)); }
__host__ __device__ __forceinline__ void stage_rc(int b, int& R, int& C) { const int st = b / 1024, sb = b % 1024, swz = sb ^ (((sb >> 9) & 1) << 5); R = (st >> 1) * 16 + swz / 64; C = (st & 1) * 32 + (swz % 64) / 2; }
__host__ __device__ __forceinline__ int perm32(int rho) { const int n = rho >> 4, i = rho & 15; return 8 * (i >> 2) + 4 * n + (i & 3); }

struct Unit { const char* A; const char* B; int lda, ldb, nt, pm, pn, seg; };
struct Gemm { const bf16_t* A; const bf16_t* Bt; int M, N, K; };

struct StaticOrder {
    int nM, nN, nwg, G, c;
    __host__ __device__ __forceinline__ void init(int M, int N, int G_, int c_) { nM = M / BM; nN = N / BM; nwg = nM * nN; G = G_; c = c_; }
    __host__ __device__ __forceinline__ bool next(int i, Unit& u) const {
        const long L = (long)i * G + c; if (L >= nwg) return false;
        int wgid = (int)L; { const int q = nwg / NXCD, r = nwg % NXCD, xcd = wgid % NXCD, off = wgid / NXCD; wgid = (xcd < r ? xcd * (q + 1) : r * (q + 1) + (xcd - r) * q) + off; }
        const int nig = WGM * nN, gid = wgid / nig, fm = gid * WGM, gsz = (nM - fm) < WGM ? (nM - fm) : WGM;
        u.pm = fm + ((wgid % nig) % gsz); u.pn = (wgid % nig) / gsz; return true;
    }
    __device__ __forceinline__ void a_ready(const Unit&) const {}
    __device__ __forceinline__ void done(const Unit&) const {}
};

__device__ __forceinline__ unsigned cvt_pk_bf16(float lo, float hi) { unsigned r; asm volatile("v_cvt_pk_bf16_f32 %0, %1, %2" : "=v"(r) : "v"(lo), "v"(hi)); return r; }
typedef float f32x2 __attribute__((ext_vector_type(2)));
template <class Epi, class Sched, bool ALIGN_EPI = false, bool SP2 = false>
__device__ __forceinline__ void gemm_phase(PG8_LAS unsigned char* lds, const Sched& S, const Epi& E) {
    int tid_l = threadIdx.x; asm volatile("" : "+v"(tid_l)); const int tid = tid_l, wid = __builtin_amdgcn_readfirstlane(tid >> 6), lane = tid & 63, wr = wid >> 2, wc = wid & 3, fr = lane & 15, fq = lane >> 4;
    unsigned rA[2], rB[2], c2[2];
#pragma unroll
    for (int i = 0; i < 2; ++i) { int R, C; stage_rc(tid * 16 + i * 8192, R, C); const int Rb = Epi::PERM ? ((R & ~31) + perm32(R & 31)) : R;
        rA[i] = (unsigned)R; rB[i] = (unsigned)Rb; c2[i] = (unsigned)C * 2u; }
    const size_t kstep = (size_t)(BK * 2);
    const unsigned ldsw = (unsigned)wid * 1024u;
    const int aoff = lds_byte(wr * 64 + fr, fq * 8), boff = lds_byte(wc * 32 + fr, fq * 8);
#define PG8_SA(b, h) (((b) * 2 + (h)) * HTB)
#define PG8_SB(b, h) ((4 + (b) * 2 + (h)) * HTB)
#define PG8_STAGE(bufoff, gbase, voff) do { _Pragma("unroll") for (int _i = 0; _i < 2; ++_i) \
        __builtin_amdgcn_global_load_lds((const unsigned*)((const char*)(gbase) + (voff)[_i]), (PG8_LAS unsigned*)(lds + (bufoff) + ldsw + _i * 8192), 16, 0, 0); } while (0)
#define PG8_LDA(dst, b, h) do { _Pragma("unroll") for (int m = 0; m < 4; ++m) _Pragma("unroll") for (int k = 0; k < 2; ++k) dst[m][k] = *(const PG8_LAS bf16x8*)(lds + PG8_SA(b, h) + aoff + m * 2048 + k * 1024); } while (0)
#define PG8_LDB(dst, b, h) do { _Pragma("unroll") for (int n = 0; n < 2; ++n) _Pragma("unroll") for (int k = 0; k < 2; ++k) dst[n][k] = *(const PG8_LAS bf16x8*)(lds + PG8_SB(b, h) + boff + n * 2048 + k * 1024); } while (0)
#define PG8_MMA(ai, bj, At, Bt) do { __builtin_amdgcn_s_setprio(1); _Pragma("unroll") for (int m = 0; m < 4; ++m) _Pragma("unroll") for (int n = 0; n < 2; ++n) _Pragma("unroll") for (int k = 0; k < 2; ++k) \
        acc[ai][bj][m][n] = __builtin_amdgcn_mfma_f32_16x16x32_bf16(Bt[n][k], At[m][k], acc[ai][bj][m][n], 0, 0, 0); __builtin_amdgcn_s_setprio(0); } while (0)
#define PG8_WAIT_V(n) asm volatile("s_waitcnt vmcnt(" #n ")" ::: "memory")
#define PG8_WAIT_L(n) asm volatile("s_waitcnt lgkmcnt(" #n ")" ::: "memory")
#define PG8_BAR __builtin_amdgcn_s_barrier()
#define PG8_SCHED __builtin_amdgcn_sched_barrier(0)
    Unit cur, nxt; int ui = 0;
    if (!S.next(0, cur)) return;
    f32x4 acc[2][2][4][2];
#pragma unroll
    for (int a = 0; a < 2; ++a)
#pragma unroll
        for (int b = 0; b < 2; ++b)
#pragma unroll
            for (int m = 0; m < 4; ++m)
#pragma unroll
                for (int n = 0; n < 2; ++n) acc[a][b][m][n] = (f32x4){0.f, 0.f, 0.f, 0.f};
    bf16x8 At[4][2], B0[2][2], B1[2][2];
    unsigned voA_c[2], voB_c[2], voA_n[2], voB_n[2]; size_t hA_c, hB_c, hA_n, hB_n; int nt_c;
#define PG8_UPARAMS(u, vA, vB, hA, hB) do { _Pragma("unroll") for (int _i = 0; _i < 2; ++_i) { vA[_i] = rA[_i] * (unsigned)(u).lda + c2[_i]; vB[_i] = rB[_i] * (unsigned)(u).ldb + c2[_i]; } hA = (size_t)HALF * (u).lda; hB = (size_t)HALF * (u).ldb; } while (0)
    PG8_UPARAMS(cur, voA_c, voB_c, hA_c, hB_c); nt_c = cur.nt;
    const char* cA = cur.A; const char* cB = cur.B;
    S.a_ready(cur);
    if constexpr (SP2) {
        PG8_STAGE(PG8_SB(0, 0), cB, voB_c); PG8_STAGE(PG8_SB(0, 1), cB + hB_c, voB_c); PG8_STAGE(PG8_SA(0, 0), cA, voA_c); PG8_STAGE(PG8_SA(0, 1), cA + hA_c, voA_c);
        if (wr == 1) PG8_BAR;
        PG8_WAIT_V(2); PG8_BAR;
        PG8_STAGE(PG8_SB(1, 0), cB + kstep, voB_c); PG8_STAGE(PG8_SA(1, 0), cA + kstep, voA_c); PG8_STAGE(PG8_SB(1, 1), cB + hB_c + kstep, voB_c);
        PG8_WAIT_V(6); PG8_BAR;
    } else {
        PG8_STAGE(PG8_SB(0, 0), cB, voB_c); PG8_STAGE(PG8_SA(0, 0), cA, voA_c); PG8_STAGE(PG8_SB(0, 1), cB + hB_c, voB_c); PG8_STAGE(PG8_SA(0, 1), cA + hA_c, voA_c);
        if (wr == 1) PG8_BAR;
        PG8_WAIT_V(4); PG8_BAR;
        PG8_STAGE(PG8_SB(1, 0), cB + kstep, voB_c); PG8_STAGE(PG8_SA(1, 0), cA + kstep, voA_c); PG8_STAGE(PG8_SB(1, 1), cB + hB_c + kstep, voB_c);
        PG8_WAIT_V(6); PG8_BAR;
    }
    for (;;) {
        const bool has_next = S.next(ui + 1, nxt);
        const char* nA = has_next ? nxt.A : cA; const char* nB = has_next ? nxt.B : cB;
        if (has_next) { PG8_UPARAMS(nxt, voA_n, voB_n, hA_n, hB_n); } else { voA_n[0] = voA_c[0]; voA_n[1] = voA_c[1]; voB_n[0] = voB_c[0]; voB_n[1] = voB_c[1]; hA_n = hA_c; hB_n = hB_c; }
        for (int t = 0; t < nt_c; t += 2) {
            const bool last = (t == nt_c - 2);
            const size_t hA2 = last ? hA_n : hA_c, hB2 = last ? hB_n : hB_c;
            unsigned vA2[2], vB2[2]; vA2[0] = last ? voA_n[0] : voA_c[0]; vA2[1] = last ? voA_n[1] : voA_c[1]; vB2[0] = last ? voB_n[0] : voB_c[0]; vB2[1] = last ? voB_n[1] : voB_c[1];
            const char* a1 = cA + (size_t)(t + 1) * kstep;
            const char* a2 = last ? nA : cA + (size_t)(t + 2) * kstep; const char* b2 = last ? nB : cB + (size_t)(t + 2) * kstep;
            const char* a3 = a2 + kstep; const char* b3 = b2 + kstep;
            if (last && has_next) S.a_ready(nxt);
            if constexpr (SP2) {
            PG8_LDB(B0, 0, 0); PG8_LDB(B1, 0, 1); PG8_SCHED; PG8_LDA(At, 0, 0); PG8_STAGE(PG8_SA(1, 1), a1 + hA_c, voA_c);
            PG8_WAIT_V(8); PG8_WAIT_L(0); PG8_BAR; PG8_MMA(0, 0, At, B0); PG8_MMA(0, 1, At, B1); PG8_BAR; PG8_SCHED;
            PG8_LDA(At, 0, 1); PG8_STAGE(PG8_SB(0, 0), b2, vB2); PG8_STAGE(PG8_SB(0, 1), b2 + hB2, vB2); PG8_STAGE(PG8_SA(0, 0), a2, vA2);
            PG8_WAIT_V(8); PG8_WAIT_L(0); PG8_BAR; PG8_MMA(1, 0, At, B0); PG8_MMA(1, 1, At, B1); PG8_BAR; PG8_SCHED;
            PG8_LDB(B0, 1, 0); PG8_LDB(B1, 1, 1); PG8_SCHED; PG8_LDA(At, 1, 0); PG8_STAGE(PG8_SA(0, 1), a2 + hA2, vA2);
            PG8_WAIT_V(8); PG8_WAIT_L(0); PG8_BAR; PG8_MMA(0, 0, At, B0); PG8_MMA(0, 1, At, B1); PG8_BAR; PG8_SCHED;
            PG8_LDA(At, 1, 1); PG8_STAGE(PG8_SB(1, 0), b3, vB2); PG8_STAGE(PG8_SB(1, 1), b3 + hB2, vB2); PG8_STAGE(PG8_SA(1, 0), a3, vA2);
            PG8_WAIT_V(8); PG8_WAIT_L(0); PG8_BAR; PG8_MMA(1, 0, At, B0); PG8_MMA(1, 1, At, B1); PG8_BAR; PG8_SCHED;
            } else {
            PG8_LDB(B0, 0, 0); PG8_SCHED; PG8_LDA(At, 0, 0); PG8_STAGE(PG8_SA(1, 1), a1 + hA_c, voA_c);
            PG8_WAIT_L(8); PG8_BAR; PG8_WAIT_L(0); PG8_MMA(0, 0, At, B0); PG8_BAR; PG8_SCHED;
            PG8_LDB(B1, 0, 1); PG8_STAGE(PG8_SB(0, 0), b2, vB2);
            PG8_BAR; PG8_WAIT_L(0); PG8_MMA(0, 1, At, B1); PG8_BAR;
            PG8_LDA(At, 0, 1); PG8_STAGE(PG8_SA(0, 0), a2, vA2);
            PG8_BAR; PG8_WAIT_L(0); PG8_MMA(1, 0, At, B0); PG8_BAR; PG8_SCHED;
            PG8_STAGE(PG8_SB(0, 1), b2 + hB2, vB2);
            PG8_WAIT_V(6); PG8_BAR; PG8_MMA(1, 1, At, B1); PG8_BAR;
            PG8_LDB(B0, 1, 0); PG8_SCHED; PG8_LDA(At, 1, 0); PG8_STAGE(PG8_SA(0, 1), a2 + hA2, vA2);
            PG8_WAIT_L(8); PG8_BAR; PG8_WAIT_L(0); PG8_MMA(0, 0, At, B0); PG8_BAR; PG8_SCHED;
            PG8_LDB(B1, 1, 1); PG8_STAGE(PG8_SB(1, 0), b3, vB2);
            PG8_BAR; PG8_WAIT_L(0); PG8_MMA(0, 1, At, B1); PG8_BAR;
            PG8_LDA(At, 1, 1); PG8_STAGE(PG8_SA(1, 0), a3, vA2);
            PG8_BAR; PG8_WAIT_L(0); PG8_MMA(1, 0, At, B0); PG8_BAR; PG8_SCHED;
            PG8_STAGE(PG8_SB(1, 1), b3 + hB2, vB2);
            PG8_WAIT_V(6); PG8_BAR; PG8_MMA(1, 1, At, B1); PG8_BAR;
            }
        }
        if constexpr (ALIGN_EPI) { if (wr == 0) PG8_BAR; }
        if constexpr (!Epi::AFTER_DRAIN) { E(acc, cur, wr, wc, fr, fq); S.done(cur); }
        if (!has_next) break;
#pragma unroll
        for (int a = 0; a < 2; ++a)
#pragma unroll
            for (int b = 0; b < 2; ++b)
#pragma unroll
                for (int m = 0; m < 4; ++m)
#pragma unroll
                    for (int n = 0; n < 2; ++n) acc[a][b][m][n] = (f32x4){0.f, 0.f, 0.f, 0.f};
        cur = nxt; cA = nA; cB = nB; ++ui; voA_c[0] = voA_n[0]; voA_c[1] = voA_n[1]; voB_c[0] = voB_n[0]; voB_c[1] = voB_n[1]; hA_c = hA_n; hB_c = hB_n; nt_c = cur.nt;
        if constexpr (ALIGN_EPI) { if (wr == 1) PG8_BAR; }
    }
    PG8_WAIT_V(0);
    if constexpr (!ALIGN_EPI) { if (wr == 0) PG8_BAR; }
    PG8_BAR;
    if constexpr (Epi::AFTER_DRAIN) { E.fused(acc, cur, wr, wc, fr, fq, lds, wid, lane); S.done(cur); }
#undef PG8_UPARAMS
#undef PG8_SA
#undef PG8_SB
#undef PG8_STAGE
#undef PG8_LDA
#undef PG8_LDB
#undef PG8_MMA
#undef PG8_WAIT_V
#undef PG8_WAIT_L
#undef PG8_BAR
#undef PG8_SCHED
}
}
namespace cg = cooperative_groups;
#define LAS __attribute__((address_space(3)))
typedef unsigned short bf16;
typedef unsigned v4u __attribute__((ext_vector_type(4)));
typedef unsigned v2u __attribute__((ext_vector_type(2)));
typedef float f32x4 __attribute__((ext_vector_type(4)));
using pg8::bf16_t;

constexpr int DMODEL = 1024, NBATCH = 4, SEQL = 4096, CTXL = 256, LKV = SEQL + CTXL, ML = NBATCH * SEQL, MC = NBATCH * CTXL, MA = ML + MC, DFF = 4096, N1 = 2816, NMOD = 6 * DMODEL;
constexpr float EPSN = 1e-6f;
constexpr float QC2 = 0.125f * 1.4426950408889634f;
constexpr int NTHR = 512;
constexpr int LDS_BYTES = 147456;

constexpr size_t MiB = 1u << 20;
constexpr size_t WS_MOD = 0, WS_ROPE = 256 * 1024;
constexpr size_t W_IN = 2 * MiB, W_POOL = W_IN + (size_t)5888 * 1024 * 2, W_PO = W_POOL + 512 * 512 * 2, W_DO = W_PO + 1024 * 512 * 2, W_GO = W_DO + 1024 * 512 * 2,
                 W_O = W_GO + 1024 * 512 * 2, W_1 = W_O + 1024 * 1024 * 2, W_2 = W_1 + (size_t)4096 * 1024 * 2, W_END = W_2 + (size_t)4096 * 1024 * 2;
static_assert(W_END <= 36 * MiB, "weights");
constexpr size_t WS_CTX = 36 * MiB, WS_H = 40 * MiB;
constexpr size_t WS_POOLIN = 74 * MiB, WS_QD = 91 * MiB, WS_QG = 108 * MiB, WS_KD = 125 * MiB, WS_VD = 142 * MiB, WS_KG = 159 * MiB, WS_VG = WS_KG + (size_t)MA * 128 * 2;
constexpr size_t WS_OD = 176 * MiB, WS_GQAO = 210 * MiB, WS_POOLED = 227 * MiB;
constexpr size_t WS_DIFFO = 74 * MiB, WS_POOLO = 91 * MiB, WS_MERGED = 108 * MiB, WS_ACC = 142 * MiB, WS_Y = 142 * MiB, WS_HF = 210 * MiB, WS_U = 40 * MiB, WS_Z = 176 * MiB;
constexpr size_t WS_TOTAL = 256 * MiB;
static_assert(WS_VG + (size_t)MA * 128 * 2 <= 176 * MiB, "p1 outs");

__device__ __forceinline__ unsigned f2bf(float f) { unsigned u = __builtin_bit_cast(unsigned, f); return (u + 0x7fffu + ((u >> 16) & 1u)) >> 16; }
__device__ __forceinline__ unsigned pk2(float lo, float hi) { return f2bf(lo) | (f2bf(hi) << 16); }
__device__ __forceinline__ float bflo(unsigned w) { return __builtin_bit_cast(float, w << 16); }
__device__ __forceinline__ float bfhi(unsigned w) { return __builtin_bit_cast(float, w & 0xffff0000u); }
__device__ __forceinline__ float wave_sum(float v) {
#pragma unroll
    for (int o = 1; o < 64; o <<= 1) v += __shfl_xor(v, o);
    return v;
}

__device__ __forceinline__ int kvrow_of(int row) { return row < ML ? (row >> 12) * LKV + CTXL + (row & 4095) : ((row - ML) >> 8) * LKV + ((row - ML) & 255); }
__device__ __forceinline__ void rope8(float (&v)[8], const float* tab, int d, int t) {
    const int p0 = d >> 1, pos = p0 < 16 ? (t >> 6) : (t & 63), j0 = p0 & 15;
    const f32x4* tp = (const f32x4*)(tab + (pos * 16 + j0) * 2);
    const f32x4 t0 = tp[0], t1 = tp[1];
    float o[8];
    o[0] = v[0] * t0[0] - v[1] * t0[1]; o[1] = v[0] * t0[1] + v[1] * t0[0];
    o[2] = v[2] * t0[2] - v[3] * t0[3]; o[3] = v[2] * t0[3] + v[3] * t0[2];
    o[4] = v[4] * t1[0] - v[5] * t1[1]; o[5] = v[4] * t1[1] + v[5] * t1[0];
    o[6] = v[6] * t1[2] - v[7] * t1[3]; o[7] = v[6] * t1[3] + v[7] * t1[2];
#pragma unroll
    for (int i = 0; i < 8; ++i) v[i] = o[i];
}

#include <hip/hip_bf16.h>
#include <cmath>
namespace attn_body {
using bf16=__hip_bfloat16;
using bf16x8=__attribute__((ext_vector_type(8)))short;
using s16x4=__attribute__((ext_vector_type(4)))short;
using f32x16=__attribute__((ext_vector_type(16)))float;
using u32x4=__attribute__((ext_vector_type(4)))unsigned;
constexpr int D=64;
constexpr int NW=8,QBLK=32,QB=QBLK*NW,KVBLK=64;
constexpr int ATTN_UNIT_ROWS=QB;
__device__ __forceinline__ int crow(int r,int hi){return (r&3)+8*(r>>2)+4*hi;}
#define SBAR() __builtin_amdgcn_sched_barrier(0)
__device__ __forceinline__ void cmask(f32x16&p0,f32x16&p1,int jb,int qrel,int hi){
  const float NEG=-INFINITY; int kb=64*jb+4*hi;
  #pragma unroll
  for(int r=0;r<16;++r){int kv=kb+(r&3)+8*(r>>2); if(kv>qrel)p0[r]=NEG; if(kv+32>qrel)p1[r]=NEG;}
}

constexpr int NSLOT=3, SLOTB=8192;
constexpr int LDS_K=0, LDS_V=NSLOT*SLOTB, LDS_WS=2*NSLOT*SLOTB, LDS_OST=LDS_WS+NW*64*4, LDS_BYTES=LDS_OST+NW*4096;
constexpr float C2=0.125f*1.4426950408889634f;
__device__ __forceinline__ void glds16(const void*gsrc,unsigned lds_dst){unsigned keep;
  asm volatile("s_mov_b32 %0, m0\n\ts_mov_b32 m0, %2\n\ts_nop 0\n\tglobal_load_lds_dwordx4 %1, off\n\ts_mov_b32 m0, %0":"=&s"(keep):"v"(gsrc),"s"(lds_dst):"memory");}
__device__ __forceinline__ float max3f(float a,float b,float c){float r;asm("v_max3_f32 %0, %1, %2, %3":"=v"(r):"v"(a),"v"(b),"v"(c));return r;}
__device__ __forceinline__ float max2f(float a,float b){float r;asm("v_max_f32_e32 %0, %1, %2":"=v"(r):"v"(a),"v"(b));return r;}
__device__ __forceinline__ float fadd_s(float a,float b){float r;asm("v_add_f32_e32 %0, %1, %2":"=v"(r):"v"(a),"v"(b));return r;}
__device__ __forceinline__ float fsub_s(float a,float b){float r;asm("v_sub_f32_e32 %0, %1, %2":"=v"(r):"v"(a),"v"(b));return r;}
typedef float f32x2_t __attribute__((ext_vector_type(2))); typedef __bf16 bf16x2_t __attribute__((ext_vector_type(2)));
__device__ __forceinline__ unsigned cvtpk_s(float lo,float hi){f32x2_t v={lo,hi};bf16x2_t b=__builtin_convertvector(v,bf16x2_t);return __builtin_bit_cast(unsigned,b);}
#define WAIT_BAR(N) asm volatile("s_waitcnt vmcnt(" #N ") lgkmcnt(0)\n\ts_barrier":::"memory")

__device__ __forceinline__ void qkt(f32x16&p0,f32x16&p1,const char*Kslot,const bf16x8*qr,const f32x16&negm,int r32,int hi){
  const char*kb=Kslot+hi*1024+r32*16;
  #pragma unroll
  for(int d0=0;d0<4;++d0){
    const bf16x8 b0=*reinterpret_cast<const bf16x8*>(kb+d0*2048);
    const bf16x8 b1=*reinterpret_cast<const bf16x8*>(kb+d0*2048+512);
    if(d0==0){p0=__builtin_amdgcn_mfma_f32_32x32x16_bf16(b0,qr[0],negm,0,0,0);p1=__builtin_amdgcn_mfma_f32_32x32x16_bf16(b1,qr[0],negm,0,0,0);}
    else{p0=__builtin_amdgcn_mfma_f32_32x32x16_bf16(b0,qr[d0],p0,0,0,0);p1=__builtin_amdgcn_mfma_f32_32x32x16_bf16(b1,qr[d0],p1,0,0,0);}}
}
typedef __attribute__((address_space(3))) const char* lds_cptr;
typedef short v4i16_t __attribute__((ext_vector_type(4)));
__device__ __forceinline__ void kload8(bf16x8*kf,lds_cptr kp){
  kf[0]=*(const __attribute__((address_space(3))) bf16x8*)(kp);      kf[1]=*(const __attribute__((address_space(3))) bf16x8*)(kp+512);
  kf[2]=*(const __attribute__((address_space(3))) bf16x8*)(kp+2048); kf[3]=*(const __attribute__((address_space(3))) bf16x8*)(kp+2560);
  kf[4]=*(const __attribute__((address_space(3))) bf16x8*)(kp+4096); kf[5]=*(const __attribute__((address_space(3))) bf16x8*)(kp+4608);
  kf[6]=*(const __attribute__((address_space(3))) bf16x8*)(kp+6144); kf[7]=*(const __attribute__((address_space(3))) bf16x8*)(kp+6656);
}
__device__ __forceinline__ void kload2(bf16x8*kf,lds_cptr kp,int j){ kf[2*j]=*(const __attribute__((address_space(3))) bf16x8*)(kp+j*2048); kf[2*j+1]=*(const __attribute__((address_space(3))) bf16x8*)(kp+j*2048+512); }
__device__ __forceinline__ s16x4 vtr(lds_cptr p){ return __builtin_bit_cast(s16x4,__builtin_amdgcn_ds_read_tr16_b64_v4i16((__attribute__((address_space(3))) v4i16_t*)p)); }
__device__ __forceinline__ float rowmax(const f32x16&p0,const f32x16&p1){
  float a=max3f(p0[0],p0[1],p1[0]),b=max3f(p0[2],p0[3],p1[1]);a=max3f(a,p1[2],p1[3]);
  #pragma unroll
  for(int r=4;r<16;r+=4){a=max3f(a,p0[r],p0[r+1]);b=max3f(b,p0[r+2],p0[r+3]);a=max3f(a,p1[r],p1[r+1]);b=max3f(b,p1[r+2],p1[r+3]);}
  const float m=max2f(a,b);
  auto rr=__builtin_amdgcn_permlane32_swap(__float_as_uint(m),__float_as_uint(m),false,false);
  return max2f(__uint_as_float(rr[0]),__uint_as_float(rr[1]));
}
__device__ __forceinline__ void pv(f32x16*o,int vb,bf16x8 pa0,bf16x8 pa1,bf16x8 pa2,bf16x8 pa3){
  #pragma unroll
  for(int d0=0;d0<2;++d0){s16x4 lo[4],hi[4];
    #pragma unroll
    for(int ks=0;ks<4;++ks){
      asm volatile("ds_read_b64_tr_b16 %0,%1 offset:%c2":"=&v"(lo[ks]):"v"(vb),"i"(d0*4096+ks*1024):"memory");
      asm volatile("ds_read_b64_tr_b16 %0,%1 offset:%c2":"=&v"(hi[ks]):"v"(vb),"i"(d0*4096+ks*1024+512):"memory");}
    asm volatile("s_waitcnt lgkmcnt(0)":::"memory");SBAR();
    #define PK(k) (bf16x8){lo[k][0],lo[k][1],lo[k][2],lo[k][3],hi[k][0],hi[k][1],hi[k][2],hi[k][3]}
    o[d0]=__builtin_amdgcn_mfma_f32_32x32x16_bf16(pa0,PK(0),o[d0],0,0,0);
    o[d0]=__builtin_amdgcn_mfma_f32_32x32x16_bf16(pa1,PK(1),o[d0],0,0,0);
    o[d0]=__builtin_amdgcn_mfma_f32_32x32x16_bf16(pa2,PK(2),o[d0],0,0,0);
    o[d0]=__builtin_amdgcn_mfma_f32_32x32x16_bf16(pa3,PK(3),o[d0],0,0,0);
    #undef PK
  }
}

#ifndef ATTN_STORE16
#define ATTN_STORE16(p,v) (*(u32x4*)(p)=(v))
#endif
template<int THRL> __device__ __forceinline__ void attn_unit(const bf16*Qw0,int pqs,const bf16*__restrict__ Kh,int pks,const bf16*__restrict__ Vh,int pvs,bf16*Ow0,int pos_,const int NT,char*shm,const float*qgain,const float*rtab,const int qt0){
  int tid_l=threadIdx.x; asm volatile("":"+v"(tid_l)); const int tid=tid_l,lane=tid&63,r32=lane&31,hi=lane>>5; const int wid=__builtin_amdgcn_readfirstlane(tid>>6);
  const bf16*Qw=Qw0+(long)(wid*QBLK)*pqs;
  const unsigned lds0=(unsigned)(uintptr_t)shm;
  float*wsf=(float*)(shm+LDS_WS)+wid*64;
  const bf16*ksrc=Kh+(long)lane*pks+wid*8;
  const bf16*vsrc=Vh+(long)(16*(wid&3)+(lane>>2))*pvs+(wid>>2)*32+(lane&3)*8;
  const unsigned kdst=lds0+LDS_K+wid*1024, vdst=lds0+LDS_V+wid*1024;
  #define DMA_K(t,slot) glds16(ksrc+(long)(t)*KVBLK*pks,(unsigned)__builtin_amdgcn_readfirstlane(kdst+(slot)))
  #define DMA_V(t,slot) glds16(vsrc+(long)(t)*KVBLK*pvs,(unsigned)__builtin_amdgcn_readfirstlane(vdst+(slot)))
  const int vb0=(int)(lds0+LDS_V)+((lane>>4)&1)*32+(lane&3)*8+(4*hi+((lane&15)>>2))*64;
  const char*Kbase=shm+LDS_K; bf16x8 kf[8];
  const lds_cptr shm3=(lds_cptr)shm; const lds_cptr kp0=shm3+LDS_K+hi*1024+r32*16; const lds_cptr vp0=shm3+LDS_V+((lane>>4)&1)*32+(lane&3)*8+(4*hi+((lane&15)>>2))*64;
  DMA_K(0,0);DMA_V(0,0);DMA_K(1,SLOTB);
  bf16x8 qr[4];
  #pragma unroll
  for(int d0=0;d0<4;++d0)qr[d0]=*reinterpret_cast<const bf16x8*>(&Qw[(long)r32*pqs+d0*16+hi*8]);
  if(qgain){
    float f[4][8]; float ss=0.f;
    #pragma unroll
    for(int d0=0;d0<4;++d0){
      #pragma unroll
      for(int i=0;i<8;++i){ f[d0][i]=__builtin_bit_cast(float,((unsigned)(unsigned short)qr[d0][i])<<16); ss+=f[d0][i]*f[d0][i]; } }
    { auto rr=__builtin_amdgcn_permlane32_swap(__float_as_uint(ss),__float_as_uint(ss),false,false); ss=__uint_as_float(rr[0])+__uint_as_float(rr[1]); }
    const float rstd=1.0f/sqrtf(ss*(1.f/64.f)+1e-6f);
    #pragma unroll
    for(int d0=0;d0<4;++d0){ const int dd=d0*16+hi*8;
      #pragma unroll
      for(int i=0;i<8;++i) f[d0][i]*=rstd*qgain[dd+i];
      if(qt0>=0) rope8(f[d0],rtab,dd,qt0+wid*QBLK+r32);
      u32x4 w; w.x=pk2(f[d0][0]*C2,f[d0][1]*C2); w.y=pk2(f[d0][2]*C2,f[d0][3]*C2); w.z=pk2(f[d0][4]*C2,f[d0][5]*C2); w.w=pk2(f[d0][6]*C2,f[d0][7]*C2);
      qr[d0]=__builtin_bit_cast(bf16x8,w); }
  }
  float mhat=0.f,l_reg=0.f;f32x16 o[2];o[0]=f32x16{};o[1]=f32x16{};f32x16 negm=f32x16{};asm volatile("":"+v"(negm));
  #define CMASK(P0,P1,t) do{}while(0)
  bool resc=false;
  #define START(P0,P1) do{ const float rm=rowmax(P0,P1); resc=false; \
    { const float dl=rm; mhat=fadd_s(mhat,dl); \
      _Pragma("unroll") for(int r=0;r<16;++r){P0[r]=fsub_s(P0[r],dl);P1[r]=fsub_s(P1[r],dl);} \
      _Pragma("unroll") for(int r=0;r<16;++r)negm[r]=-mhat; asm volatile("":"+v"(negm)); } \
    _Pragma("unroll") for(int r=0;r<16;++r)P0[r]=__builtin_amdgcn_exp2f(P0[r]); }while(0)
  #define RESC() do{ if(resc){ asm volatile("s_waitcnt lgkmcnt(0)":::"memory"); \
      _Pragma("unroll") for(int d_=0;d_<2;++d_) _Pragma("unroll") for(int r=0;r<16;++r)o[d_][r]*=wsf[crow(r,hi)]; } }while(0)
  f32x16 pA0,pA1,pB0,pB1;
  int sl_prev=0,sl_cur=0,sl_next=SLOTB;
  #define ROT() do{sl_prev=sl_cur;sl_cur=sl_next;sl_next=(sl_next==(NSLOT-1)*SLOTB)?0:sl_next+SLOTB;}while(0)
  DMA_K(2,2*SLOTB);
  WAIT_BAR(3);
  qkt(pA0,pA1,Kbase,qr,negm,r32,hi);asm volatile("s_nop 15\n\ts_nop 7":"+v"(pA0),"+v"(pA1));CMASK(pA0,pA1,0);
  START(pA0,pA1);
  _Pragma("unroll") for(int r=0;r<16;++r)pA1[r]=__builtin_amdgcn_exp2f(pA1[r]);
  WAIT_BAR(0);
  DMA_K(3,0);DMA_V(1,SLOTB);
  ROT();
  kload8(kf,kp0+sl_cur);
  WAIT_BAR(2);
  s16x4 vlo[8],vhi[8]; u32x4 pw0,pw1,pw2,pw3;
  #define PKW(P,B) cvtpk_s(P[B],P[B+1])
  #define PAF(k) __builtin_bit_cast(bf16x8,pw##k)
  #define VFR(i) (bf16x8){vlo[i][0],vlo[i][1],vlo[i][2],vlo[i][3],vhi[i][0],vhi[i][1],vhi[i][2],vhi[i][3]}
  #define PIN(x) asm volatile("":"+v"(x))
  #define MX3(a,b,c) __builtin_fmaxf(__builtin_fmaxf((a),(b)),(c))
  #define GAPA(MF,A0,A1,A2,A3,W0,W1,PW) do{ MF; sacc+=A0; sacc+=A1; sacc+=A2; sacc+=A3; PIN(sacc); W0; W1; PIN(PW); SBAR(); }while(0)
  #define EX(v) __builtin_amdgcn_exp2f(v)
  #define GAPB(MF,X,B) do{ MF; X[B]=EX(X[B]); X[B+1]=EX(X[B+1]); X[B+2]=EX(X[B+2]); X[B+3]=EX(X[B+3]); PIN(X); SBAR(); }while(0)
  #define VRD(i) do{ vlo[i]=vtr(vp_+(((i)>>2)*4096+((i)&3)*1024)); vhi[i]=vtr(vp_+(((i)>>2)*4096+((i)&3)*1024+512)); }while(0)
  #define KRD(G,j) do{ if(G){ kload2(kf,kp0+sl_next,j); SBAR(); } }while(0)
  #define STEP(C0,C1,P0,P1,t,GK,GV,GL) do{ SBAR(); \
    const lds_cptr vp_=vp0+sl_prev; \
    VRD(0); SBAR(); float sacc=(P0[0]+P0[1]); \
    GAPA(C0=__builtin_amdgcn_mfma_f32_32x32x16_bf16(kf[0],qr[0],negm,0,0,0), P0[2],P0[3],P0[4],P0[5],     pw0[0]=PKW(P0,0), pw0[1]=PKW(P0,2), pw0); \
    VRD(4); SBAR(); GAPA(C1=__builtin_amdgcn_mfma_f32_32x32x16_bf16(kf[1],qr[0],negm,0,0,0), P0[6],P0[7],P0[8],P0[9],     pw0[2]=PKW(P0,4), pw0[3]=PKW(P0,6), pw0); \
    VRD(1); SBAR(); GAPA(C0=__builtin_amdgcn_mfma_f32_32x32x16_bf16(kf[2],qr[1],C0,0,0,0),   P0[10],P0[11],P0[12],P0[13], pw1[0]=PKW(P0,8), pw1[1]=PKW(P0,10), pw1); \
    VRD(5); SBAR(); GAPA(C1=__builtin_amdgcn_mfma_f32_32x32x16_bf16(kf[3],qr[1],C1,0,0,0),   P0[14],P0[15],P1[0],P1[1],   pw1[2]=PKW(P0,12),pw1[3]=PKW(P0,14), pw1); \
    VRD(2); SBAR(); GAPA(C0=__builtin_amdgcn_mfma_f32_32x32x16_bf16(kf[4],qr[2],C0,0,0,0),   P1[2],P1[3],P1[4],P1[5],     pw2[0]=PKW(P1,0), pw2[1]=PKW(P1,2), pw2); \
    VRD(6); SBAR(); GAPA(C1=__builtin_amdgcn_mfma_f32_32x32x16_bf16(kf[5],qr[2],C1,0,0,0),   P1[6],P1[7],P1[8],P1[9],     pw2[2]=PKW(P1,4), pw2[3]=PKW(P1,6), pw2); \
    VRD(3); SBAR(); GAPA(C0=__builtin_amdgcn_mfma_f32_32x32x16_bf16(kf[6],qr[3],C0,0,0,0),   P1[10],P1[11],P1[12],P1[13], pw3[0]=PKW(P1,8), pw3[1]=PKW(P1,10), pw3); \
    VRD(7); SBAR(); GAPA(C1=__builtin_amdgcn_mfma_f32_32x32x16_bf16(kf[7],qr[3],C1,0,0,0),   P1[14],P1[15],0.f,0.f,       pw3[2]=PKW(P1,12),pw3[3]=PKW(P1,14), pw3); \
    l_reg+=sacc; \
    if(GK){DMA_K((t)+3,sl_cur);} if(GV){DMA_V((t)+1,sl_next);} \
    CMASK(C0,C1,t); \
    { float a=MX3(C0[0],C0[1],C1[0]),b=MX3(C0[2],C0[3],C1[1]); a=MX3(a,C1[2],C1[3]); \
      _Pragma("unroll") for(int r=4;r<16;r+=4){a=MX3(a,C0[r],C0[r+1]);b=MX3(b,C0[r+2],C0[r+3]);a=MX3(a,C1[r],C1[r+1]);b=MX3(b,C1[r+2],C1[r+3]);} \
      float rm=__builtin_fmaxf(a,b); { auto rr=__builtin_amdgcn_permlane32_swap(__float_as_uint(rm),__float_as_uint(rm),false,false); rm=__builtin_fmaxf(__uint_as_float(rr[0]),__uint_as_float(rr[1])); } \
      resc=false; \
      if(__builtin_expect(__any(rm>(float)THRL),0)){ const float dl=__builtin_fmaxf(rm,0.f); mhat+=dl; \
        _Pragma("unroll") for(int r=0;r<16;++r){C0[r]-=dl;C1[r]-=dl;} \
        _Pragma("unroll") for(int r=0;r<16;++r)negm[r]=-mhat; asm volatile("":"+v"(negm)); \
        const float f=__builtin_amdgcn_exp2f(-dl); l_reg*=f; if(hi==0)wsf[r32]=f; resc=true; } } \
    SBAR(); \
    GAPB(o[0]=__builtin_amdgcn_mfma_f32_32x32x16_bf16(PAF(0),VFR(0),o[0],0,0,0), C0,0); \
    GAPB(o[1]=__builtin_amdgcn_mfma_f32_32x32x16_bf16(PAF(0),VFR(4),o[1],0,0,0), C0,4); \
    KRD(GL,0); GAPB(o[0]=__builtin_amdgcn_mfma_f32_32x32x16_bf16(PAF(1),VFR(1),o[0],0,0,0), C0,8); \
    KRD(GL,1); GAPB(o[1]=__builtin_amdgcn_mfma_f32_32x32x16_bf16(PAF(1),VFR(5),o[1],0,0,0), C0,12); \
    KRD(GL,2); GAPB(o[0]=__builtin_amdgcn_mfma_f32_32x32x16_bf16(PAF(2),VFR(2),o[0],0,0,0), C1,0); \
    KRD(GL,3); GAPB(o[1]=__builtin_amdgcn_mfma_f32_32x32x16_bf16(PAF(2),VFR(6),o[1],0,0,0), C1,4); \
    GAPB(o[0]=__builtin_amdgcn_mfma_f32_32x32x16_bf16(PAF(3),VFR(3),o[0],0,0,0), C1,8); \
    GAPB(o[1]=__builtin_amdgcn_mfma_f32_32x32x16_bf16(PAF(3),VFR(7),o[1],0,0,0), C1,12); \
    }while(0)
  int t=1;
  #undef CMASK
  #define CMASK(P0,P1,t) do{}while(0)
  for(;t+5<NT;t+=2){
    STEP(pB0,pB1,pA0,pA1,t,true,true,true);     WAIT_BAR(2); RESC(); ROT();
    STEP(pA0,pA1,pB0,pB1,t+1,true,true,true);   WAIT_BAR(2); RESC(); ROT();
  }
  #undef CMASK
  #define CMASK(P0,P1,t) do{}while(0)
  #define ENDW(tt) do{ if((tt)+3<NT){WAIT_BAR(2);} else if((tt)+2<NT){WAIT_BAR(1);} else {WAIT_BAR(0);} }while(0)
  for(;t+1<NT;t+=2){
    STEP(pB0,pB1,pA0,pA1,t,(t+3<NT),(t+1<NT),(t+1<NT));       ENDW(t);   RESC(); ROT();
    STEP(pA0,pA1,pB0,pB1,t+1,(t+4<NT),(t+2<NT),(t+2<NT));     ENDW(t+1); RESC(); ROT();
  }
  STEP(pB0,pB1,pA0,pA1,NT-1,false,false,false); RESC();
  { float sacc=pB0[0]+pB0[1]; _Pragma("unroll") for(int r=2;r<16;++r)sacc+=pB0[r]; _Pragma("unroll") for(int r=0;r<16;++r)sacc+=pB1[r]; l_reg+=sacc;
    pw0=(u32x4){PKW(pB0,0),PKW(pB0,2),PKW(pB0,4),PKW(pB0,6)};pw1=(u32x4){PKW(pB0,8),PKW(pB0,10),PKW(pB0,12),PKW(pB0,14)};pw2=(u32x4){PKW(pB1,0),PKW(pB1,2),PKW(pB1,4),PKW(pB1,6)};pw3=(u32x4){PKW(pB1,8),PKW(pB1,10),PKW(pB1,12),PKW(pB1,14)};
    SBAR(); pv(o,vb0+sl_cur,PAF(0),PAF(1),PAF(2),PAF(3)); }
  #undef PKW
  #undef PAF
  #undef VFR
  #undef PIN
  #undef MX3
  #undef GAPA
  #undef GAPB
  #undef EX
  #undef VRD
  #undef KRD
  #undef STEP
  #undef ENDW
  {auto rr=__builtin_amdgcn_permlane32_swap(__float_as_uint(l_reg),__float_as_uint(l_reg),false,false);l_reg=__uint_as_float(rr[0])+__uint_as_float(rr[1]);}
  if(hi==0)wsf[32+r32]=l_reg;asm volatile("s_waitcnt lgkmcnt(0)":::"memory");
  float rli[16];
  #pragma unroll
  for(int r=0;r<16;++r)rli[r]=__builtin_amdgcn_rcpf(wsf[32+crow(r,hi)]);
  bf16*Ow=Ow0+(long)(wid*QBLK)*pos_;
  { bf16*stg=(bf16*)(shm+LDS_OST)+wid*2048;
    #pragma unroll
    for(int r=0;r<16;++r){const int orow=crow(r,hi);
      #pragma unroll
      for(int d0=0;d0<2;++d0)stg[orow*64+d0*32+r32]=__float2bfloat16(o[d0][r]*rli[r]);}
    asm volatile("s_waitcnt lgkmcnt(0)":::"memory");
    #pragma unroll
    for(int i=0;i<4;++i){const int row=i*8+(lane>>3),ch=lane&7; const u32x4 v=*(const u32x4*)(stg+row*64+ch*8); ATTN_STORE16(Ow+(long)row*pos_+ch*8,v);} }
  asm volatile("s_waitcnt lgkmcnt(0)\n\ts_barrier":::"memory");
  #undef DMA_K
  #undef DMA_V
  #undef CMASK
  #undef START
  #undef RESC
  #undef ROT
}
constexpr int ATTN_LDS_BYTES=LDS_BYTES;
#undef SBAR
#undef WAIT_BAR
}
struct Args { const float* in[26]; float* out; unsigned char* ws; };

template <int ACT  > struct EpiAct {
    static constexpr bool PERM = true, AFTER_DRAIN = false;
    bf16_t* O; int ldc;
    __device__ __forceinline__ void operator()(const pg8::f32x4 (&acc)[2][2][4][2], const pg8::Unit& u, int wr, int wc, int fr, int fq) const {
        const int row0 = u.pm * 256 + wr * 64 + fr, col0 = u.pn * 256 + wc * 32 + 8 * fq;
#pragma unroll
        for (int ai = 0; ai < 2; ++ai)
#pragma unroll
            for (int m = 0; m < 4; ++m) { bf16_t* rowp = O + (size_t)(row0 + ai * 128 + m * 16) * ldc + col0;
#pragma unroll
                for (int bj = 0; bj < 2; ++bj) { float v[8];
#pragma unroll
                    for (int i = 0; i < 4; ++i) { v[i] = acc[ai][bj][m][0][i]; v[4 + i] = acc[ai][bj][m][1][i]; }
#pragma unroll
                    for (int i = 0; i < 8; ++i) {
                        if (ACT == 1) v[i] = 1.f / (1.f + __expf(-v[i]));
                        if (ACT == 2) { const float r = fmaxf(v[i], 0.f); v[i] = r * r; } }
                    pg8::u32x4 w; w.x = pg8::cvt_pk_bf16(v[0], v[1]); w.y = pg8::cvt_pk_bf16(v[2], v[3]); w.z = pg8::cvt_pk_bf16(v[4], v[5]); w.w = pg8::cvt_pk_bf16(v[6], v[7]);
                    *(pg8::u32x4*)(rowp + bj * 128) = w; } }
    }
};
struct EpiF32 {
    static constexpr bool PERM = true, AFTER_DRAIN = false;
    float* O; int ldc;
    __device__ __forceinline__ void operator()(const pg8::f32x4 (&acc)[2][2][4][2], const pg8::Unit& u, int wr, int wc, int fr, int fq) const {
        const int row0 = u.pm * 256 + wr * 64 + fr, col0 = u.pn * 256 + wc * 32 + 8 * fq;
#pragma unroll
        for (int ai = 0; ai < 2; ++ai)
#pragma unroll
            for (int m = 0; m < 4; ++m) { float* rowp = O + (size_t)(row0 + ai * 128 + m * 16) * ldc + col0;
#pragma unroll
                for (int bj = 0; bj < 2; ++bj) { *(pg8::f32x4*)(rowp + bj * 128) = acc[ai][bj][m][0]; *(pg8::f32x4*)(rowp + bj * 128 + 4) = acc[ai][bj][m][1]; } }
    }
};
struct EpiBranch {
    static constexpr bool PERM = true, AFTER_DRAIN = false;
    bf16_t* GO; float* ACC; int mode;
    __device__ __forceinline__ void fin(const pg8::u32x4 g, const pg8::f32x4 a0, const pg8::f32x4 a1, pg8::f32x4 v0, pg8::f32x4 v1, size_t idx) const {
        v0[0] *= bflo(g.x); v0[1] *= bfhi(g.x); v0[2] *= bflo(g.y); v0[3] *= bfhi(g.y);
        v1[0] *= bflo(g.z); v1[1] *= bfhi(g.z); v1[2] *= bflo(g.w); v1[3] *= bfhi(g.w);
        if (mode > 0) { v0 += a0; v1 += a1; }
        if (mode < 2) { *(pg8::f32x4*)(ACC + idx) = v0; *(pg8::f32x4*)(ACC + idx + 4) = v1; }
        else { pg8::u32x4 w; w.x = pg8::cvt_pk_bf16(v0[0], v0[1]); w.y = pg8::cvt_pk_bf16(v0[2], v0[3]); w.z = pg8::cvt_pk_bf16(v1[0], v1[1]); w.w = pg8::cvt_pk_bf16(v1[2], v1[3]); *(pg8::u32x4*)(GO + idx) = w; }
    }
    __device__ __forceinline__ void operator()(const pg8::f32x4 (&acc)[2][2][4][2], const pg8::Unit& u, int wr, int wc, int fr, int fq) const {
        const int row0 = u.pm * 256 + wr * 64 + fr, col0 = u.pn * 256 + wc * 32 + 8 * fq;
#pragma unroll
        for (int ai = 0; ai < 2; ++ai)
#pragma unroll
            for (int bj = 0; bj < 2; ++bj)
#pragma unroll
                for (int mh = 0; mh < 4; mh += 2) {
                    const size_t ia = (size_t)(row0 + ai * 128 + mh * 16) * 1024 + col0 + bj * 128, ib = ia + (size_t)16 * 1024;
                    const pg8::u32x4 ga = *(const pg8::u32x4*)(GO + ia), gb = *(const pg8::u32x4*)(GO + ib);
                    pg8::f32x4 aa0 = {0.f, 0.f, 0.f, 0.f}, aa1 = aa0, ab0 = aa0, ab1 = aa0;
                    if (mode > 0) { aa0 = *(const pg8::f32x4*)(ACC + ia); aa1 = *(const pg8::f32x4*)(ACC + ia + 4); ab0 = *(const pg8::f32x4*)(ACC + ib); ab1 = *(const pg8::f32x4*)(ACC + ib + 4); }
                    fin(ga, aa0, aa1, acc[ai][bj][mh][0], acc[ai][bj][mh][1], ia);
                    fin(gb, ab0, ab1, acc[ai][bj][mh + 1][0], acc[ai][bj][mh + 1][1], ib);
                }
    }
};
struct EpiIn {
    static constexpr bool PERM = true, AFTER_DRAIN = false;
    unsigned char* ws;
    __device__ __forceinline__ void operator()(const pg8::f32x4 (&acc)[2][2][4][2], const pg8::Unit& u, int wr, int wc, int fr, int fq) const {
        const bool latent = u.pm < (ML / 256);
        const int cw = wc * 32 + 8 * fq;
        bf16_t* const poolin = (bf16_t*)(ws + WS_POOLIN); bf16_t* const qd = (bf16_t*)(ws + WS_QD); bf16_t* const qg = (bf16_t*)(ws + WS_QG); bf16_t* const kd = (bf16_t*)(ws + WS_KD);
        bf16_t* const vd = (bf16_t*)(ws + WS_VD); bf16_t* const kg = (bf16_t*)(ws + WS_KG); bf16_t* const vg = (bf16_t*)(ws + WS_VG); const float* const rope = (const float*)(ws + WS_ROPE);
#pragma unroll
        for (int bj = 0; bj < 2; ++bj) {
            const int cb = u.pn * 2 + bj;
            bf16_t* base; int pitch, coff; bool kvmap = false, dorope = false; float sc = 1.f;
            if (cb < 4) { base = poolin; pitch = 512; coff = cb * 128; }
            else if (cb < 8) { base = qd; pitch = 512; coff = (cb - 4) * 128; dorope = latent; sc = QC2; }
            else if (cb < 12) { base = qg; pitch = 512; coff = (cb - 8) * 128; }
            else if (cb < 16) { base = kd; pitch = 512; coff = (cb - 12) * 128; kvmap = true; dorope = latent; }
            else if (cb < 20) { base = vd; pitch = 512; coff = (cb - 16) * 128; kvmap = true; }
            else if (cb == 20) { base = kg; pitch = 128; coff = 0; kvmap = true; }
            else { base = vg; pitch = 128; coff = 0; kvmap = true; }
#pragma unroll
            for (int ai = 0; ai < 2; ++ai)
#pragma unroll
                for (int mh = 0; mh < 4; mh += 2) {
                    const int rowa = u.pm * 256 + ai * 128 + wr * 64 + mh * 16 + fr, rowb = rowa + 16;
                    f32x4 ta0 = {1.f, 0.f, 1.f, 0.f}, ta1 = ta0, tb0 = ta0, tb1 = ta0;
                    if (dorope) { const int p0 = (cw & 63) >> 1, j0 = p0 & 15, ta = rowa & 4095, tb = rowb & 4095, posa = p0 < 16 ? (ta >> 6) : (ta & 63), posb = p0 < 16 ? (tb >> 6) : (tb & 63);
                        const f32x4* pa = (const f32x4*)(rope + (posa * 16 + j0) * 2); const f32x4* pb = (const f32x4*)(rope + (posb * 16 + j0) * 2);
                        ta0 = pa[0]; ta1 = pa[1]; tb0 = pb[0]; tb1 = pb[1]; }
#pragma unroll
                    for (int h2 = 0; h2 < 2; ++h2) {
                        const int m = mh + h2, row = h2 ? rowb : rowa;
                        const f32x4 t0 = h2 ? tb0 : ta0, t1 = h2 ? tb1 : ta1;
                        const int drow = kvmap ? kvrow_of(row) : row;
                        float v[8];
#pragma unroll
                        for (int i = 0; i < 4; ++i) { v[i] = acc[ai][bj][m][0][i]; v[4 + i] = acc[ai][bj][m][1][i]; }
                        if (dorope) { float o[8];
                            o[0] = v[0] * t0[0] - v[1] * t0[1]; o[1] = v[0] * t0[1] + v[1] * t0[0];
                            o[2] = v[2] * t0[2] - v[3] * t0[3]; o[3] = v[2] * t0[3] + v[3] * t0[2];
                            o[4] = v[4] * t1[0] - v[5] * t1[1]; o[5] = v[4] * t1[1] + v[5] * t1[0];
                            o[6] = v[6] * t1[2] - v[7] * t1[3]; o[7] = v[6] * t1[3] + v[7] * t1[2];
#pragma unroll
                            for (int i = 0; i < 8; ++i) v[i] = o[i]; }
#pragma unroll
                        for (int i = 0; i < 8; ++i) v[i] *= sc;
                        pg8::u32x4 w; w.x = pg8::cvt_pk_bf16(v[0], v[1]); w.y = pg8::cvt_pk_bf16(v[2], v[3]); w.z = pg8::cvt_pk_bf16(v[4], v[5]); w.w = pg8::cvt_pk_bf16(v[6], v[7]);
                        *(pg8::u32x4*)(base + (size_t)drow * pitch + coff + cw) = w;
                    }
                }
        }
    }
};
struct SchedG {
    pg8::StaticOrder so; const char* A; const char* Bt; int ld, nt;
    __device__ __forceinline__ void init(const void* A_, const void* Bt_, int M, int N, int K, int G, int c) { so.init(M, N, G, c); A = (const char*)A_; Bt = (const char*)Bt_; ld = K * 2; nt = K / 64; }
    __device__ __forceinline__ bool next(int i, pg8::Unit& u) const { if (!so.next(i, u)) return false;
        u.A = A + (size_t)u.pm * 256 * ld; u.B = Bt + (size_t)u.pn * 256 * ld; u.lda = ld; u.ldb = ld; u.nt = nt; u.seg = 0; return true; }
    __device__ __forceinline__ void a_ready(const pg8::Unit&) const {}
    __device__ __forceinline__ void done(const pg8::Unit&) const {}
};
struct SchedP4 {
    pg8::StaticOrder so; const char* ws;
    __device__ __forceinline__ void init(const unsigned char* ws_, int M, int G, int c) { so.init(M, 1024, G, c); ws = (const char*)ws_; }
    __device__ __forceinline__ bool next(int i, pg8::Unit& u) const { const int job = i / 6, seg = i - job * 6, b = seg >> 1; if (!so.next(job, u)) return false;
        if ((seg & 1) == 0) { u.A = ws + WS_H + (size_t)u.pm * 256 * 2048; u.lda = 2048; u.B = ws + W_IN + (size_t)(N1 + b * 1024 + u.pn * 256) * 2048; u.ldb = 2048; u.nt = 16; }
        else { const size_t ao = b == 0 ? WS_POOLO : b == 1 ? WS_DIFFO : WS_GQAO, bo = b == 0 ? W_PO : b == 1 ? W_DO : W_GO;
            u.A = ws + ao + (size_t)u.pm * 256 * 1024; u.lda = 1024; u.B = ws + bo + (size_t)u.pn * 256 * 1024; u.ldb = 1024; u.nt = 8; }
        u.seg = seg; return true; }
    __device__ __forceinline__ void a_ready(const pg8::Unit&) const {}
    __device__ __forceinline__ void done(const pg8::Unit&) const {}
};
constexpr size_t WS_GC = 244 * MiB, WS_MP = 252 * MiB, WS_YP = 244 * MiB;
struct SchedP4C {
    pg8::StaticOrder so; const char* ws; int G, c, nl;
    __device__ __forceinline__ void init(const unsigned char* ws_, int G_, int c_) { so.init(ML, 1024, G_, c_); ws = (const char*)ws_; G = G_; c = c_; nl = c_ < 256 ? (256 - c_ + G_ - 1) / G_ : 0; }
    __device__ __forceinline__ bool next(int i, pg8::Unit& u) const {
        if (i < 6 * nl) { const int job = i / 6, seg = i - job * 6, b = seg >> 1; so.next(job, u);
            if ((seg & 1) == 0) { u.A = ws + WS_H + (size_t)u.pm * 256 * 2048; u.lda = 2048; u.B = ws + W_IN + (size_t)(N1 + b * 1024 + u.pn * 256) * 2048; u.ldb = 2048; u.nt = 16; }
            else { const size_t ao = b == 0 ? WS_POOLO : b == 1 ? WS_DIFFO : WS_GQAO, bo = b == 0 ? W_PO : b == 1 ? W_DO : W_GO;
                u.A = ws + ao + (size_t)u.pm * 256 * 1024; u.lda = 1024; u.B = ws + bo + (size_t)u.pn * 256 * 1024; u.ldb = 1024; u.nt = 8; }
            u.seg = seg; return true; }
        const int i2 = i - 6 * nl, s = i2 >> 1, part = i2 & 1; const long p = (long)s * G + c; if (p >= 48) return false;
        const int tc = (int)p / 3, b = (int)p - tc * 3; u.pm = ML / 256 + (tc >> 2); u.pn = tc & 3;
        if (part == 0) { u.A = ws + WS_H + (size_t)u.pm * 256 * 2048; u.lda = 2048; u.B = ws + W_IN + (size_t)(N1 + b * 1024 + u.pn * 256) * 2048; u.ldb = 2048; u.nt = 16; u.seg = 8 + b; }
        else { const size_t ao = b == 0 ? WS_POOLO : b == 1 ? WS_DIFFO : WS_GQAO, bo = b == 0 ? W_PO : b == 1 ? W_DO : W_GO;
            u.A = ws + ao + (size_t)u.pm * 256 * 1024; u.lda = 1024; u.B = ws + bo + (size_t)u.pn * 256 * 1024; u.ldb = 1024; u.nt = 8; u.seg = 12 + b; }
        return true; }
    __device__ __forceinline__ void a_ready(const pg8::Unit&) const {}
    __device__ __forceinline__ void done(const pg8::Unit&) const {}
};
struct SchedP5C {
    pg8::StaticOrder so; const char* ws; int G, c;
    __device__ __forceinline__ void init(const unsigned char* ws_, int G_, int c_) { so.init(ML, 1024, G_, c_); ws = (const char*)ws_; G = G_; c = c_; }
    __device__ __forceinline__ bool next(int i, pg8::Unit& u) const { const long L = (long)i * G + c;
        if (L < 256) { so.next(i, u); u.A = ws + WS_MERGED + (size_t)u.pm * 256 * 2048; u.B = ws + W_O + (size_t)u.pn * 256 * 2048; u.lda = 2048; u.ldb = 2048; u.nt = 16; u.seg = 0; return true; }
        if (L < 304) { const int p = (int)L - 256, tc = p / 3, b = p - tc * 3; u.pm = ML / 256 + (tc >> 2); u.pn = tc & 3;
            const size_t mp = b == 0 ? WS_MERGED + (size_t)ML * 2048 : WS_MP + (size_t)(b - 1) * 2 * MiB;
            u.A = ws + mp + (size_t)(tc >> 2) * 256 * 2048; u.B = ws + W_O + (size_t)u.pn * 256 * 2048; u.lda = 2048; u.ldb = 2048; u.nt = 16; u.seg = 1 + b; return true; }
        return false; }
    __device__ __forceinline__ void a_ready(const pg8::Unit&) const {}
    __device__ __forceinline__ void done(const pg8::Unit&) const {}
};
struct EpiGateMul {
    static constexpr bool PERM = true, AFTER_DRAIN = false;
    const bf16_t* Gp; bf16_t* O;
    __device__ __forceinline__ void operator()(const pg8::f32x4 (&acc)[2][2][4][2], const pg8::Unit& u, int wr, int wc, int fr, int fq) const {
        const int row0 = u.pm * 256 + wr * 64 + fr, col0 = u.pn * 256 + wc * 32 + 8 * fq;
#pragma unroll
        for (int ai = 0; ai < 2; ++ai)
#pragma unroll
            for (int bj = 0; bj < 2; ++bj)
#pragma unroll
                for (int mh = 0; mh < 4; mh += 2) {
                    const size_t ia = (size_t)(row0 + ai * 128 + mh * 16) * 1024 + col0 + bj * 128, ib = ia + (size_t)16 * 1024;
                    const pg8::u32x4 ga = *(const pg8::u32x4*)(Gp + ia), gb = *(const pg8::u32x4*)(Gp + ib);
                    { pg8::f32x4 v0 = acc[ai][bj][mh][0], v1 = acc[ai][bj][mh][1]; pg8::u32x4 w;
                      w.x = pg8::cvt_pk_bf16(v0[0] * bflo(ga.x), v0[1] * bfhi(ga.x)); w.y = pg8::cvt_pk_bf16(v0[2] * bflo(ga.y), v0[3] * bfhi(ga.y));
                      w.z = pg8::cvt_pk_bf16(v1[0] * bflo(ga.z), v1[1] * bfhi(ga.z)); w.w = pg8::cvt_pk_bf16(v1[2] * bflo(ga.w), v1[3] * bfhi(ga.w)); *(pg8::u32x4*)(O + ia) = w; }
                    { pg8::f32x4 v0 = acc[ai][bj][mh + 1][0], v1 = acc[ai][bj][mh + 1][1]; pg8::u32x4 w;
                      w.x = pg8::cvt_pk_bf16(v0[0] * bflo(gb.x), v0[1] * bfhi(gb.x)); w.y = pg8::cvt_pk_bf16(v0[2] * bflo(gb.y), v0[3] * bfhi(gb.y));
                      w.z = pg8::cvt_pk_bf16(v1[0] * bflo(gb.z), v1[1] * bfhi(gb.z)); w.w = pg8::cvt_pk_bf16(v1[2] * bflo(gb.w), v1[3] * bfhi(gb.w)); *(pg8::u32x4*)(O + ib) = w; }
                }
    }
};
constexpr size_t WS_ZP = 244 * MiB;
struct SchedP8C {
    pg8::StaticOrder so; const char* ws; int G, c;
    __device__ __forceinline__ void init(const unsigned char* ws_, int G_, int c_) { so.init(ML, 1024, G_, c_); ws = (const char*)ws_; G = G_; c = c_; }
    __device__ __forceinline__ bool next(int i, pg8::Unit& u) const { const long L = (long)i * G + c;
        if (L < 256) { so.next(i, u); u.A = ws + WS_U + (size_t)u.pm * 256 * 8192; u.B = ws + W_2 + (size_t)u.pn * 256 * 8192; u.lda = 8192; u.ldb = 8192; u.nt = 64; u.seg = 0; return true; }
        if (L < 320) { const int p = (int)L - 256, kc = p & 3; u.pn = (p >> 2) & 3; u.pm = ML / 256 + (p >> 4);
            u.A = ws + WS_U + (size_t)u.pm * 256 * 8192 + kc * 2048; u.B = ws + W_2 + (size_t)u.pn * 256 * 8192 + kc * 2048; u.lda = 8192; u.ldb = 8192; u.nt = 16; u.seg = 1 + kc; return true; }
        return false; }
    __device__ __forceinline__ void a_ready(const pg8::Unit&) const {}
    __device__ __forceinline__ void done(const pg8::Unit&) const {}
};
struct EpiP4 {
    static constexpr bool PERM = true, AFTER_DRAIN = false;
    bf16_t* GO; float* ACC; unsigned char* ws;
    __device__ __forceinline__ void operator()(const pg8::f32x4 (&acc)[2][2][4][2], const pg8::Unit& u, int wr, int wc, int fr, int fq) const {
        if (u.seg < 6) {
            if ((u.seg & 1) == 0) { EpiAct<1> e{GO, 1024}; e(acc, u, wr, wc, fr, fq); }
            else { EpiBranch e{GO, ACC, u.seg >> 1}; e(acc, u, wr, wc, fr, fq); }
        } else {
            pg8::Unit v = u; v.pm = u.pm - ML / 256; const int b = u.seg & 3;
            bf16_t* gc = (bf16_t*)(ws + WS_GC + (size_t)b * 2 * MiB);
            if (u.seg < 12) { EpiAct<1> e{gc, 1024}; e(acc, v, wr, wc, fr, fq); }
            else { bf16_t* mp = b == 0 ? GO + (size_t)ML * 1024 : (bf16_t*)(ws + WS_MP + (size_t)(b - 1) * 2 * MiB); EpiGateMul e{gc, mp}; e(acc, v, wr, wc, fr, fq); }
        }
    }
};
struct EpiP5 {
    static constexpr bool PERM = true, AFTER_DRAIN = false;
    float* Y; float* YP;
    __device__ __forceinline__ void operator()(const pg8::f32x4 (&acc)[2][2][4][2], const pg8::Unit& u, int wr, int wc, int fr, int fq) const {
        float* base = Y; pg8::Unit v = u;
        if (u.seg > 1) { base = YP + (size_t)(u.seg - 2) * MC * 1024; v.pm = u.pm - ML / 256; }
        EpiF32 e{base, 1024}; e(acc, v, wr, wc, fr, fq);
    }
};
struct EpiP8 {
    static constexpr bool PERM = true, AFTER_DRAIN = false;
    float* Z; float* ZP;
    __device__ __forceinline__ void operator()(const pg8::f32x4 (&acc)[2][2][4][2], const pg8::Unit& u, int wr, int wc, int fr, int fq) const {
        float* base = Z; pg8::Unit v = u;
        if (u.seg > 1) { base = ZP + (size_t)(u.seg - 2) * MC * 1024; v.pm = u.pm - ML / 256; }
        EpiF32 e{base, 1024}; e(acc, v, wr, wc, fr, fq);
    }
};
__device__ __forceinline__ void head_norm_fix(bf16_t* p, const float* gain, bool dorope, int t, float sc, const float* tab) {
    float ss = 0.f;
#pragma unroll
    for (int ch = 0; ch < 8; ++ch) { const v4u w = *(const v4u*)(p + ch * 8);
        const float a0 = bflo(w.x), a1 = bfhi(w.x), a2 = bflo(w.y), a3 = bfhi(w.y), a4 = bflo(w.z), a5 = bfhi(w.z), a6 = bflo(w.w), a7 = bfhi(w.w);
        ss += (a0 * a0 + a1 * a1) + (a2 * a2 + a3 * a3) + (a4 * a4 + a5 * a5) + (a6 * a6 + a7 * a7); }
    const float rstd = 1.0f / sqrtf(ss * (1.f / 64.f) + EPSN);
#pragma unroll
    for (int ch = 0; ch < 8; ++ch) { const v4u w = *(const v4u*)(p + ch * 8);
        float v[8] = {bflo(w.x), bfhi(w.x), bflo(w.y), bfhi(w.y), bflo(w.z), bfhi(w.z), bflo(w.w), bfhi(w.w)};
        const f32x4 g0 = *(const f32x4*)(gain + ch * 8), g1 = *(const f32x4*)(gain + ch * 8 + 4);
        v[0] *= rstd * g0[0]; v[1] *= rstd * g0[1]; v[2] *= rstd * g0[2]; v[3] *= rstd * g0[3];
        v[4] *= rstd * g1[0]; v[5] *= rstd * g1[1]; v[6] *= rstd * g1[2]; v[7] *= rstd * g1[3];
        if (dorope) rope8(v, tab, ch * 8, t);
        v4u o; o.x = pk2(v[0] * sc, v[1] * sc); o.y = pk2(v[2] * sc, v[3] * sc); o.z = pk2(v[4] * sc, v[5] * sc); o.w = pk2(v[6] * sc, v[7] * sc);
        *(v4u*)(p + ch * 8) = o; }
}

__device__ __forceinline__ void transpose_item(const float* W, int K, int N, bf16* WT, int k0, int n0, int drow0, LAS float* scr, int lane) {
#pragma unroll 8
    for (int i = 0; i < 32; ++i) { const int kk = 2 * i + (lane >> 5); scr[kk * 33 + (lane & 31)] = W[(size_t)(k0 + kk) * N + n0 + (lane & 31)]; }
    asm volatile("s_waitcnt lgkmcnt(0)" ::: "memory");
    const int c = lane & 7;
#pragma unroll
    for (int j = 0; j < 4; ++j) { const int n = (lane >> 3) + 8 * j; const LAS float* s = scr + (8 * c) * 33 + n;
        v4u o; o.x = pk2(s[0 * 33], s[1 * 33]); o.y = pk2(s[2 * 33], s[3 * 33]); o.z = pk2(s[4 * 33], s[5 * 33]); o.w = pk2(s[6 * 33], s[7 * 33]);
        *(v4u*)(WT + (size_t)(drow0 + n) * K + k0 + 8 * c) = o; }
    asm volatile("s_waitcnt lgkmcnt(0)" ::: "memory");
}
struct WPtrs { const float *w_in, *w_grp, *pscale, *w_po, *w_do, *w_go, *w_o, *w_1, *w_2; };
__device__ __forceinline__ void convert_weights(const WPtrs& p, int l, unsigned char* ws, LAS unsigned char* lds, int gw, int NGW, int wave, int lane, int gtid, int NTH) {
    LAS float* scr = (LAS float*)(lds + wave * 16384);
    constexpr int I_IN = (1024 / 64) * (5888 / 32), I_BR = (512 / 64) * (1024 / 32), I_O = (1024 / 64) * (1024 / 32), I_1 = (1024 / 64) * (4096 / 32), I_2 = (4096 / 64) * (1024 / 32);
    constexpr int NITEMS = I_IN + 3 * I_BR + I_O + I_1 + I_2;
    for (int it = gw; it < NITEMS; it += NGW) {
        int r = it;
        if (r < I_IN) { const int nblk = 5888 / 32, kb = r / nblk, nb = r % nblk, n0 = nb * 32;
            const int d0 = n0 < 1536 ? n0 : (n0 < 4608 ? n0 - 1536 + N1 : n0 - 4608 + 1536);
            transpose_item(p.w_in + (size_t)l * 1024 * 5888, 1024, 5888, (bf16*)(ws + W_IN), kb * 64, n0, d0, scr, lane); continue; } r -= I_IN;
        if (r < I_BR) { const int nblk = 1024 / 32, kb = r / nblk, nb = r % nblk;
            transpose_item(p.w_po + (size_t)l * 512 * 1024, 512, 1024, (bf16*)(ws + W_PO), kb * 64, nb * 32, nb * 32, scr, lane); continue; } r -= I_BR;
        if (r < I_BR) { const int nblk = 1024 / 32, kb = r / nblk, nb = r % nblk;
            transpose_item(p.w_do + (size_t)l * 512 * 1024, 512, 1024, (bf16*)(ws + W_DO), kb * 64, nb * 32, nb * 32, scr, lane); continue; } r -= I_BR;
        if (r < I_BR) { const int nblk = 1024 / 32, kb = r / nblk, nb = r % nblk;
            transpose_item(p.w_go + (size_t)l * 512 * 1024, 512, 1024, (bf16*)(ws + W_GO), kb * 64, nb * 32, nb * 32, scr, lane); continue; } r -= I_BR;
        if (r < I_O) { const int nblk = 1024 / 32, kb = r / nblk, nb = r % nblk;
            transpose_item(p.w_o + (size_t)l * 1024 * 1024, 1024, 1024, (bf16*)(ws + W_O), kb * 64, nb * 32, nb * 32, scr, lane); continue; } r -= I_O;
        if (r < I_1) { const int nblk = 4096 / 32, kb = r / nblk, nb = r % nblk;
            transpose_item(p.w_1 + (size_t)l * 1024 * 4096, 1024, 4096, (bf16*)(ws + W_1), kb * 64, nb * 32, nb * 32, scr, lane); continue; } r -= I_1;
        { const int nblk = 1024 / 32, kb = r / nblk, nb = r % nblk;
            transpose_item(p.w_2 + (size_t)l * 4096 * 1024, 4096, 1024, (bf16*)(ws + W_2), kb * 64, nb * 32, nb * 32, scr, lane); }
    }
    const float* wg = p.w_grp + (size_t)l * 4 * 128 * 128; const float* psc = p.pscale + l * 512;
    unsigned* PT = (unsigned*)(ws + W_POOL);
    for (int i = gtid; i < 512 * 256; i += NTH) { const int n = i >> 8, k = (i & 255) * 2, g = n >> 7; float v0 = 0.f, v1 = 0.f;
        if ((k >> 7) == g) { const float* q = wg + ((size_t)(g * 128 + (k & 127))) * 128 + (n & 127); const float s = psc[n]; v0 = q[0] * s; v1 = q[128] * s; }
        PT[i] = pk2(v0, v1); }
}
__device__ __forceinline__ void mod_gemv(const float* cvec, const float* cctx, const float* wmod, const float* bmod, float* modout, LAS unsigned char* lds, int tid, int lane, int wave, int bx) {
    LAS float* st = (LAS float*)lds;
    LAS float* red = (LAS float*)(lds + 32768);
    for (int i = tid; i < 5 * 1024; i += NTHR) { const int bb = i >> 10, k = i & 1023; const float v = bb < 4 ? cvec[bb * 1024 + k] : cctx[k]; st[i] = v / (1.f + expf(-v)); }
    __syncthreads();
    if (bx < 192) {
        const int l = bx / 96, n0 = (bx % 96) * 64;
        const float* w = wmod + (size_t)l * 1024 * NMOD + n0 + lane;
        float a0 = 0.f, a1 = 0.f, a2 = 0.f, a3 = 0.f, a4 = 0.f;
        const int k0 = wave * 128;
#pragma unroll 16
        for (int kk = 0; kk < 128; ++kk) { const float wv = w[(size_t)(k0 + kk) * NMOD]; const int k = k0 + kk;
            a0 += st[k] * wv; a1 += st[1024 + k] * wv; a2 += st[2048 + k] * wv; a3 += st[3072 + k] * wv; a4 += st[4096 + k] * wv; }
        red[(wave * 5 + 0) * 64 + lane] = a0; red[(wave * 5 + 1) * 64 + lane] = a1; red[(wave * 5 + 2) * 64 + lane] = a2; red[(wave * 5 + 3) * 64 + lane] = a3; red[(wave * 5 + 4) * 64 + lane] = a4;
        __syncthreads();
        if (tid < 320) { const int bb = tid >> 6; float s = bmod[l * NMOD + n0 + lane];
#pragma unroll
            for (int w8 = 0; w8 < 8; ++w8) s += red[(w8 * 5 + bb) * 64 + lane];
            modout[(l * 5 + bb) * NMOD + n0 + lane] = s; }
    }
    __syncthreads();
}
__device__ __forceinline__ void norm_phase(int M, const float* xs_lat, const float* xs_ctx, float* xd_lat, float* xd_ctx, const float* z, const float* zp, int nzp, const float* modl, int gtc, const float* gpost,
                                           bf16* hdst, const float* gnext, const float* modn, int shc, int scc, int gw, int NGW, int lane) {
    for (int m = gw; m < M; m += NGW) {
        const bool lat = m < ML; const int bb = lat ? (m >> 12) : 4;
        const float* xs = lat ? xs_lat + (size_t)m * 1024 : xs_ctx + (size_t)(m - ML) * 1024;
        f32x4 v[4];
#pragma unroll
        for (int j = 0; j < 4; ++j) v[j] = *(const f32x4*)(xs + 4 * lane + 256 * j);
        float* xd = lat ? xd_lat + (size_t)m * 1024 : xd_ctx + (size_t)(m - ML) * 1024;
        if (!z) {
#pragma unroll
            for (int j = 0; j < 4; ++j) *(f32x4*)(xd + 4 * lane + 256 * j) = v[j];
        } else {
            f32x4 zz[4]; float ss = 0.f;
#pragma unroll
            for (int j = 0; j < 4; ++j) { zz[j] = *(const f32x4*)(z + (size_t)m * 1024 + 4 * lane + 256 * j);
                if (zp && !lat) {
#pragma unroll
                    for (int kc = 0; kc < 3; ++kc) if (kc < nzp) zz[j] += *(const f32x4*)(zp + ((size_t)kc * MC + (m - ML)) * 1024 + 4 * lane + 256 * j); }
                ss += (zz[j][0] * zz[j][0] + zz[j][1] * zz[j][1]) + (zz[j][2] * zz[j][2] + zz[j][3] * zz[j][3]); }
            const float rz = 1.0f / sqrtf(wave_sum(ss) * (1.f / 1024.f) + EPSN);
            const float* gt = modl + bb * NMOD + gtc * 1024;
#pragma unroll
            for (int j = 0; j < 4; ++j) { const int c = 4 * lane + 256 * j; const f32x4 g4 = *(const f32x4*)(gpost + c), t4 = *(const f32x4*)(gt + c);
                v[j] = v[j] + t4 * ((zz[j] * rz) * g4); *(f32x4*)(xd + c) = v[j]; }
        }
        if (hdst) {
            float ss = 0.f;
#pragma unroll
            for (int j = 0; j < 4; ++j) ss += (v[j][0] * v[j][0] + v[j][1] * v[j][1]) + (v[j][2] * v[j][2] + v[j][3] * v[j][3]);
            const float rx = 1.0f / sqrtf(wave_sum(ss) * (1.f / 1024.f) + EPSN);
            const float* sh = modn + bb * NMOD + shc * 1024; const float* sc = modn + bb * NMOD + scc * 1024;
#pragma unroll
            for (int j = 0; j < 4; ++j) { const int c = 4 * lane + 256 * j; const f32x4 g4 = *(const f32x4*)(gnext + c), s4 = *(const f32x4*)(sc + c), h4 = *(const f32x4*)(sh + c);
                const f32x4 o = ((v[j] * rx) * g4) * (s4 + 1.0f) + h4;
                v2u w; w.x = pk2(o[0], o[1]); w.y = pk2(o[2], o[3]); *(v2u*)(hdst + (size_t)m * 1024 + c) = w; }
        }
    }
}
__device__ __forceinline__ void pool_phase(int M, const bf16* zin, bf16* pooled, int gtid, int NTH) {
    for (int it = gtid; it < M * 64; it += NTH) {
        const int m = it >> 6, ch = it & 63, g = ch >> 4, w2 = 1 << g;
        int t, l;
        if (m < ML) { t = m & 4095; l = SEQL; } else { t = (m - ML) & 255; l = CTXL; }
        const int base = m - t, lo = max(t - w2, 0), hi = min(t + w2, l);
        v4u w[16];
#pragma unroll
        for (int dj = 0; dj < 16; ++dj) { const int j = t + dj - 8; const int jj = min(max(j, lo), hi - 1);
            w[dj] = *(const v4u*)(zin + (size_t)(base + jj) * 512 + ch * 8); }
        float s[8];
#pragma unroll
        for (int i = 0; i < 8; ++i) s[i] = 0.f;
#pragma unroll
        for (int dj = 0; dj < 16; ++dj) { const int j = t + dj - 8; const float k = (j >= lo && j < hi) ? 1.0f : 0.0f;
            s[0] += k * bflo(w[dj].x); s[1] += k * bfhi(w[dj].x); s[2] += k * bflo(w[dj].y); s[3] += k * bfhi(w[dj].y);
            s[4] += k * bflo(w[dj].z); s[5] += k * bfhi(w[dj].z); s[6] += k * bflo(w[dj].w); s[7] += k * bfhi(w[dj].w); }
        const float inv = 1.0f / (float)(hi - lo);
        const v4u ws_ = w[8];
        v4u o; o.x = pk2(s[0] * inv - bflo(ws_.x), s[1] * inv - bfhi(ws_.x)); o.y = pk2(s[2] * inv - bflo(ws_.y), s[3] * inv - bfhi(ws_.y));
        o.z = pk2(s[4] * inv - bflo(ws_.z), s[5] * inv - bfhi(ws_.z)); o.w = pk2(s[6] * inv - bflo(ws_.w), s[7] * inv - bfhi(ws_.w));
        *(v4u*)(pooled + (size_t)m * 512 + ch * 8) = o;
    }
}
__device__ __forceinline__ void diff_combine_phase(int M, const bf16* od, bf16* diffo, const float* subln, float lam, float lam_init, int gtid, int NTH) {
    for (int it = gtid; it < M * 64; it += NTH) {
        const int l16 = it & 15, hd = (it >> 4) & 3, m = it >> 6;
        const bf16* p1 = od + (size_t)m * 1024 + hd * 256 + l16 * 8;
        const v4u a = *(const v4u*)p1, b = *(const v4u*)(p1 + 128);
        float d[8];
        d[0] = bflo(a.x) - lam * bflo(b.x); d[1] = bfhi(a.x) - lam * bfhi(b.x); d[2] = bflo(a.y) - lam * bflo(b.y); d[3] = bfhi(a.y) - lam * bfhi(b.y);
        d[4] = bflo(a.z) - lam * bflo(b.z); d[5] = bfhi(a.z) - lam * bfhi(b.z); d[6] = bflo(a.w) - lam * bflo(b.w); d[7] = bfhi(a.w) - lam * bfhi(b.w);
        float ss = 0.f;
#pragma unroll
        for (int i = 0; i < 8; ++i) ss += d[i] * d[i];
        ss += __shfl_xor(ss, 1); ss += __shfl_xor(ss, 2); ss += __shfl_xor(ss, 4); ss += __shfl_xor(ss, 8);
        const float rstd = 1.0f / sqrtf(ss * (1.f / 128.f) + EPSN), k1 = 1.0f - lam_init;
        const f32x4 g0 = *(const f32x4*)(subln + l16 * 8), g1 = *(const f32x4*)(subln + l16 * 8 + 4);
        v4u o; o.x = pk2(d[0] * rstd * g0[0] * k1, d[1] * rstd * g0[1] * k1); o.y = pk2(d[2] * rstd * g0[2] * k1, d[3] * rstd * g0[3] * k1);
        o.z = pk2(d[4] * rstd * g1[0] * k1, d[5] * rstd * g1[1] * k1); o.w = pk2(d[6] * rstd * g1[2] * k1, d[7] * rstd * g1[3] * k1);
        *(v4u*)(diffo + (size_t)m * 512 + hd * 128 + l16 * 8) = o;
    }
}

#define RLX_AGENT __ATOMIC_RELAXED, __HIP_MEMORY_SCOPE_AGENT
#define XB_TMO      128
#define XB_XCNT(j)  (256  + 64 * (j))
#define XB_XSUB(j)  (1280 + 64 * (j))
#define XB_XGEN(j)  (2304 + 64 * (j))
#define XB_TOP      3328
#define XB_TOPGEN   3392
#define XCD_BAR_WORDS 3456
#define XB_SPIN_CAP (1u << 22)

__device__ __forceinline__ unsigned xb_ld(unsigned* p)              { return __hip_atomic_load(p, __ATOMIC_RELAXED, __HIP_MEMORY_SCOPE_AGENT); }
__device__ __forceinline__ unsigned xb_add(unsigned* p, unsigned v) { return __hip_atomic_fetch_add(p, v, __ATOMIC_RELAXED, __HIP_MEMORY_SCOPE_AGENT); }
__device__ __forceinline__ unsigned xb_xcc_id() { return (unsigned)__builtin_amdgcn_s_getreg((3 << 11) | 20) & 0xFu; }
#define XB_SPIN(cond, bar) do { unsigned _sp = 0; while (cond) { __builtin_amdgcn_s_sleep(1); \
    if ((++_sp & 255u) == 0u) { if (xb_ld(&(bar)[XB_TMO])) break; if (_sp > XB_SPIN_CAP) { atomicAdd(&(bar)[XB_TMO], 1u); break; } } } } while (0)

struct XcdBarrier {
    unsigned* bar; unsigned x;
    volatile LAS unsigned* st;
};

__device__ __forceinline__ XcdBarrier xcd_barrier_post(unsigned* bar, volatile LAS unsigned* st) {
    XcdBarrier b; b.bar = bar; b.x = xb_xcc_id(); b.st = st;
    if (threadIdx.x == 0) (void)xb_add(&bar[XB_XCNT(b.x)], 1u);
    return b;
}
__device__ __forceinline__ void xcd_barrier_complete(unsigned* bar, unsigned x, unsigned& nloc, unsigned& nx) {
    const unsigned G = gridDim.x * gridDim.y * gridDim.z;
    unsigned sum, cnt, mine, sp = 0u;
    for (;;) {
        sum = 0u; cnt = 0u; mine = 0u;
#pragma unroll
        for (unsigned j = 0; j < 16; ++j) { const unsigned c = xb_ld(&bar[XB_XCNT(j)]); sum += c; cnt += (c > 0u) ? 1u : 0u; mine = (j == x) ? c : mine; }
        if (sum == G) break;
        __builtin_amdgcn_s_sleep(1);
        if ((++sp & 255u) == 0u) { if (xb_ld(&bar[XB_TMO])) break; if (sp > XB_SPIN_CAP) { atomicAdd(&bar[XB_TMO], 1u); break; } }
    }
    nloc = mine > 0u ? mine : 1u; nx = cnt > 0u ? cnt : 1u;
}

__device__ __forceinline__ void xcd_barrier(const XcdBarrier& b) {
    asm volatile("s_waitcnt vmcnt(0)" ::: "memory");
    __syncthreads();
    if (threadIdx.x == 0) {
        unsigned* bar = b.bar;
        __builtin_amdgcn_s_waitcnt(0);
        unsigned nloc = b.st[0], nx = b.st[1];
        if (nloc == 0u) { xcd_barrier_complete(bar, b.x, nloc, nx); b.st[0] = nloc; b.st[1] = nx; }
        const unsigned old = xb_add(&bar[XB_XSUB(b.x)], 1u);
        const unsigned gen = old / nloc;
        if (old + 1u == (gen + 1u) * nloc) {
            __builtin_amdgcn_fence(__ATOMIC_RELEASE, "agent");
            asm volatile("s_waitcnt vmcnt(0)" ::: "memory");
            const unsigned og = xb_add(&bar[XB_TOP], 1u);
            const unsigned tg = og / nx;
            if (og + 1u == (tg + 1u) * nx) xb_add(&bar[XB_TOPGEN], 1u);
            else XB_SPIN(xb_ld(&bar[XB_TOPGEN]) == tg, bar);
            __builtin_amdgcn_fence(__ATOMIC_ACQUIRE, "agent");
            xb_add(&bar[XB_XGEN(b.x)], 1u);
            asm volatile("s_waitcnt vmcnt(0)" ::: "memory");
        } else {
            XB_SPIN(xb_ld(&bar[XB_XGEN(b.x)]) == gen, bar);
            __builtin_amdgcn_fence(__ATOMIC_ACQUIRE, "agent");
            asm volatile("s_waitcnt vmcnt(0)" ::: "memory");
        }
    }
    __syncthreads();
}
constexpr size_t WS_BAR = 320 * 1024;
constexpr int LDS_CTL = 131072, LDS_BARST = LDS_CTL + 352;
constexpr size_t WS_PTR = 300 * 1024;
struct Ids { int tid, lane, wave, bx, G, vcu, gw, NGW, gtid, NTH; };
#define FRESH_IDS(I) Ids I; { int t_ = threadIdx.x; asm volatile("" : "+v"(t_)); int b_ = blockIdx.x; asm volatile("" : "+s"(b_)); int g_ = gridDim.x; asm volatile("" : "+s"(g_)); \
    I.tid = t_; I.lane = t_ & 63; I.wave = __builtin_amdgcn_readfirstlane(t_ >> 6); I.bx = b_; I.G = g_; I.vcu = (g_ % 8 == 0) ? (b_ % 8) * (g_ / 8) + b_ / 8 : b_; \
    I.gw = I.vcu * 8 + I.wave; I.NGW = g_ * 8; I.gtid = b_ * NTHR + t_; I.NTH = g_ * NTHR; }
#define PTAB(i) (((const float* const*)(ws + WS_PTR))[i])

__global__ void __launch_bounds__(NTHR, 2) mk_fwd(Args a) {
    extern __shared__ __attribute__((aligned(16))) unsigned char lds_raw[];
    cg::grid_group grid = cg::this_grid();
    LAS unsigned char* lds = (LAS unsigned char*)lds_raw;
    unsigned char* ws = a.ws;
#define GSYNC_CG() do { asm volatile("s_waitcnt vmcnt(0) lgkmcnt(0)" ::: "memory"); grid.sync(); asm volatile("" ::: "memory"); } while (0)
#define GSYNC() do { XcdBarrier b_; b_.bar = (unsigned*)(ws + WS_BAR); b_.x = xb_xcc_id(); b_.st = (volatile LAS unsigned*)(lds + LDS_BARST); xcd_barrier(b_); asm volatile("" ::: "memory"); } while (0)
#ifndef REP_P1
#define REP_P1 1
#endif
#ifndef REP_P2
#define REP_P2 1
#endif
#ifndef REP_P3
#define REP_P3 1
#endif
#ifndef REP_P4
#define REP_P4 1
#endif
#ifndef REP_P5
#define REP_P5 1
#endif
#ifndef REP_P7
#define REP_P7 1
#endif
#ifndef REP_P8
#define REP_P8 1
#endif
#ifndef EXTRA_SYNCS
#define EXTRA_SYNCS 0
#endif
#define REPEAT(n) _Pragma("unroll 1") for (int rep_ = 0; rep_ < (n); ++rep_)
    for (int u = threadIdx.x; u < (LDS_BYTES - LDS_CTL) / 4; u += NTHR) ((LAS unsigned*)(lds + LDS_CTL))[u] = 0u;
    if (blockIdx.x == 0) for (int i = threadIdx.x; i < XCD_BAR_WORDS; i += NTHR) ((unsigned*)(ws + WS_BAR))[i] = 0u;
    __syncthreads();

    {
        FRESH_IDS(I);
        if (I.bx == 0 && I.tid == 0) {
            const float** tab = (const float**)(ws + WS_PTR);
#pragma unroll
            for (int i = 0; i < 26; ++i) tab[i] = a.in[i];
            tab[26] = a.out;
        }
        mod_gemv(a.in[1], a.in[3], a.in[4], a.in[5], (float*)(ws + WS_MOD), lds, I.tid, I.lane, I.wave, I.bx);
        WPtrs wp{a.in[10], a.in[11], a.in[12], a.in[20], a.in[21], a.in[22], a.in[23], a.in[24], a.in[25]};
        convert_weights(wp, 0, ws, lds, I.gw, I.NGW, I.wave, I.lane, I.gtid, I.NTH);
        if (I.bx == I.G - 1) { float* ropet = (float*)(ws + WS_ROPE);
            for (int i = I.tid; i < 1024; i += NTHR) { const int pos = i >> 4, j = i & 15; const float inv = 1.0f / powf(10000.0f, (float)j * 2.0f / 32.0f); const float ang = (float)pos * inv;
                ropet[2 * i] = cosf(ang); ropet[2 * i + 1] = sinf(ang); } }
    }
    GSYNC_CG();
#ifdef EXTRA_CG
    for (int e_ = 0; e_ < EXTRA_CG; ++e_) GSYNC_CG();
#endif
    (void)xcd_barrier_post((unsigned*)(ws + WS_BAR), (volatile LAS unsigned*)(lds + LDS_BARST));
    for (int e_ = 0; e_ < EXTRA_SYNCS; ++e_) GSYNC();
    {
        FRESH_IDS(I);
        float* modv = (float*)(ws + WS_MOD);
        norm_phase(MA, PTAB(0), PTAB(2), (float*)PTAB(26), (float*)(ws + WS_CTX), nullptr, nullptr, 0, nullptr, 0, nullptr, (bf16*)(ws + WS_H), PTAB(6), modv, 0, 1, I.gw, I.NGW, I.lane);
    }
    GSYNC();

#pragma unroll 1
    for (int l = 0; l < 2; ++l) {
        REPEAT(REP_P1) {
        {
            FRESH_IDS(I);
            const float* ropet = (const float*)(ws + WS_ROPE);
            SchedG S; S.init(ws + WS_H, ws + W_IN, MA, N1, 1024, I.G, I.bx);
            EpiIn E{ws};
            pg8::gemm_phase<EpiIn, SchedG, true, true>(lds, S, E);
        }
        {
            asm volatile("s_waitcnt vmcnt(0)" ::: "memory"); __syncthreads(); __builtin_amdgcn_fence(__ATOMIC_ACQUIRE, "agent"); asm volatile("s_waitcnt vmcnt(0)" ::: "memory");
            FRESH_IDS(I);
            const float* ropet = (const float*)(ws + WS_ROPE);
            const float* kn = PTAB(19) + l * 64;
            pg8::StaticOrder S; S.init(MA, N1, I.G, I.bx);
            pg8::Unit u;
            for (int i = 0; S.next(i, u); ++i) {
                const bool latent = u.pm < (ML / 256);
                if (u.pn == 10) {
                    const int hh = I.tid & 1, rl = I.tid >> 1, row = u.pm * 256 + rl;
                    head_norm_fix((bf16_t*)(ws + WS_KG) + (size_t)kvrow_of(row) * 128 + hh * 64, kn, latent, row & 4095, 1.0f, ropet);
                }
            }
        }
        GSYNC();
        }
        REPEAT(REP_P2) {
        {
            FRESH_IDS(I);
            const bool last = (l == 1); const int M2 = last ? ML : MA;
            pool_phase(M2, (const bf16*)(ws + WS_POOLIN), (bf16*)(ws + WS_POOLED), I.gtid, I.NTH);
            const int total = 1536 + (last ? 0 : 96);
            for (int i = 0;; ++i) {
                const int L = i * I.G + I.vcu; if (L >= total) break;
                int b, r, m0, NT;
                if (L < 1536) { const int qb = L & 15, pair = L >> 4; b = pair / 24; r = pair % 24; m0 = b * SEQL + qb * 256; NT = LKV / 64; }
                else { const int L2 = L - 1536; b = L2 / 24; r = L2 % 24; m0 = ML + b * CTXL; NT = CTXL / 64; }
                const attn_body::bf16 *Q, *K, *V; attn_body::bf16* O; int pq, pk, pv, po; const float* qgain = nullptr; int qt0 = -1;
                if (r < 16) { const int hd = r >> 2, qs = (r >> 1) & 1, vh = r & 1;
                    Q = (const attn_body::bf16*)(ws + WS_QD) + (size_t)m0 * 512 + hd * 128 + qs * 64; pq = 512;
                    K = (const attn_body::bf16*)(ws + WS_KD) + (size_t)(b * LKV) * 512 + hd * 128 + qs * 64; pk = 512;
                    V = (const attn_body::bf16*)(ws + WS_VD) + (size_t)(b * LKV) * 512 + hd * 128 + vh * 64; pv = 512;
                    O = (attn_body::bf16*)(ws + WS_OD) + (size_t)m0 * 1024 + hd * 256 + qs * 128 + vh * 64; po = 1024; }
                else { const int h = r - 16;
                    Q = (const attn_body::bf16*)(ws + WS_QG) + (size_t)m0 * 512 + h * 64; pq = 512;
                    K = (const attn_body::bf16*)(ws + WS_KG) + (size_t)(b * LKV) * 128 + (h >> 2) * 64; pk = 128;
                    V = (const attn_body::bf16*)(ws + WS_VG) + (size_t)(b * LKV) * 128 + (h >> 2) * 64; pv = 128;
                    O = (attn_body::bf16*)(ws + WS_GQAO) + (size_t)m0 * 512 + h * 64; po = 512; qgain = PTAB(18) + l * 64; qt0 = (L < 1536) ? (m0 & 4095) : -1; }
#ifndef NO_ATTN
                attn_body::attn_unit<8>(Q, pq, K, pk, V, pv, O, po, NT, (char*)lds_raw, qgain, (const float*)(ws + WS_ROPE), qt0);
#endif
            }
        }
        GSYNC();
        }
        REPEAT(REP_P3) {
        {
            FRESH_IDS(I);
            const bool last = (l == 1); const int M2 = last ? ML : MA; const float lam_init = last ? 0.35550906759f : 0.2f;
            const float *lq1 = PTAB(13) + l * 64, *lk1 = PTAB(14) + l * 64, *lq2 = PTAB(15) + l * 64, *lk2 = PTAB(16) + l * 64;
            float d1 = 0.f, d2 = 0.f;
            for (int i = 0; i < 64; ++i) { d1 += lq1[i] * lk1[i]; d2 += lq2[i] * lk2[i]; }
            const float lam = expf(d1) - expf(d2) + lam_init;
            diff_combine_phase(M2, (const bf16*)(ws + WS_OD), (bf16*)(ws + WS_DIFFO), PTAB(17) + l * 128, lam, lam_init, I.gtid, I.NTH);
            SchedG S; S.init(ws + WS_POOLED, ws + W_POOL, M2, 512, 512, I.G, I.bx);
            EpiAct<0> E{(bf16_t*)(ws + WS_POOLO), 512};
            pg8::gemm_phase<EpiAct<0>, SchedG, true, true>(lds, S, E);
        }
        GSYNC();
        }
        REPEAT(REP_P4) {
        { FRESH_IDS(I); const int M2 = (l == 1) ? ML : MA;
          EpiP4 E{(bf16_t*)(ws + WS_MERGED), (float*)(ws + WS_ACC), ws};
          if (l == 0) { SchedP4C S; S.init(ws, I.G, I.bx); pg8::gemm_phase<EpiP4, SchedP4C, true, true>(lds, S, E); }
          else { SchedP4 S; S.init(ws, M2, I.G, I.bx); pg8::gemm_phase<EpiP4, SchedP4, true, true>(lds, S, E); } }
        GSYNC();
        }
        REPEAT(REP_P5) {
        {
            FRESH_IDS(I); const int M2 = (l == 1) ? ML : MA;
            EpiP5 E{(float*)(ws + WS_Y), (float*)(ws + WS_YP)};
            if (l == 0) { SchedP5C S; S.init(ws, I.G, I.bx); pg8::gemm_phase<EpiP5, SchedP5C, true, true>(lds, S, E); }
            else { SchedG S; S.init(ws + WS_MERGED, ws + W_O, M2, 1024, 1024, I.G, I.bx); pg8::gemm_phase<EpiP5, SchedG, true, true>(lds, S, E); }
        }
        GSYNC();
        }
        {
            FRESH_IDS(I); const int M2 = (l == 1) ? ML : MA;
            const float* modl = (const float*)(ws + WS_MOD) + l * 5 * NMOD; float* outp = (float*)PTAB(26); float* ctxx = (float*)(ws + WS_CTX);
            norm_phase(M2, outp, ctxx, outp, ctxx, (const float*)(ws + WS_Y), l == 0 ? (const float*)(ws + WS_YP) : nullptr, 2, modl, 2, PTAB(7) + l * 1024, (bf16*)(ws + WS_HF), PTAB(8) + l * 1024, modl, 3, 4, I.gw, I.NGW, I.lane);
        }
        GSYNC();
        REPEAT(REP_P7) {
        {
            FRESH_IDS(I); const int M2 = (l == 1) ? ML : MA;
            SchedG S; S.init(ws + WS_HF, ws + W_1, M2, DFF, 1024, I.G, I.bx);
            EpiAct<2> E{(bf16_t*)(ws + WS_U), DFF};
            pg8::gemm_phase<EpiAct<2>, SchedG, true, true>(lds, S, E);
        }
        GSYNC();
        }
        REPEAT(REP_P8) {
        {
            FRESH_IDS(I);
            EpiP8 E{(float*)(ws + WS_Z), (float*)(ws + WS_ZP)};
            if (l == 0) { SchedP8C S; S.init(ws, I.G, I.bx); pg8::gemm_phase<EpiP8, SchedP8C, true, true>(lds, S, E); }
            else { SchedG S; S.init(ws + WS_U, ws + W_2, ML, 1024, DFF, I.G, I.bx); pg8::gemm_phase<EpiP8, SchedG, true, true>(lds, S, E); }
        }
        GSYNC();
        }
        {
            FRESH_IDS(I);
            const float* modl = (const float*)(ws + WS_MOD) + l * 5 * NMOD; float* outp = (float*)PTAB(26); float* ctxx = (float*)(ws + WS_CTX);
            if (l == 0) {
                WPtrs wp{PTAB(10), PTAB(11), PTAB(12), PTAB(20), PTAB(21), PTAB(22), PTAB(23), PTAB(24), PTAB(25)};
                convert_weights(wp, 1, ws, lds, I.gw, I.NGW, I.wave, I.lane, I.gtid, I.NTH);
                norm_phase(MA, outp, ctxx, outp, ctxx, (const float*)(ws + WS_Z), (const float*)(ws + WS_ZP), 3, modl, 5, PTAB(9) + l * 1024, (bf16*)(ws + WS_H), PTAB(6) + 1024, modl + 5 * NMOD, 0, 1, I.gw, I.NGW, I.lane);
            } else {
                norm_phase(ML, outp, ctxx, outp, ctxx, (const float*)(ws + WS_Z), nullptr, 0, modl, 5, PTAB(9) + l * 1024, nullptr, nullptr, nullptr, 0, 0, I.gw, I.NGW, I.lane);
            }
        }
        if (l == 0) GSYNC();
    }
#undef GSYNC
}

extern "C" void kernel_launch(void* const* d_in, const int* in_sizes, int n_in, void* d_out, int out_size, void* d_ws, size_t ws_size, hipStream_t stream) {
    static int grid = 0;
    if (grid == 0) {
        if (n_in != 26 || out_size != ML * DMODEL || ws_size < WS_TOTAL) { fprintf(stderr, "kernel_launch: unexpected shapes (n_in %d out %d ws %zu)\n", n_in, out_size, ws_size); grid = -1; return; }
        int dev = 0, cus = 0, per_cu = 0;
        if (hipGetDevice(&dev) != hipSuccess || hipDeviceGetAttribute(&cus, hipDeviceAttributeMultiprocessorCount, dev) != hipSuccess) { grid = -1; return; }
        if (hipFuncSetAttribute((const void*)mk_fwd, hipFuncAttributeMaxDynamicSharedMemorySize, LDS_BYTES) != hipSuccess) { fprintf(stderr, "kernel_launch: hipFuncSetAttribute failed\n"); grid = -1; return; }
        if (hipOccupancyMaxActiveBlocksPerMultiprocessor(&per_cu, (const void*)mk_fwd, NTHR, LDS_BYTES) != hipSuccess || per_cu < 1) per_cu = 1;
        (void)hipGetLastError();
        grid = cus * per_cu;
    }
    if (grid < 0) return;
    Args a{};
    for (int i = 0; i < 26; ++i) a.in[i] = (const float*)d_in[i];
    a.out = (float*)d_out; a.ws = (unsigned char*)d_ws;
    void* args[] = {&a};
    hipError_t e = hipLaunchCooperativeKernel((const void*)mk_fwd, dim3(grid), dim3(NTHR), args, LDS_BYTES, stream);
    if (e != hipSuccess) fprintf(stderr, "kernel_launch: cooperative launch failed: %s (grid %d)\n", hipGetErrorString(e), grid);
}
```

```cpp
#include <hip/hip_runtime.h>
#include <hip/hip_cooperative_groups.h>
#include <cstdio>
#include <cstdint>

namespace pg8 {
#define PG8_LAS __attribute__((address_space(3)))
typedef unsigned short bf16_t;
typedef short bf16x8 __attribute__((ext_vector_type(8)));
typedef float f32x4 __attribute__((ext_vector_type(4)));
typedef unsigned u32x4 __attribute__((ext_vector_type(4)));
constexpr int BM = 256, BK = 64, HALF = 128, HTB = HALF * BK * 2  , STAGE_BYTES = 8 * HTB, NXCD = 8, WGM = 8;

__host__ __device__ __forceinline__ int lds_byte(int r, int c) { const int st = (r >> 4) * 2 + (c >> 5), rr = r & 15, cc = c & 31, ob = rr * 64 + cc * 2; return st * 1024 + (ob ^ (((ob >> 9) & 1) << 5)); }
__host__ __device__ __forceinline__ void stage_rc(int b, int& R, int& C) { const int st = b / 1024, sb = b % 1024, swz = sb ^ (((sb >> 9) & 1) << 5); R = (st >> 1) * 16 + swz / 64; C = (st & 1) * 32 + (swz % 64) / 2; }
__host__ __device__ __forceinline__ int perm32(int rho) { const int n = rho >> 4, i = rho & 15; return 8 * (i >> 2) + 4 * n + (i & 3); }

struct Unit { const char* A; const char* B; int lda, ldb, nt, pm, pn, seg; };
struct Gemm { const bf16_t* A; const bf16_t* Bt; int M, N, K; };

struct StaticOrder {
    int nM, nN, nwg, G, c;
    __host__ __device__ __forceinline__ void init(int M, int N, int G_, int c_) { nM = M / BM; nN = N / BM; nwg = nM * nN; G = G_; c = c_; }
    __host__ __device__ __forceinline__ bool next(int i, Unit& u) const {
        const long L = (long)i * G + c; if (L >= nwg) return false;
        int wgid = (int)L; { const int q = nwg / NXCD, r = nwg % NXCD, xcd = wgid % NXCD, off = wgid / NXCD; wgid = (xcd < r ? xcd * (q + 1) : r * (q + 1) + (xcd - r) * q) + off; }
        const int nig = WGM * nN, gid = wgid / nig, fm = gid * WGM, gsz = (nM - fm) < WGM ? (nM - fm) : WGM;
        u.pm = fm + ((wgid % nig) % gsz); u.pn = (wgid % nig) / gsz; return true;
    }
    __device__ __forceinline__ void a_ready(const Unit&) const {}
    __device__ __forceinline__ void done(const Unit&) const {}
};

__device__ __forceinline__ unsigned cvt_pk_bf16(float lo, float hi) { unsigned r; asm volatile("v_cvt_pk_bf16_f32 %0, %1, %2" : "=v"(r) : "v"(lo), "v"(hi)); return r; }
typedef float f32x2 __attribute__((ext_vector_type(2)));
template <class Epi, class Sched, bool ALIGN_EPI = false, bool SP2 = false>
__device__ __forceinline__ void gemm_phase(PG8_LAS unsigned char* lds, const Sched& S, const Epi& E) {
    int tid_l = threadIdx.x; asm volatile("" : "+v"(tid_l)); const int tid = tid_l, wid = __builtin_amdgcn_readfirstlane(tid >> 6), lane = tid & 63, wr = wid >> 2, wc = wid & 3, fr = lane & 15, fq = lane >> 4;
    unsigned rA[2], rB[2], c2[2];
#pragma unroll
    for (int i = 0; i < 2; ++i) { int R, C; stage_rc(tid * 16 + i * 8192, R, C); const int Rb = Epi::PERM ? ((R & ~31) + perm32(R & 31)) : R;
        rA[i] = (unsigned)R; rB[i] = (unsigned)Rb; c2[i] = (unsigned)C * 2u; }
    const size_t kstep = (size_t)(BK * 2);
    const unsigned ldsw = (unsigned)wid * 1024u;
    const int aoff = lds_byte(wr * 64 + fr, fq * 8), boff = lds_byte(wc * 32 + fr, fq * 8);
#define PG8_SA(b, h) (((b) * 2 + (h)) * HTB)
#define PG8_SB(b, h) ((4 + (b) * 2 + (h)) * HTB)
#define PG8_STAGE(bufoff, gbase, voff) do { _Pragma("unroll") for (int _i = 0; _i < 2; ++_i) \
        __builtin_amdgcn_global_load_lds((const unsigned*)((const char*)(gbase) + (voff)[_i]), (PG8_LAS unsigned*)(lds + (bufoff) + ldsw + _i * 8192), 16, 0, 0); } while (0)
#define PG8_LDA(dst, b, h) do { _Pragma("unroll") for (int m = 0; m < 4; ++m) _Pragma("unroll") for (int k = 0; k < 2; ++k) dst[m][k] = *(const PG8_LAS bf16x8*)(lds + PG8_SA(b, h) + aoff + m * 2048 + k * 1024); } while (0)
#define PG8_LDB(dst, b, h) do { _Pragma("unroll") for (int n = 0; n < 2; ++n) _Pragma("unroll") for (int k = 0; k < 2; ++k) dst[n][k] = *(const PG8_LAS bf16x8*)(lds + PG8_SB(b, h) + boff + n * 2048 + k * 1024); } while (0)
#define PG8_MMA(ai, bj, At, Bt) do { __builtin_amdgcn_s_setprio(1); _Pragma("unroll") for (int m = 0; m < 4; ++m) _Pragma("unroll") for (int n = 0; n < 2; ++n) _Pragma("unroll") for (int k = 0; k < 2; ++k) \
        acc[ai][bj][m][n] = __builtin_amdgcn_mfma_f32_16x16x32_bf16(Bt[n][k], At[m][k], acc[ai][bj][m][n], 0, 0, 0); __builtin_amdgcn_s_setprio(0); } while (0)
#define PG8_WAIT_V(n) asm volatile("s_waitcnt vmcnt(" #n ")" ::: "memory")
#define PG8_WAIT_L(n) asm volatile("s_waitcnt lgkmcnt(" #n ")" ::: "memory")
#define PG8_BAR __builtin_amdgcn_s_barrier()
#define PG8_SCHED __builtin_amdgcn_sched_barrier(0)
    Unit cur, nxt; int ui = 0;
    if (!S.next(0, cur)) return;
    f32x4 acc[2][2][4][2];
#pragma unroll
    for (int a = 0; a < 2; ++a)
#pragma unroll
        for (int b = 0; b < 2; ++b)
#pragma unroll
            for (int m = 0; m < 4; ++m)
#pragma unroll
                for (int n = 0; n < 2; ++n) acc[a][b][m][n] = (f32x4){0.f, 0.f, 0.f, 0.f};
    bf16x8 At[4][2], B0[2][2], B1[2][2];
    unsigned voA_c[2], voB_c[2], voA_n[2], voB_n[2]; size_t hA_c, hB_c, hA_n, hB_n; int nt_c;
#define PG8_UPARAMS(u, vA, vB, hA, hB) do { _Pragma("unroll") for (int _i = 0; _i < 2; ++_i) { vA[_i] = rA[_i] * (unsigned)(u).lda + c2[_i]; vB[_i] = rB[_i] * (unsigned)(u).ldb + c2[_i]; } hA = (size_t)HALF * (u).lda; hB = (size_t)HALF * (u).ldb; } while (0)
    PG8_UPARAMS(cur, voA_c, voB_c, hA_c, hB_c); nt_c = cur.nt;
    const char* cA = cur.A; const char* cB = cur.B;
    S.a_ready(cur);
    if constexpr (SP2) {
        PG8_STAGE(PG8_SB(0, 0), cB, voB_c); PG8_STAGE(PG8_SB(0, 1), cB + hB_c, voB_c); PG8_STAGE(PG8_SA(0, 0), cA, voA_c); PG8_STAGE(PG8_SA(0, 1), cA + hA_c, voA_c);
        if (wr == 1) PG8_BAR;
        PG8_WAIT_V(2); PG8_BAR;
        PG8_STAGE(PG8_SB(1, 0), cB + kstep, voB_c); PG8_STAGE(PG8_SA(1, 0), cA + kstep, voA_c); PG8_STAGE(PG8_SB(1, 1), cB + hB_c + kstep, voB_c);
        PG8_WAIT_V(6); PG8_BAR;
    } else {
        PG8_STAGE(PG8_SB(0, 0), cB, voB_c); PG8_STAGE(PG8_SA(0, 0), cA, voA_c); PG8_STAGE(PG8_SB(0, 1), cB + hB_c, voB_c); PG8_STAGE(PG8_SA(0, 1), cA + hA_c, voA_c);
        if (wr == 1) PG8_BAR;
        PG8_WAIT_V(4); PG8_BAR;
        PG8_STAGE(PG8_SB(1, 0), cB + kstep, voB_c); PG8_STAGE(PG8_SA(1, 0), cA + kstep, voA_c); PG8_STAGE(PG8_SB(1, 1), cB + hB_c + kstep, voB_c);
        PG8_WAIT_V(6); PG8_BAR;
    }
    for (;;) {
        const bool has_next = S.next(ui + 1, nxt);
        const char* nA = has_next ? nxt.A : cA; const char* nB = has_next ? nxt.B : cB;
        if (has_next) { PG8_UPARAMS(nxt, voA_n, voB_n, hA_n, hB_n); } else { voA_n[0] = voA_c[0]; voA_n[1] = voA_c[1]; voB_n[0] = voB_c[0]; voB_n[1] = voB_c[1]; hA_n = hA_c; hB_n = hB_c; }
        for (int t = 0; t < nt_c; t += 2) {
            const bool last = (t == nt_c - 2);
            const size_t hA2 = last ? hA_n : hA_c, hB2 = last ? hB_n : hB_c;
            unsigned vA2[2], vB2[2]; vA2[0] = last ? voA_n[0] : voA_c[0]; vA2[1] = last ? voA_n[1] : voA_c[1]; vB2[0] = last ? voB_n[0] : voB_c[0]; vB2[1] = last ? voB_n[1] : voB_c[1];
            const char* a1 = cA + (size_t)(t + 1) * kstep;
            const char* a2 = last ? nA : cA + (size_t)(t + 2) * kstep; const char* b2 = last ? nB : cB + (size_t)(t + 2) * kstep;
            const char* a3 = a2 + kstep; const char* b3 = b2 + kstep;
            if (last && has_next) S.a_ready(nxt);
            if constexpr (SP2) {
            PG8_LDB(B0, 0, 0); PG8_LDB(B1, 0, 1); PG8_SCHED; PG8_LDA(At, 0, 0); PG8_STAGE(PG8_SA(1, 1), a1 + hA_c, voA_c);
            PG8_WAIT_V(8); PG8_WAIT_L(0); PG8_BAR; PG8_MMA(0, 0, At, B0); PG8_MMA(0, 1, At, B1); PG8_BAR; PG8_SCHED;
            PG8_LDA(At, 0, 1); PG8_STAGE(PG8_SB(0, 0), b2, vB2); PG8_STAGE(PG8_SB(0, 1), b2 + hB2, vB2); PG8_STAGE(PG8_SA(0, 0), a2, vA2);
            PG8_WAIT_V(8); PG8_WAIT_L(0); PG8_BAR; PG8_MMA(1, 0, At, B0); PG8_MMA(1, 1, At, B1); PG8_BAR; PG8_SCHED;
            PG8_LDB(B0, 1, 0); PG8_LDB(B1, 1, 1); PG8_SCHED; PG8_LDA(At, 1, 0); PG8_STAGE(PG8_SA(0, 1), a2 + hA2, vA2);
            PG8_WAIT_V(8); PG8_WAIT_L(0); PG8_BAR; PG8_MMA(0, 0, At, B0); PG8_MMA(0, 1, At, B1); PG8_BAR; PG8_SCHED;
            PG8_LDA(At, 1, 1); PG8_STAGE(PG8_SB(1, 0), b3, vB2); PG8_STAGE(PG8_SB(1, 1), b3 + hB2, vB2); PG8_STAGE(PG8_SA(1, 0), a3, vA2);
            PG8_WAIT_V(8); PG8_WAIT_L(0); PG8_BAR; PG8_MMA(1, 0, At, B0); PG8_MMA(1, 1, At, B1); PG8_BAR; PG8_SCHED;
            } else {
            PG8_LDB(B0, 0, 0); PG8_SCHED; PG8_LDA(At, 0, 0); PG8_STAGE(PG8_SA(1, 1), a1 + hA_c, voA_c);
            PG8_WAIT_L(8); PG8_BAR; PG8_WAIT_L(0); PG8_MMA(0, 0, At, B0); PG8_BAR; PG8_SCHED;
            PG8_LDB(B1, 0, 1); PG8_STAGE(PG8_SB(0, 0), b2, vB2);
            PG8_BAR; PG8_WAIT_L(0); PG8_MMA(0, 1, At, B1); PG8_BAR;
            PG8_LDA(At, 0, 1); PG8_STAGE(PG8_SA(0, 0), a2, vA2);
            PG8_BAR; PG8_WAIT_L(0); PG8_MMA(1, 0, At, B0); PG8_BAR; PG8_SCHED;
            PG8_STAGE(PG8_SB(0, 1), b2 + hB2, vB2);
            PG8_WAIT_V(6); PG8_BAR; PG8_MMA(1, 1, At, B1); PG8_BAR;
            PG8_LDB(B0, 1, 0); PG8_SCHED; PG8_LDA(At, 1, 0); PG8_STAGE(PG8_SA(0, 1), a2 + hA2, vA2);
            PG8_WAIT_L(8); PG8_BAR; PG8_WAIT_L(0); PG8_MMA(0, 0, At, B0); PG8_BAR; PG8_SCHED;
            PG8_LDB(B1, 1, 1); PG8_STAGE(PG8_SB(1, 0), b3, vB2);
            PG8_BAR; PG8_WAIT_L(0); PG8_MMA(0, 1, At, B1); PG8_BAR;
            PG8_LDA(At, 1, 1); PG8_STAGE(PG8_SA(1, 0), a3, vA2);
            PG8_BAR; PG8_WAIT_L(0); PG8_MMA(1, 0, At, B0); PG8_BAR; PG8_SCHED;
            PG8_STAGE(PG8_SB(1, 1), b3 + hB2, vB2);
            PG8_WAIT_V(6); PG8_BAR; PG8_MMA(1, 1, At, B1); PG8_BAR;
            }
        }
        if constexpr (ALIGN_EPI) { if (wr == 0) PG8_BAR; }
        if constexpr (!Epi::AFTER_DRAIN) { E(acc, cur, wr, wc, fr, fq); S.done(cur); }
        if (!has_next) break;
#pragma unroll
        for (int a = 0; a < 2; ++a)
#pragma unroll
            for (int b = 0; b < 2; ++b)
#pragma unroll
                for (int m = 0; m < 4; ++m)
#pragma unroll
                    for (int n = 0; n < 2; ++n) acc[a][b][m][n] = (f32x4){0.f, 0.f, 0.f, 0.f};
        cur = nxt; cA = nA; cB = nB; ++ui; voA_c[0] = voA_n[0]; voA_c[1] = voA_n[1]; voB_c[0] = voB_n[0]; voB_c[1] = voB_n[1]; hA_c = hA_n; hB_c = hB_n; nt_c = cur.nt;
        if constexpr (ALIGN_EPI) { if (wr == 1) PG8_BAR; }
    }
    PG8_WAIT_V(0);
    if constexpr (!ALIGN_EPI) { if (wr == 0) PG8_BAR; }
    PG8_BAR;
    if constexpr (Epi::AFTER_DRAIN) { E.fused(acc, cur, wr, wc, fr, fq, lds, wid, lane); S.done(cur); }
#undef PG8_UPARAMS
#undef PG8_SA
#undef PG8_SB
#undef PG8_STAGE
#undef PG8_LDA
#undef PG8_LDB
#undef PG8_MMA
#undef PG8_WAIT_V
#undef PG8_WAIT_L
#undef PG8_BAR
#undef PG8_SCHED
}
}
namespace cg = cooperative_groups;
#define LAS __attribute__((address_space(3)))
typedef unsigned short bf16;
typedef unsigned v4u __attribute__((ext_vector_type(4)));
typedef unsigned v2u __attribute__((ext_vector_type(2)));
typedef float f32x4 __attribute__((ext_vector_type(4)));
using pg8::bf16_t;

constexpr int DMODEL = 1024, NBATCH = 4, SEQL = 4096, CTXL = 256, LKV = SEQL + CTXL, ML = NBATCH * SEQL, MC = NBATCH * CTXL, MA = ML + MC, DFF = 4096, N1 = 2816, NMOD = 6 * DMODEL;
constexpr float EPSN = 1e-6f;
constexpr float QC2 = 0.125f * 1.4426950408889634f;
constexpr int NTHR = 512;
constexpr int LDS_BYTES = 147456;

constexpr size_t MiB = 1u << 20;
constexpr size_t WS_MOD = 0, WS_ROPE = 256 * 1024;
constexpr size_t W_IN = 2 * MiB, W_POOL = W_IN + (size_t)5888 * 1024 * 2, W_PO = W_POOL + 512 * 512 * 2, W_DO = W_PO + 1024 * 512 * 2, W_GO = W_DO + 1024 * 512 * 2,
                 W_O = W_GO + 1024 * 512 * 2, W_1 = W_O + 1024 * 1024 * 2, W_2 = W_1 + (size_t)4096 * 1024 * 2, W_END = W_2 + (size_t)4096 * 1024 * 2;
static_assert(W_END <= 36 * MiB, "weights");
constexpr size_t WS_CTX = 36 * MiB, WS_H = 40 * MiB;
constexpr size_t WS_POOLIN = 74 * MiB, WS_QD = 91 * MiB, WS_QG = 108 * MiB, WS_KD = 125 * MiB, WS_VD = 142 * MiB, WS_KG = 159 * MiB, WS_VG = WS_KG + (size_t)MA * 128 * 2;
constexpr size_t WS_OD = 176 * MiB, WS_GQAO = 210 * MiB, WS_POOLED = 227 * MiB;
constexpr size_t WS_DIFFO = 74 * MiB, WS_POOLO = 91 * MiB, WS_MERGED = 108 * MiB, WS_ACC = 142 * MiB, WS_Y = 142 * MiB, WS_HF = 210 * MiB, WS_U = 40 * MiB, WS_Z = 176 * MiB;
constexpr size_t WS_TOTAL = 256 * MiB;
static_assert(WS_VG + (size_t)MA * 128 * 2 <= 176 * MiB, "p1 outs");

__device__ __forceinline__ unsigned f2bf(float f) { unsigned u = __builtin_bit_cast(unsigned, f); return (u + 0x7fffu + ((u >> 16) & 1u)) >> 16; }
__device__ __forceinline__ unsigned pk2(float lo, float hi) { return f2bf(lo) | (f2bf(hi) << 16); }
__device__ __forceinline__ float bflo(unsigned w) { return __builtin_bit_cast(float, w << 16); }
__device__ __forceinline__ float bfhi(unsigned w) { return __builtin_bit_cast(float, w & 0xffff0000u); }
__device__ __forceinline__ float wave_sum(float v) {
#pragma unroll
    for (int o = 1; o < 64; o <<= 1) v += __shfl_xor(v, o);
    return v;
}

__device__ __forceinline__ int kvrow_of(int row) { return row < ML ? (row >> 12) * LKV + CTXL + (row & 4095) : ((row - ML) >> 8) * LKV + ((row - ML) & 255); }
__device__ __forceinline__ void rope8(float (&v)[8], const float* tab, int d, int t) {
    const int p0 = d >> 1, pos = p0 < 16 ? (t >> 6) : (t & 63), j0 = p0 & 15;
    const f32x4* tp = (const f32x4*)(tab + (pos * 16 + j0) * 2);
    const f32x4 t0 = tp[0], t1 = tp[1];
    float o[8];
    o[0] = v[0] * t0[0] - v[1] * t0[1]; o[1] = v[0] * t0[1] + v[1] * t0[0];
    o[2] = v[2] * t0[2] - v[3] * t0[3]; o[3] = v[2] * t0[3] + v[3] * t0[2];
    o[4] = v[4] * t1[0] - v[5] * t1[1]; o[5] = v[4] * t1[1] + v[5] * t1[0];
    o[6] = v[6] * t1[2] - v[7] * t1[3]; o[7] = v[6] * t1[3] + v[7] * t1[2];
#pragma unroll
    for (int i = 0; i < 8; ++i) v[i] = o[i];
}

#include <hip/hip_bf16.h>
#include <cmath>
namespace attn_body {
using bf16=__hip_bfloat16;
using bf16x8=__attribute__((ext_vector_type(8)))short;
using s16x4=__attribute__((ext_vector_type(4)))short;
using f32x16=__attribute__((ext_vector_type(16)))float;
using u32x4=__attribute__((ext_vector_type(4)))unsigned;
constexpr int D=64;
constexpr int NW=8,QBLK=32,QB=QBLK*NW,KVBLK=64;
constexpr int ATTN_UNIT_ROWS=QB;
__device__ __forceinline__ int crow(int r,int hi){return (r&3)+8*(r>>2)+4*hi;}
#define SBAR() __builtin_amdgcn_sched_barrier(0)
__device__ __forceinline__ void cmask(f32x16&p0,f32x16&p1,int jb,int qrel,int hi){
  const float NEG=-INFINITY; int kb=64*jb+4*hi;
  #pragma unroll
  for(int r=0;r<16;++r){int kv=kb+(r&3)+8*(r>>2); if(kv>qrel)p0[r]=NEG; if(kv+32>qrel)p1[r]=NEG;}
}

constexpr int NSLOT=3, SLOTB=8192;
constexpr int LDS_K=0, LDS_V=NSLOT*SLOTB, LDS_WS=2*NSLOT*SLOTB, LDS_OST=LDS_WS+NW*64*4, LDS_BYTES=LDS_OST+NW*4096;
constexpr float C2=0.125f*1.4426950408889634f;
__device__ __forceinline__ void glds16(const void*gsrc,unsigned lds_dst){unsigned keep;
  asm volatile("s_mov_b32 %0, m0\n\ts_mov_b32 m0, %2\n\ts_nop 0\n\tglobal_load_lds_dwordx4 %1, off\n\ts_mov_b32 m0, %0":"=&s"(keep):"v"(gsrc),"s"(lds_dst):"memory");}
__device__ __forceinline__ float max3f(float a,float b,float c){float r;asm("v_max3_f32 %0, %1, %2, %3":"=v"(r):"v"(a),"v"(b),"v"(c));return r;}
__device__ __forceinline__ float max2f(float a,float b){float r;asm("v_max_f32_e32 %0, %1, %2":"=v"(r):"v"(a),"v"(b));return r;}
__device__ __forceinline__ float fadd_s(float a,float b){float r;asm("v_add_f32_e32 %0, %1, %2":"=v"(r):"v"(a),"v"(b));return r;}
__device__ __forceinline__ float fsub_s(float a,float b){float r;asm("v_sub_f32_e32 %0, %1, %2":"=v"(r):"v"(a),"v"(b));return r;}
typedef float f32x2_t __attribute__((ext_vector_type(2))); typedef __bf16 bf16x2_t __attribute__((ext_vector_type(2)));
__device__ __forceinline__ unsigned cvtpk_s(float lo,float hi){f32x2_t v={lo,hi};bf16x2_t b=__builtin_convertvector(v,bf16x2_t);return __builtin_bit_cast(unsigned,b);}
#define WAIT_BAR(N) asm volatile("s_waitcnt vmcnt(" #N ") lgkmcnt(0)\n\ts_barrier":::"memory")

__device__ __forceinline__ void qkt(f32x16&p0,f32x16&p1,const char*Kslot,const bf16x8*qr,const f32x16&negm,int r32,int hi){
  const char*kb=Kslot+hi*1024+r32*16;
  #pragma unroll
  for(int d0=0;d0<4;++d0){
    const bf16x8 b0=*reinterpret_cast<const bf16x8*>(kb+d0*2048);
    const bf16x8 b1=*reinterpret_cast<const bf16x8*>(kb+d0*2048+512);
    if(d0==0){p0=__builtin_amdgcn_mfma_f32_32x32x16_bf16(b0,qr[0],negm,0,0,0);p1=__builtin_amdgcn_mfma_f32_32x32x16_bf16(b1,qr[0],negm,0,0,0);}
    else{p0=__builtin_amdgcn_mfma_f32_32x32x16_bf16(b0,qr[d0],p0,0,0,0);p1=__builtin_amdgcn_mfma_f32_32x32x16_bf16(b1,qr[d0],p1,0,0,0);}}
}
typedef __attribute__((address_space(3))) const char* lds_cptr;
typedef short v4i16_t __attribute__((ext_vector_type(4)));
__device__ __forceinline__ void kload8(bf16x8*kf,lds_cptr kp){
  kf[0]=*(const __attribute__((address_space(3))) bf16x8*)(kp);      kf[1]=*(const __attribute__((address_space(3))) bf16x8*)(kp+512);
  kf[2]=*(const __attribute__((address_space(3))) bf16x8*)(kp+2048); kf[3]=*(const __attribute__((address_space(3))) bf16x8*)(kp+2560);
  kf[4]=*(const __attribute__((address_space(3))) bf16x8*)(kp+4096); kf[5]=*(const __attribute__((address_space(3))) bf16x8*)(kp+4608);
  kf[6]=*(const __attribute__((address_space(3))) bf16x8*)(kp+6144); kf[7]=*(const __attribute__((address_space(3))) bf16x8*)(kp+6656);
}
__device__ __forceinline__ void kload2(bf16x8*kf,lds_cptr kp,int j){ kf[2*j]=*(const __attribute__((address_space(3))) bf16x8*)(kp+j*2048); kf[2*j+1]=*(const __attribute__((address_space(3))) bf16x8*)(kp+j*2048+512); }
__device__ __forceinline__ s16x4 vtr(lds_cptr p){ return __builtin_bit_cast(s16x4,__builtin_amdgcn_ds_read_tr16_b64_v4i16((__attribute__((address_space(3))) v4i16_t*)p)); }
__device__ __forceinline__ float rowmax(const f32x16&p0,const f32x16&p1){
  float a=max3f(p0[0],p0[1],p1[0]),b=max3f(p0[2],p0[3],p1[1]);a=max3f(a,p1[2],p1[3]);
  #pragma unroll
  for(int r=4;r<16;r+=4){a=max3f(a,p0[r],p0[r+1]);b=max3f(b,p0[r+2],p0[r+3]);a=max3f(a,p1[r],p1[r+1]);b=max3f(b,p1[r+2],p1[r+3]);}
  const float m=max2f(a,b);
  auto rr=__builtin_amdgcn_permlane32_swap(__float_as_uint(m),__float_as_uint(m),false,false);
  return max2f(__uint_as_float(rr[0]),__uint_as_float(rr[1]));
}
__device__ __forceinline__ void pv(f32x16*o,int vb,bf16x8 pa0,bf16x8 pa1,bf16x8 pa2,bf16x8 pa3){
  #pragma unroll
  for(int d0=0;d0<2;++d0){s16x4 lo[4],hi[4];
    #pragma unroll
    for(int ks=0;ks<4;++ks){
      asm volatile("ds_read_b64_tr_b16 %0,%1 offset:%c2":"=&v"(lo[ks]):"v"(vb),"i"(d0*4096+ks*1024):"memory");
      asm volatile("ds_read_b64_tr_b16 %0,%1 offset:%c2":"=&v"(hi[ks]):"v"(vb),"i"(d0*4096+ks*1024+512):"memory");}
    asm volatile("s_waitcnt lgkmcnt(0)":::"memory");SBAR();
    #define PK(k) (bf16x8){lo[k][0],lo[k][1],lo[k][2],lo[k][3],hi[k][0],hi[k][1],hi[k][2],hi[k][3]}
    o[d0]=__builtin_amdgcn_mfma_f32_32x32x16_bf16(pa0,PK(0),o[d0],0,0,0);
    o[d0]=__builtin_amdgcn_mfma_f32_32x32x16_bf16(pa1,PK(1),o[d0],0,0,0);
    o[d0]=__builtin_amdgcn_mfma_f32_32x32x16_bf16(pa2,PK(2),o[d0],0,0,0);
    o[d0]=__builtin_amdgcn_mfma_f32_32x32x16_bf16(pa3,PK(3),o[d0],0,0,0);
    #undef PK
  }
}

#ifndef ATTN_STORE16
#define ATTN_STORE16(p,v) (*(u32x4*)(p)=(v))
#endif
template<int THRL> __device__ __forceinline__ void attn_unit(const bf16*Qw0,int pqs,const bf16*__restrict__ Kh,int pks,const bf16*__restrict__ Vh,int pvs,bf16*Ow0,int pos_,const int NT,char*shm,const float*qgain,const float*rtab,const int qt0){
  int tid_l=threadIdx.x; asm volatile("":"+v"(tid_l)); const int tid=tid_l,lane=tid&63,r32=lane&31,hi=lane>>5; const int wid=__builtin_amdgcn_readfirstlane(tid>>6);
  const bf16*Qw=Qw0+(long)(wid*QBLK)*pqs;
  const unsigned lds0=(unsigned)(uintptr_t)shm;
  float*wsf=(float*)(shm+LDS_WS)+wid*64;
  const bf16*ksrc=Kh+(long)lane*pks+wid*8;
  const bf16*vsrc=Vh+(long)(16*(wid&3)+(lane>>2))*pvs+(wid>>2)*32+(lane&3)*8;
  const unsigned kdst=lds0+LDS_K+wid*1024, vdst=lds0+LDS_V+wid*1024;
  #define DMA_K(t,slot) glds16(ksrc+(long)(t)*KVBLK*pks,(unsigned)__builtin_amdgcn_readfirstlane(kdst+(slot)))
  #define DMA_V(t,slot) glds16(vsrc+(long)(t)*KVBLK*pvs,(unsigned)__builtin_amdgcn_readfirstlane(vdst+(slot)))
  const int vb0=(int)(lds0+LDS_V)+((lane>>4)&1)*32+(lane&3)*8+(4*hi+((lane&15)>>2))*64;
  const char*Kbase=shm+LDS_K; bf16x8 kf[8];
  const lds_cptr shm3=(lds_cptr)shm; const lds_cptr kp0=shm3+LDS_K+hi*1024+r32*16; const lds_cptr vp0=shm3+LDS_V+((lane>>4)&1)*32+(lane&3)*8+(4*hi+((lane&15)>>2))*64;
  DMA_K(0,0);DMA_V(0,0);DMA_K(1,SLOTB);
  bf16x8 qr[4];
  #pragma unroll
  for(int d0=0;d0<4;++d0)qr[d0]=*reinterpret_cast<const bf16x8*>(&Qw[(long)r32*pqs+d0*16+hi*8]);
  if(qgain){
    float f[4][8]; float ss=0.f;
    #pragma unroll
    for(int d0=0;d0<4;++d0){
      #pragma unroll
      for(int i=0;i<8;++i){ f[d0][i]=__builtin_bit_cast(float,((unsigned)(unsigned short)qr[d0][i])<<16); ss+=f[d0][i]*f[d0][i]; } }
    { auto rr=__builtin_amdgcn_permlane32_swap(__float_as_uint(ss),__float_as_uint(ss),false,false); ss=__uint_as_float(rr[0])+__uint_as_float(rr[1]); }
    const float rstd=1.0f/sqrtf(ss*(1.f/64.f)+1e-6f);
    #pragma unroll
    for(int d0=0;d0<4;++d0){ const int dd=d0*16+hi*8;
      #pragma unroll
      for(int i=0;i<8;++i) f[d0][i]*=rstd*qgain[dd+i];
      if(qt0>=0) rope8(f[d0],rtab,dd,qt0+wid*QBLK+r32);
      u32x4 w; w.x=pk2(f[d0][0]*C2,f[d0][1]*C2); w.y=pk2(f[d0][2]*C2,f[d0][3]*C2); w.z=pk2(f[d0][4]*C2,f[d0][5]*C2); w.w=pk2(f[d0][6]*C2,f[d0][7]*C2);
      qr[d0]=__builtin_bit_cast(bf16x8,w); }
  }
  float mhat=0.f,l_reg=0.f;f32x16 o[2];o[0]=f32x16{};o[1]=f32x16{};f32x16 negm=f32x16{};asm volatile("":"+v"(negm));
  #define CMASK(P0,P1,t) do{}while(0)
  bool resc=false;
  #define START(P0,P1) do{ const float rm=rowmax(P0,P1); resc=false; \
    { const float dl=rm; mhat=fadd_s(mhat,dl); \
      _Pragma("unroll") for(int r=0;r<16;++r){P0[r]=fsub_s(P0[r],dl);P1[r]=fsub_s(P1[r],dl);} \
      _Pragma("unroll") for(int r=0;r<16;++r)negm[r]=-mhat; asm volatile("":"+v"(negm)); } \
    _Pragma("unroll") for(int r=0;r<16;++r)P0[r]=__builtin_amdgcn_exp2f(P0[r]); }while(0)
  #define RESC() do{ if(resc){ asm volatile("s_waitcnt lgkmcnt(0)":::"memory"); \
      _Pragma("unroll") for(int d_=0;d_<2;++d_) _Pragma("unroll") for(int r=0;r<16;++r)o[d_][r]*=wsf[crow(r,hi)]; } }while(0)
  f32x16 pA0,pA1,pB0,pB1;
  int sl_prev=0,sl_cur=0,sl_next=SLOTB;
  #define ROT() do{sl_prev=sl_cur;sl_cur=sl_next;sl_next=(sl_next==(NSLOT-1)*SLOTB)?0:sl_next+SLOTB;}while(0)
  DMA_K(2,2*SLOTB);
  WAIT_BAR(3);
  qkt(pA0,pA1,Kbase,qr,negm,r32,hi);asm volatile("s_nop 15\n\ts_nop 7":"+v"(pA0),"+v"(pA1));CMASK(pA0,pA1,0);
  START(pA0,pA1);
  _Pragma("unroll") for(int r=0;r<16;++r)pA1[r]=__builtin_amdgcn_exp2f(pA1[r]);
  WAIT_BAR(0);
  DMA_K(3,0);DMA_V(1,SLOTB);
  ROT();
  kload8(kf,kp0+sl_cur);
  WAIT_BAR(2);
  s16x4 vlo[8],vhi[8]; u32x4 pw0,pw1,pw2,pw3;
  #define PKW(P,B) cvtpk_s(P[B],P[B+1])
  #define PAF(k) __builtin_bit_cast(bf16x8,pw##k)
  #define VFR(i) (bf16x8){vlo[i][0],vlo[i][1],vlo[i][2],vlo[i][3],vhi[i][0],vhi[i][1],vhi[i][2],vhi[i][3]}
  #define PIN(x) asm volatile("":"+v"(x))
  #define MX3(a,b,c) __builtin_fmaxf(__builtin_fmaxf((a),(b)),(c))
  #define GAPA(MF,A0,A1,A2,A3,W0,W1,PW) do{ MF; sacc+=A0; sacc+=A1; sacc+=A2; sacc+=A3; PIN(sacc); W0; W1; PIN(PW); SBAR(); }while(0)
  #define EX(v) __builtin_amdgcn_exp2f(v)
  #define GAPB(MF,X,B) do{ MF; X[B]=EX(X[B]); X[B+1]=EX(X[B+1]); X[B+2]=EX(X[B+2]); X[B+3]=EX(X[B+3]); PIN(X); SBAR(); }while(0)
  #define VRD(i) do{ vlo[i]=vtr(vp_+(((i)>>2)*4096+((i)&3)*1024)); vhi[i]=vtr(vp_+(((i)>>2)*4096+((i)&3)*1024+512)); }while(0)
  #define KRD(G,j) do{ if(G){ kload2(kf,kp0+sl_next,j); SBAR(); } }while(0)
  #define STEP(C0,C1,P0,P1,t,GK,GV,GL) do{ SBAR(); \
    const lds_cptr vp_=vp0+sl_prev; \
    VRD(0); SBAR(); float sacc=(P0[0]+P0[1]); \
    GAPA(C0=__builtin_amdgcn_mfma_f32_32x32x16_bf16(kf[0],qr[0],negm,0,0,0), P0[2],P0[3],P0[4],P0[5],     pw0[0]=PKW(P0,0), pw0[1]=PKW(P0,2), pw0); \
    VRD(4); SBAR(); GAPA(C1=__builtin_amdgcn_mfma_f32_32x32x16_bf16(kf[1],qr[0],negm,0,0,0), P0[6],P0[7],P0[8],P0[9],     pw0[2]=PKW(P0,4), pw0[3]=PKW(P0,6), pw0); \
    VRD(1); SBAR(); GAPA(C0=__builtin_amdgcn_mfma_f32_32x32x16_bf16(kf[2],qr[1],C0,0,0,0),   P0[10],P0[11],P0[12],P0[13], pw1[0]=PKW(P0,8), pw1[1]=PKW(P0,10), pw1); \
    VRD(5); SBAR(); GAPA(C1=__builtin_amdgcn_mfma_f32_32x32x16_bf16(kf[3],qr[1],C1,0,0,0),   P0[14],P0[15],P1[0],P1[1],   pw1[2]=PKW(P0,12),pw1[3]=PKW(P0,14), pw1); \
    VRD(2); SBAR(); GAPA(C0=__builtin_amdgcn_mfma_f32_32x32x16_bf16(kf[4],qr[2],C0,0,0,0),   P1[2],P1[3],P1[4],P1[5],     pw2[0]=PKW(P1,0), pw2[1]=PKW(P1,2), pw2); \
    VRD(6); SBAR(); GAPA(C1=__builtin_amdgcn_mfma_f32_32x32x16_bf16(kf[5],qr[2],C1,0,0,0),   P1[6],P1[7],P1[8],P1[9],     pw2[2]=PKW(P1,4), pw2[3]=PKW(P1,6), pw2); \
    VRD(3); SBAR(); GAPA(C0=__builtin_amdgcn_mfma_f32_32x32x16_bf16(kf[6],qr[3],C0,0,0,0),   P1[10],P1[11],P1[12],P1[13], pw3[0]=PKW(P1,8), pw3[1]=PKW(P1,10), pw3); \
    VRD(7); SBAR(); GAPA(C1=__builtin_amdgcn_mfma_f32_32x32x16_bf16(kf[7],qr[3],C1,0,0,0),   P1[14],P1[15],0.f,0.f,       pw3[2]=PKW(P1,12),pw3[3]=PKW(P1,14), pw3); \
    l_reg+=sacc; \
    if(GK){DMA_K((t)+3,sl_cur);} if(GV){DMA_V((t)+1,sl_next);} \
    CMASK(C0,C1,t); \
    { float a=MX3(C0[0],C0[1],C1[0]),b=MX3(C0[2],C0[3],C1[1]); a=MX3(a,C1[2],C1[3]); \
      _Pragma("unroll") for(int r=4;r<16;r+=4){a=MX3(a,C0[r],C0[r+1]);b=MX3(b,C0[r+2],C0[r+3]);a=MX3(a,C1[r],C1[r+1]);b=MX3(b,C1[r+2],C1[r+3]);} \
      float rm=__builtin_fmaxf(a,b); { auto rr=__builtin_amdgcn_permlane32_swap(__float_as_uint(rm),__float_as_uint(rm),false,false); rm=__builtin_fmaxf(__uint_as_float(rr[0]),__uint_as_float(rr[1])); } \
      resc=false; \
      if(__builtin_expect(__any(rm>(float)THRL),0)){ const float dl=__builtin_fmaxf(rm,0.f); mhat+=dl; \
        _Pragma("unroll") for(int r=0;r<16;++r){C0[r]-=dl;C1[r]-=dl;} \
        _Pragma("unroll") for(int r=0;r<16;++r)negm[r]=-mhat; asm volatile("":"+v"(negm)); \
        const float f=__builtin_amdgcn_exp2f(-dl); l_reg*=f; if(hi==0)wsf[r32]=f; resc=true; } } \
    SBAR(); \
    GAPB(o[0]=__builtin_amdgcn_mfma_f32_32x32x16_bf16(PAF(0),VFR(0),o[0],0,0,0), C0,0); \
    GAPB(o[1]=__builtin_amdgcn_mfma_f32_32x32x16_bf16(PAF(0),VFR(4),o[1],0,0,0), C0,4); \
    KRD(GL,0); GAPB(o[0]=__builtin_amdgcn_mfma_f32_32x32x16_bf16(PAF(1),VFR(1),o[0],0,0,0), C0,8); \
    KRD(GL,1); GAPB(o[1]=__builtin_amdgcn_mfma_f32_32x32x16_bf16(PAF(1),VFR(5),o[1],0,0,0), C0,12); \
    KRD(GL,2); GAPB(o[0]=__builtin_amdgcn_mfma_f32_32x32x16_bf16(PAF(2),VFR(2),o[0],0,0,0), C1,0); \
    KRD(GL,3); GAPB(o[1]=__builtin_amdgcn_mfma_f32_32x32x16_bf16(PAF(2),VFR(6),o[1],0,0,0), C1,4); \
    GAPB(o[0]=__builtin_amdgcn_mfma_f32_32x32x16_bf16(PAF(3),VFR(3),o[0],0,0,0), C1,8); \
    GAPB(o[1]=__builtin_amdgcn_mfma_f32_32x32x16_bf16(PAF(3),VFR(7),o[1],0,0,0), C1,12); \
    }while(0)
  int t=1;
  #undef CMASK
  #define CMASK(P0,P1,t) do{}while(0)
  for(;t+5<NT;t+=2){
    STEP(pB0,pB1,pA0,pA1,t,true,true,true);     WAIT_BAR(2); RESC(); ROT();
    STEP(pA0,pA1,pB0,pB1,t+1,true,true,true);   WAIT_BAR(2); RESC(); ROT();
  }
  #undef CMASK
  #define CMASK(P0,P1,t) do{}while(0)
  #define ENDW(tt) do{ if((tt)+3<NT){WAIT_BAR(2);} else if((tt)+2<NT){WAIT_BAR(1);} else {WAIT_BAR(0);} }while(0)
  for(;t+1<NT;t+=2){
    STEP(pB0,pB1,pA0,pA1,t,(t+3<NT),(t+1<NT),(t+1<NT));       ENDW(t);   RESC(); ROT();
    STEP(pA0,pA1,pB0,pB1,t+1,(t+4<NT),(t+2<NT),(t+2<NT));     ENDW(t+1); RESC(); ROT();
  }
  STEP(pB0,pB1,pA0,pA1,NT-1,false,false,false); RESC();
  { float sacc=pB0[0]+pB0[1]; _Pragma("unroll") for(int r=2;r<16;++r)sacc+=pB0[r]; _Pragma("unroll") for(int r=0;r<16;++r)sacc+=pB1[r]; l_reg+=sacc;
    pw0=(u32x4){PKW(pB0,0),PKW(pB0,2),PKW(pB0,4),PKW(pB0,6)};pw1=(u32x4){PKW(pB0,8),PKW(pB0,10),PKW(pB0,12),PKW(pB0,14)};pw2=(u32x4){PKW(pB1,0),PKW(pB1,2),PKW(pB1,4),PKW(pB1,6)};pw3=(u32x4){PKW(pB1,8),PKW(pB1,10),PKW(pB1,12),PKW(pB1,14)};
    SBAR(); pv(o,vb0+sl_cur,PAF(0),PAF(1),PAF(2),PAF(3)); }
  #undef PKW
  #undef PAF
  #undef VFR
  #undef PIN
  #undef MX3
  #undef GAPA
  #undef GAPB
  #undef EX
  #undef VRD
  #undef KRD
  #undef STEP
  #undef ENDW
  {auto rr=__builtin_amdgcn_permlane32_swap(__float_as_uint(l_reg),__float_as_uint(l_reg),false,false);l_reg=__uint_as_float(rr[0])+__uint_as_float(rr[1]);}
  if(hi==0)wsf[32+r32]=l_reg;asm volatile("s_waitcnt lgkmcnt(0)":::"memory");
  float rli[16];
  #pragma unroll
  for(int r=0;r<16;++r)rli[r]=__builtin_amdgcn_rcpf(wsf[32+crow(r,hi)]);
  bf16*Ow=Ow0+(long)(wid*QBLK)*pos_;
  { bf16*stg=(bf16*)(shm+LDS_OST)+wid*2048;
    #pragma unroll
    for(int r=0;r<16;++r){const int orow=crow(r,hi);
      #pragma unroll
      for(int d0=0;d0<2;++d0)stg[orow*64+d0*32+r32]=__float2bfloat16(o[d0][r]*rli[r]);}
    asm volatile("s_waitcnt lgkmcnt(0)":::"memory");
    #pragma unroll
    for(int i=0;i<4;++i){const int row=i*8+(lane>>3),ch=lane&7; const u32x4 v=*(const u32x4*)(stg+row*64+ch*8); ATTN_STORE16(Ow+(long)row*pos_+ch*8,v);} }
  asm volatile("s_waitcnt lgkmcnt(0)\n\ts_barrier":::"memory");
  #undef DMA_K
  #undef DMA_V
  #undef CMASK
  #undef START
  #undef RESC
  #undef ROT
}
constexpr int L128_WS=LDS_V+NSLOT*16384, L128_OST=L128_WS+NW*64*4, LDS_BYTES128=L128_OST+NW*4096;
template<int THRL> __device__ __forceinline__ void attn_unit128(const bf16*Qw0,int pqs,const bf16*__restrict__ Kh,int pks,const bf16*__restrict__ Vh,int pvs,bf16*Ow0,int pos_,const int NT,char*shm,const float*qgain,const float*rtab,const int qt0){
  int tid_l=threadIdx.x; asm volatile("":"+v"(tid_l)); const int tid=tid_l,lane=tid&63,r32=lane&31,hi=lane>>5; const int wid=__builtin_amdgcn_readfirstlane(tid>>6);
  const bf16*Qw=Qw0+(long)(wid*QBLK)*pqs;
  const unsigned lds0=(unsigned)(uintptr_t)shm;
  float*wsf=(float*)(shm+L128_WS)+wid*64;
  const bf16*ksrc=Kh+(long)lane*pks+wid*8;
  const bf16*vsrc=Vh+(long)(16*(wid&3)+(lane>>2))*pvs+(wid>>2)*32+(lane&3)*8;
  const unsigned kdst=lds0+LDS_K+wid*1024, vdst=lds0+LDS_V+wid*1024;
  #define DMA_K(t,slot) glds16(ksrc+(long)(t)*KVBLK*pks,(unsigned)__builtin_amdgcn_readfirstlane(kdst+(slot)))
  #define DMA_V(t,slot) do{ glds16(vsrc+(long)(t)*KVBLK*pvs,(unsigned)__builtin_amdgcn_readfirstlane(vdst+2*(slot))); glds16(vsrc+64+(long)(t)*KVBLK*pvs,(unsigned)__builtin_amdgcn_readfirstlane(vdst+2*(slot)+8192)); }while(0)
  const int vb0=(int)(lds0+LDS_V)+((lane>>4)&1)*32+(lane&3)*8+(4*hi+((lane&15)>>2))*64;
  const char*Kbase=shm+LDS_K; bf16x8 kf[8];
  const lds_cptr shm3=(lds_cptr)shm; const lds_cptr kp0=shm3+LDS_K+hi*1024+r32*16; const lds_cptr vp0=shm3+LDS_V+((lane>>4)&1)*32+(lane&3)*8+(4*hi+((lane&15)>>2))*64;
  DMA_K(0,0);DMA_V(0,0);DMA_K(1,SLOTB);
  bf16x8 qr[4];
  #pragma unroll
  for(int d0=0;d0<4;++d0)qr[d0]=*reinterpret_cast<const bf16x8*>(&Qw[(long)r32*pqs+d0*16+hi*8]);
  if(qgain){
    float f[4][8]; float ss=0.f;
    #pragma unroll
    for(int d0=0;d0<4;++d0){
      #pragma unroll
      for(int i=0;i<8;++i){ f[d0][i]=__builtin_bit_cast(float,((unsigned)(unsigned short)qr[d0][i])<<16); ss+=f[d0][i]*f[d0][i]; } }
    { auto rr=__builtin_amdgcn_permlane32_swap(__float_as_uint(ss),__float_as_uint(ss),false,false); ss=__uint_as_float(rr[0])+__uint_as_float(rr[1]); }
    const float rstd=1.0f/sqrtf(ss*(1.f/64.f)+1e-6f);
    #pragma unroll
    for(int d0=0;d0<4;++d0){ const int dd=d0*16+hi*8;
      #pragma unroll
      for(int i=0;i<8;++i) f[d0][i]*=rstd*qgain[dd+i];
      if(qt0>=0) rope8(f[d0],rtab,dd,qt0+wid*QBLK+r32);
      u32x4 w; w.x=pk2(f[d0][0]*C2,f[d0][1]*C2); w.y=pk2(f[d0][2]*C2,f[d0][3]*C2); w.z=pk2(f[d0][4]*C2,f[d0][5]*C2); w.w=pk2(f[d0][6]*C2,f[d0][7]*C2);
      qr[d0]=__builtin_bit_cast(bf16x8,w); }
  }
  float mhat=0.f,l_reg=0.f;f32x16 o[4];o[0]=f32x16{};o[1]=f32x16{};o[2]=f32x16{};o[3]=f32x16{};
  #define CMASK(P0,P1,t) do{}while(0)
  bool resc=false;
  #define START(P0,P1) do{ const float rm=rowmax(P0,P1); resc=false; mhat=rm; \
    _Pragma("unroll") for(int r=0;r<16;++r)P0[r]=__builtin_amdgcn_exp2f(fsub_s(P0[r],mhat)); }while(0)
  #define RESC() do{ if(resc){ asm volatile("s_waitcnt lgkmcnt(0)":::"memory"); \
      _Pragma("unroll") for(int d_=0;d_<4;++d_) _Pragma("unroll") for(int r=0;r<16;++r)o[d_][r]*=wsf[crow(r,hi)]; } }while(0)
  f32x16 pA0,pA1,pB0,pB1;
  int sl_prev=0,sl_cur=0,sl_next=SLOTB;
  #define ROT() do{sl_prev=sl_cur;sl_cur=sl_next;sl_next=(sl_next==(NSLOT-1)*SLOTB)?0:sl_next+SLOTB;}while(0)
  DMA_K(2,2*SLOTB);
  WAIT_BAR(4);
  qkt(pA0,pA1,Kbase,qr,f32x16{},r32,hi);asm volatile("s_nop 15\n\ts_nop 7":"+v"(pA0),"+v"(pA1));CMASK(pA0,pA1,0);
  START(pA0,pA1);
  _Pragma("unroll") for(int r=0;r<16;++r)pA1[r]=__builtin_amdgcn_exp2f(fsub_s(pA1[r],mhat));
  WAIT_BAR(0);
  DMA_K(3,0);DMA_V(1,SLOTB);
  ROT();
  kload8(kf,kp0+sl_cur);
  WAIT_BAR(3);
  s16x4 vlo[4],vhi[4]; u32x4 pw0,pw1,pw2,pw3;
  #define PKW(P,B) cvtpk_s(P[B],P[B+1])
  #define PAF(k) __builtin_bit_cast(bf16x8,pw##k)
  #define VFR(i) (bf16x8){vlo[i][0],vlo[i][1],vlo[i][2],vlo[i][3],vhi[i][0],vhi[i][1],vhi[i][2],vhi[i][3]}
  #define PIN(x) asm volatile("":"+v"(x))
  #define MX3(a,b,c) __builtin_fmaxf(__builtin_fmaxf((a),(b)),(c))
  #define GAPA(MF,A0,A1,A2,A3,W0,W1,PW) do{ MF; sacc+=A0; sacc+=A1; sacc+=A2; sacc+=A3; PIN(sacc); W0; W1; PIN(PW); SBAR(); }while(0)
  #define EX(v) __builtin_amdgcn_exp2f(v)
  #define GAPB2(MF,RD,X,B) do{ MF; RD; X[B]=EX(fsub_s(X[B],mhat)); X[B+1]=EX(fsub_s(X[B+1],mhat)); PIN(X); SBAR(); }while(0)
  #define NORD do{}while(0)
  #define VRDS(s) do{ vlo[(s)&3]=vtr(vp_+(((s)>>3)*8192+((s)&1)*4096+(((s)&7)>>1)*1024)); vhi[(s)&3]=vtr(vp_+(((s)>>3)*8192+((s)&1)*4096+(((s)&7)>>1)*1024+512)); }while(0)
  #define VFRS(s) (bf16x8){vlo[(s)&3][0],vlo[(s)&3][1],vlo[(s)&3][2],vlo[(s)&3][3],vhi[(s)&3][0],vhi[(s)&3][1],vhi[(s)&3][2],vhi[(s)&3][3]}
  #define KRD(G,j) do{ if(G){ kload2(kf,kp0+sl_next,j); SBAR(); } }while(0)
  #define MFQ(a,b,c) __builtin_amdgcn_mfma_f32_32x32x16_bf16(a,b,c,0,0,0)
  #define STEP(C0,C1,P0,P1,t,GK,GV,GL) do{ SBAR(); \
    const lds_cptr vp_=vp0+2*sl_prev; \
    VRDS(0); SBAR(); float sacc=(P0[0]+P0[1]); \
    GAPA(C0=MFQ(kf[0],qr[0],f32x16{}), P0[2],P0[3],P0[4],P0[5],     pw0[0]=PKW(P0,0), pw0[1]=PKW(P0,2), pw0); \
    VRDS(1); SBAR(); GAPA(C1=MFQ(kf[1],qr[0],f32x16{}), P0[6],P0[7],P0[8],P0[9],     pw0[2]=PKW(P0,4), pw0[3]=PKW(P0,6), pw0); \
    VRDS(2); SBAR(); GAPA(C0=MFQ(kf[2],qr[1],C0),   P0[10],P0[11],P0[12],P0[13], pw1[0]=PKW(P0,8), pw1[1]=PKW(P0,10), pw1); \
    VRDS(3); SBAR(); GAPA(C1=MFQ(kf[3],qr[1],C1),   P0[14],P0[15],P1[0],P1[1],   pw1[2]=PKW(P0,12),pw1[3]=PKW(P0,14), pw1); \
    GAPA(C0=MFQ(kf[4],qr[2],C0),   P1[2],P1[3],P1[4],P1[5],     pw2[0]=PKW(P1,0), pw2[1]=PKW(P1,2), pw2); \
    GAPA(C1=MFQ(kf[5],qr[2],C1),   P1[6],P1[7],P1[8],P1[9],     pw2[2]=PKW(P1,4), pw2[3]=PKW(P1,6), pw2); \
    GAPA(C0=MFQ(kf[6],qr[3],C0),   P1[10],P1[11],P1[12],P1[13], pw3[0]=PKW(P1,8), pw3[1]=PKW(P1,10), pw3); \
    GAPA(C1=MFQ(kf[7],qr[3],C1),   P1[14],P1[15],0.f,0.f,       pw3[2]=PKW(P1,12),pw3[3]=PKW(P1,14), pw3); \
    l_reg+=sacc; \
    if(GK){DMA_K((t)+3,sl_cur);} if(GV){DMA_V((t)+1,sl_next);} \
    { float a=MX3(C0[0],C0[1],C1[0]),b=MX3(C0[2],C0[3],C1[1]); a=MX3(a,C1[2],C1[3]); \
      _Pragma("unroll") for(int r=4;r<16;r+=4){a=MX3(a,C0[r],C0[r+1]);b=MX3(b,C0[r+2],C0[r+3]);a=MX3(a,C1[r],C1[r+1]);b=MX3(b,C1[r+2],C1[r+3]);} \
      float rm=__builtin_fmaxf(a,b); { auto rr=__builtin_amdgcn_permlane32_swap(__float_as_uint(rm),__float_as_uint(rm),false,false); rm=__builtin_fmaxf(__uint_as_float(rr[0]),__uint_as_float(rr[1])); } \
      const float rel=rm-mhat; resc=false; \
      if(__builtin_expect(__any(rel>(float)THRL),0)){ const float dl=__builtin_fmaxf(rel,0.f); mhat+=dl; \
        const float f=__builtin_amdgcn_exp2f(-dl); l_reg*=f; if(hi==0)wsf[r32]=f; resc=true; } } \
    SBAR(); \
    GAPB2(o[0]=MFQ(PAF(0),VFRS(0),o[0]), VRDS(4), C0,0); \
    GAPB2(o[1]=MFQ(PAF(0),VFRS(1),o[1]), VRDS(5), C0,2); \
    KRD(GL,0); GAPB2(o[0]=MFQ(PAF(1),VFRS(2),o[0]), VRDS(6), C0,4); \
    KRD(GL,1); GAPB2(o[1]=MFQ(PAF(1),VFRS(3),o[1]), VRDS(7), C0,6); \
    KRD(GL,2); GAPB2(o[0]=MFQ(PAF(2),VFRS(4),o[0]), VRDS(8), C0,8); \
    KRD(GL,3); GAPB2(o[1]=MFQ(PAF(2),VFRS(5),o[1]), VRDS(9), C0,10); \
    GAPB2(o[0]=MFQ(PAF(3),VFRS(6),o[0]), VRDS(10), C0,12); \
    GAPB2(o[1]=MFQ(PAF(3),VFRS(7),o[1]), VRDS(11), C0,14); \
    GAPB2(o[2]=MFQ(PAF(0),VFRS(8),o[2]), VRDS(12), C1,0); \
    GAPB2(o[3]=MFQ(PAF(0),VFRS(9),o[3]), VRDS(13), C1,2); \
    GAPB2(o[2]=MFQ(PAF(1),VFRS(10),o[2]), VRDS(14), C1,4); \
    GAPB2(o[3]=MFQ(PAF(1),VFRS(11),o[3]), VRDS(15), C1,6); \
    GAPB2(o[2]=MFQ(PAF(2),VFRS(12),o[2]), NORD, C1,8); \
    GAPB2(o[3]=MFQ(PAF(2),VFRS(13),o[3]), NORD, C1,10); \
    GAPB2(o[2]=MFQ(PAF(3),VFRS(14),o[2]), NORD, C1,12); \
    GAPB2(o[3]=MFQ(PAF(3),VFRS(15),o[3]), NORD, C1,14); \
    }while(0)
  int t=1;
  #undef CMASK
  #define CMASK(P0,P1,t) do{}while(0)
  for(;t+5<NT;t+=2){
    STEP(pB0,pB1,pA0,pA1,t,true,true,true);     WAIT_BAR(3); RESC(); ROT();
    STEP(pA0,pA1,pB0,pB1,t+1,true,true,true);   WAIT_BAR(3); RESC(); ROT();
  }
  #undef CMASK
  #define CMASK(P0,P1,t) do{}while(0)
  #define ENDW(tt) do{ if((tt)+3<NT){WAIT_BAR(3);} else if((tt)+2<NT){WAIT_BAR(2);} else {WAIT_BAR(0);} }while(0)
  for(;t+1<NT;t+=2){
    STEP(pB0,pB1,pA0,pA1,t,(t+3<NT),(t+1<NT),(t+1<NT));       ENDW(t);   RESC(); ROT();
    STEP(pA0,pA1,pB0,pB1,t+1,(t+4<NT),(t+2<NT),(t+2<NT));     ENDW(t+1); RESC(); ROT();
  }
  STEP(pB0,pB1,pA0,pA1,NT-1,false,false,false); RESC();
  { float sacc=pB0[0]+pB0[1]; _Pragma("unroll") for(int r=2;r<16;++r)sacc+=pB0[r]; _Pragma("unroll") for(int r=0;r<16;++r)sacc+=pB1[r]; l_reg+=sacc;
    pw0=(u32x4){PKW(pB0,0),PKW(pB0,2),PKW(pB0,4),PKW(pB0,6)};pw1=(u32x4){PKW(pB0,8),PKW(pB0,10),PKW(pB0,12),PKW(pB0,14)};pw2=(u32x4){PKW(pB1,0),PKW(pB1,2),PKW(pB1,4),PKW(pB1,6)};pw3=(u32x4){PKW(pB1,8),PKW(pB1,10),PKW(pB1,12),PKW(pB1,14)};
    SBAR(); pv(o,vb0+2*sl_cur,PAF(0),PAF(1),PAF(2),PAF(3)); pv(o+2,vb0+2*sl_cur+8192,PAF(0),PAF(1),PAF(2),PAF(3)); }
  #undef PKW
  #undef PAF
  #undef VFR
  #undef VFRS
  #undef VRDS
  #undef GAPB2
  #undef NORD
  #undef MFQ
  #undef PIN
  #undef MX3
  #undef GAPA
  #undef EX
  #undef KRD
  #undef STEP
  #undef ENDW
  {auto rr=__builtin_amdgcn_permlane32_swap(__float_as_uint(l_reg),__float_as_uint(l_reg),false,false);l_reg=__uint_as_float(rr[0])+__uint_as_float(rr[1]);}
  if(hi==0)wsf[32+r32]=l_reg;asm volatile("s_waitcnt lgkmcnt(0)":::"memory");
  float rli[16];
  #pragma unroll
  for(int r=0;r<16;++r)rli[r]=__builtin_amdgcn_rcpf(wsf[32+crow(r,hi)]);
  bf16*Ow=Ow0+(long)(wid*QBLK)*pos_;
  { bf16*stg=(bf16*)(shm+L128_OST)+wid*2048;
    #pragma unroll
    for(int h=0;h<2;++h){
      #pragma unroll
      for(int r=0;r<16;++r){const int orow=crow(r,hi);
        #pragma unroll
        for(int d0=0;d0<2;++d0)stg[orow*64+d0*32+r32]=__float2bfloat16(o[2*h+d0][r]*rli[r]);}
      asm volatile("s_waitcnt lgkmcnt(0)":::"memory");
      #pragma unroll
      for(int i=0;i<4;++i){const int row=i*8+(lane>>3),ch=lane&7; const u32x4 v=*(const u32x4*)(stg+row*64+ch*8); ATTN_STORE16(Ow+(long)row*pos_+h*64+ch*8,v);}
      asm volatile("s_waitcnt lgkmcnt(0)":::"memory"); } }
  asm volatile("s_waitcnt lgkmcnt(0)\n\ts_barrier":::"memory");
  #undef DMA_K
  #undef DMA_V
  #undef CMASK
  #undef START
  #undef RESC
  #undef ROT
}
constexpr int ATTN_LDS_BYTES=LDS_BYTES;
#undef SBAR
#undef WAIT_BAR
}
struct Args { const float* in[26]; float* out; unsigned char* ws; };

template <int ACT  > struct EpiAct {
    static constexpr bool PERM = true, AFTER_DRAIN = false;
    bf16_t* O; int ldc;
    __device__ __forceinline__ void operator()(const pg8::f32x4 (&acc)[2][2][4][2], const pg8::Unit& u, int wr, int wc, int fr, int fq) const {
        const int row0 = u.pm * 256 + wr * 64 + fr, col0 = u.pn * 256 + wc * 32 + 8 * fq;
#pragma unroll
        for (int ai = 0; ai < 2; ++ai)
#pragma unroll
            for (int m = 0; m < 4; ++m) { bf16_t* rowp = O + (size_t)(row0 + ai * 128 + m * 16) * ldc + col0;
#pragma unroll
                for (int bj = 0; bj < 2; ++bj) { float v[8];
#pragma unroll
                    for (int i = 0; i < 4; ++i) { v[i] = acc[ai][bj][m][0][i]; v[4 + i] = acc[ai][bj][m][1][i]; }
#pragma unroll
                    for (int i = 0; i < 8; ++i) {
                        if (ACT == 1) v[i] = 1.f / (1.f + __expf(-v[i]));
                        if (ACT == 2) { const float r = fmaxf(v[i], 0.f); v[i] = r * r; } }
                    pg8::u32x4 w; w.x = pg8::cvt_pk_bf16(v[0], v[1]); w.y = pg8::cvt_pk_bf16(v[2], v[3]); w.z = pg8::cvt_pk_bf16(v[4], v[5]); w.w = pg8::cvt_pk_bf16(v[6], v[7]);
                    *(pg8::u32x4*)(rowp + bj * 128) = w; } }
    }
};
struct EpiF32 {
    static constexpr bool PERM = true, AFTER_DRAIN = false;
    float* O; int ldc;
    __device__ __forceinline__ void operator()(const pg8::f32x4 (&acc)[2][2][4][2], const pg8::Unit& u, int wr, int wc, int fr, int fq) const {
        const int row0 = u.pm * 256 + wr * 64 + fr, col0 = u.pn * 256 + wc * 32 + 8 * fq;
#pragma unroll
        for (int ai = 0; ai < 2; ++ai)
#pragma unroll
            for (int m = 0; m < 4; ++m) { float* rowp = O + (size_t)(row0 + ai * 128 + m * 16) * ldc + col0;
#pragma unroll
                for (int bj = 0; bj < 2; ++bj) { *(pg8::f32x4*)(rowp + bj * 128) = acc[ai][bj][m][0]; *(pg8::f32x4*)(rowp + bj * 128 + 4) = acc[ai][bj][m][1]; } }
    }
};
struct EpiBranch {
    static constexpr bool PERM = true, AFTER_DRAIN = false;
    bf16_t* GO; float* ACC; int mode;
    __device__ __forceinline__ void fin(const pg8::u32x4 g, const pg8::f32x4 a0, const pg8::f32x4 a1, pg8::f32x4 v0, pg8::f32x4 v1, size_t idx) const {
        v0[0] *= bflo(g.x); v0[1] *= bfhi(g.x); v0[2] *= bflo(g.y); v0[3] *= bfhi(g.y);
        v1[0] *= bflo(g.z); v1[1] *= bfhi(g.z); v1[2] *= bflo(g.w); v1[3] *= bfhi(g.w);
        if (mode > 0) { v0 += a0; v1 += a1; }
        if (mode < 2) { *(pg8::f32x4*)(ACC + idx) = v0; *(pg8::f32x4*)(ACC + idx + 4) = v1; }
        else { pg8::u32x4 w; w.x = pg8::cvt_pk_bf16(v0[0], v0[1]); w.y = pg8::cvt_pk_bf16(v0[2], v0[3]); w.z = pg8::cvt_pk_bf16(v1[0], v1[1]); w.w = pg8::cvt_pk_bf16(v1[2], v1[3]); *(pg8::u32x4*)(GO + idx) = w; }
    }
    __device__ __forceinline__ void operator()(const pg8::f32x4 (&acc)[2][2][4][2], const pg8::Unit& u, int wr, int wc, int fr, int fq) const {
        const int row0 = u.pm * 256 + wr * 64 + fr, col0 = u.pn * 256 + wc * 32 + 8 * fq;
#pragma unroll
        for (int ai = 0; ai < 2; ++ai)
#pragma unroll
            for (int bj = 0; bj < 2; ++bj)
#pragma unroll
                for (int mh = 0; mh < 4; mh += 2) {
                    const size_t ia = (size_t)(row0 + ai * 128 + mh * 16) * 1024 + col0 + bj * 128, ib = ia + (size_t)16 * 1024;
                    const pg8::u32x4 ga = *(const pg8::u32x4*)(GO + ia), gb = *(const pg8::u32x4*)(GO + ib);
                    pg8::f32x4 aa0 = {0.f, 0.f, 0.f, 0.f}, aa1 = aa0, ab0 = aa0, ab1 = aa0;
                    if (mode > 0) { aa0 = *(const pg8::f32x4*)(ACC + ia); aa1 = *(const pg8::f32x4*)(ACC + ia + 4); ab0 = *(const pg8::f32x4*)(ACC + ib); ab1 = *(const pg8::f32x4*)(ACC + ib + 4); }
                    fin(ga, aa0, aa1, acc[ai][bj][mh][0], acc[ai][bj][mh][1], ia);
                    fin(gb, ab0, ab1, acc[ai][bj][mh + 1][0], acc[ai][bj][mh + 1][1], ib);
                }
    }
};
struct EpiIn {
    static constexpr bool PERM = true, AFTER_DRAIN = false;
    unsigned char* ws;
    __device__ __forceinline__ void operator()(const pg8::f32x4 (&acc)[2][2][4][2], const pg8::Unit& u, int wr, int wc, int fr, int fq) const {
        const bool latent = u.pm < (ML / 256);
        const int cw = wc * 32 + 8 * fq;
        bf16_t* const poolin = (bf16_t*)(ws + WS_POOLIN); bf16_t* const qd = (bf16_t*)(ws + WS_QD); bf16_t* const qg = (bf16_t*)(ws + WS_QG); bf16_t* const kd = (bf16_t*)(ws + WS_KD);
        bf16_t* const vd = (bf16_t*)(ws + WS_VD); bf16_t* const kg = (bf16_t*)(ws + WS_KG); bf16_t* const vg = (bf16_t*)(ws + WS_VG); const float* const rope = (const float*)(ws + WS_ROPE);
#pragma unroll
        for (int bj = 0; bj < 2; ++bj) {
            const int cb = u.pn * 2 + bj;
            bf16_t* base; int pitch, coff; bool kvmap = false, dorope = false; float sc = 1.f;
            if (cb < 4) { base = poolin; pitch = 512; coff = cb * 128; }
            else if (cb < 8) { base = qd; pitch = 512; coff = (cb - 4) * 128; dorope = latent; sc = QC2; }
            else if (cb < 12) { base = qg; pitch = 512; coff = (cb - 8) * 128; }
            else if (cb < 16) { base = kd; pitch = 512; coff = (cb - 12) * 128; kvmap = true; dorope = latent; }
            else if (cb < 20) { base = vd; pitch = 512; coff = (cb - 16) * 128; kvmap = true; }
            else if (cb == 20) { base = kg; pitch = 128; coff = 0; kvmap = true; }
            else { base = vg; pitch = 128; coff = 0; kvmap = true; }
#pragma unroll
            for (int ai = 0; ai < 2; ++ai)
#pragma unroll
                for (int mh = 0; mh < 4; mh += 2) {
                    const int rowa = u.pm * 256 + ai * 128 + wr * 64 + mh * 16 + fr, rowb = rowa + 16;
                    f32x4 ta0 = {1.f, 0.f, 1.f, 0.f}, ta1 = ta0, tb0 = ta0, tb1 = ta0;
                    if (dorope) { const int p0 = (cw & 63) >> 1, j0 = p0 & 15, ta = rowa & 4095, tb = rowb & 4095, posa = p0 < 16 ? (ta >> 6) : (ta & 63), posb = p0 < 16 ? (tb >> 6) : (tb & 63);
                        const f32x4* pa = (const f32x4*)(rope + (posa * 16 + j0) * 2); const f32x4* pb = (const f32x4*)(rope + (posb * 16 + j0) * 2);
                        ta0 = pa[0]; ta1 = pa[1]; tb0 = pb[0]; tb1 = pb[1]; }
#pragma unroll
                    for (int h2 = 0; h2 < 2; ++h2) {
                        const int m = mh + h2, row = h2 ? rowb : rowa;
                        const f32x4 t0 = h2 ? tb0 : ta0, t1 = h2 ? tb1 : ta1;
                        const int drow = kvmap ? kvrow_of(row) : row;
                        float v[8];
#pragma unroll
                        for (int i = 0; i < 4; ++i) { v[i] = acc[ai][bj][m][0][i]; v[4 + i] = acc[ai][bj][m][1][i]; }
                        if (dorope) { float o[8];
                            o[0] = v[0] * t0[0] - v[1] * t0[1]; o[1] = v[0] * t0[1] + v[1] * t0[0];
                            o[2] = v[2] * t0[2] - v[3] * t0[3]; o[3] = v[2] * t0[3] + v[3] * t0[2];
                            o[4] = v[4] * t1[0] - v[5] * t1[1]; o[5] = v[4] * t1[1] + v[5] * t1[0];
                            o[6] = v[6] * t1[2] - v[7] * t1[3]; o[7] = v[6] * t1[3] + v[7] * t1[2];
#pragma unroll
                            for (int i = 0; i < 8; ++i) v[i] = o[i]; }
#pragma unroll
                        for (int i = 0; i < 8; ++i) v[i] *= sc;
                        pg8::u32x4 w; w.x = pg8::cvt_pk_bf16(v[0], v[1]); w.y = pg8::cvt_pk_bf16(v[2], v[3]); w.z = pg8::cvt_pk_bf16(v[4], v[5]); w.w = pg8::cvt_pk_bf16(v[6], v[7]);
                        *(pg8::u32x4*)(base + (size_t)drow * pitch + coff + cw) = w;
                    }
                }
        }
    }
};
struct SchedG {
    pg8::StaticOrder so; const char* A; const char* Bt; int ld, nt;
    __device__ __forceinline__ void init(const void* A_, const void* Bt_, int M, int N, int K, int G, int c) { so.init(M, N, G, c); A = (const char*)A_; Bt = (const char*)Bt_; ld = K * 2; nt = K / 64; }
    __device__ __forceinline__ bool next(int i, pg8::Unit& u) const { if (!so.next(i, u)) return false;
        u.A = A + (size_t)u.pm * 256 * ld; u.B = Bt + (size_t)u.pn * 256 * ld; u.lda = ld; u.ldb = ld; u.nt = nt; u.seg = 0; return true; }
    __device__ __forceinline__ void a_ready(const pg8::Unit&) const {}
    __device__ __forceinline__ void done(const pg8::Unit&) const {}
};
struct SchedP4 {
    pg8::StaticOrder so; const char* ws;
    __device__ __forceinline__ void init(const unsigned char* ws_, int M, int G, int c) { so.init(M, 1024, G, c); ws = (const char*)ws_; }
    __device__ __forceinline__ bool next(int i, pg8::Unit& u) const { const int job = i / 6, seg = i - job * 6, b = seg >> 1; if (!so.next(job, u)) return false;
        if ((seg & 1) == 0) { u.A = ws + WS_H + (size_t)u.pm * 256 * 2048; u.lda = 2048; u.B = ws + W_IN + (size_t)(N1 + b * 1024 + u.pn * 256) * 2048; u.ldb = 2048; u.nt = 16; }
        else { const size_t ao = b == 0 ? WS_POOLO : b == 1 ? WS_DIFFO : WS_GQAO, bo = b == 0 ? W_PO : b == 1 ? W_DO : W_GO;
            u.A = ws + ao + (size_t)u.pm * 256 * 1024; u.lda = 1024; u.B = ws + bo + (size_t)u.pn * 256 * 1024; u.ldb = 1024; u.nt = 8; }
        u.seg = seg; return true; }
    __device__ __forceinline__ void a_ready(const pg8::Unit&) const {}
    __device__ __forceinline__ void done(const pg8::Unit&) const {}
};
constexpr size_t WS_GC = 244 * MiB, WS_MP = 252 * MiB, WS_YP = 244 * MiB;
struct SchedP4C {
    pg8::StaticOrder so; const char* ws; int G, c, nl;
    __device__ __forceinline__ void init(const unsigned char* ws_, int G_, int c_) { so.init(ML, 1024, G_, c_); ws = (const char*)ws_; G = G_; c = c_; nl = c_ < 256 ? (256 - c_ + G_ - 1) / G_ : 0; }
    __device__ __forceinline__ bool next(int i, pg8::Unit& u) const {
        if (i < 6 * nl) { const int job = i / 6, seg = i - job * 6, b = seg >> 1; so.next(job, u);
            if ((seg & 1) == 0) { u.A = ws + WS_H + (size_t)u.pm * 256 * 2048; u.lda = 2048; u.B = ws + W_IN + (size_t)(N1 + b * 1024 + u.pn * 256) * 2048; u.ldb = 2048; u.nt = 16; }
            else { const size_t ao = b == 0 ? WS_POOLO : b == 1 ? WS_DIFFO : WS_GQAO, bo = b == 0 ? W_PO : b == 1 ? W_DO : W_GO;
                u.A = ws + ao + (size_t)u.pm * 256 * 1024; u.lda = 1024; u.B = ws + bo + (size_t)u.pn * 256 * 1024; u.ldb = 1024; u.nt = 8; }
            u.seg = seg; return true; }
        const int i2 = i - 6 * nl, s = i2 >> 1, part = i2 & 1; const long p = (long)s * G + c; if (p >= 48) return false;
        const int tc = (int)p / 3, b = (int)p - tc * 3; u.pm = ML / 256 + (tc >> 2); u.pn = tc & 3;
        if (part == 0) { u.A = ws + WS_H + (size_t)u.pm * 256 * 2048; u.lda = 2048; u.B = ws + W_IN + (size_t)(N1 + b * 1024 + u.pn * 256) * 2048; u.ldb = 2048; u.nt = 16; u.seg = 8 + b; }
        else { const size_t ao = b == 0 ? WS_POOLO : b == 1 ? WS_DIFFO : WS_GQAO, bo = b == 0 ? W_PO : b == 1 ? W_DO : W_GO;
            u.A = ws + ao + (size_t)u.pm * 256 * 1024; u.lda = 1024; u.B = ws + bo + (size_t)u.pn * 256 * 1024; u.ldb = 1024; u.nt = 8; u.seg = 12 + b; }
        return true; }
    __device__ __forceinline__ void a_ready(const pg8::Unit&) const {}
    __device__ __forceinline__ void done(const pg8::Unit&) const {}
};
struct SchedP5C {
    pg8::StaticOrder so; const char* ws; int G, c;
    __device__ __forceinline__ void init(const unsigned char* ws_, int G_, int c_) { so.init(ML, 1024, G_, c_); ws = (const char*)ws_; G = G_; c = c_; }
    __device__ __forceinline__ bool next(int i, pg8::Unit& u) const { const long L = (long)i * G + c;
        if (L < 256) { so.next(i, u); u.A = ws + WS_MERGED + (size_t)u.pm * 256 * 2048; u.B = ws + W_O + (size_t)u.pn * 256 * 2048; u.lda = 2048; u.ldb = 2048; u.nt = 16; u.seg = 0; return true; }
        if (L < 304) { const int p = (int)L - 256, tc = p / 3, b = p - tc * 3; u.pm = ML / 256 + (tc >> 2); u.pn = tc & 3;
            const size_t mp = b == 0 ? WS_MERGED + (size_t)ML * 2048 : WS_MP + (size_t)(b - 1) * 2 * MiB;
            u.A = ws + mp + (size_t)(tc >> 2) * 256 * 2048; u.B = ws + W_O + (size_t)u.pn * 256 * 2048; u.lda = 2048; u.ldb = 2048; u.nt = 16; u.seg = 1 + b; return true; }
        return false; }
    __device__ __forceinline__ void a_ready(const pg8::Unit&) const {}
    __device__ __forceinline__ void done(const pg8::Unit&) const {}
};
struct EpiGateMul {
    static constexpr bool PERM = true, AFTER_DRAIN = false;
    const bf16_t* Gp; bf16_t* O;
    __device__ __forceinline__ void operator()(const pg8::f32x4 (&acc)[2][2][4][2], const pg8::Unit& u, int wr, int wc, int fr, int fq) const {
        const int row0 = u.pm * 256 + wr * 64 + fr, col0 = u.pn * 256 + wc * 32 + 8 * fq;
#pragma unroll
        for (int ai = 0; ai < 2; ++ai)
#pragma unroll
            for (int bj = 0; bj < 2; ++bj)
#pragma unroll
                for (int mh = 0; mh < 4; mh += 2) {
                    const size_t ia = (size_t)(row0 + ai * 128 + mh * 16) * 1024 + col0 + bj * 128, ib = ia + (size_t)16 * 1024;
                    const pg8::u32x4 ga = *(const pg8::u32x4*)(Gp + ia), gb = *(const pg8::u32x4*)(Gp + ib);
                    { pg8::f32x4 v0 = acc[ai][bj][mh][0], v1 = acc[ai][bj][mh][1]; pg8::u32x4 w;
                      w.x = pg8::cvt_pk_bf16(v0[0] * bflo(ga.x), v0[1] * bfhi(ga.x)); w.y = pg8::cvt_pk_bf16(v0[2] * bflo(ga.y), v0[3] * bfhi(ga.y));
                      w.z = pg8::cvt_pk_bf16(v1[0] * bflo(ga.z), v1[1] * bfhi(ga.z)); w.w = pg8::cvt_pk_bf16(v1[2] * bflo(ga.w), v1[3] * bfhi(ga.w)); *(pg8::u32x4*)(O + ia) = w; }
                    { pg8::f32x4 v0 = acc[ai][bj][mh + 1][0], v1 = acc[ai][bj][mh + 1][1]; pg8::u32x4 w;
                      w.x = pg8::cvt_pk_bf16(v0[0] * bflo(gb.x), v0[1] * bfhi(gb.x)); w.y = pg8::cvt_pk_bf16(v0[2] * bflo(gb.y), v0[3] * bfhi(gb.y));
                      w.z = pg8::cvt_pk_bf16(v1[0] * bflo(gb.z), v1[1] * bfhi(gb.z)); w.w = pg8::cvt_pk_bf16(v1[2] * bflo(gb.w), v1[3] * bfhi(gb.w)); *(pg8::u32x4*)(O + ib) = w; }
                }
    }
};
constexpr size_t WS_ZP = 244 * MiB;
struct SchedP8C {
    pg8::StaticOrder so; const char* ws; int G, c;
    __device__ __forceinline__ void init(const unsigned char* ws_, int G_, int c_) { so.init(ML, 1024, G_, c_); ws = (const char*)ws_; G = G_; c = c_; }
    __device__ __forceinline__ bool next(int i, pg8::Unit& u) const { const long L = (long)i * G + c;
        if (L < 256) { so.next(i, u); u.A = ws + WS_U + (size_t)u.pm * 256 * 8192; u.B = ws + W_2 + (size_t)u.pn * 256 * 8192; u.lda = 8192; u.ldb = 8192; u.nt = 64; u.seg = 0; return true; }
        if (L < 320) { const int p = (int)L - 256, kc = p & 3; u.pn = (p >> 2) & 3; u.pm = ML / 256 + (p >> 4);
            u.A = ws + WS_U + (size_t)u.pm * 256 * 8192 + kc * 2048; u.B = ws + W_2 + (size_t)u.pn * 256 * 8192 + kc * 2048; u.lda = 8192; u.ldb = 8192; u.nt = 16; u.seg = 1 + kc; return true; }
        return false; }
    __device__ __forceinline__ void a_ready(const pg8::Unit&) const {}
    __device__ __forceinline__ void done(const pg8::Unit&) const {}
};
struct EpiP4 {
    static constexpr bool PERM = true, AFTER_DRAIN = false;
    bf16_t* GO; float* ACC; unsigned char* ws;
    __device__ __forceinline__ void operator()(const pg8::f32x4 (&acc)[2][2][4][2], const pg8::Unit& u, int wr, int wc, int fr, int fq) const {
        if (u.seg < 6) {
            if ((u.seg & 1) == 0) { EpiAct<1> e{GO, 1024}; e(acc, u, wr, wc, fr, fq); }
            else { EpiBranch e{GO, ACC, u.seg >> 1}; e(acc, u, wr, wc, fr, fq); }
        } else {
            pg8::Unit v = u; v.pm = u.pm - ML / 256; const int b = u.seg & 3;
            bf16_t* gc = (bf16_t*)(ws + WS_GC + (size_t)b * 2 * MiB);
            if (u.seg < 12) { EpiAct<1> e{gc, 1024}; e(acc, v, wr, wc, fr, fq); }
            else { bf16_t* mp = b == 0 ? GO + (size_t)ML * 1024 : (bf16_t*)(ws + WS_MP + (size_t)(b - 1) * 2 * MiB); EpiGateMul e{gc, mp}; e(acc, v, wr, wc, fr, fq); }
        }
    }
};
struct EpiP5 {
    static constexpr bool PERM = true, AFTER_DRAIN = false;
    float* Y; float* YP;
    __device__ __forceinline__ void operator()(const pg8::f32x4 (&acc)[2][2][4][2], const pg8::Unit& u, int wr, int wc, int fr, int fq) const {
        float* base = Y; pg8::Unit v = u;
        if (u.seg > 1) { base = YP + (size_t)(u.seg - 2) * MC * 1024; v.pm = u.pm - ML / 256; }
        EpiF32 e{base, 1024}; e(acc, v, wr, wc, fr, fq);
    }
};
struct EpiP8 {
    static constexpr bool PERM = true, AFTER_DRAIN = false;
    float* Z; float* ZP;
    __device__ __forceinline__ void operator()(const pg8::f32x4 (&acc)[2][2][4][2], const pg8::Unit& u, int wr, int wc, int fr, int fq) const {
        float* base = Z; pg8::Unit v = u;
        if (u.seg > 1) { base = ZP + (size_t)(u.seg - 2) * MC * 1024; v.pm = u.pm - ML / 256; }
        EpiF32 e{base, 1024}; e(acc, v, wr, wc, fr, fq);
    }
};
__device__ __forceinline__ void head_norm_fix(bf16_t* p, const float* gain, bool dorope, int t, float sc, const float* tab) {
    float ss = 0.f;
#pragma unroll
    for (int ch = 0; ch < 8; ++ch) { const v4u w = *(const v4u*)(p + ch * 8);
        const float a0 = bflo(w.x), a1 = bfhi(w.x), a2 = bflo(w.y), a3 = bfhi(w.y), a4 = bflo(w.z), a5 = bfhi(w.z), a6 = bflo(w.w), a7 = bfhi(w.w);
        ss += (a0 * a0 + a1 * a1) + (a2 * a2 + a3 * a3) + (a4 * a4 + a5 * a5) + (a6 * a6 + a7 * a7); }
    const float rstd = 1.0f / sqrtf(ss * (1.f / 64.f) + EPSN);
#pragma unroll
    for (int ch = 0; ch < 8; ++ch) { const v4u w = *(const v4u*)(p + ch * 8);
        float v[8] = {bflo(w.x), bfhi(w.x), bflo(w.y), bfhi(w.y), bflo(w.z), bfhi(w.z), bflo(w.w), bfhi(w.w)};
        const f32x4 g0 = *(const f32x4*)(gain + ch * 8), g1 = *(const f32x4*)(gain + ch * 8 + 4);
        v[0] *= rstd * g0[0]; v[1] *= rstd * g0[1]; v[2] *= rstd * g0[2]; v[3] *= rstd * g0[3];
        v[4] *= rstd * g1[0]; v[5] *= rstd * g1[1]; v[6] *= rstd * g1[2]; v[7] *= rstd * g1[3];
        if (dorope) rope8(v, tab, ch * 8, t);
        v4u o; o.x = pk2(v[0] * sc, v[1] * sc); o.y = pk2(v[2] * sc, v[3] * sc); o.z = pk2(v[4] * sc, v[5] * sc); o.w = pk2(v[6] * sc, v[7] * sc);
        *(v4u*)(p + ch * 8) = o; }
}

__device__ __forceinline__ void transpose_item(const float* W, int K, int N, bf16* WT, int k0, int n0, int drow0, LAS float* scr, int lane) {
#pragma unroll 8
    for (int i = 0; i < 32; ++i) { const int kk = 2 * i + (lane >> 5); scr[kk * 33 + (lane & 31)] = W[(size_t)(k0 + kk) * N + n0 + (lane & 31)]; }
    asm volatile("s_waitcnt lgkmcnt(0)" ::: "memory");
    const int c = lane & 7;
#pragma unroll
    for (int j = 0; j < 4; ++j) { const int n = (lane >> 3) + 8 * j; const LAS float* s = scr + (8 * c) * 33 + n;
        v4u o; o.x = pk2(s[0 * 33], s[1 * 33]); o.y = pk2(s[2 * 33], s[3 * 33]); o.z = pk2(s[4 * 33], s[5 * 33]); o.w = pk2(s[6 * 33], s[7 * 33]);
        *(v4u*)(WT + (size_t)(drow0 + n) * K + k0 + 8 * c) = o; }
    asm volatile("s_waitcnt lgkmcnt(0)" ::: "memory");
}
struct WPtrs { const float *w_in, *w_grp, *pscale, *w_po, *w_do, *w_go, *w_o, *w_1, *w_2; };
__device__ __forceinline__ void convert_weights(const WPtrs& p, int l, unsigned char* ws, LAS unsigned char* lds, int gw, int NGW, int wave, int lane, int gtid, int NTH) {
    LAS float* scr = (LAS float*)(lds + wave * 16384);
    constexpr int I_IN = (1024 / 64) * (5888 / 32), I_BR = (512 / 64) * (1024 / 32), I_O = (1024 / 64) * (1024 / 32), I_1 = (1024 / 64) * (4096 / 32), I_2 = (4096 / 64) * (1024 / 32);
    constexpr int NITEMS = I_IN + 3 * I_BR + I_O + I_1 + I_2;
    for (int it = gw; it < NITEMS; it += NGW) {
        int r = it;
        if (r < I_IN) { const int nblk = 5888 / 32, kb = r / nblk, nb = r % nblk, n0 = nb * 32;
            const int d0 = n0 < 1536 ? n0 : (n0 < 4608 ? n0 - 1536 + N1 : n0 - 4608 + 1536);
            transpose_item(p.w_in + (size_t)l * 1024 * 5888, 1024, 5888, (bf16*)(ws + W_IN), kb * 64, n0, d0, scr, lane); continue; } r -= I_IN;
        if (r < I_BR) { const int nblk = 1024 / 32, kb = r / nblk, nb = r % nblk;
            transpose_item(p.w_po + (size_t)l * 512 * 1024, 512, 1024, (bf16*)(ws + W_PO), kb * 64, nb * 32, nb * 32, scr, lane); continue; } r -= I_BR;
        if (r < I_BR) { const int nblk = 1024 / 32, kb = r / nblk, nb = r % nblk;
            transpose_item(p.w_do + (size_t)l * 512 * 1024, 512, 1024, (bf16*)(ws + W_DO), kb * 64, nb * 32, nb * 32, scr, lane); continue; } r -= I_BR;
        if (r < I_BR) { const int nblk = 1024 / 32, kb = r / nblk, nb = r % nblk;
            transpose_item(p.w_go + (size_t)l * 512 * 1024, 512, 1024, (bf16*)(ws + W_GO), kb * 64, nb * 32, nb * 32, scr, lane); continue; } r -= I_BR;
        if (r < I_O) { const int nblk = 1024 / 32, kb = r / nblk, nb = r % nblk;
            transpose_item(p.w_o + (size_t)l * 1024 * 1024, 1024, 1024, (bf16*)(ws + W_O), kb * 64, nb * 32, nb * 32, scr, lane); continue; } r -= I_O;
        if (r < I_1) { const int nblk = 4096 / 32, kb = r / nblk, nb = r % nblk;
            transpose_item(p.w_1 + (size_t)l * 1024 * 4096, 1024, 4096, (bf16*)(ws + W_1), kb * 64, nb * 32, nb * 32, scr, lane); continue; } r -= I_1;
        { const int nblk = 1024 / 32, kb = r / nblk, nb = r % nblk;
            transpose_item(p.w_2 + (size_t)l * 4096 * 1024, 4096, 1024, (bf16*)(ws + W_2), kb * 64, nb * 32, nb * 32, scr, lane); }
    }
    const float* wg = p.w_grp + (size_t)l * 4 * 128 * 128; const float* psc = p.pscale + l * 512;
    unsigned* PT = (unsigned*)(ws + W_POOL);
    for (int i = gtid; i < 512 * 256; i += NTH) { const int n = i >> 8, k = (i & 255) * 2, g = n >> 7; float v0 = 0.f, v1 = 0.f;
        if ((k >> 7) == g) { const float* q = wg + ((size_t)(g * 128 + (k & 127))) * 128 + (n & 127); const float s = psc[n]; v0 = q[0] * s; v1 = q[128] * s; }
        PT[i] = pk2(v0, v1); }
}
__device__ __forceinline__ void mod_gemv(const float* cvec, const float* cctx, const float* wmod, const float* bmod, float* modout, LAS unsigned char* lds, int tid, int lane, int wave, int bx) {
    LAS float* st = (LAS float*)lds;
    LAS float* red = (LAS float*)(lds + 32768);
    for (int i = tid; i < 5 * 1024; i += NTHR) { const int bb = i >> 10, k = i & 1023; const float v = bb < 4 ? cvec[bb * 1024 + k] : cctx[k]; st[i] = v / (1.f + expf(-v)); }
    __syncthreads();
    if (bx < 192) {
        const int l = bx / 96, n0 = (bx % 96) * 64;
        const float* w = wmod + (size_t)l * 1024 * NMOD + n0 + lane;
        float a0 = 0.f, a1 = 0.f, a2 = 0.f, a3 = 0.f, a4 = 0.f;
        const int k0 = wave * 128;
#pragma unroll 16
        for (int kk = 0; kk < 128; ++kk) { const float wv = w[(size_t)(k0 + kk) * NMOD]; const int k = k0 + kk;
            a0 += st[k] * wv; a1 += st[1024 + k] * wv; a2 += st[2048 + k] * wv; a3 += st[3072 + k] * wv; a4 += st[4096 + k] * wv; }
        red[(wave * 5 + 0) * 64 + lane] = a0; red[(wave * 5 + 1) * 64 + lane] = a1; red[(wave * 5 + 2) * 64 + lane] = a2; red[(wave * 5 + 3) * 64 + lane] = a3; red[(wave * 5 + 4) * 64 + lane] = a4;
        __syncthreads();
        if (tid < 320) { const int bb = tid >> 6; float s = bmod[l * NMOD + n0 + lane];
#pragma unroll
            for (int w8 = 0; w8 < 8; ++w8) s += red[(w8 * 5 + bb) * 64 + lane];
            modout[(l * 5 + bb) * NMOD + n0 + lane] = s; }
    }
    __syncthreads();
}
__device__ __forceinline__ void norm_phase(int M, const float* xs_lat, const float* xs_ctx, float* xd_lat, float* xd_ctx, const float* z, const float* zp, int nzp, const float* modl, int gtc, const float* gpost,
                                           bf16* hdst, const float* gnext, const float* modn, int shc, int scc, int gw, int NGW, int lane) {
    for (int m = gw; m < M; m += NGW) {
        const bool lat = m < ML; const int bb = lat ? (m >> 12) : 4;
        const float* xs = lat ? xs_lat + (size_t)m * 1024 : xs_ctx + (size_t)(m - ML) * 1024;
        f32x4 v[4];
#pragma unroll
        for (int j = 0; j < 4; ++j) v[j] = *(const f32x4*)(xs + 4 * lane + 256 * j);
        float* xd = lat ? xd_lat + (size_t)m * 1024 : xd_ctx + (size_t)(m - ML) * 1024;
        if (!z) {
#pragma unroll
            for (int j = 0; j < 4; ++j) *(f32x4*)(xd + 4 * lane + 256 * j) = v[j];
        } else {
            f32x4 zz[4]; float ss = 0.f;
#pragma unroll
            for (int j = 0; j < 4; ++j) { zz[j] = *(const f32x4*)(z + (size_t)m * 1024 + 4 * lane + 256 * j);
                if (zp && !lat) {
#pragma unroll
                    for (int kc = 0; kc < 3; ++kc) if (kc < nzp) zz[j] += *(const f32x4*)(zp + ((size_t)kc * MC + (m - ML)) * 1024 + 4 * lane + 256 * j); }
                ss += (zz[j][0] * zz[j][0] + zz[j][1] * zz[j][1]) + (zz[j][2] * zz[j][2] + zz[j][3] * zz[j][3]); }
            const float rz = 1.0f / sqrtf(wave_sum(ss) * (1.f / 1024.f) + EPSN);
            const float* gt = modl + bb * NMOD + gtc * 1024;
#pragma unroll
            for (int j = 0; j < 4; ++j) { const int c = 4 * lane + 256 * j; const f32x4 g4 = *(const f32x4*)(gpost + c), t4 = *(const f32x4*)(gt + c);
                v[j] = v[j] + t4 * ((zz[j] * rz) * g4); *(f32x4*)(xd + c) = v[j]; }
        }
        if (hdst) {
            float ss = 0.f;
#pragma unroll
            for (int j = 0; j < 4; ++j) ss += (v[j][0] * v[j][0] + v[j][1] * v[j][1]) + (v[j][2] * v[j][2] + v[j][3] * v[j][3]);
            const float rx = 1.0f / sqrtf(wave_sum(ss) * (1.f / 1024.f) + EPSN);
            const float* sh = modn + bb * NMOD + shc * 1024; const float* sc = modn + bb * NMOD + scc * 1024;
#pragma unroll
            for (int j = 0; j < 4; ++j) { const int c = 4 * lane + 256 * j; const f32x4 g4 = *(const f32x4*)(gnext + c), s4 = *(const f32x4*)(sc + c), h4 = *(const f32x4*)(sh + c);
                const f32x4 o = ((v[j] * rx) * g4) * (s4 + 1.0f) + h4;
                v2u w; w.x = pk2(o[0], o[1]); w.y = pk2(o[2], o[3]); *(v2u*)(hdst + (size_t)m * 1024 + c) = w; }
        }
    }
}
__device__ __forceinline__ void pool_phase(int M, const bf16* zin, bf16* pooled, int gtid, int NTH) {
    for (int it = gtid; it < M * 64; it += NTH) {
        const int m = it >> 6, ch = it & 63, g = ch >> 4, w2 = 1 << g;
        int t, l;
        if (m < ML) { t = m & 4095; l = SEQL; } else { t = (m - ML) & 255; l = CTXL; }
        const int base = m - t, lo = max(t - w2, 0), hi = min(t + w2, l);
        v4u w[16];
#pragma unroll
        for (int dj = 0; dj < 16; ++dj) { const int j = t + dj - 8; const int jj = min(max(j, lo), hi - 1);
            w[dj] = *(const v4u*)(zin + (size_t)(base + jj) * 512 + ch * 8); }
        float s[8];
#pragma unroll
        for (int i = 0; i < 8; ++i) s[i] = 0.f;
#pragma unroll
        for (int dj = 0; dj < 16; ++dj) { const int j = t + dj - 8; const float k = (j >= lo && j < hi) ? 1.0f : 0.0f;
            s[0] += k * bflo(w[dj].x); s[1] += k * bfhi(w[dj].x); s[2] += k * bflo(w[dj].y); s[3] += k * bfhi(w[dj].y);
            s[4] += k * bflo(w[dj].z); s[5] += k * bfhi(w[dj].z); s[6] += k * bflo(w[dj].w); s[7] += k * bfhi(w[dj].w); }
        const float inv = 1.0f / (float)(hi - lo);
        const v4u ws_ = w[8];
        v4u o; o.x = pk2(s[0] * inv - bflo(ws_.x), s[1] * inv - bfhi(ws_.x)); o.y = pk2(s[2] * inv - bflo(ws_.y), s[3] * inv - bfhi(ws_.y));
        o.z = pk2(s[4] * inv - bflo(ws_.z), s[5] * inv - bfhi(ws_.z)); o.w = pk2(s[6] * inv - bflo(ws_.w), s[7] * inv - bfhi(ws_.w));
        *(v4u*)(pooled + (size_t)m * 512 + ch * 8) = o;
    }
}
__device__ __forceinline__ void diff_combine_phase(int M, const bf16* od, bf16* diffo, const float* subln, float lam, float lam_init, int gtid, int NTH) {
    for (int it = gtid; it < M * 64; it += NTH) {
        const int l16 = it & 15, hd = (it >> 4) & 3, m = it >> 6;
        const bf16* p1 = od + (size_t)m * 1024 + hd * 256 + l16 * 8;
        const v4u a = *(const v4u*)p1, b = *(const v4u*)(p1 + 128);
        float d[8];
        d[0] = bflo(a.x) - lam * bflo(b.x); d[1] = bfhi(a.x) - lam * bfhi(b.x); d[2] = bflo(a.y) - lam * bflo(b.y); d[3] = bfhi(a.y) - lam * bfhi(b.y);
        d[4] = bflo(a.z) - lam * bflo(b.z); d[5] = bfhi(a.z) - lam * bfhi(b.z); d[6] = bflo(a.w) - lam * bflo(b.w); d[7] = bfhi(a.w) - lam * bfhi(b.w);
        float ss = 0.f;
#pragma unroll
        for (int i = 0; i < 8; ++i) ss += d[i] * d[i];
        ss += __shfl_xor(ss, 1); ss += __shfl_xor(ss, 2); ss += __shfl_xor(ss, 4); ss += __shfl_xor(ss, 8);
        const float rstd = 1.0f / sqrtf(ss * (1.f / 128.f) + EPSN), k1 = 1.0f - lam_init;
        const f32x4 g0 = *(const f32x4*)(subln + l16 * 8), g1 = *(const f32x4*)(subln + l16 * 8 + 4);
        v4u o; o.x = pk2(d[0] * rstd * g0[0] * k1, d[1] * rstd * g0[1] * k1); o.y = pk2(d[2] * rstd * g0[2] * k1, d[3] * rstd * g0[3] * k1);
        o.z = pk2(d[4] * rstd * g1[0] * k1, d[5] * rstd * g1[1] * k1); o.w = pk2(d[6] * rstd * g1[2] * k1, d[7] * rstd * g1[3] * k1);
        *(v4u*)(diffo + (size_t)m * 512 + hd * 128 + l16 * 8) = o;
    }
}

#define RLX_AGENT __ATOMIC_RELAXED, __HIP_MEMORY_SCOPE_AGENT
#define XB_TMO      128
#define XB_XCNT(j)  (256  + 64 * (j))
#define XB_XSUB(j)  (1280 + 64 * (j))
#define XB_XGEN(j)  (2304 + 64 * (j))
#define XB_TOP      3328
#define XB_TOPGEN   3392
#define XCD_BAR_WORDS 3456
#define XB_SPIN_CAP (1u << 22)

__device__ __forceinline__ unsigned xb_ld(unsigned* p)              { return __hip_atomic_load(p, __ATOMIC_RELAXED, __HIP_MEMORY_SCOPE_AGENT); }
__device__ __forceinline__ unsigned xb_add(unsigned* p, unsigned v) { return __hip_atomic_fetch_add(p, v, __ATOMIC_RELAXED, __HIP_MEMORY_SCOPE_AGENT); }
__device__ __forceinline__ unsigned xb_xcc_id() { return (unsigned)__builtin_amdgcn_s_getreg((3 << 11) | 20) & 0xFu; }
#define XB_SPIN(cond, bar) do { unsigned _sp = 0; while (cond) { __builtin_amdgcn_s_sleep(1); \
    if ((++_sp & 255u) == 0u) { if (xb_ld(&(bar)[XB_TMO])) break; if (_sp > XB_SPIN_CAP) { atomicAdd(&(bar)[XB_TMO], 1u); break; } } } } while (0)

struct XcdBarrier {
    unsigned* bar; unsigned x;
    volatile LAS unsigned* st;
};

__device__ __forceinline__ XcdBarrier xcd_barrier_post(unsigned* bar, volatile LAS unsigned* st) {
    XcdBarrier b; b.bar = bar; b.x = xb_xcc_id(); b.st = st;
    if (threadIdx.x == 0) (void)xb_add(&bar[XB_XCNT(b.x)], 1u);
    return b;
}
__device__ __forceinline__ void xcd_barrier_complete(unsigned* bar, unsigned x, unsigned& nloc, unsigned& nx) {
    const unsigned G = gridDim.x * gridDim.y * gridDim.z;
    unsigned sum, cnt, mine, sp = 0u;
    for (;;) {
        sum = 0u; cnt = 0u; mine = 0u;
#pragma unroll
        for (unsigned j = 0; j < 16; ++j) { const unsigned c = xb_ld(&bar[XB_XCNT(j)]); sum += c; cnt += (c > 0u) ? 1u : 0u; mine = (j == x) ? c : mine; }
        if (sum == G) break;
        __builtin_amdgcn_s_sleep(1);
        if ((++sp & 255u) == 0u) { if (xb_ld(&bar[XB_TMO])) break; if (sp > XB_SPIN_CAP) { atomicAdd(&bar[XB_TMO], 1u); break; } }
    }
    nloc = mine > 0u ? mine : 1u; nx = cnt > 0u ? cnt : 1u;
}

__device__ __forceinline__ void xcd_barrier(const XcdBarrier& b) {
    asm volatile("s_waitcnt vmcnt(0)" ::: "memory");
    __syncthreads();
    if (threadIdx.x == 0) {
        unsigned* bar = b.bar;
        __builtin_amdgcn_s_waitcnt(0);
        unsigned nloc = b.st[0], nx = b.st[1];
        if (nloc == 0u) { xcd_barrier_complete(bar, b.x, nloc, nx); b.st[0] = nloc; b.st[1] = nx; }
        const unsigned old = xb_add(&bar[XB_XSUB(b.x)], 1u);
        const unsigned gen = old / nloc;
        if (old + 1u == (gen + 1u) * nloc) {
            __builtin_amdgcn_fence(__ATOMIC_RELEASE, "agent");
            asm volatile("s_waitcnt vmcnt(0)" ::: "memory");
            const unsigned og = xb_add(&bar[XB_TOP], 1u);
            const unsigned tg = og / nx;
            if (og + 1u == (tg + 1u) * nx) xb_add(&bar[XB_TOPGEN], 1u);
            else XB_SPIN(xb_ld(&bar[XB_TOPGEN]) == tg, bar);
            __builtin_amdgcn_fence(__ATOMIC_ACQUIRE, "agent");
            xb_add(&bar[XB_XGEN(b.x)], 1u);
            asm volatile("s_waitcnt vmcnt(0)" ::: "memory");
        } else {
            XB_SPIN(xb_ld(&bar[XB_XGEN(b.x)]) == gen, bar);
            __builtin_amdgcn_fence(__ATOMIC_ACQUIRE, "agent");
            asm volatile("s_waitcnt vmcnt(0)" ::: "memory");
        }
    }
    __syncthreads();
}
constexpr size_t WS_BAR = 320 * 1024;
constexpr int LDS_CTL = 131072, LDS_BARST = LDS_CTL + 352;
constexpr size_t WS_PTR = 300 * 1024;
struct Ids { int tid, lane, wave, bx, G, vcu, gw, NGW, gtid, NTH; };
#define FRESH_IDS(I) Ids I; { int t_ = threadIdx.x; asm volatile("" : "+v"(t_)); int b_ = blockIdx.x; asm volatile("" : "+s"(b_)); int g_ = gridDim.x; asm volatile("" : "+s"(g_)); \
    I.tid = t_; I.lane = t_ & 63; I.wave = __builtin_amdgcn_readfirstlane(t_ >> 6); I.bx = b_; I.G = g_; I.vcu = (g_ % 8 == 0) ? (b_ % 8) * (g_ / 8) + b_ / 8 : b_; \
    I.gw = I.vcu * 8 + I.wave; I.NGW = g_ * 8; I.gtid = b_ * NTHR + t_; I.NTH = g_ * NTHR; }
#define PTAB(i) (((const float* const*)(ws + WS_PTR))[i])

__global__ void __launch_bounds__(NTHR, 2) mk_fwd(Args a) {
    extern __shared__ __attribute__((aligned(16))) unsigned char lds_raw[];
    cg::grid_group grid = cg::this_grid();
    LAS unsigned char* lds = (LAS unsigned char*)lds_raw;
    unsigned char* ws = a.ws;
#define GSYNC_CG() do { asm volatile("s_waitcnt vmcnt(0) lgkmcnt(0)" ::: "memory"); grid.sync(); asm volatile("" ::: "memory"); } while (0)
#define GSYNC() do { XcdBarrier b_; b_.bar = (unsigned*)(ws + WS_BAR); b_.x = xb_xcc_id(); b_.st = (volatile LAS unsigned*)(lds + LDS_BARST); xcd_barrier(b_); asm volatile("" ::: "memory"); } while (0)
#ifndef REP_P1
#define REP_P1 1
#endif
#ifndef REP_P2
#define REP_P2 1
#endif
#ifndef REP_P3
#define REP_P3 1
#endif
#ifndef REP_P4
#define REP_P4 1
#endif
#ifndef REP_P5
#define REP_P5 1
#endif
#ifndef REP_P7
#define REP_P7 1
#endif
#ifndef REP_P8
#define REP_P8 1
#endif
#ifndef EXTRA_SYNCS
#define EXTRA_SYNCS 0
#endif
#define REPEAT(n) _Pragma("unroll 1") for (int rep_ = 0; rep_ < (n); ++rep_)
    for (int u = threadIdx.x; u < (LDS_BYTES - LDS_CTL) / 4; u += NTHR) ((LAS unsigned*)(lds + LDS_CTL))[u] = 0u;
    if (blockIdx.x == 0) for (int i = threadIdx.x; i < XCD_BAR_WORDS; i += NTHR) ((unsigned*)(ws + WS_BAR))[i] = 0u;
    __syncthreads();

    {
        FRESH_IDS(I);
        if (I.bx == 0 && I.tid == 0) {
            const float** tab = (const float**)(ws + WS_PTR);
#pragma unroll
            for (int i = 0; i < 26; ++i) tab[i] = a.in[i];
            tab[26] = a.out;
        }
        mod_gemv(a.in[1], a.in[3], a.in[4], a.in[5], (float*)(ws + WS_MOD), lds, I.tid, I.lane, I.wave, I.bx);
        WPtrs wp{a.in[10], a.in[11], a.in[12], a.in[20], a.in[21], a.in[22], a.in[23], a.in[24], a.in[25]};
        convert_weights(wp, 0, ws, lds, I.gw, I.NGW, I.wave, I.lane, I.gtid, I.NTH);
        if (I.bx == I.G - 1) { float* ropet = (float*)(ws + WS_ROPE);
            for (int i = I.tid; i < 1024; i += NTHR) { const int pos = i >> 4, j = i & 15; const float inv = 1.0f / powf(10000.0f, (float)j * 2.0f / 32.0f); const float ang = (float)pos * inv;
                ropet[2 * i] = cosf(ang); ropet[2 * i + 1] = sinf(ang); } }
    }
    GSYNC_CG();
#ifdef EXTRA_CG
    for (int e_ = 0; e_ < EXTRA_CG; ++e_) GSYNC_CG();
#endif
    (void)xcd_barrier_post((unsigned*)(ws + WS_BAR), (volatile LAS unsigned*)(lds + LDS_BARST));
    for (int e_ = 0; e_ < EXTRA_SYNCS; ++e_) GSYNC();
    {
        FRESH_IDS(I);
        float* modv = (float*)(ws + WS_MOD);
        norm_phase(MA, PTAB(0), PTAB(2), (float*)PTAB(26), (float*)(ws + WS_CTX), nullptr, nullptr, 0, nullptr, 0, nullptr, (bf16*)(ws + WS_H), PTAB(6), modv, 0, 1, I.gw, I.NGW, I.lane);
    }
    GSYNC();

#pragma unroll 1
    for (int l = 0; l < 2; ++l) {
        REPEAT(REP_P1) {
        {
            FRESH_IDS(I);
            const float* ropet = (const float*)(ws + WS_ROPE);
            SchedG S; S.init(ws + WS_H, ws + W_IN, MA, N1, 1024, I.G, I.bx);
            EpiIn E{ws};
            pg8::gemm_phase<EpiIn, SchedG, true, true>(lds, S, E);
        }
        {
            asm volatile("s_waitcnt vmcnt(0)" ::: "memory"); __syncthreads(); __builtin_amdgcn_fence(__ATOMIC_ACQUIRE, "agent"); asm volatile("s_waitcnt vmcnt(0)" ::: "memory");
            FRESH_IDS(I);
            const float* ropet = (const float*)(ws + WS_ROPE);
            const float* kn = PTAB(19) + l * 64;
            pg8::StaticOrder S; S.init(MA, N1, I.G, I.bx);
            pg8::Unit u;
            for (int i = 0; S.next(i, u); ++i) {
                const bool latent = u.pm < (ML / 256);
                if (u.pn == 10) {
                    const int hh = I.tid & 1, rl = I.tid >> 1, row = u.pm * 256 + rl;
                    head_norm_fix((bf16_t*)(ws + WS_KG) + (size_t)kvrow_of(row) * 128 + hh * 64, kn, latent, row & 4095, 1.0f, ropet);
                }
            }
        }
        GSYNC();
        }
        REPEAT(REP_P2) {
        {
            FRESH_IDS(I);
            const bool last = (l == 1); const int M2 = last ? ML : MA;
            pool_phase(M2, (const bf16*)(ws + WS_POOLIN), (bf16*)(ws + WS_POOLED), I.gtid, I.NTH);
            const int total = 1024 + (last ? 0 : 64);
            for (int i = 0;; ++i) {
                const int U = i * I.G + I.vcu; if (U >= total) break;
                int b, r, m0, NT; bool lat;
                if (U < 1024) { const int idx = U & 511, qb = idx & 15, f = idx >> 4; b = f >> 3; r = (f & 7) + (U >= 512 ? 8 : 0); m0 = b * SEQL + qb * 256; NT = LKV / 64; lat = true; }
                else { const int U2 = U - 1024; b = U2 >> 4; r = U2 & 15; m0 = ML + b * CTXL; NT = CTXL / 64; lat = false; }
                if (r < 8) { const int hd = r >> 1, qs = r & 1;
                    const attn_body::bf16* Q = (const attn_body::bf16*)(ws + WS_QD) + (size_t)m0 * 512 + hd * 128 + qs * 64;
                    const attn_body::bf16* K = (const attn_body::bf16*)(ws + WS_KD) + (size_t)(b * LKV) * 512 + hd * 128 + qs * 64;
                    const attn_body::bf16* V = (const attn_body::bf16*)(ws + WS_VD) + (size_t)(b * LKV) * 512 + hd * 128;
                    attn_body::bf16* O = (attn_body::bf16*)(ws + WS_OD) + (size_t)m0 * 1024 + hd * 256 + qs * 128;
#ifndef NO_ATTN
                    attn_body::attn_unit128<8>(Q, 512, K, 512, V, 512, O, 1024, NT, (char*)lds_raw, nullptr, nullptr, -1);
#endif
                } else { const int h = r - 8;
                    const attn_body::bf16* Q = (const attn_body::bf16*)(ws + WS_QG) + (size_t)m0 * 512 + h * 64;
                    const attn_body::bf16* K = (const attn_body::bf16*)(ws + WS_KG) + (size_t)(b * LKV) * 128 + (h >> 2) * 64;
                    const attn_body::bf16* V = (const attn_body::bf16*)(ws + WS_VG) + (size_t)(b * LKV) * 128 + (h >> 2) * 64;
                    attn_body::bf16* O = (attn_body::bf16*)(ws + WS_GQAO) + (size_t)m0 * 512 + h * 64;
#ifndef NO_ATTN
                    attn_body::attn_unit<8>(Q, 512, K, 128, V, 128, O, 512, NT, (char*)lds_raw, PTAB(18) + l * 64, (const float*)(ws + WS_ROPE), lat ? (m0 & 4095) : -1);
#endif
                }
            }
        }
        GSYNC();
        }
        REPEAT(REP_P3) {
        {
            FRESH_IDS(I);
            const bool last = (l == 1); const int M2 = last ? ML : MA; const float lam_init = last ? 0.35550906759f : 0.2f;
            const float *lq1 = PTAB(13) + l * 64, *lk1 = PTAB(14) + l * 64, *lq2 = PTAB(15) + l * 64, *lk2 = PTAB(16) + l * 64;
            float d1 = 0.f, d2 = 0.f;
            for (int i = 0; i < 64; ++i) { d1 += lq1[i] * lk1[i]; d2 += lq2[i] * lk2[i]; }
            const float lam = expf(d1) - expf(d2) + lam_init;
            diff_combine_phase(M2, (const bf16*)(ws + WS_OD), (bf16*)(ws + WS_DIFFO), PTAB(17) + l * 128, lam, lam_init, I.gtid, I.NTH);
            SchedG S; S.init(ws + WS_POOLED, ws + W_POOL, M2, 512, 512, I.G, I.bx);
            EpiAct<0> E{(bf16_t*)(ws + WS_POOLO), 512};
            pg8::gemm_phase<EpiAct<0>, SchedG, true, true>(lds, S, E);
        }
        GSYNC();
        }
        REPEAT(REP_P4) {
        { FRESH_IDS(I); const int M2 = (l == 1) ? ML : MA;
          EpiP4 E{(bf16_t*)(ws + WS_MERGED), (float*)(ws + WS_ACC), ws};
          if (l == 0) { SchedP4C S; S.init(ws, I.G, I.bx); pg8::gemm_phase<EpiP4, SchedP4C, true, true>(lds, S, E); }
          else { SchedP4 S; S.init(ws, M2, I.G, I.bx); pg8::gemm_phase<EpiP4, SchedP4, true, true>(lds, S, E); } }
        GSYNC();
        }
        REPEAT(REP_P5) {
        {
            FRESH_IDS(I); const int M2 = (l == 1) ? ML : MA;
            EpiP5 E{(float*)(ws + WS_Y), (float*)(ws + WS_YP)};
            if (l == 0) { SchedP5C S; S.init(ws, I.G, I.bx); pg8::gemm_phase<EpiP5, SchedP5C, true, true>(lds, S, E); }
            else { SchedG S; S.init(ws + WS_MERGED, ws + W_O, M2, 1024, 1024, I.G, I.bx); pg8::gemm_phase<EpiP5, SchedG, true, true>(lds, S, E); }
        }
        GSYNC();
        }
        {
            FRESH_IDS(I); const int M2 = (l == 1) ? ML : MA;
            const float* modl = (const float*)(ws + WS_MOD) + l * 5 * NMOD; float* outp = (float*)PTAB(26); float* ctxx = (float*)(ws + WS_CTX);
            norm_phase(M2, outp, ctxx, outp, ctxx, (const float*)(ws + WS_Y), l == 0 ? (const float*)(ws + WS_YP) : nullptr, 2, modl, 2, PTAB(7) + l * 1024, (bf16*)(ws + WS_HF), PTAB(8) + l * 1024, modl, 3, 4, I.gw, I.NGW, I.lane);
        }
        GSYNC();
        REPEAT(REP_P7) {
        {
            FRESH_IDS(I); const int M2 = (l == 1) ? ML : MA;
            SchedG S; S.init(ws + WS_HF, ws + W_1, M2, DFF, 1024, I.G, I.bx);
            EpiAct<2> E{(bf16_t*)(ws + WS_U), DFF};
            pg8::gemm_phase<EpiAct<2>, SchedG, true, true>(lds, S, E);
        }
        GSYNC();
        }
        REPEAT(REP_P8) {
        {
            FRESH_IDS(I);
            EpiP8 E{(float*)(ws + WS_Z), (float*)(ws + WS_ZP)};
            if (l == 0) { SchedP8C S; S.init(ws, I.G, I.bx); pg8::gemm_phase<EpiP8, SchedP8C, true, true>(lds, S, E); }
            else { SchedG S; S.init(ws + WS_U, ws + W_2, ML, 1024, DFF, I.G, I.bx); pg8::gemm_phase<EpiP8, SchedG, true, true>(lds, S, E); }
        }
        GSYNC();
        }
        {
            FRESH_IDS(I);
            const float* modl = (const float*)(ws + WS_MOD) + l * 5 * NMOD; float* outp = (float*)PTAB(26); float* ctxx = (float*)(ws + WS_CTX);
            if (l == 0) {
                WPtrs wp{PTAB(10), PTAB(11), PTAB(12), PTAB(20), PTAB(21), PTAB(22), PTAB(23), PTAB(24), PTAB(25)};
                convert_weights(wp, 1, ws, lds, I.gw, I.NGW, I.wave, I.lane, I.gtid, I.NTH);
                norm_phase(MA, outp, ctxx, outp, ctxx, (const float*)(ws + WS_Z), (const float*)(ws + WS_ZP), 3, modl, 5, PTAB(9) + l * 1024, (bf16*)(ws + WS_H), PTAB(6) + 1024, modl + 5 * NMOD, 0, 1, I.gw, I.NGW, I.lane);
            } else {
                norm_phase(ML, outp, ctxx, outp, ctxx, (const float*)(ws + WS_Z), nullptr, 0, modl, 5, PTAB(9) + l * 1024, nullptr, nullptr, nullptr, 0, 0, I.gw, I.NGW, I.lane);
            }
        }
        if (l == 0) GSYNC();
    }
#undef GSYNC
}

extern "C" void kernel_launch(void* const* d_in, const int* in_sizes, int n_in, void* d_out, int out_size, void* d_ws, size_t ws_size, hipStream_t stream) {
    static int grid = 0;
    if (grid == 0) {
        if (n_in != 26 || out_size != ML * DMODEL || ws_size < WS_TOTAL) { fprintf(stderr, "kernel_launch: unexpected shapes (n_in %d out %d ws %zu)\n", n_in, out_size, ws_size); grid = -1; return; }
        int dev = 0, cus = 0, per_cu = 0;
        if (hipGetDevice(&dev) != hipSuccess || hipDeviceGetAttribute(&cus, hipDeviceAttributeMultiprocessorCount, dev) != hipSuccess) { grid = -1; return; }
        if (hipFuncSetAttribute((const void*)mk_fwd, hipFuncAttributeMaxDynamicSharedMemorySize, LDS_BYTES) != hipSuccess) { fprintf(stderr, "kernel_launch: hipFuncSetAttribute failed\n"); grid = -1; return; }
        if (hipOccupancyMaxActiveBlocksPerMultiprocessor(&per_cu, (const void*)mk_fwd, NTHR, LDS_BYTES) != hipSuccess || per_cu < 1) per_cu = 1;
        (void)hipGetLastError();
        grid = cus * per_cu;
    }
    if (grid < 0) return;
    Args a{};
    for (int i = 0; i < 26; ++i) a.in[i] = (const float*)d_in[i];
    a.out = (float*)d_out; a.ws = (unsigned char*)d_ws;
    void* args[] = {&a};
    hipError_t e = hipLaunchCooperativeKernel((const void*)mk_fwd, dim3(grid), dim3(NTHR), args, LDS_BYTES, stream);
    if (e != hipSuccess) fprintf(stderr, "kernel_launch: cooperative launch failed: %s (grid %d)\n", hipGetErrorString(e), grid);
}
```
